# Optimizing an MI355X kernel written in HIP

```python
import jax, jax.numpy as jnp
from jax import lax
import numpy as np

D_MODEL = 2048
BATCH = 4
SEQ = 4096
DEPTH = 1

CHUNK = 64
LEFT_CHUNKS = 8
BAND = LEFT_CHUNKS + 1
D_MIX = D_MODEL
D_ATTN = D_MIX // 2
D_CONV = D_MIX - D_ATTN
HEAD_DIM = 64
N_HEADS = D_ATTN // HEAD_DIM
REL_CLIP = 256
N_REL = 2 * REL_CLIP + 1
CONV_WIDTH = 3
D_IN_PROJ = 3 * D_ATTN + 3 * D_CONV

N_GROUPS = 4
EXPERTS_PER_GROUP = 8
N_EXPERTS = N_GROUPS * EXPERTS_PER_GROUP
TOP_K_INNER = 2
D_EXPERT = 512
MOE_BLOCK = 128

EPS = 1e-6
NEG_INF = -1e30

kernel_name = "hymba_chunk_attn_shortconv_hiermoe"


def rmsnorm(x, g):
    xf = x.astype(jnp.float32)
    y = xf * lax.rsqrt(jnp.mean(xf * xf, axis=-1, keepdims=True) + EPS)
    return (y * g.astype(jnp.float32)).astype(x.dtype)


def chunk_attention(q, k, v, rel_bias):
    b, s = q.shape[0], q.shape[1]
    nc = s // CHUNK
    qc = q.reshape(b, nc, CHUNK, N_HEADS, HEAD_DIM)
    pad = ((0, 0), (LEFT_CHUNKS, 0), (0, 0), (0, 0), (0, 0))
    kp = jnp.pad(k.reshape(b, nc, CHUNK, N_HEADS, HEAD_DIM), pad)
    vp = jnp.pad(v.reshape(b, nc, CHUNK, N_HEADS, HEAD_DIM), pad)
    k_band = jnp.concatenate([kp[:, o:o + nc] for o in range(BAND)], axis=2)
    v_band = jnp.concatenate([vp[:, o:o + nc] for o in range(BAND)], axis=2)
    qi = jnp.arange(CHUNK)[:, None]
    kj = jnp.arange(BAND * CHUNK)[None, :]
    dist = LEFT_CHUNKS * CHUNK + qi - kj
    idx = jnp.clip(dist, -REL_CLIP, REL_CLIP) + REL_CLIP
    bias = rel_bias[:, idx].astype(jnp.float32)
    key_chunk = jnp.arange(nc)[:, None] - LEFT_CHUNKS + (jnp.arange(BAND * CHUNK) // CHUNK)[None, :]
    valid = key_chunk >= 0
    scale = HEAD_DIM ** -0.5
    scores = jnp.einsum('bnqhd,bnkhd->bnhqk', qc, k_band).astype(jnp.float32) * scale + bias
    scores = jnp.where(valid[None, :, None, None, :], scores, jnp.float32(NEG_INF))
    p = jax.nn.softmax(scores, axis=-1).astype(v.dtype)
    o = jnp.einsum('bnhqk,bnkhd->bnqhd', p, v_band)
    return o.reshape(b, s, N_HEADS * HEAD_DIM)


def short_conv(bg, cg, u, w):
    z = cg * u
    y = lax.conv_general_dilated(
        z, w[:, None, :], window_strides=(1,), padding=[(CONV_WIDTH - 1, 0)],
        dimension_numbers=('NWC', 'WIO', 'NWC'), feature_group_count=D_CONV)
    return bg * y


def hier_moe(h, w_rg, b_rg, w_re, b_re, w_gate, w_up, w_down):
    bsz, s, d = h.shape
    t = bsz * s
    xt = h.reshape(t, d)
    tok = jnp.arange(t)
    glog = (xt @ w_rg + b_rg).astype(jnp.float32)
    gprob = jax.nn.softmax(glog, axis=-1)
    g_sel = jnp.argmax(glog, axis=-1).astype(jnp.int32)
    p_g = gprob[tok, g_sel]
    elog = (xt @ w_re + b_re).astype(jnp.float32).reshape(t, N_GROUPS, EXPERTS_PER_GROUP)
    elog_g = elog[tok, g_sel]
    top_v, top_i = lax.top_k(elog_g, TOP_K_INNER)
    w_tok = p_g[:, None] * jax.nn.softmax(top_v, axis=-1)
    eid = g_sel[:, None] * EXPERTS_PER_GROUP + top_i.astype(jnp.int32)

    n = t * TOP_K_INNER
    flat_e = eid.reshape(-1)
    flat_w = w_tok.reshape(-1)
    flat_tok = (jnp.arange(n) // TOP_K_INNER).astype(jnp.int32)
    order = jnp.argsort(flat_e, stable=True)
    se, stok, sw = flat_e[order], flat_tok[order], flat_w[order]
    counts = jnp.bincount(flat_e, length=N_EXPERTS).astype(jnp.int32)
    starts = jnp.cumsum(counts) - counts
    pcounts = (counts + MOE_BLOCK - 1) // MOE_BLOCK * MOE_BLOCK
    pends = jnp.cumsum(pcounts)
    pstarts = pends - pcounts
    dest = pstarts[se] + jnp.arange(n, dtype=jnp.int32) - starts[se]
    n_blocks = -(-n // MOE_BLOCK) + N_EXPERTS
    npad = n_blocks * MOE_BLOCK
    buf_tok = jnp.full((npad,), t, dtype=jnp.int32).at[dest].set(stok)
    buf_w = jnp.zeros((npad,), jnp.float32).at[dest].set(sw)
    block_e = jnp.minimum(
        jnp.searchsorted(pends, jnp.arange(n_blocks, dtype=jnp.int32) * MOE_BLOCK, side='right'),
        N_EXPERTS - 1).astype(jnp.int32)
    xpad = jnp.concatenate([xt, jnp.zeros((1, d), xt.dtype)], axis=0)
    xb = xpad[buf_tok].reshape(n_blocks, MOE_BLOCK, d)

    def expert_block(args):
        xblk, e = args
        a = jax.nn.silu(xblk @ w_gate[e]) * (xblk @ w_up[e])
        return a @ w_down[e]

    yb = lax.map(expert_block, (xb, block_e))
    y = yb.reshape(npad, d) * buf_w[:, None].astype(xt.dtype)
    out = jnp.zeros((t + 1, d), xt.dtype).at[buf_tok].add(y)[:t]
    return out.reshape(bsz, s, d)


def setup_inputs(seed: int = 0) -> dict:
    key = jax.random.key(seed)
    ks = jax.random.split(key, 18)
    f32 = jnp.float32
    nrm = lambda k, shape, sc: (jax.random.normal(k, shape, f32) * sc).astype(f32)
    return {
        "x": nrm(ks[0], (BATCH, SEQ, D_MODEL), 1.0),
        "norm1": 1.0 + nrm(ks[1], (DEPTH, D_MODEL), 0.02),
        "w_in": nrm(ks[2], (DEPTH, D_MODEL, D_IN_PROJ), D_MODEL ** -0.5),
        "rel_bias": nrm(ks[3], (DEPTH, N_HEADS, N_REL), 0.1),
        "conv_w": nrm(ks[4], (DEPTH, CONV_WIDTH, D_CONV), CONV_WIDTH ** -0.5),
        "g_out_attn": 1.0 + nrm(ks[5], (DEPTH, D_ATTN), 0.02),
        "g_out_conv": 1.0 + nrm(ks[6], (DEPTH, D_CONV), 0.02),
        "w_out": nrm(ks[7], (DEPTH, D_MIX, D_MODEL), D_MIX ** -0.5),
        "norm2": 1.0 + nrm(ks[8], (DEPTH, D_MODEL), 0.02),
        "w_router_group": nrm(ks[9], (DEPTH, D_MODEL, N_GROUPS), D_MODEL ** -0.5),
        "b_router_group": nrm(ks[10], (DEPTH, N_GROUPS), 0.01),
        "w_router_expert": nrm(ks[11], (DEPTH, D_MODEL, N_EXPERTS), D_MODEL ** -0.5),
        "b_router_expert": nrm(ks[12], (DEPTH, N_EXPERTS), 0.01),
        "w_gate": nrm(ks[13], (DEPTH, N_EXPERTS, D_MODEL, D_EXPERT), D_MODEL ** -0.5),
        "w_up": nrm(ks[14], (DEPTH, N_EXPERTS, D_MODEL, D_EXPERT), D_MODEL ** -0.5),
        "w_down": nrm(ks[15], (DEPTH, N_EXPERTS, D_EXPERT, D_MODEL), D_EXPERT ** -0.5),
        "norm_final": 1.0 + nrm(ks[16], (D_MODEL,), 0.02),
    }


def reference(x, norm1, w_in, rel_bias, conv_w, g_out_attn, g_out_conv, w_out, norm2,
              w_router_group, b_router_group, w_router_expert, b_router_expert,
              w_gate, w_up, w_down, norm_final):
    b, s, _ = x.shape
    for l in range(DEPTH):
        h = rmsnorm(x, norm1[l])
        proj = h @ w_in[l]
        q, k, v, bg, cg, u = jnp.split(proj, 6, axis=-1)
        q = q.reshape(b, s, N_HEADS, HEAD_DIM)
        k = k.reshape(b, s, N_HEADS, HEAD_DIM)
        v = v.reshape(b, s, N_HEADS, HEAD_DIM)
        a_out = chunk_attention(q, k, v, rel_bias[l])
        c_out = short_conv(bg, cg, u, conv_w[l])
        mix = jnp.concatenate([rmsnorm(a_out, g_out_attn[l]), rmsnorm(c_out, g_out_conv[l])], axis=-1)
        x = x + mix @ w_out[l]
        h2 = rmsnorm(x, norm2[l])
        x = x + hier_moe(h2, w_router_group[l], b_router_group[l], w_router_expert[l],
                         b_router_expert[l], w_gate[l], w_up[l], w_down[l])
    return rmsnorm(x, norm_final)
```

```cpp
#include <hip/hip_runtime.h>
#include <stdint.h>

typedef unsigned short bf16_t;
typedef short bf16x8 __attribute__((ext_vector_type(8)));
typedef float f32x4 __attribute__((ext_vector_type(4)));

constexpr int NB = 4, SEQ = 4096, T = NB * SEQ, DM = 2048, DATT = 1024, DCONV = 1024, NPROJ = 6144;
constexpr int NH = 16, HD = 64, NREL = 513, NE = 32, DEXP = 512, NPAIR = 2 * T;
constexpr int NPADMAX = 40960, NTILEMAX = NPADMAX / 256;
constexpr float EPS = 1e-6f;

constexpr size_t MiB = 1u << 20;
constexpr size_t WS_CTL = 0;
constexpr size_t WS_PLAN = 64 * 1024;
constexpr size_t WS_R1 = 128 * 1024;
constexpr size_t WS_RA = 192 * 1024;
constexpr size_t WS_RC = 256 * 1024;
constexpr size_t WS_R2 = 320 * 1024;
constexpr size_t WS_SSC = 384 * 1024;
constexpr size_t WS_WTS = 512 * 1024;
constexpr size_t WS_ROWPAIR = 640 * 1024;
constexpr size_t WS_WR = 1 * MiB;
constexpr size_t WS_SSA = 2 * MiB;
constexpr size_t WS_LIST = 5 * MiB;
constexpr size_t WS_W2T = 8 * MiB;
constexpr size_t WS_W1T = 16 * MiB;
constexpr size_t WS_WDT = 40 * MiB;
constexpr size_t WS_WGUT = 104 * MiB;
constexpr size_t WS_XB = 232 * MiB;
constexpr size_t WS_MIX = 296 * MiB;
constexpr size_t WS_PROJ = 360 * MiB;
constexpr size_t WS_Y = 360 * MiB;
constexpr size_t WS_H = 488 * MiB;
constexpr size_t WS_END = 552 * MiB;

__device__ __forceinline__ unsigned f2bf(float f) { unsigned u = __float_as_uint(f); return (u + 0x7fffu + ((u >> 16) & 1u)) >> 16; }
__device__ __forceinline__ unsigned pk2(float lo, float hi) { return f2bf(lo) | (f2bf(hi) << 16); }
__device__ __forceinline__ float bf2f(unsigned h) { return __uint_as_float(h << 16); }
__device__ __forceinline__ float wave_sum(float v) {
#pragma unroll
    for (int o = 1; o < 64; o <<= 1) v += __shfl_xor(v, o);
    return v;
}

__global__ __launch_bounds__(256) void prep_x(const float* __restrict__ x, bf16_t* __restrict__ xb, float* __restrict__ r1) {
    const int lane = threadIdx.x & 63, row = blockIdx.x * 4 + (threadIdx.x >> 6);
    const float4* xr = (const float4*)(x + (size_t)row * DM);
    uint2* o = (uint2*)(xb + (size_t)row * DM);
    float ss = 0.f;
#pragma unroll
    for (int j = 0; j < 8; ++j) { float4 v = xr[j * 64 + lane]; ss += v.x * v.x + v.y * v.y + v.z * v.z + v.w * v.w; o[j * 64 + lane] = make_uint2(pk2(v.x, v.y), pk2(v.z, v.w)); }
    ss = wave_sum(ss);
    if (lane == 0) r1[row] = rsqrtf(ss * (1.f / DM) + EPS);
}

__global__ __launch_bounds__(256) void tconv(const float* __restrict__ src, int ldd, int N, const float* __restrict__ g, bf16_t* __restrict__ dst, int mode, size_t sstride, size_t dstride) {
    __shared__ float tile[64][65];
    src += (size_t)blockIdx.z * sstride; dst += (size_t)blockIdx.z * dstride;
    const int k0 = blockIdx.y * 64, n0 = blockIdx.x * 64, tid = threadIdx.x;
    { const int ty = tid >> 4, tx = tid & 15;
#pragma unroll
      for (int i = 0; i < 4; ++i) { const int k = ty + 16 * i; float4 v = *(const float4*)(src + (size_t)(k0 + k) * N + n0 + 4 * tx); const float s = g ? g[k0 + k] : 1.f;
          tile[k][4 * tx + 0] = v.x * s; tile[k][4 * tx + 1] = v.y * s; tile[k][4 * tx + 2] = v.z * s; tile[k][4 * tx + 3] = v.w * s; } }
    __syncthreads();
    { const int n = tid >> 2, kc = (tid & 3) * 16; const int ng = n0 + n;
      int drow = ng; if (mode) drow = ((ng >> 7) << 8) + (ng & 127) + (mode == 2 ? 128 : 0);
      unsigned w[8];
#pragma unroll
      for (int i = 0; i < 8; ++i) w[i] = pk2(tile[kc + 2 * i][n], tile[kc + 2 * i + 1][n]);
      uint4* d = (uint4*)(dst + (size_t)drow * ldd + k0 + kc);
      d[0] = make_uint4(w[0], w[1], w[2], w[3]); d[1] = make_uint4(w[4], w[5], w[6], w[7]); }
}
__global__ __launch_bounds__(256) void prep_wr(const float* __restrict__ wrg, const float* __restrict__ wre, const float* __restrict__ g, float* __restrict__ Wr) {
    const int i = blockIdx.x * 256 + threadIdx.x; if (i >= 36 * DM) return;
    const int o = i / DM, k = i % DM;
    Wr[i] = g[k] * (o < 4 ? wrg[k * 4 + o] : wre[k * 32 + (o - 4)]);
}

struct GemmP { const bf16_t* A; int lda; const int* rowpair; const bf16_t* B; int ldb; const int* tile_e; size_t estride; int K, kmid; };
template <int MODE, class Epi>
__global__ __launch_bounds__(256) void sgemm(GemmP p, Epi epi) {
    const int tid = threadIdx.x, lane = tid & 63, w = tid >> 6, fr = lane & 15, fq = lane >> 4;
    const int r0 = blockIdx.y * 64 + (w >> 1) * 32, c0 = blockIdx.x * 64 + (w & 1) * 32;
    const bf16_t* B = p.B;
    if (p.tile_e) { const int e = p.tile_e[(blockIdx.y * 64) >> 8]; if (e < 0) return; B += (size_t)e * p.estride; }
    const bf16_t* ap[2]; const bf16_t* bp[2];
#pragma unroll
    for (int i = 0; i < 2; ++i) { const int prow = r0 + 16 * i + fr; int arow = prow; if (p.rowpair) { const int pr = p.rowpair[prow]; arow = pr >= 0 ? (pr >> 1) : 0; } ap[i] = p.A + (size_t)arow * p.lda + 8 * fq; }
#pragma unroll
    for (int j = 0; j < 2; ++j) { const int n = c0 + 16 * j + fr; const int brow = (MODE == 2) ? (((n >> 7) << 8) + (n & 127)) : n; bp[j] = B + (size_t)brow * p.ldb + 8 * fq; }
    f32x4 acc0[2][2], acc1[2][2];
#pragma unroll
    for (int i = 0; i < 2; ++i)
#pragma unroll
        for (int j = 0; j < 2; ++j) { acc0[i][j] = (f32x4){0.f, 0.f, 0.f, 0.f}; acc1[i][j] = (f32x4){0.f, 0.f, 0.f, 0.f}; }
    for (int k = 0; k < p.K; k += 32) {
        bf16x8 a[2], b0[2], b1[2];
#pragma unroll
        for (int i = 0; i < 2; ++i) a[i] = *(const bf16x8*)(ap[i] + k);
#pragma unroll
        for (int j = 0; j < 2; ++j) { b0[j] = *(const bf16x8*)(bp[j] + k); if (MODE == 2) b1[j] = *(const bf16x8*)(bp[j] + (size_t)128 * p.ldb + k); else b1[j] = b0[j]; }
        if (MODE == 1) {
            if (k < p.kmid) {
#pragma unroll
                for (int i = 0; i < 2; ++i)
#pragma unroll
                    for (int j = 0; j < 2; ++j) acc0[i][j] = __builtin_amdgcn_mfma_f32_16x16x32_bf16(b0[j], a[i], acc0[i][j], 0, 0, 0);
            } else {
#pragma unroll
                for (int i = 0; i < 2; ++i)
#pragma unroll
                    for (int j = 0; j < 2; ++j) acc1[i][j] = __builtin_amdgcn_mfma_f32_16x16x32_bf16(b0[j], a[i], acc1[i][j], 0, 0, 0);
            }
        } else {
#pragma unroll
            for (int i = 0; i < 2; ++i)
#pragma unroll
                for (int j = 0; j < 2; ++j) { acc0[i][j] = __builtin_amdgcn_mfma_f32_16x16x32_bf16(b0[j], a[i], acc0[i][j], 0, 0, 0);
                    if (MODE == 2) acc1[i][j] = __builtin_amdgcn_mfma_f32_16x16x32_bf16(b1[j], a[i], acc1[i][j], 0, 0, 0); }
        }
    }
#pragma unroll
    for (int i = 0; i < 2; ++i)
#pragma unroll
        for (int j = 0; j < 2; ++j) epi(acc0[i][j], acc1[i][j], r0 + 16 * i + fr, c0 + 16 * j + 4 * fq);
}
struct EpiProj { bf16_t* out; const float* r1;
    __device__ void operator()(f32x4 a, f32x4, int row, int col) const { const float s = r1[row]; *(uint2*)(out + (size_t)row * NPROJ + col) = make_uint2(pk2(a[0] * s, a[1] * s), pk2(a[2] * s, a[3] * s)); } };
struct EpiG2 { const float* x; const float* ra; const float* rc; float* x1; bf16_t* xb1;
    __device__ void operator()(f32x4 a, f32x4 c, int row, int col) const { const float sa = ra[row], sc = rc[row]; const float4 xv = *(const float4*)(x + (size_t)row * DM + col);
        float4 o; o.x = xv.x + sa * a[0] + sc * c[0]; o.y = xv.y + sa * a[1] + sc * c[1]; o.z = xv.z + sa * a[2] + sc * c[2]; o.w = xv.w + sa * a[3] + sc * c[3];
        *(float4*)(x1 + (size_t)row * DM + col) = o; *(uint2*)(xb1 + (size_t)row * DM + col) = make_uint2(pk2(o.x, o.y), pk2(o.z, o.w)); } };
struct EpiGU { bf16_t* Hb; const float* r2; const int* rowpair;
    __device__ void operator()(f32x4 g, f32x4 u, int row, int col) const { const int pr = rowpair[row]; const float s = r2[pr >= 0 ? (pr >> 1) : 0]; float h[4];
#pragma unroll
        for (int i = 0; i < 4; ++i) { const float gg = g[i] * s, uu = u[i] * s; h[i] = gg / (1.f + __expf(-gg)) * uu; }
        *(uint2*)(Hb + (size_t)row * DEXP + col) = make_uint2(pk2(h[0], h[1]), pk2(h[2], h[3])); } };
struct EpiDown { bf16_t* Y; const float* wts; const int* rowpair;
    __device__ void operator()(f32x4 a, f32x4, int row, int col) const { const int pr = rowpair[row]; if (pr < 0) return; const float s = wts[pr];
        *(uint2*)(Y + (size_t)pr * DM + col) = make_uint2(pk2(a[0] * s, a[1] * s), pk2(a[2] * s, a[3] * s)); } };

__global__ __launch_bounds__(64) void attn_simple(const bf16_t* __restrict__ proj, const float* __restrict__ relb, bf16_t* __restrict__ mix, float* __restrict__ ssA) {
    const int bid = blockIdx.x, h = bid & 15, c = (bid >> 4) & 63, b = bid >> 10, qi = threadIdx.x, t = b * SEQ + c * 64 + qi;
    float q[64], o[64];
    { const uint4* qp = (const uint4*)(proj + (size_t)t * NPROJ + h * HD);
#pragma unroll
      for (int i = 0; i < 8; ++i) { const uint4 v = qp[i]; const unsigned w[4] = {v.x, v.y, v.z, v.w};
#pragma unroll
          for (int j = 0; j < 4; ++j) { q[8 * i + 2 * j] = bf2f(w[j] & 0xffffu) * 0.125f; q[8 * i + 2 * j + 1] = bf2f(w[j] >> 16) * 0.125f; } } }
#pragma unroll
    for (int d = 0; d < 64; ++d) o[d] = 0.f;
    float m = -1e30f, l = 0.f;
    const float* rb = relb + h * NREL;
    const int jc0 = c - 8 < 0 ? 0 : c - 8;
    for (int jc = jc0; jc <= c; ++jc)
        for (int kj = 0; kj < 64; ++kj) {
            const int tk = b * SEQ + jc * 64 + kj;
            const uint4* kp = (const uint4*)(proj + (size_t)tk * NPROJ + DATT + h * HD);
            const uint4* vp = (const uint4*)(proj + (size_t)tk * NPROJ + 2 * DATT + h * HD);
            float s = 0.f;
#pragma unroll
            for (int i = 0; i < 8; ++i) { const uint4 v = kp[i]; const unsigned w[4] = {v.x, v.y, v.z, v.w};
#pragma unroll
                for (int j = 0; j < 4; ++j) { s += q[8 * i + 2 * j] * bf2f(w[j] & 0xffffu); s += q[8 * i + 2 * j + 1] * bf2f(w[j] >> 16); } }
            int dist = (c - jc) * 64 + qi - kj; dist = dist < -256 ? -256 : (dist > 256 ? 256 : dist);
            s += rb[dist + 256];
            const float mn = fmaxf(m, s), al = __expf(m - mn), pp = __expf(s - mn);
            l = l * al + pp; m = mn;
#pragma unroll
            for (int i = 0; i < 8; ++i) { const uint4 v = vp[i]; const unsigned w[4] = {v.x, v.y, v.z, v.w};
#pragma unroll
                for (int j = 0; j < 4; ++j) { o[8 * i + 2 * j] = o[8 * i + 2 * j] * al + pp * bf2f(w[j] & 0xffffu); o[8 * i + 2 * j + 1] = o[8 * i + 2 * j + 1] * al + pp * bf2f(w[j] >> 16); } }
        }
    const float il = 1.f / l; float ss = 0.f;
    uint4* op = (uint4*)(mix + (size_t)t * DM + h * HD);
#pragma unroll
    for (int i = 0; i < 8; ++i) { float v[8];
#pragma unroll
        for (int j = 0; j < 8; ++j) { v[j] = o[8 * i + j] * il; ss += v[j] * v[j]; }
        op[i] = make_uint4(pk2(v[0], v[1]), pk2(v[2], v[3]), pk2(v[4], v[5]), pk2(v[6], v[7])); }
    ssA[t * 16 + h] = ss;
}
__global__ __launch_bounds__(256) void conv_simple(const bf16_t* __restrict__ proj, const float* __restrict__ cw, bf16_t* __restrict__ mix, float* __restrict__ ssC) {
    __shared__ float red[4];
    const int t = blockIdx.x, s = t & (SEQ - 1), ch = threadIdx.x * 4;
    float y[4] = {0.f, 0.f, 0.f, 0.f};
#pragma unroll
    for (int j = 0; j < 3; ++j) { const int back = 2 - j; if (s - back < 0) continue;
        const bf16_t* pr = proj + (size_t)(t - back) * NPROJ;
        const uint2 cv = *(const uint2*)(pr + 4 * DATT + ch), uv = *(const uint2*)(pr + 5 * DATT + ch);
        const float4 wv = *(const float4*)(cw + j * DCONV + ch);
        y[0] += wv.x * bf2f(cv.x & 0xffffu) * bf2f(uv.x & 0xffffu); y[1] += wv.y * bf2f(cv.x >> 16) * bf2f(uv.x >> 16);
        y[2] += wv.z * bf2f(cv.y & 0xffffu) * bf2f(uv.y & 0xffffu); y[3] += wv.w * bf2f(cv.y >> 16) * bf2f(uv.y >> 16); }
    const uint2 bv = *(const uint2*)(proj + (size_t)t * NPROJ + 3 * DATT + ch);
    y[0] *= bf2f(bv.x & 0xffffu); y[1] *= bf2f(bv.x >> 16); y[2] *= bf2f(bv.y & 0xffffu); y[3] *= bf2f(bv.y >> 16);
    *(uint2*)(mix + (size_t)t * DM + DATT + ch) = make_uint2(pk2(y[0], y[1]), pk2(y[2], y[3]));
    float ss = wave_sum(y[0] * y[0] + y[1] * y[1] + y[2] * y[2] + y[3] * y[3]);
    if ((threadIdx.x & 63) == 0) red[threadIdx.x >> 6] = ss;
    __syncthreads();
    if (threadIdx.x == 0) ssC[t] = red[0] + red[1] + red[2] + red[3];
}
__global__ __launch_bounds__(256) void rowscale(const float* __restrict__ ssA, const float* __restrict__ ssC, float* __restrict__ ra, float* __restrict__ rc) {
    const int t = blockIdx.x * 256 + threadIdx.x; float s = 0.f;
#pragma unroll
    for (int h = 0; h < 16; ++h) s += ssA[t * 16 + h];
    ra[t] = rsqrtf(s * (1.f / DATT) + EPS); rc[t] = rsqrtf(ssC[t] * (1.f / DCONV) + EPS);
}
__global__ __launch_bounds__(256) void router(const float* __restrict__ x1, const float* __restrict__ Wr, const float* __restrict__ brg, const float* __restrict__ bre,
                                              int* __restrict__ cnt, int* __restrict__ list, float* __restrict__ wts, float* __restrict__ r2out) {
    const int lane = threadIdx.x & 63, t = blockIdx.x * 4 + (threadIdx.x >> 6);
    const float4* xr = (const float4*)(x1 + (size_t)t * DM);
    float4 v[8]; float ss = 0.f;
#pragma unroll
    for (int j = 0; j < 8; ++j) { v[j] = xr[j * 64 + lane]; ss += v[j].x * v[j].x + v[j].y * v[j].y + v[j].z * v[j].z + v[j].w * v[j].w; }
    const float r2 = rsqrtf(wave_sum(ss) * (1.f / DM) + EPS);
    float lg[36];
#pragma unroll
    for (int o = 0; o < 36; ++o) { const float4* wr = (const float4*)(Wr + (size_t)o * DM); float p = 0.f;
#pragma unroll
        for (int j = 0; j < 8; ++j) { const float4 wv = wr[j * 64 + lane]; p += v[j].x * wv.x + v[j].y * wv.y + v[j].z * wv.z + v[j].w * wv.w; }
        lg[o] = wave_sum(p) * r2 + (o < 4 ? brg[o] : bre[o - 4]); }
    int gs = 0; float gm = lg[0];
#pragma unroll
    for (int g = 1; g < 4; ++g) if (lg[g] > gm) { gm = lg[g]; gs = g; }
    float den = 0.f;
#pragma unroll
    for (int g = 0; g < 4; ++g) den += __expf(lg[g] - gm);
    const float pg = 1.f / den;
    float el[8];
#pragma unroll
    for (int i = 0; i < 8; ++i) { el[i] = lg[4 + i];
#pragma unroll
        for (int g = 1; g < 4; ++g) el[i] = (gs == g) ? lg[4 + 8 * g + i] : el[i]; }
    int i1 = 0; float v1 = el[0];
#pragma unroll
    for (int i = 1; i < 8; ++i) if (el[i] > v1) { v1 = el[i]; i1 = i; }
    int i2 = -1; float v2 = -3.0e38f;
#pragma unroll
    for (int i = 0; i < 8; ++i) if (i != i1 && el[i] > v2) { v2 = el[i]; i2 = i; }
    const float e2 = __expf(v2 - v1), w0 = pg / (1.f + e2), w1 = pg * e2 / (1.f + e2);
    if (lane == 0) {
        r2out[t] = r2;
        const int ea = gs * 8 + i1, eb = gs * 8 + i2;
        const int sa = atomicAdd(&cnt[ea], 1); list[ea * T + sa] = 2 * t; wts[2 * t] = w0;
        const int sb = atomicAdd(&cnt[eb], 1); list[eb * T + sb] = 2 * t + 1; wts[2 * t + 1] = w1;
    }
}
__global__ __launch_bounds__(64) void plan(const int* __restrict__ cnt, int* __restrict__ hstart, int* __restrict__ tile_e) {
    if (threadIdx.x == 0) { int tl = 0;
        for (int e = 0; e < NE; ++e) { hstart[e] = tl * 256; const int mt = (cnt[e] + 255) >> 8; for (int i = 0; i < mt; ++i) tile_e[tl + i] = e; tl += mt; }
        for (int i = tl; i < NTILEMAX; ++i) tile_e[i] = -1; }
}
__global__ __launch_bounds__(256) void fill_rows(const int* __restrict__ cnt, const int* __restrict__ hstart, const int* __restrict__ tile_e, const int* __restrict__ list, int* __restrict__ rowpair) {
    const int prow = blockIdx.x * 256 + threadIdx.x; const int e = tile_e[prow >> 8]; int r = -1;
    if (e >= 0) { const int slot = prow - hstart[e]; if (slot < cnt[e]) r = list[e * T + slot]; }
    rowpair[prow] = r;
}
__global__ __launch_bounds__(256) void final_norm(float* __restrict__ out, const bf16_t* __restrict__ Y, const float* __restrict__ g) {
    const int lane = threadIdx.x & 63, t = blockIdx.x * 4 + (threadIdx.x >> 6);
    float4* xr = (float4*)(out + (size_t)t * DM);
    const uint2* y0 = (const uint2*)(Y + (size_t)(2 * t) * DM); const uint2* y1 = (const uint2*)(Y + (size_t)(2 * t + 1) * DM);
    float4 v[8]; float ss = 0.f;
#pragma unroll
    for (int j = 0; j < 8; ++j) { float4 a = xr[j * 64 + lane]; const uint2 p = y0[j * 64 + lane], q = y1[j * 64 + lane];
        a.x += bf2f(p.x & 0xffffu) + bf2f(q.x & 0xffffu); a.y += bf2f(p.x >> 16) + bf2f(q.x >> 16); a.z += bf2f(p.y & 0xffffu) + bf2f(q.y & 0xffffu); a.w += bf2f(p.y >> 16) + bf2f(q.y >> 16);
        v[j] = a; ss += a.x * a.x + a.y * a.y + a.z * a.z + a.w * a.w; }
    const float r = rsqrtf(wave_sum(ss) * (1.f / DM) + EPS);
#pragma unroll
    for (int j = 0; j < 8; ++j) { const float4 gv = ((const float4*)g)[j * 64 + lane]; float4 a = v[j]; a.x *= r * gv.x; a.y *= r * gv.y; a.z *= r * gv.z; a.w *= r * gv.w; xr[j * 64 + lane] = a; }
}

extern "C" void kernel_launch(void* const* d_in, const int* in_sizes, int n_in, void* d_out, int out_size, void* d_ws, size_t ws_size, hipStream_t stream) {
    const float* x = (const float*)d_in[0]; const float* norm1 = (const float*)d_in[1]; const float* w_in = (const float*)d_in[2]; const float* relb = (const float*)d_in[3];
    const float* conv_w = (const float*)d_in[4]; const float* g_oa = (const float*)d_in[5]; const float* g_oc = (const float*)d_in[6]; const float* w_out = (const float*)d_in[7];
    const float* norm2 = (const float*)d_in[8]; const float* w_rg = (const float*)d_in[9]; const float* b_rg = (const float*)d_in[10]; const float* w_re = (const float*)d_in[11];
    const float* b_re = (const float*)d_in[12]; const float* w_gate = (const float*)d_in[13]; const float* w_up = (const float*)d_in[14]; const float* w_down = (const float*)d_in[15];
    const float* norm_f = (const float*)d_in[16];
    char* ws = (char*)d_ws; float* out = (float*)d_out;
    if (ws_size < WS_END) return;
    int* cnt = (int*)(ws + WS_CTL); int* hstart = (int*)(ws + WS_PLAN); int* tile_e = hstart + 64;
    float* r1 = (float*)(ws + WS_R1); float* ra = (float*)(ws + WS_RA); float* rc = (float*)(ws + WS_RC); float* r2 = (float*)(ws + WS_R2); float* ssC = (float*)(ws + WS_SSC);
    float* wts = (float*)(ws + WS_WTS); int* rowpair = (int*)(ws + WS_ROWPAIR); float* Wr = (float*)(ws + WS_WR); float* ssA = (float*)(ws + WS_SSA); int* list = (int*)(ws + WS_LIST);
    bf16_t* W2t = (bf16_t*)(ws + WS_W2T); bf16_t* W1t = (bf16_t*)(ws + WS_W1T); bf16_t* Wdt = (bf16_t*)(ws + WS_WDT); bf16_t* Wgut = (bf16_t*)(ws + WS_WGUT);
    bf16_t* xb = (bf16_t*)(ws + WS_XB); bf16_t* mix = (bf16_t*)(ws + WS_MIX); bf16_t* proj = (bf16_t*)(ws + WS_PROJ); bf16_t* Y = (bf16_t*)(ws + WS_Y); bf16_t* Hb = (bf16_t*)(ws + WS_H);

    hipMemsetAsync(ws + WS_CTL, 0, 4096, stream);
    prep_x<<<T / 4, 256, 0, stream>>>(x, xb, r1);
    tconv<<<dim3(NPROJ / 64, DM / 64, 1), 256, 0, stream>>>(w_in, DM, NPROJ, norm1, W1t, 0, 0, 0);
    tconv<<<dim3(DM / 64, DATT / 64, 1), 256, 0, stream>>>(w_out, DM, DM, g_oa, W2t, 0, 0, 0);
    tconv<<<dim3(DM / 64, DCONV / 64, 1), 256, 0, stream>>>(w_out + (size_t)DATT * DM, DM, DM, g_oc, W2t + DATT, 0, 0, 0);
    tconv<<<dim3(DEXP / 64, DM / 64, NE), 256, 0, stream>>>(w_gate, DM, DEXP, norm2, Wgut, 1, (size_t)DM * DEXP, (size_t)2 * DEXP * DM);
    tconv<<<dim3(DEXP / 64, DM / 64, NE), 256, 0, stream>>>(w_up, DM, DEXP, norm2, Wgut, 2, (size_t)DM * DEXP, (size_t)2 * DEXP * DM);
    tconv<<<dim3(DM / 64, DEXP / 64, NE), 256, 0, stream>>>(w_down, DEXP, DM, nullptr, Wdt, 0, (size_t)DEXP * DM, (size_t)DM * DEXP);
    prep_wr<<<(36 * DM + 255) / 256, 256, 0, stream>>>(w_rg, w_re, norm2, Wr);
    { GemmP p{xb, DM, nullptr, W1t, DM, nullptr, 0, DM, DM}; sgemm<0, EpiProj><<<dim3(NPROJ / 64, T / 64), 256, 0, stream>>>(p, EpiProj{proj, r1}); }
    attn_simple<<<NB * 64 * NH, 64, 0, stream>>>(proj, relb, mix, ssA);
    conv_simple<<<T, 256, 0, stream>>>(proj, conv_w, mix, ssC);
    rowscale<<<T / 256, 256, 0, stream>>>(ssA, ssC, ra, rc);
    { GemmP p{mix, DM, nullptr, W2t, DM, nullptr, 0, DM, DATT}; sgemm<1, EpiG2><<<dim3(DM / 64, T / 64), 256, 0, stream>>>(p, EpiG2{x, ra, rc, out, xb}); }
    router<<<T / 4, 256, 0, stream>>>(out, Wr, b_rg, b_re, cnt, list, wts, r2);
    plan<<<1, 64, 0, stream>>>(cnt, hstart, tile_e);
    fill_rows<<<NPADMAX / 256, 256, 0, stream>>>(cnt, hstart, tile_e, list, rowpair);
    { GemmP p{xb, DM, rowpair, Wgut, DM, tile_e, (size_t)2 * DEXP * DM, DM, DM}; sgemm<2, EpiGU><<<dim3(DEXP / 64, NPADMAX / 64), 256, 0, stream>>>(p, EpiGU{Hb, r2, rowpair}); }
    { GemmP p{Hb, DEXP, nullptr, Wdt, DEXP, tile_e, (size_t)DM * DEXP, DEXP, DEXP}; sgemm<0, EpiDown><<<dim3(DM / 64, NPADMAX / 64), 256, 0, stream>>>(p, EpiDown{Y, wts, rowpair}); }
    final_norm<<<T / 4, 256, 0, stream>>>(out, Y, norm_f);
}
```

```cpp
#include <hip/hip_runtime.h>
#include <hip/hip_cooperative_groups.h>
#include <stdint.h>
#include <cstdio>
namespace cg = cooperative_groups;

typedef unsigned short bf16_t;
typedef short bf16x8 __attribute__((ext_vector_type(8)));
typedef float f32x4 __attribute__((ext_vector_type(4)));

constexpr int NB = 4, SEQ = 4096, T = NB * SEQ, DM = 2048, DATT = 1024, DCONV = 1024, NPROJ = 6144;
constexpr int NH = 16, HD = 64, NREL = 513, NE = 32, DEXP = 512, NPAIR = 2 * T;
constexpr int NPADMAX = 40960, NTILEMAX = NPADMAX / 256;
constexpr float EPS = 1e-6f;

constexpr size_t MiB = 1u << 20;
constexpr size_t WS_CTL = 0;
constexpr size_t WS_PLAN = 64 * 1024;
constexpr size_t WS_R1 = 128 * 1024;
constexpr size_t WS_RA = 192 * 1024;
constexpr size_t WS_RC = 256 * 1024;
constexpr size_t WS_R2 = 320 * 1024;
constexpr size_t WS_SSC = 384 * 1024;
constexpr size_t WS_WTS = 512 * 1024;
constexpr size_t WS_ROWPAIR = 640 * 1024;
constexpr size_t WS_WR = 1 * MiB;
constexpr size_t WS_SSA = 2 * MiB;
constexpr size_t WS_LIST = 5 * MiB;
constexpr size_t WS_W2T = 8 * MiB;
constexpr size_t WS_W1T = 16 * MiB;
constexpr size_t WS_WDT = 40 * MiB;
constexpr size_t WS_WGUT = 104 * MiB;
constexpr size_t WS_XB = 232 * MiB;
constexpr size_t WS_MIX = 296 * MiB;
constexpr size_t WS_PROJ = 360 * MiB;
constexpr size_t WS_Y = 360 * MiB;
constexpr size_t WS_H = 488 * MiB;
constexpr size_t WS_END = 552 * MiB;

__device__ __forceinline__ unsigned f2bf(float f) { unsigned u = __float_as_uint(f); return (u + 0x7fffu + ((u >> 16) & 1u)) >> 16; }
__device__ __forceinline__ unsigned pk2(float lo, float hi) { return f2bf(lo) | (f2bf(hi) << 16); }
__device__ __forceinline__ float bf2f(unsigned h) { return __uint_as_float(h << 16); }
__device__ __forceinline__ float wave_sum(float v) {
#pragma unroll
    for (int o = 1; o < 64; o <<= 1) v += __shfl_xor(v, o);
    return v;
}


#define LAS __attribute__((address_space(3)))
constexpr int NWAVES = 8, NTHREADS = 512;
constexpr int LDS_BYTES = 147456;
constexpr int LDS_PLAN_OFF = 140 * 1024;

struct Params {
    const float *x, *norm1, *w_in, *relb, *conv_w, *g_oa, *g_oc, *w_out, *norm2, *w_rg, *b_rg, *w_re, *b_re, *w_gate, *w_up, *w_down, *norm_f;
    float* out; char* ws;
};
struct Ctx { int tid, lane, wave, gw, ngw; };

__device__ __forceinline__ void p0_x_row(const float* __restrict__ x, bf16_t* __restrict__ xb, float* __restrict__ r1, int row, int lane) {
    const float4* xr = (const float4*)(x + (size_t)row * DM);
    uint2* o = (uint2*)(xb + (size_t)row * DM);
    float ss = 0.f;
#pragma unroll
    for (int j = 0; j < 8; ++j) { float4 v = xr[j * 64 + lane]; ss += v.x * v.x + v.y * v.y + v.z * v.z + v.w * v.w; o[j * 64 + lane] = make_uint2(pk2(v.x, v.y), pk2(v.z, v.w)); }
    ss = wave_sum(ss);
    if (lane == 0) r1[row] = rsqrtf(ss * (1.f / DM) + EPS);
}
__device__ __forceinline__ void p0_titem(const float* __restrict__ W, int N, const float* __restrict__ g, bf16_t* __restrict__ WT, int ldd, int k0, int n0, int drow0, LAS float* scr, int lane) {
#pragma unroll 8
    for (int i = 0; i < 32; ++i) { const int kk = 2 * i + (lane >> 5); const float s = g ? g[k0 + kk] : 1.f; scr[kk * 33 + (lane & 31)] = W[(size_t)(k0 + kk) * N + n0 + (lane & 31)] * s; }
    asm volatile("s_waitcnt lgkmcnt(0)" ::: "memory");
    const int c = lane & 7;
#pragma unroll
    for (int j = 0; j < 4; ++j) { const int n = (lane >> 3) + 8 * j; const LAS float* sp = scr + (8 * c) * 33 + n;
        uint4 o; o.x = pk2(sp[0 * 33], sp[1 * 33]); o.y = pk2(sp[2 * 33], sp[3 * 33]); o.z = pk2(sp[4 * 33], sp[5 * 33]); o.w = pk2(sp[6 * 33], sp[7 * 33]);
        *(uint4*)(WT + (size_t)(drow0 + n) * ldd + k0 + 8 * c) = o; }
    asm volatile("s_waitcnt lgkmcnt(0)" ::: "memory");
}
__device__ __forceinline__ int gu_row(int n, int up) { return ((n >> 7) << 8) + (n & 127) + (up ? 128 : 0); }

template <int MODE, class Epi>
__device__ __forceinline__ void sg_tile(const bf16_t* A, int lda, const bf16_t* B, int ldb, int K, int kmid, int r0, int c0, const int (&arow)[2], int lane, const Epi& epi) {
    const int fr = lane & 15, fq = lane >> 4;
    const bf16_t* ap[2]; const bf16_t* bp[2];
#pragma unroll
    for (int i = 0; i < 2; ++i) ap[i] = A + (size_t)arow[i] * lda + 8 * fq;
#pragma unroll
    for (int j = 0; j < 2; ++j) { const int n = c0 + 16 * j + fr; const int brow = (MODE == 2) ? gu_row(n, 0) : n; bp[j] = B + (size_t)brow * ldb + 8 * fq; }
    f32x4 acc0[2][2], acc1[2][2];
#pragma unroll
    for (int i = 0; i < 2; ++i)
#pragma unroll
        for (int j = 0; j < 2; ++j) { acc0[i][j] = (f32x4){0.f, 0.f, 0.f, 0.f}; acc1[i][j] = (f32x4){0.f, 0.f, 0.f, 0.f}; }
    for (int k = 0; k < K; k += 32) {
        bf16x8 a[2], b0[2], b1[2];
#pragma unroll
        for (int i = 0; i < 2; ++i) a[i] = *(const bf16x8*)(ap[i] + k);
#pragma unroll
        for (int j = 0; j < 2; ++j) { b0[j] = *(const bf16x8*)(bp[j] + k); if (MODE == 2) b1[j] = *(const bf16x8*)(bp[j] + (size_t)128 * ldb + k); else b1[j] = b0[j]; }
        if (MODE == 1) {
            if (k < kmid) {
#pragma unroll
                for (int i = 0; i < 2; ++i)
#pragma unroll
                    for (int j = 0; j < 2; ++j) acc0[i][j] = __builtin_amdgcn_mfma_f32_16x16x32_bf16(b0[j], a[i], acc0[i][j], 0, 0, 0);
            } else {
#pragma unroll
                for (int i = 0; i < 2; ++i)
#pragma unroll
                    for (int j = 0; j < 2; ++j) acc1[i][j] = __builtin_amdgcn_mfma_f32_16x16x32_bf16(b0[j], a[i], acc1[i][j], 0, 0, 0);
            }
        } else {
#pragma unroll
            for (int i = 0; i < 2; ++i)
#pragma unroll
                for (int j = 0; j < 2; ++j) { acc0[i][j] = __builtin_amdgcn_mfma_f32_16x16x32_bf16(b0[j], a[i], acc0[i][j], 0, 0, 0);
                    if (MODE == 2) acc1[i][j] = __builtin_amdgcn_mfma_f32_16x16x32_bf16(b1[j], a[i], acc1[i][j], 0, 0, 0); }
        }
    }
#pragma unroll
    for (int i = 0; i < 2; ++i)
#pragma unroll
        for (int j = 0; j < 2; ++j) epi(acc0[i][j], acc1[i][j], i, r0 + 16 * i + fr, c0 + 16 * j + 4 * fq);
}
struct EpiProj { bf16_t* out; const float* r1;
    __device__ __forceinline__ void operator()(f32x4 a, f32x4, int, int row, int col) const { const float s = r1[row]; *(uint2*)(out + (size_t)row * NPROJ + col) = make_uint2(pk2(a[0] * s, a[1] * s), pk2(a[2] * s, a[3] * s)); } };
struct EpiG2 { const float* x; const float* ssA; const float* ssC; float* x1; bf16_t* xb1;
    __device__ __forceinline__ void operator()(f32x4 a, f32x4 c, int, int row, int col) const {
        float s = 0.f;
#pragma unroll
        for (int h = 0; h < 16; ++h) s += ssA[row * 16 + h];
        const float sa = rsqrtf(s * (1.f / DATT) + EPS), sc = rsqrtf(ssC[row] * (1.f / DCONV) + EPS);
        const float4 xv = *(const float4*)(x + (size_t)row * DM + col);
        float4 o; o.x = xv.x + sa * a[0] + sc * c[0]; o.y = xv.y + sa * a[1] + sc * c[1]; o.z = xv.z + sa * a[2] + sc * c[2]; o.w = xv.w + sa * a[3] + sc * c[3];
        *(float4*)(x1 + (size_t)row * DM + col) = o; *(uint2*)(xb1 + (size_t)row * DM + col) = make_uint2(pk2(o.x, o.y), pk2(o.z, o.w)); } };
struct EpiGU { bf16_t* Hb; const float* r2; int pr[2];
    __device__ __forceinline__ void operator()(f32x4 g, f32x4 u, int i, int row, int col) const { const float s = r2[pr[i] >= 0 ? (pr[i] >> 1) : 0]; float h[4];
#pragma unroll
        for (int q = 0; q < 4; ++q) { const float gg = g[q] * s, uu = u[q] * s; h[q] = gg / (1.f + __expf(-gg)) * uu; }
        *(uint2*)(Hb + (size_t)row * DEXP + col) = make_uint2(pk2(h[0], h[1]), pk2(h[2], h[3])); } };
struct EpiDown { bf16_t* Y; const float* wts; int pr[2];
    __device__ __forceinline__ void operator()(f32x4 a, f32x4, int i, int, int col) const { if (pr[i] < 0) return; const float s = wts[pr[i]];
        *(uint2*)(Y + (size_t)pr[i] * DM + col) = make_uint2(pk2(a[0] * s, a[1] * s), pk2(a[2] * s, a[3] * s)); } };

__device__ __forceinline__ void attn_simple(const bf16_t* __restrict__ proj, const float* __restrict__ relb, bf16_t* __restrict__ mix, float* __restrict__ ssA, int bid, int qi) {
    const int h = bid & 15, c = (bid >> 4) & 63, b = bid >> 10, t = b * SEQ + c * 64 + qi;
    float q[64], o[64];
    { const uint4* qp = (const uint4*)(proj + (size_t)t * NPROJ + h * HD);
#pragma unroll
      for (int i = 0; i < 8; ++i) { const uint4 v = qp[i]; const unsigned w[4] = {v.x, v.y, v.z, v.w};
#pragma unroll
          for (int j = 0; j < 4; ++j) { q[8 * i + 2 * j] = bf2f(w[j] & 0xffffu) * 0.125f; q[8 * i + 2 * j + 1] = bf2f(w[j] >> 16) * 0.125f; } } }
#pragma unroll
    for (int d = 0; d < 64; ++d) o[d] = 0.f;
    float m = -1e30f, l = 0.f;
    const float* rb = relb + h * NREL;
    const int jc0 = c - 8 < 0 ? 0 : c - 8;
    for (int jc = jc0; jc <= c; ++jc)
        for (int kj = 0; kj < 64; ++kj) {
            const int tk = b * SEQ + jc * 64 + kj;
            const uint4* kp = (const uint4*)(proj + (size_t)tk * NPROJ + DATT + h * HD);
            const uint4* vp = (const uint4*)(proj + (size_t)tk * NPROJ + 2 * DATT + h * HD);
            float s = 0.f;
#pragma unroll
            for (int i = 0; i < 8; ++i) { const uint4 v = kp[i]; const unsigned w[4] = {v.x, v.y, v.z, v.w};
#pragma unroll
                for (int j = 0; j < 4; ++j) { s += q[8 * i + 2 * j] * bf2f(w[j] & 0xffffu); s += q[8 * i + 2 * j + 1] * bf2f(w[j] >> 16); } }
            int dist = (c - jc) * 64 + qi - kj; dist = dist < -256 ? -256 : (dist > 256 ? 256 : dist);
            s += rb[dist + 256];
            const float mn = fmaxf(m, s), al = __expf(m - mn), pp = __expf(s - mn);
            l = l * al + pp; m = mn;
#pragma unroll
            for (int i = 0; i < 8; ++i) { const uint4 v = vp[i]; const unsigned w[4] = {v.x, v.y, v.z, v.w};
#pragma unroll
                for (int j = 0; j < 4; ++j) { o[8 * i + 2 * j] = o[8 * i + 2 * j] * al + pp * bf2f(w[j] & 0xffffu); o[8 * i + 2 * j + 1] = o[8 * i + 2 * j + 1] * al + pp * bf2f(w[j] >> 16); } }
        }
    const float il = 1.f / l; float ss = 0.f;
    uint4* op = (uint4*)(mix + (size_t)t * DM + h * HD);
#pragma unroll
    for (int i = 0; i < 8; ++i) { float v[8];
#pragma unroll
        for (int j = 0; j < 8; ++j) { v[j] = o[8 * i + j] * il; ss += v[j] * v[j]; }
        op[i] = make_uint4(pk2(v[0], v[1]), pk2(v[2], v[3]), pk2(v[4], v[5]), pk2(v[6], v[7])); }
    ssA[t * 16 + h] = ss;
}
__device__ __forceinline__ void conv_row(const bf16_t* __restrict__ proj, const float* __restrict__ cw, bf16_t* __restrict__ mix, float* __restrict__ ssC, int t, int lane) {
    const int s = t & (SEQ - 1); float ss = 0.f;
#pragma unroll
    for (int cc = 0; cc < 4; ++cc) { const int ch = (cc * 64 + lane) * 4;
        float y[4] = {0.f, 0.f, 0.f, 0.f};
#pragma unroll
        for (int j = 0; j < 3; ++j) { const int back = 2 - j; if (s - back < 0) continue;
            const bf16_t* pr = proj + (size_t)(t - back) * NPROJ;
            const uint2 cv = *(const uint2*)(pr + 4 * DATT + ch), uv = *(const uint2*)(pr + 5 * DATT + ch);
            const float4 wv = *(const float4*)(cw + j * DCONV + ch);
            y[0] += wv.x * bf2f(cv.x & 0xffffu) * bf2f(uv.x & 0xffffu); y[1] += wv.y * bf2f(cv.x >> 16) * bf2f(uv.x >> 16);
            y[2] += wv.z * bf2f(cv.y & 0xffffu) * bf2f(uv.y & 0xffffu); y[3] += wv.w * bf2f(cv.y >> 16) * bf2f(uv.y >> 16); }
        const uint2 bv = *(const uint2*)(proj + (size_t)t * NPROJ + 3 * DATT + ch);
        y[0] *= bf2f(bv.x & 0xffffu); y[1] *= bf2f(bv.x >> 16); y[2] *= bf2f(bv.y & 0xffffu); y[3] *= bf2f(bv.y >> 16);
        *(uint2*)(mix + (size_t)t * DM + DATT + ch) = make_uint2(pk2(y[0], y[1]), pk2(y[2], y[3]));
        ss += y[0] * y[0] + y[1] * y[1] + y[2] * y[2] + y[3] * y[3]; }
    ss = wave_sum(ss);
    if (lane == 0) ssC[t] = ss;
}
__device__ __forceinline__ void router_row(const float* __restrict__ x1, const float* __restrict__ Wr, const float* __restrict__ brg, const float* __restrict__ bre,
                                           int* __restrict__ cnt, int* __restrict__ list, float* __restrict__ wts, float* __restrict__ r2out, int t, int lane) {
    const float4* xr = (const float4*)(x1 + (size_t)t * DM);
    float4 v[8]; float ss = 0.f;
#pragma unroll
    for (int j = 0; j < 8; ++j) { v[j] = xr[j * 64 + lane]; ss += v[j].x * v[j].x + v[j].y * v[j].y + v[j].z * v[j].z + v[j].w * v[j].w; }
    const float r2 = rsqrtf(wave_sum(ss) * (1.f / DM) + EPS);
    float lg[4];
#pragma unroll
    for (int o = 0; o < 4; ++o) { const float4* wr = (const float4*)(Wr + (size_t)o * DM); float p = 0.f;
#pragma unroll
        for (int j = 0; j < 8; ++j) { const float4 wv = wr[j * 64 + lane]; p += v[j].x * wv.x + v[j].y * wv.y + v[j].z * wv.z + v[j].w * wv.w; }
        lg[o] = wave_sum(p) * r2 + brg[o]; }
    int gs = 0; float gm = lg[0];
#pragma unroll
    for (int g = 1; g < 4; ++g) if (lg[g] > gm) { gm = lg[g]; gs = g; }
    float den = 0.f;
#pragma unroll
    for (int g = 0; g < 4; ++g) den += __expf(lg[g] - gm);
    const float pg = 1.f / den;
    gs = __builtin_amdgcn_readfirstlane(gs);
    float el[8];
#pragma unroll
    for (int i = 0; i < 8; ++i) { const float4* wr = (const float4*)(Wr + (size_t)(4 + gs * 8 + i) * DM); float p = 0.f;
#pragma unroll
        for (int j = 0; j < 8; ++j) { const float4 wv = wr[j * 64 + lane]; p += v[j].x * wv.x + v[j].y * wv.y + v[j].z * wv.z + v[j].w * wv.w; }
        el[i] = wave_sum(p) * r2 + bre[gs * 8 + i]; }
    int i1 = 0; float v1 = el[0];
#pragma unroll
    for (int i = 1; i < 8; ++i) if (el[i] > v1) { v1 = el[i]; i1 = i; }
    int i2 = -1; float v2 = -3.0e38f;
#pragma unroll
    for (int i = 0; i < 8; ++i) if (i != i1 && el[i] > v2) { v2 = el[i]; i2 = i; }
    const float e2 = __expf(v2 - v1), w0 = pg / (1.f + e2), w1 = pg * e2 / (1.f + e2);
    if (lane == 0) {
        r2out[t] = r2;
        const int ea = gs * 8 + i1, eb = gs * 8 + i2;
        const int sa = atomicAdd(&cnt[ea], 1); list[ea * T + sa] = 2 * t; wts[2 * t] = w0;
        const int sb = atomicAdd(&cnt[eb], 1); list[eb * T + sb] = 2 * t + 1; wts[2 * t + 1] = w1;
    }
}
__device__ __forceinline__ void final_row(float* __restrict__ out, const bf16_t* __restrict__ Y, const float* __restrict__ g, int t, int lane) {
    float4* xr = (float4*)(out + (size_t)t * DM);
    const uint2* y0 = (const uint2*)(Y + (size_t)(2 * t) * DM); const uint2* y1 = (const uint2*)(Y + (size_t)(2 * t + 1) * DM);
    float4 v[8]; float ss = 0.f;
#pragma unroll
    for (int j = 0; j < 8; ++j) { float4 a = xr[j * 64 + lane]; const uint2 p = y0[j * 64 + lane], q = y1[j * 64 + lane];
        a.x += bf2f(p.x & 0xffffu) + bf2f(q.x & 0xffffu); a.y += bf2f(p.x >> 16) + bf2f(q.x >> 16); a.z += bf2f(p.y & 0xffffu) + bf2f(q.y & 0xffffu); a.w += bf2f(p.y >> 16) + bf2f(q.y >> 16);
        v[j] = a; ss += a.x * a.x + a.y * a.y + a.z * a.z + a.w * a.w; }
    const float r = rsqrtf(wave_sum(ss) * (1.f / DM) + EPS);
#pragma unroll
    for (int j = 0; j < 8; ++j) { const float4 gv = ((const float4*)g)[j * 64 + lane]; float4 a = v[j]; a.x *= r * gv.x; a.y *= r * gv.y; a.z *= r * gv.z; a.w *= r * gv.w; xr[j * 64 + lane] = a; }
}

__global__ void __launch_bounds__(NTHREADS, 2) mega(Params p) {
    extern __shared__ __attribute__((aligned(16))) unsigned char lds[];
    cg::grid_group grid = cg::this_grid();
    Ctx c; c.tid = threadIdx.x; c.lane = c.tid & 63; c.wave = __builtin_amdgcn_readfirstlane(c.tid >> 6); c.gw = blockIdx.x * NWAVES + c.wave; c.ngw = gridDim.x * NWAVES;
    char* ws = p.ws;
    int* cnt = (int*)(ws + WS_CTL);
    float* r1 = (float*)(ws + WS_R1); float* r2 = (float*)(ws + WS_R2); float* ssC = (float*)(ws + WS_SSC);
    float* wts = (float*)(ws + WS_WTS); float* Wr = (float*)(ws + WS_WR); float* ssA = (float*)(ws + WS_SSA); int* list = (int*)(ws + WS_LIST);
    bf16_t* W2t = (bf16_t*)(ws + WS_W2T); bf16_t* W1t = (bf16_t*)(ws + WS_W1T); bf16_t* Wdt = (bf16_t*)(ws + WS_WDT); bf16_t* Wgut = (bf16_t*)(ws + WS_WGUT);
    bf16_t* xb = (bf16_t*)(ws + WS_XB); bf16_t* mix = (bf16_t*)(ws + WS_MIX); bf16_t* proj = (bf16_t*)(ws + WS_PROJ); bf16_t* Y = (bf16_t*)(ws + WS_Y); bf16_t* Hb = (bf16_t*)(ws + WS_H);

    {
        if (blockIdx.x == 0 && c.tid < 64) cnt[c.tid] = 0;
        for (int row = c.gw; row < T; row += c.ngw) p0_x_row(p.x, xb, r1, row, c.lane);
        LAS float* scr = (LAS float*)lds + c.wave * (64 * 33);
        constexpr int I_IN = (DM / 64) * (NPROJ / 32), I_OUT = (DM / 64) * (DM / 32), I_G = NE * (DM / 64) * (DEXP / 32), I_D = NE * (DEXP / 64) * (DM / 32);
        constexpr int NIT = I_IN + I_OUT + 2 * I_G + I_D;
        for (int it = c.gw; it < NIT; it += c.ngw) {
            int r = it;
            if (r < I_IN) { const int nb = NPROJ / 32, kb = r / nb, n0 = (r % nb) * 32; p0_titem(p.w_in, NPROJ, p.norm1, W1t, DM, kb * 64, n0, n0, scr, c.lane); continue; } r -= I_IN;
            if (r < I_OUT) { const int nb = DM / 32, kb = r / nb, n0 = (r % nb) * 32, k0 = kb * 64;
                const float* g = k0 < DATT ? p.g_oa + k0 : p.g_oc + (k0 - DATT);
                p0_titem(p.w_out + (size_t)k0 * DM, DM, g, W2t + k0, DM, 0, n0, n0, scr, c.lane); continue; } r -= I_OUT;
            if (r < 2 * I_G) { const int up = r >= I_G; if (up) r -= I_G; const int per = (DM / 64) * (DEXP / 32), e = r / per, q = r % per, nb = DEXP / 32, kb = q / nb, n0 = (q % nb) * 32;
                p0_titem((up ? p.w_up : p.w_gate) + (size_t)e * DM * DEXP, DEXP, p.norm2, Wgut + (size_t)e * 2 * DEXP * DM, DM, kb * 64, n0, gu_row(n0, up), scr, c.lane); continue; } r -= 2 * I_G;
            { const int per = (DEXP / 64) * (DM / 32), e = r / per, q = r % per, nb = DM / 32, kb = q / nb, n0 = (q % nb) * 32;
              p0_titem(p.w_down + (size_t)e * DEXP * DM, DM, nullptr, Wdt + (size_t)e * DM * DEXP, DEXP, kb * 64, n0, n0, scr, c.lane); }
        }
        for (int i = blockIdx.x * NTHREADS + c.tid; i < 36 * DM; i += gridDim.x * NTHREADS) { const int o = i / DM, k = i % DM; Wr[i] = p.norm2[k] * (o < 4 ? p.w_rg[k * 4 + o] : p.w_re[k * 32 + (o - 4)]); }
    }
    grid.sync();
    {
        const EpiProj E{proj, r1};
        for (int it = c.gw; it < (T / 32) * (NPROJ / 32); it += c.ngw) { const int tr = it / (NPROJ / 32), tc = it % (NPROJ / 32); const int fr = c.lane & 15;
            const int arow[2] = {tr * 32 + fr, tr * 32 + 16 + fr};
            sg_tile<0>(xb, DM, W1t, DM, DM, DM, tr * 32, tc * 32, arow, c.lane, E); }
    }
    grid.sync();
    {
        for (int it = c.gw; it < NB * 64 * NH; it += c.ngw) attn_simple(proj, p.relb, mix, ssA, it, c.lane);
        for (int t = c.gw; t < T; t += c.ngw) conv_row(proj, p.conv_w, mix, ssC, t, c.lane);
    }
    grid.sync();
    {
        const EpiG2 E{p.x, ssA, ssC, p.out, xb};
        for (int it = c.gw; it < (T / 32) * (DM / 32); it += c.ngw) { const int tr = it / (DM / 32), tc = it % (DM / 32); const int fr = c.lane & 15;
            const int arow[2] = {tr * 32 + fr, tr * 32 + 16 + fr};
            sg_tile<1>(mix, DM, W2t, DM, DM, DATT, tr * 32, tc * 32, arow, c.lane, E); }
    }
    grid.sync();
    for (int t = c.gw; t < T; t += c.ngw) router_row(p.out, Wr, p.b_rg, p.b_re, cnt, list, wts, r2, t, c.lane);
    grid.sync();
    LAS int* pl = (LAS int*)(lds + LDS_PLAN_OFF);
    if (c.tid == 0) { int tl = 0;
        for (int e = 0; e < NE; ++e) { const int ce = cnt[e]; pl[e] = ce; pl[32 + e] = tl * 256; const int mt = (ce + 255) >> 8; for (int i = 0; i < mt; ++i) pl[64 + tl + i] = e; tl += mt; }
        for (int i = tl; i < NTILEMAX; ++i) pl[64 + i] = -1; }
    __syncthreads();
    {
        for (int it = c.gw; it < (NPADMAX / 32) * (DEXP / 32); it += c.ngw) { const int tr = it / (DEXP / 32), tc = it % (DEXP / 32); const int fr = c.lane & 15;
            const int e = pl[64 + ((tr * 32) >> 8)]; if (e < 0) continue;
            EpiGU E{Hb, r2, {0, 0}}; int arow[2];
#pragma unroll
            for (int i = 0; i < 2; ++i) { const int slot = tr * 32 + 16 * i + fr - pl[32 + e]; const int pr = slot < pl[e] ? list[e * T + slot] : -1; E.pr[i] = pr; arow[i] = pr >= 0 ? (pr >> 1) : 0; }
            sg_tile<2>(xb, DM, Wgut + (size_t)e * 2 * DEXP * DM, DM, DM, DM, tr * 32, tc * 32, arow, c.lane, E); }
    }
    grid.sync();
    {
        for (int it = c.gw; it < (NPADMAX / 32) * (DM / 32); it += c.ngw) { const int tr = it / (DM / 32), tc = it % (DM / 32); const int fr = c.lane & 15;
            const int e = pl[64 + ((tr * 32) >> 8)]; if (e < 0) continue;
            EpiDown E{Y, wts, {0, 0}}; int arow[2];
#pragma unroll
            for (int i = 0; i < 2; ++i) { const int prow = tr * 32 + 16 * i + fr, slot = prow - pl[32 + e]; E.pr[i] = slot < pl[e] ? list[e * T + slot] : -1; arow[i] = prow; }
            sg_tile<0>(Hb, DEXP, Wdt + (size_t)e * DM * DEXP, DEXP, DEXP, DEXP, tr * 32, tc * 32, arow, c.lane, E); }
    }
    grid.sync();
    for (int t = c.gw; t < T; t += c.ngw) final_row(p.out, Y, p.norm_f, t, c.lane);
}

extern "C" void kernel_launch(void* const* d_in, const int* in_sizes, int n_in, void* d_out, int out_size, void* d_ws, size_t ws_size, hipStream_t stream) {
    static int grid = 0;
    if (grid == 0) {
        int dev = 0, cus = 0, per_cu = 0;
        if (ws_size < WS_END || n_in != 17) { fprintf(stderr, "kernel_launch: unexpected sizes (ws %zu)\n", ws_size); grid = -1; return; }
        (void)hipGetDevice(&dev); (void)hipDeviceGetAttribute(&cus, hipDeviceAttributeMultiprocessorCount, dev);
        if (hipFuncSetAttribute((const void*)mega, hipFuncAttributeMaxDynamicSharedMemorySize, LDS_BYTES) != hipSuccess) { fprintf(stderr, "hipFuncSetAttribute failed\n"); grid = -1; return; }
        if (hipOccupancyMaxActiveBlocksPerMultiprocessor(&per_cu, (const void*)mega, NTHREADS, LDS_BYTES) != hipSuccess || per_cu < 1) { fprintf(stderr, "occupancy query failed (%d)\n", per_cu); grid = -1; return; }
        grid = cus * per_cu;
        fprintf(stderr, "kernel_launch: cus %d per_cu %d grid %d\n", cus, per_cu, grid);
    }
    if (grid < 0) return;
    Params p{};
    p.x = (const float*)d_in[0]; p.norm1 = (const float*)d_in[1]; p.w_in = (const float*)d_in[2]; p.relb = (const float*)d_in[3];
    p.conv_w = (const float*)d_in[4]; p.g_oa = (const float*)d_in[5]; p.g_oc = (const float*)d_in[6]; p.w_out = (const float*)d_in[7];
    p.norm2 = (const float*)d_in[8]; p.w_rg = (const float*)d_in[9]; p.b_rg = (const float*)d_in[10]; p.w_re = (const float*)d_in[11];
    p.b_re = (const float*)d_in[12]; p.w_gate = (const float*)d_in[13]; p.w_up = (const float*)d_in[14]; p.w_down = (const float*)d_in[15];
    p.norm_f = (const float*)d_in[16]; p.out = (float*)d_out; p.ws = (char*)d_ws;
    void* args[] = {&p};
    hipError_t e = hipLaunchCooperativeKernel((const void*)mega, dim3(grid), dim3(NTHREADS), args, LDS_BYTES, stream);
    if (e != hipSuccess) fprintf(stderr, "cooperative launch failed: %s (grid %d)\n", hipGetErrorString(e), grid);
}
```

```cpp
#include <hip/hip_runtime.h>
#include <hip/hip_cooperative_groups.h>
#include <stdint.h>
#include <cstdio>
namespace cg = cooperative_groups;

typedef unsigned short bf16_t;
typedef short bf16x8 __attribute__((ext_vector_type(8)));
typedef float f32x4 __attribute__((ext_vector_type(4)));

constexpr int NB = 4, SEQ = 4096, T = NB * SEQ, DM = 2048, DATT = 1024, DCONV = 1024, NPROJ = 6144;
constexpr int NH = 16, HD = 64, NREL = 513, NE = 32, DEXP = 512, NPAIR = 2 * T;
constexpr int NPADMAX = 40960, NTILEMAX = NPADMAX / 256;
constexpr float EPS = 1e-6f;

constexpr size_t MiB = 1u << 20;
constexpr size_t WS_CTL = 0;
constexpr size_t WS_PLAN = 64 * 1024;
constexpr size_t WS_R1 = 128 * 1024;
constexpr size_t WS_RA = 192 * 1024;
constexpr size_t WS_RC = 256 * 1024;
constexpr size_t WS_R2 = 320 * 1024;
constexpr size_t WS_SSC = 384 * 1024;
constexpr size_t WS_WTS = 512 * 1024;
constexpr size_t WS_ROWPAIR = 640 * 1024;
constexpr size_t WS_WR = 1 * MiB;
constexpr size_t WS_SSA = 2 * MiB;
constexpr size_t WS_LIST = 5 * MiB;
constexpr size_t WS_W2T = 8 * MiB;
constexpr size_t WS_W1T = 16 * MiB;
constexpr size_t WS_WDT = 40 * MiB;
constexpr size_t WS_WGUT = 104 * MiB;
constexpr size_t WS_XB = 232 * MiB;
constexpr size_t WS_MIX = 296 * MiB;
constexpr size_t WS_PROJ = 360 * MiB;
constexpr size_t WS_Y = 360 * MiB;
constexpr size_t WS_H = 488 * MiB;
constexpr size_t WS_END = 552 * MiB;

__device__ __forceinline__ unsigned f2bf(float f) { unsigned u = __float_as_uint(f); return (u + 0x7fffu + ((u >> 16) & 1u)) >> 16; }
__device__ __forceinline__ unsigned pk2(float lo, float hi) { return f2bf(lo) | (f2bf(hi) << 16); }
__device__ __forceinline__ float bf2f(unsigned h) { return __uint_as_float(h << 16); }
__device__ __forceinline__ float wave_sum(float v) {
#pragma unroll
    for (int o = 1; o < 64; o <<= 1) v += __shfl_xor(v, o);
    return v;
}


#define LAS __attribute__((address_space(3)))
constexpr int NWAVES = 8, NTHREADS = 512;
constexpr int LDS_BYTES = 147456;
constexpr int LDS_PLAN_OFF = 140 * 1024;

struct Params {
    const float *x, *norm1, *w_in, *relb, *conv_w, *g_oa, *g_oc, *w_out, *norm2, *w_rg, *b_rg, *w_re, *b_re, *w_gate, *w_up, *w_down, *norm_f;
    float* out; char* ws;
};
struct Ctx { int tid, lane, wave, gw, ngw; };

__device__ __forceinline__ void p0_x_row(const float* __restrict__ x, bf16_t* __restrict__ xb, float* __restrict__ r1, int row, int lane) {
    const float4* xr = (const float4*)(x + (size_t)row * DM);
    uint2* o = (uint2*)(xb + (size_t)row * DM);
    float ss = 0.f;
#pragma unroll
    for (int j = 0; j < 8; ++j) { float4 v = xr[j * 64 + lane]; ss += v.x * v.x + v.y * v.y + v.z * v.z + v.w * v.w; o[j * 64 + lane] = make_uint2(pk2(v.x, v.y), pk2(v.z, v.w)); }
    ss = wave_sum(ss);
    if (lane == 0) r1[row] = rsqrtf(ss * (1.f / DM) + EPS);
}
__device__ __forceinline__ void p0_titem(const float* __restrict__ W, int N, const float* __restrict__ g, bf16_t* __restrict__ WT, int ldd, int k0, int n0, int drow0, LAS float* scr, int lane) {
#pragma unroll 8
    for (int i = 0; i < 32; ++i) { const int kk = 2 * i + (lane >> 5); const float s = g ? g[k0 + kk] : 1.f; scr[kk * 33 + (lane & 31)] = W[(size_t)(k0 + kk) * N + n0 + (lane & 31)] * s; }
    asm volatile("s_waitcnt lgkmcnt(0)" ::: "memory");
    const int c = lane & 7;
#pragma unroll
    for (int j = 0; j < 4; ++j) { const int n = (lane >> 3) + 8 * j; const LAS float* sp = scr + (8 * c) * 33 + n;
        uint4 o; o.x = pk2(sp[0 * 33], sp[1 * 33]); o.y = pk2(sp[2 * 33], sp[3 * 33]); o.z = pk2(sp[4 * 33], sp[5 * 33]); o.w = pk2(sp[6 * 33], sp[7 * 33]);
        *(uint4*)(WT + (size_t)(drow0 + n) * ldd + k0 + 8 * c) = o; }
    asm volatile("s_waitcnt lgkmcnt(0)" ::: "memory");
}
__device__ __forceinline__ int gu_row(int n, int up) { return ((n >> 7) << 8) + (n & 127) + (up ? 128 : 0); }

template <int MODE, class Epi>
__device__ __forceinline__ void sg_tile(const bf16_t* A, int lda, const bf16_t* B, int ldb, int K, int kmid, int r0, int c0, const int (&arow)[2], int lane, const Epi& epi) {
    const int fr = lane & 15, fq = lane >> 4;
    const bf16_t* ap[2]; const bf16_t* bp[2];
#pragma unroll
    for (int i = 0; i < 2; ++i) ap[i] = A + (size_t)arow[i] * lda + 8 * fq;
#pragma unroll
    for (int j = 0; j < 2; ++j) { const int n = c0 + 16 * j + fr; const int brow = (MODE == 2) ? gu_row(n, 0) : n; bp[j] = B + (size_t)brow * ldb + 8 * fq; }
    f32x4 acc0[2][2], acc1[2][2];
#pragma unroll
    for (int i = 0; i < 2; ++i)
#pragma unroll
        for (int j = 0; j < 2; ++j) { acc0[i][j] = (f32x4){0.f, 0.f, 0.f, 0.f}; acc1[i][j] = (f32x4){0.f, 0.f, 0.f, 0.f}; }
    for (int k = 0; k < K; k += 32) {
        bf16x8 a[2], b0[2], b1[2];
#pragma unroll
        for (int i = 0; i < 2; ++i) a[i] = *(const bf16x8*)(ap[i] + k);
#pragma unroll
        for (int j = 0; j < 2; ++j) { b0[j] = *(const bf16x8*)(bp[j] + k); if (MODE == 2) b1[j] = *(const bf16x8*)(bp[j] + (size_t)128 * ldb + k); else b1[j] = b0[j]; }
        if (MODE == 1) {
            if (k < kmid) {
#pragma unroll
                for (int i = 0; i < 2; ++i)
#pragma unroll
                    for (int j = 0; j < 2; ++j) acc0[i][j] = __builtin_amdgcn_mfma_f32_16x16x32_bf16(b0[j], a[i], acc0[i][j], 0, 0, 0);
            } else {
#pragma unroll
                for (int i = 0; i < 2; ++i)
#pragma unroll
                    for (int j = 0; j < 2; ++j) acc1[i][j] = __builtin_amdgcn_mfma_f32_16x16x32_bf16(b0[j], a[i], acc1[i][j], 0, 0, 0);
            }
        } else {
#pragma unroll
            for (int i = 0; i < 2; ++i)
#pragma unroll
                for (int j = 0; j < 2; ++j) { acc0[i][j] = __builtin_amdgcn_mfma_f32_16x16x32_bf16(b0[j], a[i], acc0[i][j], 0, 0, 0);
                    if (MODE == 2) acc1[i][j] = __builtin_amdgcn_mfma_f32_16x16x32_bf16(b1[j], a[i], acc1[i][j], 0, 0, 0); }
        }
    }
#pragma unroll
    for (int i = 0; i < 2; ++i)
#pragma unroll
        for (int j = 0; j < 2; ++j) epi(acc0[i][j], acc1[i][j], i, r0 + 16 * i + fr, c0 + 16 * j + 4 * fq);
}
struct EpiProj { bf16_t* out; const float* r1;
    __device__ __forceinline__ void operator()(f32x4 a, f32x4, int, int row, int col) const { const float s = r1[row]; *(uint2*)(out + (size_t)row * NPROJ + col) = make_uint2(pk2(a[0] * s, a[1] * s), pk2(a[2] * s, a[3] * s)); } };
struct EpiG2 { const float* x; const float* ssA; const float* ssC; float* x1; bf16_t* xb1;
    __device__ __forceinline__ void operator()(f32x4 a, f32x4 c, int, int row, int col) const {
        float s = 0.f;
#pragma unroll
        for (int h = 0; h < 16; ++h) s += ssA[row * 16 + h];
        const float sa = rsqrtf(s * (1.f / DATT) + EPS), sc = rsqrtf(ssC[row] * (1.f / DCONV) + EPS);
        const float4 xv = *(const float4*)(x + (size_t)row * DM + col);
        float4 o; o.x = xv.x + sa * a[0] + sc * c[0]; o.y = xv.y + sa * a[1] + sc * c[1]; o.z = xv.z + sa * a[2] + sc * c[2]; o.w = xv.w + sa * a[3] + sc * c[3];
        *(float4*)(x1 + (size_t)row * DM + col) = o; *(uint2*)(xb1 + (size_t)row * DM + col) = make_uint2(pk2(o.x, o.y), pk2(o.z, o.w)); } };
struct EpiGU { bf16_t* Hb; const float* r2; int pr[2];
    __device__ __forceinline__ void operator()(f32x4 g, f32x4 u, int i, int row, int col) const { const float s = r2[pr[i] >= 0 ? (pr[i] >> 1) : 0]; float h[4];
#pragma unroll
        for (int q = 0; q < 4; ++q) { const float gg = g[q] * s, uu = u[q] * s; h[q] = gg / (1.f + __expf(-gg)) * uu; }
        *(uint2*)(Hb + (size_t)row * DEXP + col) = make_uint2(pk2(h[0], h[1]), pk2(h[2], h[3])); } };
struct EpiDown { bf16_t* Y; const float* wts; int pr[2];
    __device__ __forceinline__ void operator()(f32x4 a, f32x4, int i, int, int col) const { if (pr[i] < 0) return; const float s = wts[pr[i]];
        *(uint2*)(Y + (size_t)pr[i] * DM + col) = make_uint2(pk2(a[0] * s, a[1] * s), pk2(a[2] * s, a[3] * s)); } };

__device__ __forceinline__ void attn_simple(const bf16_t* __restrict__ proj, const float* __restrict__ relb, bf16_t* __restrict__ mix, float* __restrict__ ssA, int bid, int qi) {
    const int h = bid & 15, c = (bid >> 4) & 63, b = bid >> 10, t = b * SEQ + c * 64 + qi;
    float q[64], o[64];
    { const uint4* qp = (const uint4*)(proj + (size_t)t * NPROJ + h * HD);
#pragma unroll
      for (int i = 0; i < 8; ++i) { const uint4 v = qp[i]; const unsigned w[4] = {v.x, v.y, v.z, v.w};
#pragma unroll
          for (int j = 0; j < 4; ++j) { q[8 * i + 2 * j] = bf2f(w[j] & 0xffffu) * 0.125f; q[8 * i + 2 * j + 1] = bf2f(w[j] >> 16) * 0.125f; } } }
#pragma unroll
    for (int d = 0; d < 64; ++d) o[d] = 0.f;
    float m = -1e30f, l = 0.f;
    const float* rb = relb + h * NREL;
    const int jc0 = c - 8 < 0 ? 0 : c - 8;
    for (int jc = jc0; jc <= c; ++jc)
        for (int kj = 0; kj < 64; ++kj) {
            const int tk = b * SEQ + jc * 64 + kj;
            const uint4* kp = (const uint4*)(proj + (size_t)tk * NPROJ + DATT + h * HD);
            const uint4* vp = (const uint4*)(proj + (size_t)tk * NPROJ + 2 * DATT + h * HD);
            float s = 0.f;
#pragma unroll
            for (int i = 0; i < 8; ++i) { const uint4 v = kp[i]; const unsigned w[4] = {v.x, v.y, v.z, v.w};
#pragma unroll
                for (int j = 0; j < 4; ++j) { s += q[8 * i + 2 * j] * bf2f(w[j] & 0xffffu); s += q[8 * i + 2 * j + 1] * bf2f(w[j] >> 16); } }
            int dist = (c - jc) * 64 + qi - kj; dist = dist < -256 ? -256 : (dist > 256 ? 256 : dist);
            s += rb[dist + 256];
            const float mn = fmaxf(m, s), al = __expf(m - mn), pp = __expf(s - mn);
            l = l * al + pp; m = mn;
#pragma unroll
            for (int i = 0; i < 8; ++i) { const uint4 v = vp[i]; const unsigned w[4] = {v.x, v.y, v.z, v.w};
#pragma unroll
                for (int j = 0; j < 4; ++j) { o[8 * i + 2 * j] = o[8 * i + 2 * j] * al + pp * bf2f(w[j] & 0xffffu); o[8 * i + 2 * j + 1] = o[8 * i + 2 * j + 1] * al + pp * bf2f(w[j] >> 16); } }
        }
    const float il = 1.f / l; float ss = 0.f;
    uint4* op = (uint4*)(mix + (size_t)t * DM + h * HD);
#pragma unroll
    for (int i = 0; i < 8; ++i) { float v[8];
#pragma unroll
        for (int j = 0; j < 8; ++j) { v[j] = o[8 * i + j] * il; ss += v[j] * v[j]; }
        op[i] = make_uint4(pk2(v[0], v[1]), pk2(v[2], v[3]), pk2(v[4], v[5]), pk2(v[6], v[7])); }
    ssA[t * 16 + h] = ss;
}
__device__ __forceinline__ void conv_row(const bf16_t* __restrict__ proj, const float* __restrict__ cw, bf16_t* __restrict__ mix, float* __restrict__ ssC, int t, int lane) {
    const int s = t & (SEQ - 1); float ss = 0.f;
#pragma unroll
    for (int cc = 0; cc < 4; ++cc) { const int ch = (cc * 64 + lane) * 4;
        float y[4] = {0.f, 0.f, 0.f, 0.f};
#pragma unroll
        for (int j = 0; j < 3; ++j) { const int back = 2 - j; if (s - back < 0) continue;
            const bf16_t* pr = proj + (size_t)(t - back) * NPROJ;
            const uint2 cv = *(const uint2*)(pr + 4 * DATT + ch), uv = *(const uint2*)(pr + 5 * DATT + ch);
            const float4 wv = *(const float4*)(cw + j * DCONV + ch);
            y[0] += wv.x * bf2f(cv.x & 0xffffu) * bf2f(uv.x & 0xffffu); y[1] += wv.y * bf2f(cv.x >> 16) * bf2f(uv.x >> 16);
            y[2] += wv.z * bf2f(cv.y & 0xffffu) * bf2f(uv.y & 0xffffu); y[3] += wv.w * bf2f(cv.y >> 16) * bf2f(uv.y >> 16); }
        const uint2 bv = *(const uint2*)(proj + (size_t)t * NPROJ + 3 * DATT + ch);
        y[0] *= bf2f(bv.x & 0xffffu); y[1] *= bf2f(bv.x >> 16); y[2] *= bf2f(bv.y & 0xffffu); y[3] *= bf2f(bv.y >> 16);
        *(uint2*)(mix + (size_t)t * DM + DATT + ch) = make_uint2(pk2(y[0], y[1]), pk2(y[2], y[3]));
        ss += y[0] * y[0] + y[1] * y[1] + y[2] * y[2] + y[3] * y[3]; }
    ss = wave_sum(ss);
    if (lane == 0) ssC[t] = ss;
}
__device__ __forceinline__ void router_row(const float* __restrict__ x1, const float* __restrict__ Wr, const float* __restrict__ brg, const float* __restrict__ bre,
                                           int* __restrict__ cnt, int* __restrict__ list, float* __restrict__ wts, float* __restrict__ r2out, int t, int lane) {
    const float4* xr = (const float4*)(x1 + (size_t)t * DM);
    float4 v[8]; float ss = 0.f;
#pragma unroll
    for (int j = 0; j < 8; ++j) { v[j] = xr[j * 64 + lane]; ss += v[j].x * v[j].x + v[j].y * v[j].y + v[j].z * v[j].z + v[j].w * v[j].w; }
    const float r2 = rsqrtf(wave_sum(ss) * (1.f / DM) + EPS);
    float lg[4];
#pragma unroll
    for (int o = 0; o < 4; ++o) { const float4* wr = (const float4*)(Wr + (size_t)o * DM); float p = 0.f;
#pragma unroll
        for (int j = 0; j < 8; ++j) { const float4 wv = wr[j * 64 + lane]; p += v[j].x * wv.x + v[j].y * wv.y + v[j].z * wv.z + v[j].w * wv.w; }
        lg[o] = wave_sum(p) * r2 + brg[o]; }
    int gs = 0; float gm = lg[0];
#pragma unroll
    for (int g = 1; g < 4; ++g) if (lg[g] > gm) { gm = lg[g]; gs = g; }
    float den = 0.f;
#pragma unroll
    for (int g = 0; g < 4; ++g) den += __expf(lg[g] - gm);
    const float pg = 1.f / den;
    gs = __builtin_amdgcn_readfirstlane(gs);
    float el[8];
#pragma unroll
    for (int i = 0; i < 8; ++i) { const float4* wr = (const float4*)(Wr + (size_t)(4 + gs * 8 + i) * DM); float p = 0.f;
#pragma unroll
        for (int j = 0; j < 8; ++j) { const float4 wv = wr[j * 64 + lane]; p += v[j].x * wv.x + v[j].y * wv.y + v[j].z * wv.z + v[j].w * wv.w; }
        el[i] = wave_sum(p) * r2 + bre[gs * 8 + i]; }
    int i1 = 0; float v1 = el[0];
#pragma unroll
    for (int i = 1; i < 8; ++i) if (el[i] > v1) { v1 = el[i]; i1 = i; }
    int i2 = -1; float v2 = -3.0e38f;
#pragma unroll
    for (int i = 0; i < 8; ++i) if (i != i1 && el[i] > v2) { v2 = el[i]; i2 = i; }
    const float e2 = __expf(v2 - v1), w0 = pg / (1.f + e2), w1 = pg * e2 / (1.f + e2);
    if (lane == 0) {
        r2out[t] = r2;
        const int ea = gs * 8 + i1, eb = gs * 8 + i2;
        const int sa = atomicAdd(&cnt[ea], 1); list[ea * T + sa] = 2 * t; wts[2 * t] = w0;
        const int sb = atomicAdd(&cnt[eb], 1); list[eb * T + sb] = 2 * t + 1; wts[2 * t + 1] = w1;
    }
}
__device__ __forceinline__ void final_row(float* __restrict__ out, const bf16_t* __restrict__ Y, const float* __restrict__ g, int t, int lane) {
    float4* xr = (float4*)(out + (size_t)t * DM);
    const uint2* y0 = (const uint2*)(Y + (size_t)(2 * t) * DM); const uint2* y1 = (const uint2*)(Y + (size_t)(2 * t + 1) * DM);
    float4 v[8]; float ss = 0.f;
#pragma unroll
    for (int j = 0; j < 8; ++j) { float4 a = xr[j * 64 + lane]; const uint2 p = y0[j * 64 + lane], q = y1[j * 64 + lane];
        a.x += bf2f(p.x & 0xffffu) + bf2f(q.x & 0xffffu); a.y += bf2f(p.x >> 16) + bf2f(q.x >> 16); a.z += bf2f(p.y & 0xffffu) + bf2f(q.y & 0xffffu); a.w += bf2f(p.y >> 16) + bf2f(q.y >> 16);
        v[j] = a; ss += a.x * a.x + a.y * a.y + a.z * a.z + a.w * a.w; }
    const float r = rsqrtf(wave_sum(ss) * (1.f / DM) + EPS);
#pragma unroll
    for (int j = 0; j < 8; ++j) { const float4 gv = ((const float4*)g)[j * 64 + lane]; float4 a = v[j]; a.x *= r * gv.x; a.y *= r * gv.y; a.z *= r * gv.z; a.w *= r * gv.w; xr[j * 64 + lane] = a; }
}


namespace g8 {
typedef unsigned u32x4 __attribute__((ext_vector_type(4)));
constexpr int BM = 256, BK = 64, HALF = 128, HTB = HALF * BK * 2, STAGE_BYTES = 8 * HTB, NXCD = 8, WGM = 8;
__device__ __forceinline__ int lds_byte(int r, int c) { const int st = (r >> 4) * 2 + (c >> 5), rr = r & 15, cc = c & 31, ob = rr * 64 + cc * 2; return st * 1024 + (ob ^ (((ob >> 9) & 1) << 5)); }
__device__ __forceinline__ void stage_rc(int b, int& R, int& C) { const int st = b / 1024, sb = b % 1024, swz = sb ^ (((sb >> 9) & 1) << 5); R = (st >> 1) * 16 + swz / 64; C = (st & 1) * 32 + (swz % 64) / 2; }
__device__ __forceinline__ int perm32(int rho) { const int n = rho >> 4, i = rho & 15; return 8 * (i >> 2) + 4 * n + (i & 3); }
__device__ __forceinline__ unsigned cvt_pk_bf16(float lo, float hi) { unsigned r; asm volatile("v_cvt_pk_bf16_f32 %0, %1, %2" : "=v"(r) : "v"(lo), "v"(hi)); return r; }
__device__ __forceinline__ int xcd_remap(int wgid, int nwg) { const int q = nwg / NXCD, r = nwg % NXCD, xcd = wgid % NXCD, off = wgid / NXCD; return (xcd < r ? xcd * (q + 1) : r * (q + 1) + (xcd - r) * q) + off; }

struct Unit { int pm, pn, e; const char* a; const char* b; };

struct DenseOrder {
    const char* A; const char* Bt; int K, nM, nN, nwg, G, c;
    __device__ __forceinline__ void init(const void* A_, const void* Bt_, int M, int N, int K_, int G_, int c_) { A = (const char*)A_; Bt = (const char*)Bt_; K = K_; nM = M / BM; nN = N / BM; nwg = nM * nN; G = G_; c = c_; }
    __device__ __forceinline__ bool next(int i, Unit& u) const {
        const int L = i * G + c; if (L >= nwg) return false;
        const int wgid = xcd_remap(L, nwg);
        const int nig = WGM * nN, gid = wgid / nig, fm = gid * WGM, gsz = (nM - fm) < WGM ? (nM - fm) : WGM;
        u.pm = fm + ((wgid % nig) % gsz); u.pn = (wgid % nig) / gsz; u.e = i;
        u.a = A + (size_t)u.pm * BM * K * 2; u.b = Bt + (size_t)u.pn * BM * K * 2; return true;
    }
    __device__ __forceinline__ unsigned arow_off(const Unit&, int r, int Kb) const { return (unsigned)r * (unsigned)Kb; }
};
template <bool GATHER> struct MoeOrder {
    const char* A; const char* Bt; const int* list; LAS const int* pl; int K, NPN, nwg, G, c; size_t estride;
    __device__ __forceinline__ bool next(int i, Unit& u) const {
        const int L = i * G + c; if (L >= nwg) return false;
        const int wgid = xcd_remap(L, nwg);
        u.pm = wgid / NPN; u.pn = wgid % NPN; u.e = pl[64 + u.pm];
        u.a = GATHER ? A : A + (size_t)u.pm * BM * K * 2; u.b = Bt + (size_t)u.e * estride + (size_t)u.pn * BM * K * 2; return true;
    }
    __device__ __forceinline__ int pair_of(const Unit& u, int r) const { const int slot = u.pm * BM + r - pl[32 + u.e]; return slot < pl[u.e] ? list[u.e * T + slot] : -1; }
    __device__ __forceinline__ unsigned arow_off(const Unit& u, int r, int Kb) const {
        if (GATHER) { const int pr = pair_of(u, r); return (unsigned)(pr >= 0 ? (pr >> 1) : 0) * (unsigned)Kb; }
        return (unsigned)r * (unsigned)Kb;
    }
};

template <bool GATHER, class Epi, class Sched>
__device__ __forceinline__ void gemm_phase(LAS unsigned char* lds, const int K, const Sched& S, const Epi& E) {
    const int tid = threadIdx.x, wid = __builtin_amdgcn_readfirstlane(tid >> 6), lane = tid & 63, wr = wid >> 2, wc = wid & 3, fr = lane & 15, fq = lane >> 4;
    const int nt = K / BK, Kb = K * 2;
    int RA[2], CA[2]; unsigned voffB[2];
#pragma unroll
    for (int i = 0; i < 2; ++i) { int R, C; stage_rc(tid * 16 + i * 8192, R, C); RA[i] = R; CA[i] = C * 2; const int Rb = Epi::PERM ? ((R & ~31) + perm32(R & 31)) : R; voffB[i] = (unsigned)(Rb * K + C) * 2u; }
    const size_t kstep = (size_t)(BK * 2);
    const size_t hstep = (size_t)HALF * K * 2;
    const unsigned ldsw = (unsigned)wid * 1024u;
    const int aoff = lds_byte(wr * 64 + fr, fq * 8), boff = lds_byte(wc * 32 + fr, fq * 8);
#define G8_SA(b, h) (((b) * 2 + (h)) * HTB)
#define G8_SB(b, h) ((4 + (b) * 2 + (h)) * HTB)
#define G8_STAGE(bufoff, gbase, voff) do { _Pragma("unroll") for (int _i = 0; _i < 2; ++_i) \
        __builtin_amdgcn_global_load_lds((const unsigned*)((const char*)(gbase) + (voff)[_i]), (LAS unsigned*)(lds + (bufoff) + ldsw + _i * 8192), 16, 0, 0); } while (0)
#define G8_LDA(dst, b, h) do { _Pragma("unroll") for (int m = 0; m < 4; ++m) _Pragma("unroll") for (int k = 0; k < 2; ++k) dst[m][k] = *(const LAS bf16x8*)(lds + G8_SA(b, h) + aoff + m * 2048 + k * 1024); } while (0)
#define G8_LDB(dst, b, h) do { _Pragma("unroll") for (int n = 0; n < 2; ++n) _Pragma("unroll") for (int k = 0; k < 2; ++k) dst[n][k] = *(const LAS bf16x8*)(lds + G8_SB(b, h) + boff + n * 2048 + k * 1024); } while (0)
#define G8_MMA(ai, bj, At, Bt) do { __builtin_amdgcn_s_setprio(1); _Pragma("unroll") for (int m = 0; m < 4; ++m) _Pragma("unroll") for (int n = 0; n < 2; ++n) _Pragma("unroll") for (int k = 0; k < 2; ++k) \
        acc[ai][bj][m][n] = __builtin_amdgcn_mfma_f32_16x16x32_bf16(Bt[n][k], At[m][k], acc[ai][bj][m][n], 0, 0, 0); __builtin_amdgcn_s_setprio(0); } while (0)
#define G8_WAIT_V(n) asm volatile("s_waitcnt vmcnt(" #n ")" ::: "memory")
#define G8_WAIT_L(n) asm volatile("s_waitcnt lgkmcnt(" #n ")" ::: "memory")
#define G8_BAR __builtin_amdgcn_s_barrier()
#define G8_SCHED __builtin_amdgcn_sched_barrier(0)
    Unit cur, nxt; int ui = 0;
    if (!S.next(0, cur)) return;
    f32x4 acc[2][2][4][2];
#pragma unroll
    for (int a = 0; a < 2; ++a)
#pragma unroll
        for (int b = 0; b < 2; ++b)
#pragma unroll
            for (int m = 0; m < 4; ++m)
#pragma unroll
                for (int n = 0; n < 2; ++n) acc[a][b][m][n] = (f32x4){0.f, 0.f, 0.f, 0.f};
    bf16x8 At[4][2], B0[2][2], B1[2][2];
    unsigned vA[2][2], vN[2][2];
#pragma unroll
    for (int h = 0; h < 2; ++h)
#pragma unroll
        for (int i = 0; i < 2; ++i) { vA[h][i] = S.arow_off(cur, h * HALF + RA[i], Kb) + (unsigned)CA[i]; vN[h][i] = vA[h][i]; }
    const char* cA = cur.a; const char* cB = cur.b;
    G8_STAGE(G8_SB(0, 0), cB, voffB); G8_STAGE(G8_SB(0, 1), cB + hstep, voffB); G8_STAGE(G8_SA(0, 0), cA, vA[0]); G8_STAGE(G8_SA(0, 1), cA, vA[1]);
    if (wr == 1) G8_BAR;
    G8_WAIT_V(2); G8_BAR;
    G8_STAGE(G8_SB(1, 0), cB + kstep, voffB); G8_STAGE(G8_SA(1, 0), cA + kstep, vA[0]); G8_STAGE(G8_SB(1, 1), cB + hstep + kstep, voffB);
    G8_WAIT_V(6); G8_BAR;
    for (;;) {
        const bool has_next = S.next(ui + 1, nxt);
        const char* nA = has_next ? nxt.a : cA; const char* nB = has_next ? nxt.b : cB;
        if (GATHER && has_next) {
#pragma unroll
            for (int h = 0; h < 2; ++h)
#pragma unroll
                for (int i = 0; i < 2; ++i) vN[h][i] = S.arow_off(nxt, h * HALF + RA[i], Kb) + (unsigned)CA[i];
        }
        for (int t = 0; t < nt; t += 2) {
            const bool last = (t == nt - 2);
            if (Epi::MID_T >= 0 && t == Epi::MID_T) E.mid(acc, cur, wr, wc, fr, fq);
            const char* a1 = cA + (size_t)(t + 1) * kstep;
            const char* a2 = last ? nA : cA + (size_t)(t + 2) * kstep; const char* b2 = last ? nB : cB + (size_t)(t + 2) * kstep;
            const char* a3 = a2 + kstep; const char* b3 = b2 + kstep;
            unsigned v2[2][2];
#pragma unroll
            for (int h = 0; h < 2; ++h)
#pragma unroll
                for (int i = 0; i < 2; ++i) v2[h][i] = (GATHER && last) ? vN[h][i] : vA[h][i];
            G8_LDB(B0, 0, 0); G8_LDB(B1, 0, 1); G8_SCHED; G8_LDA(At, 0, 0); G8_STAGE(G8_SA(1, 1), a1, vA[1]);
            G8_WAIT_V(8); G8_WAIT_L(0); G8_BAR; G8_MMA(0, 0, At, B0); G8_MMA(0, 1, At, B1); G8_BAR; G8_SCHED;
            G8_LDA(At, 0, 1); G8_STAGE(G8_SB(0, 0), b2, voffB); G8_STAGE(G8_SB(0, 1), b2 + hstep, voffB); G8_STAGE(G8_SA(0, 0), a2, v2[0]);
            G8_WAIT_V(8); G8_WAIT_L(0); G8_BAR; G8_MMA(1, 0, At, B0); G8_MMA(1, 1, At, B1); G8_BAR; G8_SCHED;
            G8_LDB(B0, 1, 0); G8_LDB(B1, 1, 1); G8_SCHED; G8_LDA(At, 1, 0); G8_STAGE(G8_SA(0, 1), a2, v2[1]);
            G8_WAIT_V(8); G8_WAIT_L(0); G8_BAR; G8_MMA(0, 0, At, B0); G8_MMA(0, 1, At, B1); G8_BAR; G8_SCHED;
            G8_LDA(At, 1, 1); G8_STAGE(G8_SB(1, 0), b3, voffB); G8_STAGE(G8_SB(1, 1), b3 + hstep, voffB); G8_STAGE(G8_SA(1, 0), a3, v2[0]);
            G8_WAIT_V(8); G8_WAIT_L(0); G8_BAR; G8_MMA(1, 0, At, B0); G8_MMA(1, 1, At, B1); G8_BAR; G8_SCHED;
        }
        if (wr == 0) G8_BAR;
        E(acc, cur, wr, wc, fr, fq);
        if (!has_next) break;
#pragma unroll
        for (int a = 0; a < 2; ++a)
#pragma unroll
            for (int b = 0; b < 2; ++b)
#pragma unroll
                for (int m = 0; m < 4; ++m)
#pragma unroll
                    for (int n = 0; n < 2; ++n) acc[a][b][m][n] = (f32x4){0.f, 0.f, 0.f, 0.f};
        cur = nxt; cA = nA; cB = nB; ++ui;
#pragma unroll
        for (int h = 0; h < 2; ++h)
#pragma unroll
            for (int i = 0; i < 2; ++i) vA[h][i] = vN[h][i];
        if (wr == 1) G8_BAR;
    }
    G8_WAIT_V(0);
    G8_BAR;
#undef G8_SA
#undef G8_SB
#undef G8_STAGE
#undef G8_LDA
#undef G8_LDB
#undef G8_MMA
#undef G8_WAIT_V
#undef G8_WAIT_L
#undef G8_BAR
#undef G8_SCHED
}

struct EpiProjF { static constexpr bool PERM = true; static constexpr int MID_T = -1; bf16_t* out; const float* r1;
    __device__ __forceinline__ void mid(f32x4 (&)[2][2][4][2], const Unit&, int, int, int, int) const {}
    __device__ __forceinline__ void operator()(const f32x4 (&acc)[2][2][4][2], const Unit& u, int wr, int wc, int fr, int fq) const {
        const int row0 = u.pm * BM + wr * 64 + fr, col0 = u.pn * BM + wc * 32 + 8 * fq;
#pragma unroll
        for (int ai = 0; ai < 2; ++ai)
#pragma unroll
            for (int m = 0; m < 4; ++m) { const int row = row0 + ai * HALF + m * 16; const float s = r1[row]; bf16_t* rowp = out + (size_t)row * NPROJ + col0;
#pragma unroll
                for (int bj = 0; bj < 2; ++bj) { const f32x4 v0 = acc[ai][bj][m][0] * s, v1 = acc[ai][bj][m][1] * s; u32x4 w; w.x = cvt_pk_bf16(v0[0], v0[1]); w.y = cvt_pk_bf16(v0[2], v0[3]); w.z = cvt_pk_bf16(v1[0], v1[1]); w.w = cvt_pk_bf16(v1[2], v1[3]);
                    *(u32x4*)(rowp + bj * HALF) = w; } }
    }
};
struct EpiG2F { static constexpr bool PERM = false; static constexpr int MID_T = DATT / BK; const float* x; float* x1; bf16_t* xb1; LAS const float* tab; int G;
    __device__ __forceinline__ void mid(f32x4 (&acc)[2][2][4][2], const Unit& u, int wr, int wc, int fr, int fq) const {
        LAS const float* tb = tab + (size_t)(u.e) * 512;
#pragma unroll
        for (int ai = 0; ai < 2; ++ai)
#pragma unroll
            for (int m = 0; m < 4; ++m) { const float s = tb[(ai * HALF + wr * 64 + m * 16 + fr) * 2];
#pragma unroll
                for (int bj = 0; bj < 2; ++bj)
#pragma unroll
                    for (int n = 0; n < 2; ++n) acc[ai][bj][m][n] *= s; }
    }
    __device__ __forceinline__ void operator()(const f32x4 (&acc)[2][2][4][2], const Unit& u, int wr, int wc, int fr, int fq) const {
        LAS const float* tb = tab + (size_t)(u.e) * 512;
        const int col0 = u.pn * BM + wc * 32 + 4 * fq;
#pragma unroll
        for (int ai = 0; ai < 2; ++ai)
#pragma unroll
            for (int m = 0; m < 4; ++m) { const int r = ai * HALF + wr * 64 + m * 16 + fr; const float s = tb[r * 2 + 1]; const size_t off = (size_t)(u.pm * BM + r) * DM + col0;
#pragma unroll
                for (int bj = 0; bj < 2; ++bj)
#pragma unroll
                    for (int n = 0; n < 2; ++n) { const f32x4 xv = *(const f32x4*)(x + off + bj * HALF + n * 16); const f32x4 o = xv + acc[ai][bj][m][n] * s;
                        *(f32x4*)(x1 + off + bj * HALF + n * 16) = o; *(uint2*)(xb1 + off + bj * HALF + n * 16) = make_uint2(cvt_pk_bf16(o[0], o[1]), cvt_pk_bf16(o[2], o[3])); } }
    }
};
template <class Sched> struct EpiGUF { static constexpr bool PERM = true; static constexpr int MID_T = -1; bf16_t* Hb; const float* r2; const Sched* S;
    __device__ __forceinline__ void mid(f32x4 (&)[2][2][4][2], const Unit&, int, int, int, int) const {}
    __device__ __forceinline__ void operator()(const f32x4 (&acc)[2][2][4][2], const Unit& u, int wr, int wc, int fr, int fq) const {
        const int col0 = u.pn * HALF + wc * 32 + 8 * fq;
#pragma unroll
        for (int ai = 0; ai < 2; ++ai)
#pragma unroll
            for (int m = 0; m < 4; ++m) { const int r = ai * HALF + wr * 64 + m * 16 + fr; const int pr = S->pair_of(u, r); const float s = r2[pr >= 0 ? (pr >> 1) : 0];
                float h[8];
#pragma unroll
                for (int n = 0; n < 2; ++n)
#pragma unroll
                    for (int q = 0; q < 4; ++q) { const float gg = acc[ai][0][m][n][q] * s, uu = acc[ai][1][m][n][q] * s; h[4 * n + q] = gg * __builtin_amdgcn_rcpf(1.f + __expf(-gg)) * uu; }
                u32x4 w; w.x = cvt_pk_bf16(h[0], h[1]); w.y = cvt_pk_bf16(h[2], h[3]); w.z = cvt_pk_bf16(h[4], h[5]); w.w = cvt_pk_bf16(h[6], h[7]);
                *(u32x4*)(Hb + (size_t)(u.pm * BM + r) * DEXP + col0) = w; }
    }
};
template <class Sched> struct EpiDownF { static constexpr bool PERM = true; static constexpr int MID_T = -1; bf16_t* Y; const float* wts; const Sched* S;
    __device__ __forceinline__ void mid(f32x4 (&)[2][2][4][2], const Unit&, int, int, int, int) const {}
    __device__ __forceinline__ void operator()(const f32x4 (&acc)[2][2][4][2], const Unit& u, int wr, int wc, int fr, int fq) const {
        const int col0 = u.pn * BM + wc * 32 + 8 * fq;
#pragma unroll
        for (int ai = 0; ai < 2; ++ai)
#pragma unroll
            for (int m = 0; m < 4; ++m) { const int r = ai * HALF + wr * 64 + m * 16 + fr; const int pr = S->pair_of(u, r); if (pr < 0) continue; const float s = wts[pr]; bf16_t* rowp = Y + (size_t)pr * DM + col0;
#pragma unroll
                for (int bj = 0; bj < 2; ++bj) { const f32x4 v0 = acc[ai][bj][m][0] * s, v1 = acc[ai][bj][m][1] * s; u32x4 w; w.x = cvt_pk_bf16(v0[0], v0[1]); w.y = cvt_pk_bf16(v0[2], v0[3]); w.z = cvt_pk_bf16(v1[0], v1[1]); w.w = cvt_pk_bf16(v1[2], v1[3]);
                    *(u32x4*)(rowp + bj * HALF) = w; } }
    }
};
}

__global__ void __launch_bounds__(NTHREADS, 2) mega(Params p) {
    extern __shared__ __attribute__((aligned(16))) unsigned char lds[];
    cg::grid_group grid = cg::this_grid();
    Ctx c; c.tid = threadIdx.x; c.lane = c.tid & 63; c.wave = __builtin_amdgcn_readfirstlane(c.tid >> 6); c.gw = blockIdx.x * NWAVES + c.wave; c.ngw = gridDim.x * NWAVES;
    char* ws = p.ws;
    int* cnt = (int*)(ws + WS_CTL);
    float* r1 = (float*)(ws + WS_R1); float* r2 = (float*)(ws + WS_R2); float* ssC = (float*)(ws + WS_SSC);
    float* wts = (float*)(ws + WS_WTS); float* Wr = (float*)(ws + WS_WR); float* ssA = (float*)(ws + WS_SSA); int* list = (int*)(ws + WS_LIST);
    bf16_t* W2t = (bf16_t*)(ws + WS_W2T); bf16_t* W1t = (bf16_t*)(ws + WS_W1T); bf16_t* Wdt = (bf16_t*)(ws + WS_WDT); bf16_t* Wgut = (bf16_t*)(ws + WS_WGUT);
    bf16_t* xb = (bf16_t*)(ws + WS_XB); bf16_t* mix = (bf16_t*)(ws + WS_MIX); bf16_t* proj = (bf16_t*)(ws + WS_PROJ); bf16_t* Y = (bf16_t*)(ws + WS_Y); bf16_t* Hb = (bf16_t*)(ws + WS_H);

    {
        if (blockIdx.x == 0 && c.tid < 64) cnt[c.tid] = 0;
        for (int row = c.gw; row < T; row += c.ngw) p0_x_row(p.x, xb, r1, row, c.lane);
        LAS float* scr = (LAS float*)lds + c.wave * (64 * 33);
        constexpr int I_IN = (DM / 64) * (NPROJ / 32), I_OUT = (DM / 64) * (DM / 32), I_G = NE * (DM / 64) * (DEXP / 32), I_D = NE * (DEXP / 64) * (DM / 32);
        constexpr int NIT = I_IN + I_OUT + 2 * I_G + I_D;
        for (int it = c.gw; it < NIT; it += c.ngw) {
            int r = it;
            if (r < I_IN) { const int nb = NPROJ / 32, kb = r / nb, n0 = (r % nb) * 32; p0_titem(p.w_in, NPROJ, p.norm1, W1t, DM, kb * 64, n0, n0, scr, c.lane); continue; } r -= I_IN;
            if (r < I_OUT) { const int nb = DM / 32, kb = r / nb, n0 = (r % nb) * 32, k0 = kb * 64;
                const float* g = k0 < DATT ? p.g_oa + k0 : p.g_oc + (k0 - DATT);
                p0_titem(p.w_out + (size_t)k0 * DM, DM, g, W2t + k0, DM, 0, n0, n0, scr, c.lane); continue; } r -= I_OUT;
            if (r < 2 * I_G) { const int up = r >= I_G; if (up) r -= I_G; const int per = (DM / 64) * (DEXP / 32), e = r / per, q = r % per, nb = DEXP / 32, kb = q / nb, n0 = (q % nb) * 32;
                p0_titem((up ? p.w_up : p.w_gate) + (size_t)e * DM * DEXP, DEXP, p.norm2, Wgut + (size_t)e * 2 * DEXP * DM, DM, kb * 64, n0, gu_row(n0, up), scr, c.lane); continue; } r -= 2 * I_G;
            { const int per = (DEXP / 64) * (DM / 32), e = r / per, q = r % per, nb = DM / 32, kb = q / nb, n0 = (q % nb) * 32;
              p0_titem(p.w_down + (size_t)e * DEXP * DM, DM, nullptr, Wdt + (size_t)e * DM * DEXP, DEXP, kb * 64, n0, n0, scr, c.lane); }
        }
        for (int i = blockIdx.x * NTHREADS + c.tid; i < 36 * DM; i += gridDim.x * NTHREADS) { const int o = i / DM, k = i % DM; Wr[i] = p.norm2[k] * (o < 4 ? p.w_rg[k * 4 + o] : p.w_re[k * 32 + (o - 4)]); }
    }
    grid.sync();
    {
        g8::DenseOrder S; S.init(xb, W1t, T, NPROJ, DM, (int)gridDim.x, (int)blockIdx.x);
        const g8::EpiProjF E{proj, r1};
        g8::gemm_phase<false>((LAS unsigned char*)lds, DM, S, E);
    }
    grid.sync();
    {
        for (int it = c.gw; it < NB * 64 * NH; it += c.ngw) attn_simple(proj, p.relb, mix, ssA, it, c.lane);
        for (int t = c.gw; t < T; t += c.ngw) conv_row(proj, p.conv_w, mix, ssC, t, c.lane);
    }
    grid.sync();
    {
        g8::DenseOrder S; S.init(mix, W2t, T, DM, DM, (int)gridDim.x, (int)blockIdx.x);
        LAS float* tab = (LAS float*)(lds + 131072);
        g8::Unit u;
        for (int i = 0; i < 4; ++i) if (S.next(i, u) && c.tid < 256) { const int row = u.pm * 256 + c.tid; float sa = 0.f;
#pragma unroll
            for (int h = 0; h < 16; ++h) sa += ssA[row * 16 + h];
            const float ra = rsqrtf(sa * (1.f / DATT) + EPS), rc = rsqrtf(ssC[row] * (1.f / DCONV) + EPS);
            tab[(i * 256 + c.tid) * 2] = ra / rc; tab[(i * 256 + c.tid) * 2 + 1] = rc; }
        __syncthreads();
        const g8::EpiG2F E{p.x, p.out, xb, tab, (int)gridDim.x};
        g8::gemm_phase<false>((LAS unsigned char*)lds, DM, S, E);
    }
    grid.sync();
    for (int t = c.gw; t < T; t += c.ngw) router_row(p.out, Wr, p.b_rg, p.b_re, cnt, list, wts, r2, t, c.lane);
    grid.sync();
    LAS int* pl = (LAS int*)(lds + LDS_PLAN_OFF);
    if (c.tid == 0) { int tl = 0;
        for (int e = 0; e < NE; ++e) { const int ce = cnt[e]; pl[e] = ce; pl[32 + e] = tl * 256; const int mt = (ce + 255) >> 8; for (int i = 0; i < mt; ++i) pl[64 + tl + i] = e; tl += mt; }
        for (int i = tl; i < NTILEMAX; ++i) pl[64 + i] = -1;
        pl[224] = tl; }
    __syncthreads();
    const int ntile = pl[224];
    {
        const g8::MoeOrder<true> S{(const char*)xb, (const char*)Wgut, list, pl, DM, 4, ntile * 4, (int)gridDim.x, (int)blockIdx.x, (size_t)2 * DEXP * DM * 2};
        const g8::EpiGUF<g8::MoeOrder<true>> E{Hb, r2, &S};
        g8::gemm_phase<true>((LAS unsigned char*)lds, DM, S, E);
    }
    grid.sync();
    {
        const g8::MoeOrder<false> S{(const char*)Hb, (const char*)Wdt, list, pl, DEXP, 8, ntile * 8, (int)gridDim.x, (int)blockIdx.x, (size_t)DM * DEXP * 2};
        const g8::EpiDownF<g8::MoeOrder<false>> E{Y, wts, &S};
        g8::gemm_phase<false>((LAS unsigned char*)lds, DEXP, S, E);
    }
    grid.sync();
    for (int t = c.gw; t < T; t += c.ngw) final_row(p.out, Y, p.norm_f, t, c.lane);
}

extern "C" void kernel_launch(void* const* d_in, const int* in_sizes, int n_in, void* d_out, int out_size, void* d_ws, size_t ws_size, hipStream_t stream) {
    static int grid = 0;
    if (grid == 0) {
        int dev = 0, cus = 0, per_cu = 0;
        if (ws_size < WS_END || n_in != 17) { fprintf(stderr, "kernel_launch: unexpected sizes (ws %zu)\n", ws_size); grid = -1; return; }
        (void)hipGetDevice(&dev); (void)hipDeviceGetAttribute(&cus, hipDeviceAttributeMultiprocessorCount, dev);
        if (hipFuncSetAttribute((const void*)mega, hipFuncAttributeMaxDynamicSharedMemorySize, LDS_BYTES) != hipSuccess) { fprintf(stderr, "hipFuncSetAttribute failed\n"); grid = -1; return; }
        if (hipOccupancyMaxActiveBlocksPerMultiprocessor(&per_cu, (const void*)mega, NTHREADS, LDS_BYTES) != hipSuccess || per_cu < 1) { fprintf(stderr, "occupancy query failed (%d)\n", per_cu); grid = -1; return; }
        grid = cus * per_cu;
        fprintf(stderr, "kernel_launch: cus %d per_cu %d grid %d\n", cus, per_cu, grid);
    }
    if (grid < 0) return;
    Params p{};
    p.x = (const float*)d_in[0]; p.norm1 = (const float*)d_in[1]; p.w_in = (const float*)d_in[2]; p.relb = (const float*)d_in[3];
    p.conv_w = (const float*)d_in[4]; p.g_oa = (const float*)d_in[5]; p.g_oc = (const float*)d_in[6]; p.w_out = (const float*)d_in[7];
    p.norm2 = (const float*)d_in[8]; p.w_rg = (const float*)d_in[9]; p.b_rg = (const float*)d_in[10]; p.w_re = (const float*)d_in[11];
    p.b_re = (const float*)d_in[12]; p.w_gate = (const float*)d_in[13]; p.w_up = (const float*)d_in[14]; p.w_down = (const float*)d_in[15];
    p.norm_f = (const float*)d_in[16]; p.out = (float*)d_out; p.ws = (char*)d_ws;
    void* args[] = {&p};
    hipError_t e = hipLaunchCooperativeKernel((const void*)mega, dim3(grid), dim3(NTHREADS), args, LDS_BYTES, stream);
    if (e != hipSuccess) fprintf(stderr, "cooperative launch failed: %s (grid %d)\n", hipGetErrorString(e), grid);
}
```

```cpp
#include <hip/hip_runtime.h>
#include <hip/hip_cooperative_groups.h>
#include <stdint.h>
#include <cstdio>
namespace cg = cooperative_groups;

typedef unsigned short bf16_t;
typedef short bf16x8 __attribute__((ext_vector_type(8)));
typedef float f32x4 __attribute__((ext_vector_type(4)));

constexpr int NB = 4, SEQ = 4096, T = NB * SEQ, DM = 2048, DATT = 1024, DCONV = 1024, NPROJ = 6144;
constexpr int NH = 16, HD = 64, NREL = 513, NE = 32, DEXP = 512, NPAIR = 2 * T;
constexpr int NPADMAX = 40960, NTILEMAX = NPADMAX / 256;
constexpr float EPS = 1e-6f;
constexpr float LOG2E = 1.4426950408889634f, QSCALE = 0.125f * LOG2E;

constexpr size_t MiB = 1u << 20;
constexpr size_t WS_CTL = 0;
constexpr size_t WS_PLAN = 64 * 1024;
constexpr size_t WS_R1 = 128 * 1024;
constexpr size_t WS_RA = 192 * 1024;
constexpr size_t WS_RC = 256 * 1024;
constexpr size_t WS_R2 = 320 * 1024;
constexpr size_t WS_SSC = 3 * MiB;
constexpr size_t WS_WTS = 512 * 1024;
constexpr size_t WS_ROWPAIR = 640 * 1024;
constexpr size_t WS_WR = 1 * MiB;
constexpr size_t WS_SSA = 2 * MiB;
constexpr size_t WS_LIST = 5 * MiB;
constexpr size_t WS_W2T = 8 * MiB;
constexpr size_t WS_W1T = 16 * MiB;
constexpr size_t WS_WDT = 40 * MiB;
constexpr size_t WS_WGUT = 104 * MiB;
constexpr size_t WS_XB = 232 * MiB;
constexpr size_t WS_MIX = 296 * MiB;
constexpr size_t WS_PROJ = 360 * MiB;
constexpr size_t WS_Y = 360 * MiB;
constexpr size_t WS_H = 488 * MiB;
constexpr size_t WS_END = 552 * MiB;

__device__ __forceinline__ unsigned f2bf(float f) { unsigned u = __float_as_uint(f); return (u + 0x7fffu + ((u >> 16) & 1u)) >> 16; }
__device__ __forceinline__ unsigned pk2(float lo, float hi) { return f2bf(lo) | (f2bf(hi) << 16); }
__device__ __forceinline__ float bf2f(unsigned h) { return __uint_as_float(h << 16); }
__device__ __forceinline__ float wave_sum(float v) {
#pragma unroll
    for (int o = 1; o < 64; o <<= 1) v += __shfl_xor(v, o);
    return v;
}


#define LAS __attribute__((address_space(3)))
constexpr int NWAVES = 8, NTHREADS = 512;
constexpr int LDS_BYTES = 147456;
constexpr int LDS_PLAN_OFF = 140 * 1024;

struct Params {
    const float *x, *norm1, *w_in, *relb, *conv_w, *g_oa, *g_oc, *w_out, *norm2, *w_rg, *b_rg, *w_re, *b_re, *w_gate, *w_up, *w_down, *norm_f;
    float* out; char* ws;
};
struct Ctx { int tid, lane, wave, gw, ngw; };

__device__ __forceinline__ void p0_x_row(const float* __restrict__ x, bf16_t* __restrict__ xb, float* __restrict__ r1, int row, int lane) {
    const float4* xr = (const float4*)(x + (size_t)row * DM);
    uint2* o = (uint2*)(xb + (size_t)row * DM);
    float ss = 0.f;
#pragma unroll
    for (int j = 0; j < 8; ++j) { float4 v = xr[j * 64 + lane]; ss += v.x * v.x + v.y * v.y + v.z * v.z + v.w * v.w; o[j * 64 + lane] = make_uint2(pk2(v.x, v.y), pk2(v.z, v.w)); }
    ss = wave_sum(ss);
    if (lane == 0) r1[row] = rsqrtf(ss * (1.f / DM) + EPS);
}
__device__ __forceinline__ void p0_titem(const float* __restrict__ W, int N, const float* __restrict__ g, bf16_t* __restrict__ WT, int ldd, int k0, int n0, int drow0, LAS float* scr, int lane, float cs = 1.f) {
#pragma unroll 8
    for (int i = 0; i < 32; ++i) { const int kk = 2 * i + (lane >> 5); const float s = (g ? g[k0 + kk] : 1.f) * cs; scr[kk * 33 + (lane & 31)] = W[(size_t)(k0 + kk) * N + n0 + (lane & 31)] * s; }
    asm volatile("s_waitcnt lgkmcnt(0)" ::: "memory");
    const int c = lane & 7;
#pragma unroll
    for (int j = 0; j < 4; ++j) { const int n = (lane >> 3) + 8 * j; const LAS float* sp = scr + (8 * c) * 33 + n;
        uint4 o; o.x = pk2(sp[0 * 33], sp[1 * 33]); o.y = pk2(sp[2 * 33], sp[3 * 33]); o.z = pk2(sp[4 * 33], sp[5 * 33]); o.w = pk2(sp[6 * 33], sp[7 * 33]);
        *(uint4*)(WT + (size_t)(drow0 + n) * ldd + k0 + 8 * c) = o; }
    asm volatile("s_waitcnt lgkmcnt(0)" ::: "memory");
}
__device__ __forceinline__ int gu_row(int n, int up) { return ((n >> 7) << 8) + (n & 127) + (up ? 128 : 0); }

template <int MODE, class Epi>
__device__ __forceinline__ void sg_tile(const bf16_t* A, int lda, const bf16_t* B, int ldb, int K, int kmid, int r0, int c0, const int (&arow)[2], int lane, const Epi& epi) {
    const int fr = lane & 15, fq = lane >> 4;
    const bf16_t* ap[2]; const bf16_t* bp[2];
#pragma unroll
    for (int i = 0; i < 2; ++i) ap[i] = A + (size_t)arow[i] * lda + 8 * fq;
#pragma unroll
    for (int j = 0; j < 2; ++j) { const int n = c0 + 16 * j + fr; const int brow = (MODE == 2) ? gu_row(n, 0) : n; bp[j] = B + (size_t)brow * ldb + 8 * fq; }
    f32x4 acc0[2][2], acc1[2][2];
#pragma unroll
    for (int i = 0; i < 2; ++i)
#pragma unroll
        for (int j = 0; j < 2; ++j) { acc0[i][j] = (f32x4){0.f, 0.f, 0.f, 0.f}; acc1[i][j] = (f32x4){0.f, 0.f, 0.f, 0.f}; }
    for (int k = 0; k < K; k += 32) {
        bf16x8 a[2], b0[2], b1[2];
#pragma unroll
        for (int i = 0; i < 2; ++i) a[i] = *(const bf16x8*)(ap[i] + k);
#pragma unroll
        for (int j = 0; j < 2; ++j) { b0[j] = *(const bf16x8*)(bp[j] + k); if (MODE == 2) b1[j] = *(const bf16x8*)(bp[j] + (size_t)128 * ldb + k); else b1[j] = b0[j]; }
        if (MODE == 1) {
            if (k < kmid) {
#pragma unroll
                for (int i = 0; i < 2; ++i)
#pragma unroll
                    for (int j = 0; j < 2; ++j) acc0[i][j] = __builtin_amdgcn_mfma_f32_16x16x32_bf16(b0[j], a[i], acc0[i][j], 0, 0, 0);
            } else {
#pragma unroll
                for (int i = 0; i < 2; ++i)
#pragma unroll
                    for (int j = 0; j < 2; ++j) acc1[i][j] = __builtin_amdgcn_mfma_f32_16x16x32_bf16(b0[j], a[i], acc1[i][j], 0, 0, 0);
            }
        } else {
#pragma unroll
            for (int i = 0; i < 2; ++i)
#pragma unroll
                for (int j = 0; j < 2; ++j) { acc0[i][j] = __builtin_amdgcn_mfma_f32_16x16x32_bf16(b0[j], a[i], acc0[i][j], 0, 0, 0);
                    if (MODE == 2) acc1[i][j] = __builtin_amdgcn_mfma_f32_16x16x32_bf16(b1[j], a[i], acc1[i][j], 0, 0, 0); }
        }
    }
#pragma unroll
    for (int i = 0; i < 2; ++i)
#pragma unroll
        for (int j = 0; j < 2; ++j) epi(acc0[i][j], acc1[i][j], i, r0 + 16 * i + fr, c0 + 16 * j + 4 * fq);
}
struct EpiProj { bf16_t* out; const float* r1;
    __device__ __forceinline__ void operator()(f32x4 a, f32x4, int, int row, int col) const { const float s = r1[row]; *(uint2*)(out + (size_t)row * NPROJ + col) = make_uint2(pk2(a[0] * s, a[1] * s), pk2(a[2] * s, a[3] * s)); } };
struct EpiG2 { const float* x; const float* ssA; const float* ssC; float* x1; bf16_t* xb1;
    __device__ __forceinline__ void operator()(f32x4 a, f32x4 c, int, int row, int col) const {
        float s = 0.f;
#pragma unroll
        for (int h = 0; h < 16; ++h) s += ssA[row * 16 + h];
        const float sa = rsqrtf(s * (1.f / DATT) + EPS), sc = rsqrtf(ssC[row] * (1.f / DCONV) + EPS);
        const float4 xv = *(const float4*)(x + (size_t)row * DM + col);
        float4 o; o.x = xv.x + sa * a[0] + sc * c[0]; o.y = xv.y + sa * a[1] + sc * c[1]; o.z = xv.z + sa * a[2] + sc * c[2]; o.w = xv.w + sa * a[3] + sc * c[3];
        *(float4*)(x1 + (size_t)row * DM + col) = o; *(uint2*)(xb1 + (size_t)row * DM + col) = make_uint2(pk2(o.x, o.y), pk2(o.z, o.w)); } };
struct EpiGU { bf16_t* Hb; const float* r2; int pr[2];
    __device__ __forceinline__ void operator()(f32x4 g, f32x4 u, int i, int row, int col) const { const float s = r2[pr[i] >= 0 ? (pr[i] >> 1) : 0]; float h[4];
#pragma unroll
        for (int q = 0; q < 4; ++q) { const float gg = g[q] * s, uu = u[q] * s; h[q] = gg / (1.f + __expf(-gg)) * uu; }
        *(uint2*)(Hb + (size_t)row * DEXP + col) = make_uint2(pk2(h[0], h[1]), pk2(h[2], h[3])); } };
struct EpiDown { bf16_t* Y; const float* wts; int pr[2];
    __device__ __forceinline__ void operator()(f32x4 a, f32x4, int i, int, int col) const { if (pr[i] < 0) return; const float s = wts[pr[i]];
        *(uint2*)(Y + (size_t)pr[i] * DM + col) = make_uint2(pk2(a[0] * s, a[1] * s), pk2(a[2] * s, a[3] * s)); } };

__device__ __forceinline__ void attn_simple(const bf16_t* __restrict__ proj, const float* __restrict__ relb, bf16_t* __restrict__ mix, float* __restrict__ ssA, int bid, int qi) {
    const int h = bid & 15, c = (bid >> 4) & 63, b = bid >> 10, t = b * SEQ + c * 64 + qi;
    float q[64], o[64];
    { const uint4* qp = (const uint4*)(proj + (size_t)t * NPROJ + h * HD);
#pragma unroll
      for (int i = 0; i < 8; ++i) { const uint4 v = qp[i]; const unsigned w[4] = {v.x, v.y, v.z, v.w};
#pragma unroll
          for (int j = 0; j < 4; ++j) { q[8 * i + 2 * j] = bf2f(w[j] & 0xffffu) * (1.f / LOG2E); q[8 * i + 2 * j + 1] = bf2f(w[j] >> 16) * (1.f / LOG2E); } } }
#pragma unroll
    for (int d = 0; d < 64; ++d) o[d] = 0.f;
    float m = -1e30f, l = 0.f;
    const float* rb = relb + h * NREL;
    const int jc0 = c - 8 < 0 ? 0 : c - 8;
    for (int jc = jc0; jc <= c; ++jc)
        for (int kj = 0; kj < 64; ++kj) {
            const int tk = b * SEQ + jc * 64 + kj;
            const uint4* kp = (const uint4*)(proj + (size_t)tk * NPROJ + DATT + h * HD);
            const uint4* vp = (const uint4*)(proj + (size_t)tk * NPROJ + 2 * DATT + h * HD);
            float s = 0.f;
#pragma unroll
            for (int i = 0; i < 8; ++i) { const uint4 v = kp[i]; const unsigned w[4] = {v.x, v.y, v.z, v.w};
#pragma unroll
                for (int j = 0; j < 4; ++j) { s += q[8 * i + 2 * j] * bf2f(w[j] & 0xffffu); s += q[8 * i + 2 * j + 1] * bf2f(w[j] >> 16); } }
            int dist = (c - jc) * 64 + qi - kj; dist = dist < -256 ? -256 : (dist > 256 ? 256 : dist);
            s += rb[dist + 256];
            const float mn = fmaxf(m, s), al = __expf(m - mn), pp = __expf(s - mn);
            l = l * al + pp; m = mn;
#pragma unroll
            for (int i = 0; i < 8; ++i) { const uint4 v = vp[i]; const unsigned w[4] = {v.x, v.y, v.z, v.w};
#pragma unroll
                for (int j = 0; j < 4; ++j) { o[8 * i + 2 * j] = o[8 * i + 2 * j] * al + pp * bf2f(w[j] & 0xffffu); o[8 * i + 2 * j + 1] = o[8 * i + 2 * j + 1] * al + pp * bf2f(w[j] >> 16); } }
        }
    const float il = 1.f / l; float ss = 0.f;
    uint4* op = (uint4*)(mix + (size_t)t * DM + h * HD);
#pragma unroll
    for (int i = 0; i < 8; ++i) { float v[8];
#pragma unroll
        for (int j = 0; j < 8; ++j) { v[j] = o[8 * i + j] * il; ss += v[j] * v[j]; }
        op[i] = make_uint4(pk2(v[0], v[1]), pk2(v[2], v[3]), pk2(v[4], v[5]), pk2(v[6], v[7])); }
    ssA[t * 16 + h] = ss;
}
__device__ __forceinline__ void conv_row(const bf16_t* __restrict__ proj, const float* __restrict__ cw, bf16_t* __restrict__ mix, float* __restrict__ ssC, int t, int lane) {
    const int s = t & (SEQ - 1); float ss = 0.f;
#pragma unroll
    for (int cc = 0; cc < 4; ++cc) { const int ch = (cc * 64 + lane) * 4;
        float y[4] = {0.f, 0.f, 0.f, 0.f};
#pragma unroll
        for (int j = 0; j < 3; ++j) { const int back = 2 - j; if (s - back < 0) continue;
            const bf16_t* pr = proj + (size_t)(t - back) * NPROJ;
            const uint2 cv = *(const uint2*)(pr + 4 * DATT + ch), uv = *(const uint2*)(pr + 5 * DATT + ch);
            const float4 wv = *(const float4*)(cw + j * DCONV + ch);
            y[0] += wv.x * bf2f(cv.x & 0xffffu) * bf2f(uv.x & 0xffffu); y[1] += wv.y * bf2f(cv.x >> 16) * bf2f(uv.x >> 16);
            y[2] += wv.z * bf2f(cv.y & 0xffffu) * bf2f(uv.y & 0xffffu); y[3] += wv.w * bf2f(cv.y >> 16) * bf2f(uv.y >> 16); }
        const uint2 bv = *(const uint2*)(proj + (size_t)t * NPROJ + 3 * DATT + ch);
        y[0] *= bf2f(bv.x & 0xffffu); y[1] *= bf2f(bv.x >> 16); y[2] *= bf2f(bv.y & 0xffffu); y[3] *= bf2f(bv.y >> 16);
        *(uint2*)(mix + (size_t)t * DM + DATT + ch) = make_uint2(pk2(y[0], y[1]), pk2(y[2], y[3]));
        ss += y[0] * y[0] + y[1] * y[1] + y[2] * y[2] + y[3] * y[3]; }
    ss = wave_sum(ss);
    if (lane == 0) ssC[t] = ss;
}
__device__ __forceinline__ void router_row(const float* __restrict__ x1, const float* __restrict__ Wr, const float* __restrict__ brg, const float* __restrict__ bre,
                                           int* __restrict__ cnt, int* __restrict__ list, float* __restrict__ wts, float* __restrict__ r2out, int t, int lane) {
    const float4* xr = (const float4*)(x1 + (size_t)t * DM);
    float4 v[8]; float ss = 0.f;
#pragma unroll
    for (int j = 0; j < 8; ++j) { v[j] = xr[j * 64 + lane]; ss += v[j].x * v[j].x + v[j].y * v[j].y + v[j].z * v[j].z + v[j].w * v[j].w; }
    const float r2 = rsqrtf(wave_sum(ss) * (1.f / DM) + EPS);
    float lg[4];
#pragma unroll
    for (int o = 0; o < 4; ++o) { const float4* wr = (const float4*)(Wr + (size_t)o * DM); float p = 0.f;
#pragma unroll
        for (int j = 0; j < 8; ++j) { const float4 wv = wr[j * 64 + lane]; p += v[j].x * wv.x + v[j].y * wv.y + v[j].z * wv.z + v[j].w * wv.w; }
        lg[o] = wave_sum(p) * r2 + brg[o]; }
    int gs = 0; float gm = lg[0];
#pragma unroll
    for (int g = 1; g < 4; ++g) if (lg[g] > gm) { gm = lg[g]; gs = g; }
    float den = 0.f;
#pragma unroll
    for (int g = 0; g < 4; ++g) den += __expf(lg[g] - gm);
    const float pg = 1.f / den;
    gs = __builtin_amdgcn_readfirstlane(gs);
    float el[8];
#pragma unroll
    for (int i = 0; i < 8; ++i) { const float4* wr = (const float4*)(Wr + (size_t)(4 + gs * 8 + i) * DM); float p = 0.f;
#pragma unroll
        for (int j = 0; j < 8; ++j) { const float4 wv = wr[j * 64 + lane]; p += v[j].x * wv.x + v[j].y * wv.y + v[j].z * wv.z + v[j].w * wv.w; }
        el[i] = wave_sum(p) * r2 + bre[gs * 8 + i]; }
    int i1 = 0; float v1 = el[0];
#pragma unroll
    for (int i = 1; i < 8; ++i) if (el[i] > v1) { v1 = el[i]; i1 = i; }
    int i2 = -1; float v2 = -3.0e38f;
#pragma unroll
    for (int i = 0; i < 8; ++i) if (i != i1 && el[i] > v2) { v2 = el[i]; i2 = i; }
    const float e2 = __expf(v2 - v1), w0 = pg / (1.f + e2), w1 = pg * e2 / (1.f + e2);
    if (lane == 0) {
        r2out[t] = r2;
        const int ea = gs * 8 + i1, eb = gs * 8 + i2;
        const int sa = atomicAdd(&cnt[ea], 1); list[ea * T + sa] = 2 * t; wts[2 * t] = w0;
        const int sb = atomicAdd(&cnt[eb], 1); list[eb * T + sb] = 2 * t + 1; wts[2 * t + 1] = w1;
    }
}
__device__ __forceinline__ void final_row(float* __restrict__ out, const bf16_t* __restrict__ Y, const float* __restrict__ g, int t, int lane) {
    float4* xr = (float4*)(out + (size_t)t * DM);
    const uint2* y0 = (const uint2*)(Y + (size_t)(2 * t) * DM); const uint2* y1 = (const uint2*)(Y + (size_t)(2 * t + 1) * DM);
    float4 v[8]; float ss = 0.f;
#pragma unroll
    for (int j = 0; j < 8; ++j) { float4 a = xr[j * 64 + lane]; const uint2 p = y0[j * 64 + lane], q = y1[j * 64 + lane];
        a.x += bf2f(p.x & 0xffffu) + bf2f(q.x & 0xffffu); a.y += bf2f(p.x >> 16) + bf2f(q.x >> 16); a.z += bf2f(p.y & 0xffffu) + bf2f(q.y & 0xffffu); a.w += bf2f(p.y >> 16) + bf2f(q.y >> 16);
        v[j] = a; ss += a.x * a.x + a.y * a.y + a.z * a.z + a.w * a.w; }
    const float r = rsqrtf(wave_sum(ss) * (1.f / DM) + EPS);
#pragma unroll
    for (int j = 0; j < 8; ++j) { const float4 gv = ((const float4*)g)[j * 64 + lane]; float4 a = v[j]; a.x *= r * gv.x; a.y *= r * gv.y; a.z *= r * gv.z; a.w *= r * gv.w; xr[j * 64 + lane] = a; }
}


namespace att {
typedef float f32x16 __attribute__((ext_vector_type(16)));
typedef short s16x4 __attribute__((ext_vector_type(4)));
typedef short v4i16_t __attribute__((ext_vector_type(4)));
constexpr int SLOT = 8192, L_K = 0, L_V = 2 * SLOT, L_TB = 4 * SLOT, NTB = 576;
__device__ __forceinline__ float rowmax32(const f32x16& p0, const f32x16& p1) {
    float a = fmaxf(p0[0], p1[0]);
#pragma unroll
    for (int r = 1; r < 16; ++r) a = fmaxf(a, fmaxf(p0[r], p1[r]));
    auto rr = __builtin_amdgcn_permlane32_swap(__float_as_uint(a), __float_as_uint(a), false, false);
    return fmaxf(__uint_as_float(rr[0]), __uint_as_float(rr[1]));
}
__device__ __forceinline__ unsigned cvtpk(float lo, float hi) { typedef float f2 __attribute__((ext_vector_type(2))); typedef __bf16 b2 __attribute__((ext_vector_type(2))); f2 v = {lo, hi}; b2 b = __builtin_convertvector(v, b2); return __builtin_bit_cast(unsigned, b); }
__device__ __forceinline__ s16x4 vtr(LAS const unsigned char* p) { return __builtin_bit_cast(s16x4, __builtin_amdgcn_ds_read_tr16_b64_v4i16((LAS v4i16_t*)p)); }

__device__ __forceinline__ void attn_unit(LAS unsigned char* lds, const bf16_t* __restrict__ proj, const float* __restrict__ relb, bf16_t* __restrict__ mix, float* __restrict__ ssA, int b, int h, int cg) {
    const int tid = threadIdx.x, lane = tid & 63, r32 = lane & 31, hi = lane >> 5, w = __builtin_amdgcn_readfirstlane(tid >> 6);
    const int c0 = cg * 4, cq = c0 + (w >> 1), qi = 32 * (w & 1) + r32;
    const int j0 = c0 - 8 < 0 ? 0 : c0 - 8, j1 = c0 + 3;
    LAS float* tb = (LAS float*)(lds + L_TB);
    for (int i = tid; i < NTB; i += NTHREADS) tb[i] = relb[h * NREL + (i > 512 ? 512 : i)] * LOG2E;
    const size_t tq = (size_t)b * SEQ + (size_t)c0 * 64 + 32 * w + r32;
    bf16x8 qr[4];
#pragma unroll
    for (int d0 = 0; d0 < 4; ++d0) qr[d0] = *(const bf16x8*)(proj + tq * NPROJ + h * HD + d0 * 16 + hi * 8);
    const int krow = 8 * w + (lane >> 3);
    const bf16_t* ksrc = proj + ((size_t)b * SEQ + krow) * NPROJ + DATT + h * HD + (((lane & 7) ^ ((krow >> 1) & 7)) * 8);
    const bf16_t* vsrc = proj + ((size_t)b * SEQ + 16 * (w & 3) + (lane >> 2)) * NPROJ + 2 * DATT + h * HD + (w >> 2) * 32 + (lane & 3) * 8;
#define ATT_DMA(j, slot) do { __builtin_amdgcn_global_load_lds((const unsigned*)(ksrc + (size_t)(j) * 64 * NPROJ), (LAS unsigned*)(lds + L_K + (slot) * SLOT + w * 1024), 16, 0, 0); \
                              __builtin_amdgcn_global_load_lds((const unsigned*)(vsrc + (size_t)(j) * 64 * NPROJ), (LAS unsigned*)(lds + L_V + (slot) * SLOT + w * 1024), 16, 0, 0); } while (0)
    int ka[4];
#pragma unroll
    for (int d0 = 0; d0 < 4; ++d0) ka[d0] = r32 * 128 + (((2 * d0 + hi) ^ ((r32 >> 1) & 7)) * 16);
    const int va = ((lane >> 4) & 1) * 32 + (lane & 3) * 8 + (4 * hi + ((lane & 15) >> 2)) * 64;
    float m = -1e30f, l = 0.f; f32x16 o[2];
#pragma unroll
    for (int r = 0; r < 16; ++r) { o[0][r] = 0.f; o[1][r] = 0.f; }
    ATT_DMA(j0, 0);
    for (int j = j0; j <= j1; ++j) {
        const int slot = (j - j0) & 1;
        asm volatile("s_waitcnt vmcnt(0) lgkmcnt(0)\n\ts_barrier" ::: "memory");
        if (j < j1) ATT_DMA(j + 1, slot ^ 1);
        const int dl = cq - j;
        if (dl >= 0 && dl <= 8) {
            LAS const unsigned char* Ks = lds + L_K + slot * SLOT; LAS const unsigned char* Vs = lds + L_V + slot * SLOT + va;
            f32x16 p0, p1;
            if (dl <= 4) { LAS const float* tp = tb + (64 * dl + qi + 256 - 4 * hi - 59);
#pragma unroll
                for (int r = 0; r < 16; ++r) { p0[r] = tp[59 - ((r & 3) + 8 * (r >> 2))]; p1[r] = tp[27 - ((r & 3) + 8 * (r >> 2))]; } }
            else { const float bf = tb[NTB - 1];
#pragma unroll
                for (int r = 0; r < 16; ++r) { p0[r] = bf; p1[r] = bf; } }
#pragma unroll
            for (int d0 = 0; d0 < 4; ++d0) { const bf16x8 k0 = *(LAS const bf16x8*)(Ks + ka[d0]), k1 = *(LAS const bf16x8*)(Ks + ka[d0] + 4096);
                p0 = __builtin_amdgcn_mfma_f32_32x32x16_bf16(k0, qr[d0], p0, 0, 0, 0); p1 = __builtin_amdgcn_mfma_f32_32x32x16_bf16(k1, qr[d0], p1, 0, 0, 0); }
            const float mn = fmaxf(m, rowmax32(p0, p1)), al = __builtin_amdgcn_exp2f(m - mn); m = mn;
            float rs = 0.f;
#pragma unroll
            for (int r = 0; r < 16; ++r) { p0[r] = __builtin_amdgcn_exp2f(p0[r] - mn); p1[r] = __builtin_amdgcn_exp2f(p1[r] - mn); rs += p0[r] + p1[r]; }
            l = l * al + rs;
#pragma unroll
            for (int r = 0; r < 16; ++r) { o[0][r] *= al; o[1][r] *= al; }
            bf16x8 pw[4];
#pragma unroll
            for (int ks = 0; ks < 4; ++ks) { const f32x16& P = ks < 2 ? p0 : p1; const int bo = (ks & 1) * 8; typedef unsigned u4 __attribute__((ext_vector_type(4)));
                u4 t4 = {cvtpk(P[bo], P[bo + 1]), cvtpk(P[bo + 2], P[bo + 3]), cvtpk(P[bo + 4], P[bo + 5]), cvtpk(P[bo + 6], P[bo + 7])}; pw[ks] = __builtin_bit_cast(bf16x8, t4); }
#pragma unroll
            for (int d0 = 0; d0 < 2; ++d0)
#pragma unroll
                for (int ks = 0; ks < 4; ++ks) { const s16x4 lo = vtr(Vs + d0 * 4096 + ks * 1024), hh = vtr(Vs + d0 * 4096 + ks * 1024 + 512);
                    const bf16x8 vf = {lo[0], lo[1], lo[2], lo[3], hh[0], hh[1], hh[2], hh[3]};
                    o[d0] = __builtin_amdgcn_mfma_f32_32x32x16_bf16(vf, pw[ks], o[d0], 0, 0, 0); }
        }
    }
    { auto rr = __builtin_amdgcn_permlane32_swap(__float_as_uint(l), __float_as_uint(l), false, false); l = __uint_as_float(rr[0]) + __uint_as_float(rr[1]); }
    const float il = 1.f / l; float ss = 0.f;
    bf16_t* op = mix + tq * DM + h * HD + 4 * hi;
#pragma unroll
    for (int d0 = 0; d0 < 2; ++d0)
#pragma unroll
        for (int g = 0; g < 4; ++g) { const float v0 = o[d0][4 * g] * il, v1 = o[d0][4 * g + 1] * il, v2 = o[d0][4 * g + 2] * il, v3 = o[d0][4 * g + 3] * il;
            ss += v0 * v0 + v1 * v1 + v2 * v2 + v3 * v3; *(uint2*)(op + 32 * d0 + 8 * g) = make_uint2(cvtpk(v0, v1), cvtpk(v2, v3)); }
    { auto rr = __builtin_amdgcn_permlane32_swap(__float_as_uint(ss), __float_as_uint(ss), false, false); ss = __uint_as_float(rr[0]) + __uint_as_float(rr[1]); }
    if (hi == 0) ssA[tq * 16 + h] = ss;
    asm volatile("s_waitcnt vmcnt(0) lgkmcnt(0)\n\ts_barrier" ::: "memory");
#undef ATT_DMA
}
}

__device__ __forceinline__ void conv_slab(const bf16_t* __restrict__ proj, const float* __restrict__ cw, bf16_t* __restrict__ mix, float* __restrict__ ssC4, int item, int lane) {
    const int slab = item & 3, t0 = (item >> 2) * 32, ch = slab * 256 + lane * 4;
    const float4 w0 = *(const float4*)(cw + ch), w1 = *(const float4*)(cw + DCONV + ch), w2 = *(const float4*)(cw + 2 * DCONV + ch);
    float z1[4] = {0.f, 0.f, 0.f, 0.f}, z2[4] = {0.f, 0.f, 0.f, 0.f};
    if ((t0 & (SEQ - 1)) != 0) {
#pragma unroll
        for (int back = 2; back >= 1; --back) { const bf16_t* pr = proj + (size_t)(t0 - back) * NPROJ; const uint2 cv = *(const uint2*)(pr + 4 * DATT + ch), uv = *(const uint2*)(pr + 5 * DATT + ch);
            float z[4] = {bf2f(cv.x & 0xffffu) * bf2f(uv.x & 0xffffu), bf2f(cv.x >> 16) * bf2f(uv.x >> 16), bf2f(cv.y & 0xffffu) * bf2f(uv.y & 0xffffu), bf2f(cv.y >> 16) * bf2f(uv.y >> 16)};
#pragma unroll
            for (int q = 0; q < 4; ++q) { if (back == 2) z2[q] = z[q]; else z1[q] = z[q]; } }
    }
#pragma unroll 4
    for (int i = 0; i < 32; ++i) { const int t = t0 + i; const bf16_t* pr = proj + (size_t)t * NPROJ;
        const uint2 bv = *(const uint2*)(pr + 3 * DATT + ch), cv = *(const uint2*)(pr + 4 * DATT + ch), uv = *(const uint2*)(pr + 5 * DATT + ch);
        const float z[4] = {bf2f(cv.x & 0xffffu) * bf2f(uv.x & 0xffffu), bf2f(cv.x >> 16) * bf2f(uv.x >> 16), bf2f(cv.y & 0xffffu) * bf2f(uv.y & 0xffffu), bf2f(cv.y >> 16) * bf2f(uv.y >> 16)};
        const float bb[4] = {bf2f(bv.x & 0xffffu), bf2f(bv.x >> 16), bf2f(bv.y & 0xffffu), bf2f(bv.y >> 16)};
        const float wa[4] = {w0.x, w0.y, w0.z, w0.w}, wb[4] = {w1.x, w1.y, w1.z, w1.w}, wc[4] = {w2.x, w2.y, w2.z, w2.w};
        float y[4]; float ss = 0.f;
#pragma unroll
        for (int q = 0; q < 4; ++q) { y[q] = bb[q] * (wa[q] * z2[q] + wb[q] * z1[q] + wc[q] * z[q]); ss += y[q] * y[q]; z2[q] = z1[q]; z1[q] = z[q]; }
        *(uint2*)(mix + (size_t)t * DM + DATT + ch) = make_uint2(pk2(y[0], y[1]), pk2(y[2], y[3]));
        ss = wave_sum(ss);
        if (lane == 0) ssC4[t * 4 + slab] = ss; }
}

namespace g8 {
typedef unsigned u32x4 __attribute__((ext_vector_type(4)));
constexpr int BM = 256, BK = 64, HALF = 128, HTB = HALF * BK * 2, STAGE_BYTES = 8 * HTB, NXCD = 8, WGM = 8;
__device__ __forceinline__ int lds_byte(int r, int c) { const int st = (r >> 4) * 2 + (c >> 5), rr = r & 15, cc = c & 31, ob = rr * 64 + cc * 2; return st * 1024 + (ob ^ (((ob >> 9) & 1) << 5)); }
__device__ __forceinline__ void stage_rc(int b, int& R, int& C) { const int st = b / 1024, sb = b % 1024, swz = sb ^ (((sb >> 9) & 1) << 5); R = (st >> 1) * 16 + swz / 64; C = (st & 1) * 32 + (swz % 64) / 2; }
__device__ __forceinline__ int perm32(int rho) { const int n = rho >> 4, i = rho & 15; return 8 * (i >> 2) + 4 * n + (i & 3); }
__device__ __forceinline__ unsigned cvt_pk_bf16(float lo, float hi) { unsigned r; asm volatile("v_cvt_pk_bf16_f32 %0, %1, %2" : "=v"(r) : "v"(lo), "v"(hi)); return r; }
__device__ __forceinline__ int xcd_remap(int wgid, int nwg) { const int q = nwg / NXCD, r = nwg % NXCD, xcd = wgid % NXCD, off = wgid / NXCD; return (xcd < r ? xcd * (q + 1) : r * (q + 1) + (xcd - r) * q) + off; }

struct Unit { int pm, pn, e; const char* a; const char* b; };

struct DenseOrder {
    const char* A; const char* Bt; int K, nM, nN, nwg, G, c;
    __device__ __forceinline__ void init(const void* A_, const void* Bt_, int M, int N, int K_, int G_, int c_) { A = (const char*)A_; Bt = (const char*)Bt_; K = K_; nM = M / BM; nN = N / BM; nwg = nM * nN; G = G_; c = c_; }
    __device__ __forceinline__ bool next(int i, Unit& u) const {
        const int L = i * G + c; if (L >= nwg) return false;
        const int wgid = xcd_remap(L, nwg);
        const int nig = WGM * nN, gid = wgid / nig, fm = gid * WGM, gsz = (nM - fm) < WGM ? (nM - fm) : WGM;
        u.pm = fm + ((wgid % nig) % gsz); u.pn = (wgid % nig) / gsz; u.e = i;
        u.a = A + (size_t)u.pm * BM * K * 2; u.b = Bt + (size_t)u.pn * BM * K * 2; return true;
    }
    __device__ __forceinline__ unsigned arow_off(const Unit&, int r, int Kb) const { return (unsigned)r * (unsigned)Kb; }
};
template <bool GATHER> struct MoeOrder {
    const char* A; const char* Bt; const int* list; LAS const int* pl; int K, NPN, nwg, G, c; size_t estride;
    __device__ __forceinline__ bool next(int i, Unit& u) const {
        const int L = i * G + c; if (L >= nwg) return false;
        const int wgid = xcd_remap(L, nwg);
        u.pm = wgid / NPN; u.pn = wgid % NPN; u.e = pl[64 + u.pm];
        u.a = GATHER ? A : A + (size_t)u.pm * BM * K * 2; u.b = Bt + (size_t)u.e * estride + (size_t)u.pn * BM * K * 2; return true;
    }
    __device__ __forceinline__ int pair_of(const Unit& u, int r) const { const int slot = u.pm * BM + r - pl[32 + u.e]; return slot < pl[u.e] ? list[u.e * T + slot] : -1; }
    __device__ __forceinline__ unsigned arow_off(const Unit& u, int r, int Kb) const {
        if (GATHER) { const int pr = pair_of(u, r); return (unsigned)(pr >= 0 ? (pr >> 1) : 0) * (unsigned)Kb; }
        return (unsigned)r * (unsigned)Kb;
    }
};

template <bool GATHER, class Epi, class Sched>
__device__ __forceinline__ void gemm_phase(LAS unsigned char* lds, const int K, const Sched& S, const Epi& E) {
    const int tid = threadIdx.x, wid = __builtin_amdgcn_readfirstlane(tid >> 6), lane = tid & 63, wr = wid >> 2, wc = wid & 3, fr = lane & 15, fq = lane >> 4;
    const int nt = K / BK, Kb = K * 2;
    int RA[2], CA[2]; unsigned voffB[2];
#pragma unroll
    for (int i = 0; i < 2; ++i) { int R, C; stage_rc(tid * 16 + i * 8192, R, C); RA[i] = R; CA[i] = C * 2; const int Rb = Epi::PERM ? ((R & ~31) + perm32(R & 31)) : R; voffB[i] = (unsigned)(Rb * K + C) * 2u; }
    const size_t kstep = (size_t)(BK * 2);
    const size_t hstep = (size_t)HALF * K * 2;
    const unsigned ldsw = (unsigned)wid * 1024u;
    const int aoff = lds_byte(wr * 64 + fr, fq * 8), boff = lds_byte(wc * 32 + fr, fq * 8);
#define G8_SA(b, h) (((b) * 2 + (h)) * HTB)
#define G8_SB(b, h) ((4 + (b) * 2 + (h)) * HTB)
#define G8_STAGE(bufoff, gbase, voff) do { _Pragma("unroll") for (int _i = 0; _i < 2; ++_i) \
        __builtin_amdgcn_global_load_lds((const unsigned*)((const char*)(gbase) + (voff)[_i]), (LAS unsigned*)(lds + (bufoff) + ldsw + _i * 8192), 16, 0, 0); } while (0)
#define G8_LDA(dst, b, h) do { _Pragma("unroll") for (int m = 0; m < 4; ++m) _Pragma("unroll") for (int k = 0; k < 2; ++k) dst[m][k] = *(const LAS bf16x8*)(lds + G8_SA(b, h) + aoff + m * 2048 + k * 1024); } while (0)
#define G8_LDB(dst, b, h) do { _Pragma("unroll") for (int n = 0; n < 2; ++n) _Pragma("unroll") for (int k = 0; k < 2; ++k) dst[n][k] = *(const LAS bf16x8*)(lds + G8_SB(b, h) + boff + n * 2048 + k * 1024); } while (0)
#define G8_MMA(ai, bj, At, Bt) do { __builtin_amdgcn_s_setprio(1); _Pragma("unroll") for (int m = 0; m < 4; ++m) _Pragma("unroll") for (int n = 0; n < 2; ++n) _Pragma("unroll") for (int k = 0; k < 2; ++k) \
        acc[ai][bj][m][n] = __builtin_amdgcn_mfma_f32_16x16x32_bf16(Bt[n][k], At[m][k], acc[ai][bj][m][n], 0, 0, 0); __builtin_amdgcn_s_setprio(0); } while (0)
#define G8_WAIT_V(n) asm volatile("s_waitcnt vmcnt(" #n ")" ::: "memory")
#define G8_WAIT_L(n) asm volatile("s_waitcnt lgkmcnt(" #n ")" ::: "memory")
#define G8_BAR __builtin_amdgcn_s_barrier()
#define G8_SCHED __builtin_amdgcn_sched_barrier(0)
    Unit cur, nxt; int ui = 0;
    if (!S.next(0, cur)) return;
    f32x4 acc[2][2][4][2];
#pragma unroll
    for (int a = 0; a < 2; ++a)
#pragma unroll
        for (int b = 0; b < 2; ++b)
#pragma unroll
            for (int m = 0; m < 4; ++m)
#pragma unroll
                for (int n = 0; n < 2; ++n) acc[a][b][m][n] = (f32x4){0.f, 0.f, 0.f, 0.f};
    bf16x8 At[4][2], B0[2][2], B1[2][2];
    unsigned vA[2][2], vN[2][2];
#pragma unroll
    for (int h = 0; h < 2; ++h)
#pragma unroll
        for (int i = 0; i < 2; ++i) { vA[h][i] = S.arow_off(cur, h * HALF + RA[i], Kb) + (unsigned)CA[i]; vN[h][i] = vA[h][i]; }
    const char* cA = cur.a; const char* cB = cur.b;
    G8_STAGE(G8_SB(0, 0), cB, voffB); G8_STAGE(G8_SB(0, 1), cB + hstep, voffB); G8_STAGE(G8_SA(0, 0), cA, vA[0]); G8_STAGE(G8_SA(0, 1), cA, vA[1]);
    if (wr == 1) G8_BAR;
    G8_WAIT_V(2); G8_BAR;
    G8_STAGE(G8_SB(1, 0), cB + kstep, voffB); G8_STAGE(G8_SA(1, 0), cA + kstep, vA[0]); G8_STAGE(G8_SB(1, 1), cB + hstep + kstep, voffB);
    G8_WAIT_V(6); G8_BAR;
    for (;;) {
        const bool has_next = S.next(ui + 1, nxt);
        const char* nA = has_next ? nxt.a : cA; const char* nB = has_next ? nxt.b : cB;
        if (GATHER && has_next) {
#pragma unroll
            for (int h = 0; h < 2; ++h)
#pragma unroll
                for (int i = 0; i < 2; ++i) vN[h][i] = S.arow_off(nxt, h * HALF + RA[i], Kb) + (unsigned)CA[i];
        }
        for (int t = 0; t < nt; t += 2) {
            const bool last = (t == nt - 2);
            if (Epi::MID_T >= 0 && t == Epi::MID_T) E.mid(acc, cur, wr, wc, fr, fq);
            const char* a1 = cA + (size_t)(t + 1) * kstep;
            const char* a2 = last ? nA : cA + (size_t)(t + 2) * kstep; const char* b2 = last ? nB : cB + (size_t)(t + 2) * kstep;
            const char* a3 = a2 + kstep; const char* b3 = b2 + kstep;
            unsigned v2[2][2];
#pragma unroll
            for (int h = 0; h < 2; ++h)
#pragma unroll
                for (int i = 0; i < 2; ++i) v2[h][i] = (GATHER && last) ? vN[h][i] : vA[h][i];
            G8_LDB(B0, 0, 0); G8_LDB(B1, 0, 1); G8_SCHED; G8_LDA(At, 0, 0); G8_STAGE(G8_SA(1, 1), a1, vA[1]);
            G8_WAIT_V(8); G8_WAIT_L(0); G8_BAR; G8_MMA(0, 0, At, B0); G8_MMA(0, 1, At, B1); G8_BAR; G8_SCHED;
            G8_LDA(At, 0, 1); G8_STAGE(G8_SB(0, 0), b2, voffB); G8_STAGE(G8_SB(0, 1), b2 + hstep, voffB); G8_STAGE(G8_SA(0, 0), a2, v2[0]);
            G8_WAIT_V(8); G8_WAIT_L(0); G8_BAR; G8_MMA(1, 0, At, B0); G8_MMA(1, 1, At, B1); G8_BAR; G8_SCHED;
            G8_LDB(B0, 1, 0); G8_LDB(B1, 1, 1); G8_SCHED; G8_LDA(At, 1, 0); G8_STAGE(G8_SA(0, 1), a2, v2[1]);
            G8_WAIT_V(8); G8_WAIT_L(0); G8_BAR; G8_MMA(0, 0, At, B0); G8_MMA(0, 1, At, B1); G8_BAR; G8_SCHED;
            G8_LDA(At, 1, 1); G8_STAGE(G8_SB(1, 0), b3, voffB); G8_STAGE(G8_SB(1, 1), b3 + hstep, voffB); G8_STAGE(G8_SA(1, 0), a3, v2[0]);
            G8_WAIT_V(8); G8_WAIT_L(0); G8_BAR; G8_MMA(1, 0, At, B0); G8_MMA(1, 1, At, B1); G8_BAR; G8_SCHED;
        }
        if (wr == 0) G8_BAR;
        E(acc, cur, wr, wc, fr, fq);
        if (!has_next) break;
#pragma unroll
        for (int a = 0; a < 2; ++a)
#pragma unroll
            for (int b = 0; b < 2; ++b)
#pragma unroll
                for (int m = 0; m < 4; ++m)
#pragma unroll
                    for (int n = 0; n < 2; ++n) acc[a][b][m][n] = (f32x4){0.f, 0.f, 0.f, 0.f};
        cur = nxt; cA = nA; cB = nB; ++ui;
#pragma unroll
        for (int h = 0; h < 2; ++h)
#pragma unroll
            for (int i = 0; i < 2; ++i) vA[h][i] = vN[h][i];
        if (wr == 1) G8_BAR;
    }
    G8_WAIT_V(0);
    G8_BAR;
#undef G8_SA
#undef G8_SB
#undef G8_STAGE
#undef G8_LDA
#undef G8_LDB
#undef G8_MMA
#undef G8_WAIT_V
#undef G8_WAIT_L
#undef G8_BAR
#undef G8_SCHED
}

struct EpiProjF { static constexpr bool PERM = true; static constexpr int MID_T = -1; bf16_t* out; const float* r1;
    __device__ __forceinline__ void mid(f32x4 (&)[2][2][4][2], const Unit&, int, int, int, int) const {}
    __device__ __forceinline__ void operator()(const f32x4 (&acc)[2][2][4][2], const Unit& u, int wr, int wc, int fr, int fq) const {
        const int row0 = u.pm * BM + wr * 64 + fr, col0 = u.pn * BM + wc * 32 + 8 * fq;
#pragma unroll
        for (int ai = 0; ai < 2; ++ai)
#pragma unroll
            for (int m = 0; m < 4; ++m) { const int row = row0 + ai * HALF + m * 16; const float s = r1[row]; bf16_t* rowp = out + (size_t)row * NPROJ + col0;
#pragma unroll
                for (int bj = 0; bj < 2; ++bj) { const f32x4 v0 = acc[ai][bj][m][0] * s, v1 = acc[ai][bj][m][1] * s; u32x4 w; w.x = cvt_pk_bf16(v0[0], v0[1]); w.y = cvt_pk_bf16(v0[2], v0[3]); w.z = cvt_pk_bf16(v1[0], v1[1]); w.w = cvt_pk_bf16(v1[2], v1[3]);
                    *(u32x4*)(rowp + bj * HALF) = w; } }
    }
};
struct EpiG2F { static constexpr bool PERM = false; static constexpr int MID_T = DATT / BK; const float* x; float* x1; bf16_t* xb1; LAS const float* tab; int G;
    __device__ __forceinline__ void mid(f32x4 (&acc)[2][2][4][2], const Unit& u, int wr, int wc, int fr, int fq) const {
        LAS const float* tb = tab + (size_t)(u.e) * 512;
#pragma unroll
        for (int ai = 0; ai < 2; ++ai)
#pragma unroll
            for (int m = 0; m < 4; ++m) { const float s = tb[(ai * HALF + wr * 64 + m * 16 + fr) * 2];
#pragma unroll
                for (int bj = 0; bj < 2; ++bj)
#pragma unroll
                    for (int n = 0; n < 2; ++n) acc[ai][bj][m][n] *= s; }
    }
    __device__ __forceinline__ void operator()(const f32x4 (&acc)[2][2][4][2], const Unit& u, int wr, int wc, int fr, int fq) const {
        LAS const float* tb = tab + (size_t)(u.e) * 512;
        const int col0 = u.pn * BM + wc * 32 + 4 * fq;
#pragma unroll
        for (int ai = 0; ai < 2; ++ai)
#pragma unroll
            for (int m = 0; m < 4; ++m) { const int r = ai * HALF + wr * 64 + m * 16 + fr; const float s = tb[r * 2 + 1]; const size_t off = (size_t)(u.pm * BM + r) * DM + col0;
#pragma unroll
                for (int bj = 0; bj < 2; ++bj)
#pragma unroll
                    for (int n = 0; n < 2; ++n) { const f32x4 xv = *(const f32x4*)(x + off + bj * HALF + n * 16); const f32x4 o = xv + acc[ai][bj][m][n] * s;
                        *(f32x4*)(x1 + off + bj * HALF + n * 16) = o; *(uint2*)(xb1 + off + bj * HALF + n * 16) = make_uint2(cvt_pk_bf16(o[0], o[1]), cvt_pk_bf16(o[2], o[3])); } }
    }
};
template <class Sched> struct EpiGUF { static constexpr bool PERM = true; static constexpr int MID_T = -1; bf16_t* Hb; const float* r2; const Sched* S;
    __device__ __forceinline__ void mid(f32x4 (&)[2][2][4][2], const Unit&, int, int, int, int) const {}
    __device__ __forceinline__ void operator()(const f32x4 (&acc)[2][2][4][2], const Unit& u, int wr, int wc, int fr, int fq) const {
        const int col0 = u.pn * HALF + wc * 32 + 8 * fq;
#pragma unroll
        for (int ai = 0; ai < 2; ++ai)
#pragma unroll
            for (int m = 0; m < 4; ++m) { const int r = ai * HALF + wr * 64 + m * 16 + fr; const int pr = S->pair_of(u, r); const float s = r2[pr >= 0 ? (pr >> 1) : 0];
                float h[8];
#pragma unroll
                for (int n = 0; n < 2; ++n)
#pragma unroll
                    for (int q = 0; q < 4; ++q) { const float gg = acc[ai][0][m][n][q] * s, uu = acc[ai][1][m][n][q] * s; h[4 * n + q] = gg * __builtin_amdgcn_rcpf(1.f + __expf(-gg)) * uu; }
                u32x4 w; w.x = cvt_pk_bf16(h[0], h[1]); w.y = cvt_pk_bf16(h[2], h[3]); w.z = cvt_pk_bf16(h[4], h[5]); w.w = cvt_pk_bf16(h[6], h[7]);
                *(u32x4*)(Hb + (size_t)(u.pm * BM + r) * DEXP + col0) = w; }
    }
};
template <class Sched> struct EpiDownF { static constexpr bool PERM = true; static constexpr int MID_T = -1; bf16_t* Y; const float* wts; const Sched* S;
    __device__ __forceinline__ void mid(f32x4 (&)[2][2][4][2], const Unit&, int, int, int, int) const {}
    __device__ __forceinline__ void operator()(const f32x4 (&acc)[2][2][4][2], const Unit& u, int wr, int wc, int fr, int fq) const {
        const int col0 = u.pn * BM + wc * 32 + 8 * fq;
#pragma unroll
        for (int ai = 0; ai < 2; ++ai)
#pragma unroll
            for (int m = 0; m < 4; ++m) { const int r = ai * HALF + wr * 64 + m * 16 + fr; const int pr = S->pair_of(u, r); if (pr < 0) continue; const float s = wts[pr]; bf16_t* rowp = Y + (size_t)pr * DM + col0;
#pragma unroll
                for (int bj = 0; bj < 2; ++bj) { const f32x4 v0 = acc[ai][bj][m][0] * s, v1 = acc[ai][bj][m][1] * s; u32x4 w; w.x = cvt_pk_bf16(v0[0], v0[1]); w.y = cvt_pk_bf16(v0[2], v0[3]); w.z = cvt_pk_bf16(v1[0], v1[1]); w.w = cvt_pk_bf16(v1[2], v1[3]);
                    *(u32x4*)(rowp + bj * HALF) = w; } }
    }
};
}

__global__ void __launch_bounds__(NTHREADS, 2) mega(Params p) {
    extern __shared__ __attribute__((aligned(16))) unsigned char lds[];
    cg::grid_group grid = cg::this_grid();
    Ctx c; c.tid = threadIdx.x; c.lane = c.tid & 63; c.wave = __builtin_amdgcn_readfirstlane(c.tid >> 6); c.gw = blockIdx.x * NWAVES + c.wave; c.ngw = gridDim.x * NWAVES;
    char* ws = p.ws;
    int* cnt = (int*)(ws + WS_CTL);
    float* r1 = (float*)(ws + WS_R1); float* r2 = (float*)(ws + WS_R2); float* ssC = (float*)(ws + WS_SSC);
    float* wts = (float*)(ws + WS_WTS); float* Wr = (float*)(ws + WS_WR); float* ssA = (float*)(ws + WS_SSA); int* list = (int*)(ws + WS_LIST);
    bf16_t* W2t = (bf16_t*)(ws + WS_W2T); bf16_t* W1t = (bf16_t*)(ws + WS_W1T); bf16_t* Wdt = (bf16_t*)(ws + WS_WDT); bf16_t* Wgut = (bf16_t*)(ws + WS_WGUT);
    bf16_t* xb = (bf16_t*)(ws + WS_XB); bf16_t* mix = (bf16_t*)(ws + WS_MIX); bf16_t* proj = (bf16_t*)(ws + WS_PROJ); bf16_t* Y = (bf16_t*)(ws + WS_Y); bf16_t* Hb = (bf16_t*)(ws + WS_H);

    {
        if (blockIdx.x == 0 && c.tid < 64) cnt[c.tid] = 0;
        for (int row = c.gw; row < T; row += c.ngw) p0_x_row(p.x, xb, r1, row, c.lane);
        LAS float* scr = (LAS float*)lds + c.wave * (64 * 33);
        constexpr int I_IN = (DM / 64) * (NPROJ / 32), I_OUT = (DM / 64) * (DM / 32), I_G = NE * (DM / 64) * (DEXP / 32), I_D = NE * (DEXP / 64) * (DM / 32);
        constexpr int NIT = I_IN + I_OUT + 2 * I_G + I_D;
        for (int it = c.gw; it < NIT; it += c.ngw) {
            int r = it;
            if (r < I_IN) { const int nb = NPROJ / 32, kb = r / nb, n0 = (r % nb) * 32; p0_titem(p.w_in, NPROJ, p.norm1, W1t, DM, kb * 64, n0, n0, scr, c.lane, n0 < DATT ? QSCALE : 1.f); continue; } r -= I_IN;
            if (r < I_OUT) { const int nb = DM / 32, kb = r / nb, n0 = (r % nb) * 32, k0 = kb * 64;
                const float* g = k0 < DATT ? p.g_oa + k0 : p.g_oc + (k0 - DATT);
                p0_titem(p.w_out + (size_t)k0 * DM, DM, g, W2t + k0, DM, 0, n0, n0, scr, c.lane); continue; } r -= I_OUT;
            if (r < 2 * I_G) { const int up = r >= I_G; if (up) r -= I_G; const int per = (DM / 64) * (DEXP / 32), e = r / per, q = r % per, nb = DEXP / 32, kb = q / nb, n0 = (q % nb) * 32;
                p0_titem((up ? p.w_up : p.w_gate) + (size_t)e * DM * DEXP, DEXP, p.norm2, Wgut + (size_t)e * 2 * DEXP * DM, DM, kb * 64, n0, gu_row(n0, up), scr, c.lane); continue; } r -= 2 * I_G;
            { const int per = (DEXP / 64) * (DM / 32), e = r / per, q = r % per, nb = DM / 32, kb = q / nb, n0 = (q % nb) * 32;
              p0_titem(p.w_down + (size_t)e * DEXP * DM, DM, nullptr, Wdt + (size_t)e * DM * DEXP, DEXP, kb * 64, n0, n0, scr, c.lane); }
        }
        for (int i = blockIdx.x * NTHREADS + c.tid; i < 36 * DM; i += gridDim.x * NTHREADS) { const int o = i / DM, k = i % DM; Wr[i] = p.norm2[k] * (o < 4 ? p.w_rg[k * 4 + o] : p.w_re[k * 32 + (o - 4)]); }
    }
    grid.sync();
    {
        g8::DenseOrder S; S.init(xb, W1t, T, NPROJ, DM, (int)gridDim.x, (int)blockIdx.x);
        const g8::EpiProjF E{proj, r1};
        g8::gemm_phase<false>((LAS unsigned char*)lds, DM, S, E);
    }
    grid.sync();
    {
        for (int u0 = blockIdx.x; u0 < NB * NH * 4; u0 += gridDim.x) { const int bh = u0 >> 2;
            for (int i = 0; i < 4; ++i) att::attn_unit((LAS unsigned char*)lds, proj, p.relb, mix, ssA, bh >> 4, bh & 15, (u0 & 3) + 4 * i); }
        for (int it = c.gw; it < (T / 32) * 4; it += c.ngw) conv_slab(proj, p.conv_w, mix, ssC, it, c.lane);
    }
    grid.sync();
    {
        g8::DenseOrder S; S.init(mix, W2t, T, DM, DM, (int)gridDim.x, (int)blockIdx.x);
        LAS float* tab = (LAS float*)(lds + 131072);
        g8::Unit u;
        for (int i = 0; i < 4; ++i) if (S.next(i, u) && c.tid < 256) { const int row = u.pm * 256 + c.tid; float sa = 0.f;
#pragma unroll
            for (int h = 0; h < 16; ++h) sa += ssA[row * 16 + h];
            const float4 sc4 = *(const float4*)(ssC + row * 4); const float ra = rsqrtf(sa * (1.f / DATT) + EPS), rc = rsqrtf((sc4.x + sc4.y + sc4.z + sc4.w) * (1.f / DCONV) + EPS);
            tab[(i * 256 + c.tid) * 2] = ra / rc; tab[(i * 256 + c.tid) * 2 + 1] = rc; }
        __syncthreads();
        const g8::EpiG2F E{p.x, p.out, xb, tab, (int)gridDim.x};
        g8::gemm_phase<false>((LAS unsigned char*)lds, DM, S, E);
    }
    grid.sync();
    for (int t = c.gw; t < T; t += c.ngw) router_row(p.out, Wr, p.b_rg, p.b_re, cnt, list, wts, r2, t, c.lane);
    grid.sync();
    LAS int* pl = (LAS int*)(lds + LDS_PLAN_OFF);
    if (c.tid == 0) { int tl = 0;
        for (int e = 0; e < NE; ++e) { const int ce = cnt[e]; pl[e] = ce; pl[32 + e] = tl * 256; const int mt = (ce + 255) >> 8; for (int i = 0; i < mt; ++i) pl[64 + tl + i] = e; tl += mt; }
        for (int i = tl; i < NTILEMAX; ++i) pl[64 + i] = -1;
        pl[224] = tl; }
    __syncthreads();
    const int ntile = pl[224];
    {
        const g8::MoeOrder<true> S{(const char*)xb, (const char*)Wgut, list, pl, DM, 4, ntile * 4, (int)gridDim.x, (int)blockIdx.x, (size_t)2 * DEXP * DM * 2};
        const g8::EpiGUF<g8::MoeOrder<true>> E{Hb, r2, &S};
        g8::gemm_phase<true>((LAS unsigned char*)lds, DM, S, E);
    }
    grid.sync();
    {
        const g8::MoeOrder<false> S{(const char*)Hb, (const char*)Wdt, list, pl, DEXP, 8, ntile * 8, (int)gridDim.x, (int)blockIdx.x, (size_t)DM * DEXP * 2};
        const g8::EpiDownF<g8::MoeOrder<false>> E{Y, wts, &S};
        g8::gemm_phase<false>((LAS unsigned char*)lds, DEXP, S, E);
    }
    grid.sync();
    for (int t = c.gw; t < T; t += c.ngw) final_row(p.out, Y, p.norm_f, t, c.lane);
}

extern "C" void kernel_launch(void* const* d_in, const int* in_sizes, int n_in, void* d_out, int out_size, void* d_ws, size_t ws_size, hipStream_t stream) {
    static int grid = 0;
    if (grid == 0) {
        int dev = 0, cus = 0, per_cu = 0;
        if (ws_size < WS_END || n_in != 17) { fprintf(stderr, "kernel_launch: unexpected sizes (ws %zu)\n", ws_size); grid = -1; return; }
        (void)hipGetDevice(&dev); (void)hipDeviceGetAttribute(&cus, hipDeviceAttributeMultiprocessorCount, dev);
        if (hipFuncSetAttribute((const void*)mega, hipFuncAttributeMaxDynamicSharedMemorySize, LDS_BYTES) != hipSuccess) { fprintf(stderr, "hipFuncSetAttribute failed\n"); grid = -1; return; }
        if (hipOccupancyMaxActiveBlocksPerMultiprocessor(&per_cu, (const void*)mega, NTHREADS, LDS_BYTES) != hipSuccess || per_cu < 1) { fprintf(stderr, "occupancy query failed (%d)\n", per_cu); grid = -1; return; }
        grid = cus * per_cu;
        fprintf(stderr, "kernel_launch: cus %d per_cu %d grid %d\n", cus, per_cu, grid);
    }
    if (grid < 0) return;
    Params p{};
    p.x = (const float*)d_in[0]; p.norm1 = (const float*)d_in[1]; p.w_in = (const float*)d_in[2]; p.relb = (const float*)d_in[3];
    p.conv_w = (const float*)d_in[4]; p.g_oa = (const float*)d_in[5]; p.g_oc = (const float*)d_in[6]; p.w_out = (const float*)d_in[7];
    p.norm2 = (const float*)d_in[8]; p.w_rg = (const float*)d_in[9]; p.b_rg = (const float*)d_in[10]; p.w_re = (const float*)d_in[11];
    p.b_re = (const float*)d_in[12]; p.w_gate = (const float*)d_in[13]; p.w_up = (const float*)d_in[14]; p.w_down = (const float*)d_in[15];
    p.norm_f = (const float*)d_in[16]; p.out = (float*)d_out; p.ws = (char*)d_ws;
    void* args[] = {&p};
    hipError_t e = hipLaunchCooperativeKernel((const void*)mega, dim3(grid), dim3(NTHREADS), args, LDS_BYTES, stream);
    if (e != hipSuccess) fprintf(stderr, "cooperative launch failed: %s (grid %d)\n", hipGetErrorString(e), grid);
}
```

```cpp
#include <hip/hip_runtime.h>
#include <hip/hip_cooperative_groups.h>
#include <stdint.h>
#include <cstdio>
namespace cg = cooperative_groups;

typedef unsigned short bf16_t;
typedef short bf16x8 __attribute__((ext_vector_type(8)));
typedef float f32x4 __attribute__((ext_vector_type(4)));

constexpr int NB = 4, SEQ = 4096, T = NB * SEQ, DM = 2048, DATT = 1024, DCONV = 1024, NPROJ = 6144;
constexpr int NH = 16, HD = 64, NREL = 513, NE = 32, DEXP = 512, NPAIR = 2 * T;
constexpr int NPADMAX = 40960, NTILEMAX = NPADMAX / 256;
constexpr float EPS = 1e-6f;
constexpr float LOG2E = 1.4426950408889634f, QSCALE = 0.125f * LOG2E;

constexpr size_t MiB = 1u << 20;
constexpr size_t WS_CTL = 0;
constexpr size_t WS_BAR = 16 * 1024;
constexpr size_t WS_PLAN = 64 * 1024;
constexpr size_t WS_R1 = 128 * 1024;
constexpr size_t WS_RA = 192 * 1024;
constexpr size_t WS_RC = 256 * 1024;
constexpr size_t WS_R2 = 320 * 1024;
constexpr size_t WS_SSC = 3 * MiB;
constexpr size_t WS_WTS = 512 * 1024;
constexpr size_t WS_ROWPAIR = 640 * 1024;
constexpr size_t WS_WR = 1 * MiB;
constexpr size_t WS_SSA = 2 * MiB;
constexpr size_t WS_LIST = 5 * MiB;
constexpr size_t WS_W2T = 8 * MiB;
constexpr size_t WS_W1T = 16 * MiB;
constexpr size_t WS_WDT = 40 * MiB;
constexpr size_t WS_WGUT = 104 * MiB;
constexpr size_t WS_XB = 232 * MiB;
constexpr size_t WS_MIX = 296 * MiB;
constexpr size_t WS_PROJ = 360 * MiB;
constexpr size_t WS_Y = 360 * MiB;
constexpr size_t WS_H = 488 * MiB;
constexpr size_t WS_END = 552 * MiB;

__device__ __forceinline__ unsigned f2bf(float f) { unsigned u = __float_as_uint(f); return (u + 0x7fffu + ((u >> 16) & 1u)) >> 16; }
__device__ __forceinline__ unsigned pk2(float lo, float hi) { return f2bf(lo) | (f2bf(hi) << 16); }
__device__ __forceinline__ float bf2f(unsigned h) { return __uint_as_float(h << 16); }
__device__ __forceinline__ float wave_sum(float v) {
#pragma unroll
    for (int o = 1; o < 64; o <<= 1) v += __shfl_xor(v, o);
    return v;
}


#define LAS __attribute__((address_space(3)))
constexpr int NWAVES = 8, NTHREADS = 512;
constexpr int LDS_BYTES = 147456;
constexpr int LDS_PLAN_OFF = 140 * 1024;

struct Params {
    const float *x, *norm1, *w_in, *relb, *conv_w, *g_oa, *g_oc, *w_out, *norm2, *w_rg, *b_rg, *w_re, *b_re, *w_gate, *w_up, *w_down, *norm_f;
    float* out; char* ws; int never; int pad;
};
struct Ctx { int tid, lane, wave, gw, ngw; };

__device__ __forceinline__ void p0_x_row(const float* __restrict__ x, bf16_t* __restrict__ xb, float* __restrict__ r1, int row, int lane) {
    const float4* xr = (const float4*)(x + (size_t)row * DM);
    uint2* o = (uint2*)(xb + (size_t)row * DM);
    float ss = 0.f;
#pragma unroll
    for (int j = 0; j < 8; ++j) { float4 v = xr[j * 64 + lane]; ss += v.x * v.x + v.y * v.y + v.z * v.z + v.w * v.w; o[j * 64 + lane] = make_uint2(pk2(v.x, v.y), pk2(v.z, v.w)); }
    ss = wave_sum(ss);
    if (lane == 0) r1[row] = rsqrtf(ss * (1.f / DM) + EPS);
}
__device__ __forceinline__ void p0_titem(const float* __restrict__ W, int N, const float* __restrict__ g, bf16_t* __restrict__ WT, int ldd, int k0, int n0, int drow0, LAS float* scr, int lane, float cs = 1.f) {
#pragma unroll 8
    for (int i = 0; i < 32; ++i) { const int kk = 2 * i + (lane >> 5); const float s = (g ? g[k0 + kk] : 1.f) * cs; scr[kk * 33 + (lane & 31)] = W[(size_t)(k0 + kk) * N + n0 + (lane & 31)] * s; }
    asm volatile("s_waitcnt lgkmcnt(0)" ::: "memory");
    const int c = lane & 7;
#pragma unroll
    for (int j = 0; j < 4; ++j) { const int n = (lane >> 3) + 8 * j; const LAS float* sp = scr + (8 * c) * 33 + n;
        uint4 o; o.x = pk2(sp[0 * 33], sp[1 * 33]); o.y = pk2(sp[2 * 33], sp[3 * 33]); o.z = pk2(sp[4 * 33], sp[5 * 33]); o.w = pk2(sp[6 * 33], sp[7 * 33]);
        *(uint4*)(WT + (size_t)(drow0 + n) * ldd + k0 + 8 * c) = o; }
    asm volatile("s_waitcnt lgkmcnt(0)" ::: "memory");
}
__device__ __forceinline__ int gu_row(int n, int up) { return ((n >> 7) << 8) + (n & 127) + (up ? 128 : 0); }

template <int MODE, class Epi>
__device__ __forceinline__ void sg_tile(const bf16_t* A, int lda, const bf16_t* B, int ldb, int K, int kmid, int r0, int c0, const int (&arow)[2], int lane, const Epi& epi) {
    const int fr = lane & 15, fq = lane >> 4;
    const bf16_t* ap[2]; const bf16_t* bp[2];
#pragma unroll
    for (int i = 0; i < 2; ++i) ap[i] = A + (size_t)arow[i] * lda + 8 * fq;
#pragma unroll
    for (int j = 0; j < 2; ++j) { const int n = c0 + 16 * j + fr; const int brow = (MODE == 2) ? gu_row(n, 0) : n; bp[j] = B + (size_t)brow * ldb + 8 * fq; }
    f32x4 acc0[2][2], acc1[2][2];
#pragma unroll
    for (int i = 0; i < 2; ++i)
#pragma unroll
        for (int j = 0; j < 2; ++j) { acc0[i][j] = (f32x4){0.f, 0.f, 0.f, 0.f}; acc1[i][j] = (f32x4){0.f, 0.f, 0.f, 0.f}; }
    for (int k = 0; k < K; k += 32) {
        bf16x8 a[2], b0[2], b1[2];
#pragma unroll
        for (int i = 0; i < 2; ++i) a[i] = *(const bf16x8*)(ap[i] + k);
#pragma unroll
        for (int j = 0; j < 2; ++j) { b0[j] = *(const bf16x8*)(bp[j] + k); if (MODE == 2) b1[j] = *(const bf16x8*)(bp[j] + (size_t)128 * ldb + k); else b1[j] = b0[j]; }
        if (MODE == 1) {
            if (k < kmid) {
#pragma unroll
                for (int i = 0; i < 2; ++i)
#pragma unroll
                    for (int j = 0; j < 2; ++j) acc0[i][j] = __builtin_amdgcn_mfma_f32_16x16x32_bf16(b0[j], a[i], acc0[i][j], 0, 0, 0);
            } else {
#pragma unroll
                for (int i = 0; i < 2; ++i)
#pragma unroll
                    for (int j = 0; j < 2; ++j) acc1[i][j] = __builtin_amdgcn_mfma_f32_16x16x32_bf16(b0[j], a[i], acc1[i][j], 0, 0, 0);
            }
        } else {
#pragma unroll
            for (int i = 0; i < 2; ++i)
#pragma unroll
                for (int j = 0; j < 2; ++j) { acc0[i][j] = __builtin_amdgcn_mfma_f32_16x16x32_bf16(b0[j], a[i], acc0[i][j], 0, 0, 0);
                    if (MODE == 2) acc1[i][j] = __builtin_amdgcn_mfma_f32_16x16x32_bf16(b1[j], a[i], acc1[i][j], 0, 0, 0); }
        }
    }
#pragma unroll
    for (int i = 0; i < 2; ++i)
#pragma unroll
        for (int j = 0; j < 2; ++j) epi(acc0[i][j], acc1[i][j], i, r0 + 16 * i + fr, c0 + 16 * j + 4 * fq);
}
struct EpiProj { bf16_t* out; const float* r1;
    __device__ __forceinline__ void operator()(f32x4 a, f32x4, int, int row, int col) const { const float s = r1[row]; *(uint2*)(out + (size_t)row * NPROJ + col) = make_uint2(pk2(a[0] * s, a[1] * s), pk2(a[2] * s, a[3] * s)); } };
struct EpiG2 { const float* x; const float* ssA; const float* ssC; float* x1; bf16_t* xb1;
    __device__ __forceinline__ void operator()(f32x4 a, f32x4 c, int, int row, int col) const {
        float s = 0.f;
#pragma unroll
        for (int h = 0; h < 16; ++h) s += ssA[row * 16 + h];
        const float sa = rsqrtf(s * (1.f / DATT) + EPS), sc = rsqrtf(ssC[row] * (1.f / DCONV) + EPS);
        const float4 xv = *(const float4*)(x + (size_t)row * DM + col);
        float4 o; o.x = xv.x + sa * a[0] + sc * c[0]; o.y = xv.y + sa * a[1] + sc * c[1]; o.z = xv.z + sa * a[2] + sc * c[2]; o.w = xv.w + sa * a[3] + sc * c[3];
        *(float4*)(x1 + (size_t)row * DM + col) = o; *(uint2*)(xb1 + (size_t)row * DM + col) = make_uint2(pk2(o.x, o.y), pk2(o.z, o.w)); } };
struct EpiGU { bf16_t* Hb; const float* r2; int pr[2];
    __device__ __forceinline__ void operator()(f32x4 g, f32x4 u, int i, int row, int col) const { const float s = r2[pr[i] >= 0 ? (pr[i] >> 1) : 0]; float h[4];
#pragma unroll
        for (int q = 0; q < 4; ++q) { const float gg = g[q] * s, uu = u[q] * s; h[q] = gg / (1.f + __expf(-gg)) * uu; }
        *(uint2*)(Hb + (size_t)row * DEXP + col) = make_uint2(pk2(h[0], h[1]), pk2(h[2], h[3])); } };
struct EpiDown { bf16_t* Y; const float* wts; int pr[2];
    __device__ __forceinline__ void operator()(f32x4 a, f32x4, int i, int, int col) const { if (pr[i] < 0) return; const float s = wts[pr[i]];
        *(uint2*)(Y + (size_t)pr[i] * DM + col) = make_uint2(pk2(a[0] * s, a[1] * s), pk2(a[2] * s, a[3] * s)); } };

__device__ __forceinline__ void attn_simple(const bf16_t* __restrict__ proj, const float* __restrict__ relb, bf16_t* __restrict__ mix, float* __restrict__ ssA, int bid, int qi) {
    const int h = bid & 15, c = (bid >> 4) & 63, b = bid >> 10, t = b * SEQ + c * 64 + qi;
    float q[64], o[64];
    { const uint4* qp = (const uint4*)(proj + (size_t)t * NPROJ + h * HD);
#pragma unroll
      for (int i = 0; i < 8; ++i) { const uint4 v = qp[i]; const unsigned w[4] = {v.x, v.y, v.z, v.w};
#pragma unroll
          for (int j = 0; j < 4; ++j) { q[8 * i + 2 * j] = bf2f(w[j] & 0xffffu) * (1.f / LOG2E); q[8 * i + 2 * j + 1] = bf2f(w[j] >> 16) * (1.f / LOG2E); } } }
#pragma unroll
    for (int d = 0; d < 64; ++d) o[d] = 0.f;
    float m = -1e30f, l = 0.f;
    const float* rb = relb + h * NREL;
    const int jc0 = c - 8 < 0 ? 0 : c - 8;
    for (int jc = jc0; jc <= c; ++jc)
        for (int kj = 0; kj < 64; ++kj) {
            const int tk = b * SEQ + jc * 64 + kj;
            const uint4* kp = (const uint4*)(proj + (size_t)tk * NPROJ + DATT + h * HD);
            const uint4* vp = (const uint4*)(proj + (size_t)tk * NPROJ + 2 * DATT + h * HD);
            float s = 0.f;
#pragma unroll
            for (int i = 0; i < 8; ++i) { const uint4 v = kp[i]; const unsigned w[4] = {v.x, v.y, v.z, v.w};
#pragma unroll
                for (int j = 0; j < 4; ++j) { s += q[8 * i + 2 * j] * bf2f(w[j] & 0xffffu); s += q[8 * i + 2 * j + 1] * bf2f(w[j] >> 16); } }
            int dist = (c - jc) * 64 + qi - kj; dist = dist < -256 ? -256 : (dist > 256 ? 256 : dist);
            s += rb[dist + 256];
            const float mn = fmaxf(m, s), al = __expf(m - mn), pp = __expf(s - mn);
            l = l * al + pp; m = mn;
#pragma unroll
            for (int i = 0; i < 8; ++i) { const uint4 v = vp[i]; const unsigned w[4] = {v.x, v.y, v.z, v.w};
#pragma unroll
                for (int j = 0; j < 4; ++j) { o[8 * i + 2 * j] = o[8 * i + 2 * j] * al + pp * bf2f(w[j] & 0xffffu); o[8 * i + 2 * j + 1] = o[8 * i + 2 * j + 1] * al + pp * bf2f(w[j] >> 16); } }
        }
    const float il = 1.f / l; float ss = 0.f;
    uint4* op = (uint4*)(mix + (size_t)t * DM + h * HD);
#pragma unroll
    for (int i = 0; i < 8; ++i) { float v[8];
#pragma unroll
        for (int j = 0; j < 8; ++j) { v[j] = o[8 * i + j] * il; ss += v[j] * v[j]; }
        op[i] = make_uint4(pk2(v[0], v[1]), pk2(v[2], v[3]), pk2(v[4], v[5]), pk2(v[6], v[7])); }
    ssA[t * 16 + h] = ss;
}
__device__ __forceinline__ void conv_row(const bf16_t* __restrict__ proj, const float* __restrict__ cw, bf16_t* __restrict__ mix, float* __restrict__ ssC, int t, int lane) {
    const int s = t & (SEQ - 1); float ss = 0.f;
#pragma unroll
    for (int cc = 0; cc < 4; ++cc) { const int ch = (cc * 64 + lane) * 4;
        float y[4] = {0.f, 0.f, 0.f, 0.f};
#pragma unroll
        for (int j = 0; j < 3; ++j) { const int back = 2 - j; if (s - back < 0) continue;
            const bf16_t* pr = proj + (size_t)(t - back) * NPROJ;
            const uint2 cv = *(const uint2*)(pr + 4 * DATT + ch), uv = *(const uint2*)(pr + 5 * DATT + ch);
            const float4 wv = *(const float4*)(cw + j * DCONV + ch);
            y[0] += wv.x * bf2f(cv.x & 0xffffu) * bf2f(uv.x & 0xffffu); y[1] += wv.y * bf2f(cv.x >> 16) * bf2f(uv.x >> 16);
            y[2] += wv.z * bf2f(cv.y & 0xffffu) * bf2f(uv.y & 0xffffu); y[3] += wv.w * bf2f(cv.y >> 16) * bf2f(uv.y >> 16); }
        const uint2 bv = *(const uint2*)(proj + (size_t)t * NPROJ + 3 * DATT + ch);
        y[0] *= bf2f(bv.x & 0xffffu); y[1] *= bf2f(bv.x >> 16); y[2] *= bf2f(bv.y & 0xffffu); y[3] *= bf2f(bv.y >> 16);
        *(uint2*)(mix + (size_t)t * DM + DATT + ch) = make_uint2(pk2(y[0], y[1]), pk2(y[2], y[3]));
        ss += y[0] * y[0] + y[1] * y[1] + y[2] * y[2] + y[3] * y[3]; }
    ss = wave_sum(ss);
    if (lane == 0) ssC[t] = ss;
}
__device__ __forceinline__ void router_row(const float* __restrict__ x1, const float* __restrict__ Wr, const float* __restrict__ brg, const float* __restrict__ bre,
                                           int* __restrict__ cnt, int* __restrict__ list, float* __restrict__ wts, float* __restrict__ r2out, int t, int lane, bool commit = true) {
    const float4* xr = (const float4*)(x1 + (size_t)t * DM);
    float4 v[8]; float ss = 0.f;
#pragma unroll
    for (int j = 0; j < 8; ++j) { v[j] = xr[j * 64 + lane]; ss += v[j].x * v[j].x + v[j].y * v[j].y + v[j].z * v[j].z + v[j].w * v[j].w; }
    const float r2 = rsqrtf(wave_sum(ss) * (1.f / DM) + EPS);
    float lg[4];
#pragma unroll
    for (int o = 0; o < 4; ++o) { const float4* wr = (const float4*)(Wr + (size_t)o * DM); float p = 0.f;
#pragma unroll
        for (int j = 0; j < 8; ++j) { const float4 wv = wr[j * 64 + lane]; p += v[j].x * wv.x + v[j].y * wv.y + v[j].z * wv.z + v[j].w * wv.w; }
        lg[o] = wave_sum(p) * r2 + brg[o]; }
    int gs = 0; float gm = lg[0];
#pragma unroll
    for (int g = 1; g < 4; ++g) if (lg[g] > gm) { gm = lg[g]; gs = g; }
    float den = 0.f;
#pragma unroll
    for (int g = 0; g < 4; ++g) den += __expf(lg[g] - gm);
    const float pg = 1.f / den;
    gs = __builtin_amdgcn_readfirstlane(gs);
    float el[8];
#pragma unroll
    for (int i = 0; i < 8; ++i) { const float4* wr = (const float4*)(Wr + (size_t)(4 + gs * 8 + i) * DM); float p = 0.f;
#pragma unroll
        for (int j = 0; j < 8; ++j) { const float4 wv = wr[j * 64 + lane]; p += v[j].x * wv.x + v[j].y * wv.y + v[j].z * wv.z + v[j].w * wv.w; }
        el[i] = wave_sum(p) * r2 + bre[gs * 8 + i]; }
    int i1 = 0; float v1 = el[0];
#pragma unroll
    for (int i = 1; i < 8; ++i) if (el[i] > v1) { v1 = el[i]; i1 = i; }
    int i2 = -1; float v2 = -3.0e38f;
#pragma unroll
    for (int i = 0; i < 8; ++i) if (i != i1 && el[i] > v2) { v2 = el[i]; i2 = i; }
    const float e2 = __expf(v2 - v1), w0 = pg / (1.f + e2), w1 = pg * e2 / (1.f + e2);
    if (lane == 0 && commit) {
        r2out[t] = r2;
        const int ea = gs * 8 + i1, eb = gs * 8 + i2;
        const int sa = atomicAdd(&cnt[ea], 1); list[ea * T + sa] = 2 * t; wts[2 * t] = w0;
        const int sb = atomicAdd(&cnt[eb], 1); list[eb * T + sb] = 2 * t + 1; wts[2 * t + 1] = w1;
    }
}
__device__ __forceinline__ void final_row(float* __restrict__ out, const bf16_t* __restrict__ Y, const float* __restrict__ g, int t, int lane) {
    float4* xr = (float4*)(out + (size_t)t * DM);
    const uint2* y0 = (const uint2*)(Y + (size_t)(2 * t) * DM); const uint2* y1 = (const uint2*)(Y + (size_t)(2 * t + 1) * DM);
    float4 v[8]; float ss = 0.f;
#pragma unroll
    for (int j = 0; j < 8; ++j) { float4 a = xr[j * 64 + lane]; const uint2 p = y0[j * 64 + lane], q = y1[j * 64 + lane];
        a.x += bf2f(p.x & 0xffffu) + bf2f(q.x & 0xffffu); a.y += bf2f(p.x >> 16) + bf2f(q.x >> 16); a.z += bf2f(p.y & 0xffffu) + bf2f(q.y & 0xffffu); a.w += bf2f(p.y >> 16) + bf2f(q.y >> 16);
        v[j] = a; ss += a.x * a.x + a.y * a.y + a.z * a.z + a.w * a.w; }
    const float r = rsqrtf(wave_sum(ss) * (1.f / DM) + EPS);
#pragma unroll
    for (int j = 0; j < 8; ++j) { const float4 gv = ((const float4*)g)[j * 64 + lane]; float4 a = v[j]; a.x *= r * gv.x; a.y *= r * gv.y; a.z *= r * gv.z; a.w *= r * gv.w; xr[j * 64 + lane] = a; }
}


namespace att {
typedef float f32x16 __attribute__((ext_vector_type(16)));
typedef short s16x4 __attribute__((ext_vector_type(4)));
typedef short v4i16_t __attribute__((ext_vector_type(4)));
constexpr int SLOT = 8192, L_K = 0, L_V = 2 * SLOT, L_TB = 4 * SLOT, NTB = 576;
__device__ __forceinline__ float rowmax32(const f32x16& p0, const f32x16& p1) {
    float a = fmaxf(p0[0], p1[0]);
#pragma unroll
    for (int r = 1; r < 16; ++r) a = fmaxf(a, fmaxf(p0[r], p1[r]));
    auto rr = __builtin_amdgcn_permlane32_swap(__float_as_uint(a), __float_as_uint(a), false, false);
    return fmaxf(__uint_as_float(rr[0]), __uint_as_float(rr[1]));
}
__device__ __forceinline__ unsigned cvtpk(float lo, float hi) { typedef float f2 __attribute__((ext_vector_type(2))); typedef __bf16 b2 __attribute__((ext_vector_type(2))); f2 v = {lo, hi}; b2 b = __builtin_convertvector(v, b2); return __builtin_bit_cast(unsigned, b); }
__device__ __forceinline__ s16x4 vtr(LAS const unsigned char* p) { return __builtin_bit_cast(s16x4, __builtin_amdgcn_ds_read_tr16_b64_v4i16((LAS v4i16_t*)p)); }

__device__ __forceinline__ void attn_unit(LAS unsigned char* lds, const bf16_t* __restrict__ proj, const float* __restrict__ relb, bf16_t* __restrict__ mix, float* __restrict__ ssA, int b, int h, int cg) {
    const int tid = threadIdx.x, lane = tid & 63, r32 = lane & 31, hi = lane >> 5, w = __builtin_amdgcn_readfirstlane(tid >> 6);
    const int c0 = cg * 4, cq = c0 + (w >> 1), qi = 32 * (w & 1) + r32;
    const int j0 = c0 - 8 < 0 ? 0 : c0 - 8, j1 = c0 + 3;
    LAS float* tb = (LAS float*)(lds + L_TB);
    for (int i = tid; i < NTB; i += NTHREADS) tb[i] = relb[h * NREL + (i > 512 ? 512 : i)] * LOG2E;
    const size_t tq = (size_t)b * SEQ + (size_t)c0 * 64 + 32 * w + r32;
    bf16x8 qr[4];
#pragma unroll
    for (int d0 = 0; d0 < 4; ++d0) qr[d0] = *(const bf16x8*)(proj + tq * NPROJ + h * HD + d0 * 16 + hi * 8);
    const int krow = 8 * w + (lane >> 3);
    const bf16_t* ksrc = proj + ((size_t)b * SEQ + krow) * NPROJ + DATT + h * HD + (((lane & 7) ^ ((krow >> 1) & 7)) * 8);
    const bf16_t* vsrc = proj + ((size_t)b * SEQ + 16 * (w & 3) + (lane >> 2)) * NPROJ + 2 * DATT + h * HD + (w >> 2) * 32 + (lane & 3) * 8;
#define ATT_DMA(j, slot) do { __builtin_amdgcn_global_load_lds((const unsigned*)(ksrc + (size_t)(j) * 64 * NPROJ), (LAS unsigned*)(lds + L_K + (slot) * SLOT + w * 1024), 16, 0, 0); \
                              __builtin_amdgcn_global_load_lds((const unsigned*)(vsrc + (size_t)(j) * 64 * NPROJ), (LAS unsigned*)(lds + L_V + (slot) * SLOT + w * 1024), 16, 0, 0); } while (0)
    int ka[4];
#pragma unroll
    for (int d0 = 0; d0 < 4; ++d0) ka[d0] = r32 * 128 + (((2 * d0 + hi) ^ ((r32 >> 1) & 7)) * 16);
    const int va = ((lane >> 4) & 1) * 32 + (lane & 3) * 8 + (4 * hi + ((lane & 15) >> 2)) * 64;
    float m = -1e30f, l = 0.f; f32x16 o[2];
#pragma unroll
    for (int r = 0; r < 16; ++r) { o[0][r] = 0.f; o[1][r] = 0.f; }
    ATT_DMA(j0, 0);
    for (int j = j0; j <= j1; ++j) {
        const int slot = (j - j0) & 1;
        asm volatile("s_waitcnt vmcnt(0) lgkmcnt(0)\n\ts_barrier" ::: "memory");
        if (j < j1) ATT_DMA(j + 1, slot ^ 1);
        const int dl = cq - j;
        if (dl >= 0 && dl <= 8) {
            LAS const unsigned char* Ks = lds + L_K + slot * SLOT; LAS const unsigned char* Vs = lds + L_V + slot * SLOT + va;
            f32x16 p0, p1;
            if (dl <= 4) { LAS const float* tp = tb + (64 * dl + qi + 256 - 4 * hi - 59);
#pragma unroll
                for (int r = 0; r < 16; ++r) { p0[r] = tp[59 - ((r & 3) + 8 * (r >> 2))]; p1[r] = tp[27 - ((r & 3) + 8 * (r >> 2))]; } }
            else { const float bf = tb[NTB - 1];
#pragma unroll
                for (int r = 0; r < 16; ++r) { p0[r] = bf; p1[r] = bf; } }
#pragma unroll
            for (int d0 = 0; d0 < 4; ++d0) { const bf16x8 k0 = *(LAS const bf16x8*)(Ks + ka[d0]), k1 = *(LAS const bf16x8*)(Ks + ka[d0] + 4096);
                p0 = __builtin_amdgcn_mfma_f32_32x32x16_bf16(k0, qr[d0], p0, 0, 0, 0); p1 = __builtin_amdgcn_mfma_f32_32x32x16_bf16(k1, qr[d0], p1, 0, 0, 0); }
            const float mn = fmaxf(m, rowmax32(p0, p1)), al = __builtin_amdgcn_exp2f(m - mn); m = mn;
            float rs = 0.f;
#pragma unroll
            for (int r = 0; r < 16; ++r) { p0[r] = __builtin_amdgcn_exp2f(p0[r] - mn); p1[r] = __builtin_amdgcn_exp2f(p1[r] - mn); rs += p0[r] + p1[r]; }
            l = l * al + rs;
#pragma unroll
            for (int r = 0; r < 16; ++r) { o[0][r] *= al; o[1][r] *= al; }
            bf16x8 pw[4];
#pragma unroll
            for (int ks = 0; ks < 4; ++ks) { const f32x16& P = ks < 2 ? p0 : p1; const int bo = (ks & 1) * 8; typedef unsigned u4 __attribute__((ext_vector_type(4)));
                u4 t4 = {cvtpk(P[bo], P[bo + 1]), cvtpk(P[bo + 2], P[bo + 3]), cvtpk(P[bo + 4], P[bo + 5]), cvtpk(P[bo + 6], P[bo + 7])}; pw[ks] = __builtin_bit_cast(bf16x8, t4); }
#pragma unroll
            for (int d0 = 0; d0 < 2; ++d0)
#pragma unroll
                for (int ks = 0; ks < 4; ++ks) { const s16x4 lo = vtr(Vs + d0 * 4096 + ks * 1024), hh = vtr(Vs + d0 * 4096 + ks * 1024 + 512);
                    const bf16x8 vf = {lo[0], lo[1], lo[2], lo[3], hh[0], hh[1], hh[2], hh[3]};
                    o[d0] = __builtin_amdgcn_mfma_f32_32x32x16_bf16(vf, pw[ks], o[d0], 0, 0, 0); }
        }
    }
    { auto rr = __builtin_amdgcn_permlane32_swap(__float_as_uint(l), __float_as_uint(l), false, false); l = __uint_as_float(rr[0]) + __uint_as_float(rr[1]); }
    const float il = 1.f / l; float ss = 0.f;
    bf16_t* op = mix + tq * DM + h * HD + 4 * hi;
#pragma unroll
    for (int d0 = 0; d0 < 2; ++d0)
#pragma unroll
        for (int g = 0; g < 4; ++g) { const float v0 = o[d0][4 * g] * il, v1 = o[d0][4 * g + 1] * il, v2 = o[d0][4 * g + 2] * il, v3 = o[d0][4 * g + 3] * il;
            ss += v0 * v0 + v1 * v1 + v2 * v2 + v3 * v3; *(uint2*)(op + 32 * d0 + 8 * g) = make_uint2(cvtpk(v0, v1), cvtpk(v2, v3)); }
    { auto rr = __builtin_amdgcn_permlane32_swap(__float_as_uint(ss), __float_as_uint(ss), false, false); ss = __uint_as_float(rr[0]) + __uint_as_float(rr[1]); }
    if (hi == 0) ssA[tq * 16 + h] = ss;
    asm volatile("s_waitcnt vmcnt(0) lgkmcnt(0)\n\ts_barrier" ::: "memory");
#undef ATT_DMA
}
}

__device__ __forceinline__ void conv_slab(const bf16_t* __restrict__ proj, const float* __restrict__ cw, bf16_t* __restrict__ mix, float* __restrict__ ssC4, int item, int lane) {
    const int slab = item & 3, t0 = (item >> 2) * 32, ch = slab * 256 + lane * 4;
    const float4 w0 = *(const float4*)(cw + ch), w1 = *(const float4*)(cw + DCONV + ch), w2 = *(const float4*)(cw + 2 * DCONV + ch);
    float z1[4] = {0.f, 0.f, 0.f, 0.f}, z2[4] = {0.f, 0.f, 0.f, 0.f};
    if ((t0 & (SEQ - 1)) != 0) {
#pragma unroll
        for (int back = 2; back >= 1; --back) { const bf16_t* pr = proj + (size_t)(t0 - back) * NPROJ; const uint2 cv = *(const uint2*)(pr + 4 * DATT + ch), uv = *(const uint2*)(pr + 5 * DATT + ch);
            float z[4] = {bf2f(cv.x & 0xffffu) * bf2f(uv.x & 0xffffu), bf2f(cv.x >> 16) * bf2f(uv.x >> 16), bf2f(cv.y & 0xffffu) * bf2f(uv.y & 0xffffu), bf2f(cv.y >> 16) * bf2f(uv.y >> 16)};
#pragma unroll
            for (int q = 0; q < 4; ++q) { if (back == 2) z2[q] = z[q]; else z1[q] = z[q]; } }
    }
#pragma unroll 4
    for (int i = 0; i < 32; ++i) { const int t = t0 + i; const bf16_t* pr = proj + (size_t)t * NPROJ;
        const uint2 bv = *(const uint2*)(pr + 3 * DATT + ch), cv = *(const uint2*)(pr + 4 * DATT + ch), uv = *(const uint2*)(pr + 5 * DATT + ch);
        const float z[4] = {bf2f(cv.x & 0xffffu) * bf2f(uv.x & 0xffffu), bf2f(cv.x >> 16) * bf2f(uv.x >> 16), bf2f(cv.y & 0xffffu) * bf2f(uv.y & 0xffffu), bf2f(cv.y >> 16) * bf2f(uv.y >> 16)};
        const float bb[4] = {bf2f(bv.x & 0xffffu), bf2f(bv.x >> 16), bf2f(bv.y & 0xffffu), bf2f(bv.y >> 16)};
        const float wa[4] = {w0.x, w0.y, w0.z, w0.w}, wb[4] = {w1.x, w1.y, w1.z, w1.w}, wc[4] = {w2.x, w2.y, w2.z, w2.w};
        float y[4]; float ss = 0.f;
#pragma unroll
        for (int q = 0; q < 4; ++q) { y[q] = bb[q] * (wa[q] * z2[q] + wb[q] * z1[q] + wc[q] * z[q]); ss += y[q] * y[q]; z2[q] = z1[q]; z1[q] = z[q]; }
        *(uint2*)(mix + (size_t)t * DM + DATT + ch) = make_uint2(pk2(y[0], y[1]), pk2(y[2], y[3]));
        ss = wave_sum(ss);
        if (lane == 0) ssC4[t * 4 + slab] = ss; }
}

namespace g8 {
typedef unsigned u32x4 __attribute__((ext_vector_type(4)));
constexpr int BM = 256, BK = 64, HALF = 128, HTB = HALF * BK * 2, STAGE_BYTES = 8 * HTB, NXCD = 8, WGM = 8;
__device__ __forceinline__ int lds_byte(int r, int c) { const int st = (r >> 4) * 2 + (c >> 5), rr = r & 15, cc = c & 31, ob = rr * 64 + cc * 2; return st * 1024 + (ob ^ (((ob >> 9) & 1) << 5)); }
__device__ __forceinline__ void stage_rc(int b, int& R, int& C) { const int st = b / 1024, sb = b % 1024, swz = sb ^ (((sb >> 9) & 1) << 5); R = (st >> 1) * 16 + swz / 64; C = (st & 1) * 32 + (swz % 64) / 2; }
__device__ __forceinline__ int perm32(int rho) { const int n = rho >> 4, i = rho & 15; return 8 * (i >> 2) + 4 * n + (i & 3); }
__device__ __forceinline__ unsigned cvt_pk_bf16(float lo, float hi) { unsigned r; asm volatile("v_cvt_pk_bf16_f32 %0, %1, %2" : "=v"(r) : "v"(lo), "v"(hi)); return r; }
__device__ __forceinline__ int xcd_remap(int wgid, int nwg) { const int q = nwg / NXCD, r = nwg % NXCD, xcd = wgid % NXCD, off = wgid / NXCD; return (xcd < r ? xcd * (q + 1) : r * (q + 1) + (xcd - r) * q) + off; }

struct Unit { int pm, pn, e; const char* a; const char* b; };

struct DenseOrder {
    const char* A; const char* Bt; int K, nM, nN, nwg, G, c, mul = 1;
    __device__ __forceinline__ void init(const void* A_, const void* Bt_, int M, int N, int K_, int G_, int c_) { A = (const char*)A_; Bt = (const char*)Bt_; K = K_; nM = M / BM; nN = N / BM; nwg = nM * nN; G = G_; c = c_; }
    __device__ __forceinline__ bool next(int i, Unit& u) const {
        int L = i * G + c; if (L >= nwg * mul) return false; L %= nwg;
        const int wgid = xcd_remap(L, nwg);
        const int nig = WGM * nN, gid = wgid / nig, fm = gid * WGM, gsz = (nM - fm) < WGM ? (nM - fm) : WGM;
        u.pm = fm + ((wgid % nig) % gsz); u.pn = (wgid % nig) / gsz; u.e = i;
        u.a = A + (size_t)u.pm * BM * K * 2; u.b = Bt + (size_t)u.pn * BM * K * 2; return true;
    }
    __device__ __forceinline__ unsigned arow_off(const Unit&, int r, int Kb) const { return (unsigned)r * (unsigned)Kb; }
};
template <bool GATHER> struct MoeOrder {
    const char* A; const char* Bt; const int* list; LAS const int* pl; int K, NPN, nwg, G, c; size_t estride; int mul;
    __device__ __forceinline__ bool next(int i, Unit& u) const {
        int L = i * G + c; if (L >= nwg * mul) return false; L %= nwg;
        const int wgid = xcd_remap(L, nwg);
        u.pm = wgid / NPN; u.pn = wgid % NPN; u.e = pl[64 + u.pm];
        u.a = GATHER ? A : A + (size_t)u.pm * BM * K * 2; u.b = Bt + (size_t)u.e * estride + (size_t)u.pn * BM * K * 2; return true;
    }
    __device__ __forceinline__ int pair_of(const Unit& u, int r) const { const int slot = u.pm * BM + r - pl[32 + u.e]; return slot < pl[u.e] ? list[u.e * T + slot] : -1; }
    __device__ __forceinline__ unsigned arow_off(const Unit& u, int r, int Kb) const {
        if (GATHER) { const int pr = pair_of(u, r); return (unsigned)(pr >= 0 ? (pr >> 1) : 0) * (unsigned)Kb; }
        return (unsigned)r * (unsigned)Kb;
    }
};

template <bool GATHER, class Epi, class Sched>
__device__ __forceinline__ void gemm_phase(LAS unsigned char* lds, const int K, const Sched& S, const Epi& E) {
    const int tid = threadIdx.x, wid = __builtin_amdgcn_readfirstlane(tid >> 6), lane = tid & 63, wr = wid >> 2, wc = wid & 3, fr = lane & 15, fq = lane >> 4;
    const int nt = K / BK, Kb = K * 2;
    int RA[2], CA[2]; unsigned voffB[2];
#pragma unroll
    for (int i = 0; i < 2; ++i) { int R, C; stage_rc(tid * 16 + i * 8192, R, C); RA[i] = R; CA[i] = C * 2; const int Rb = Epi::PERM ? ((R & ~31) + perm32(R & 31)) : R; voffB[i] = (unsigned)(Rb * K + C) * 2u; }
    const size_t kstep = (size_t)(BK * 2);
    const size_t hstep = (size_t)HALF * K * 2;
    const unsigned ldsw = (unsigned)wid * 1024u;
    const int aoff = lds_byte(wr * 64 + fr, fq * 8), boff = lds_byte(wc * 32 + fr, fq * 8);
#define G8_SA(b, h) (((b) * 2 + (h)) * HTB)
#define G8_SB(b, h) ((4 + (b) * 2 + (h)) * HTB)
#define G8_STAGE(bufoff, gbase, voff) do { _Pragma("unroll") for (int _i = 0; _i < 2; ++_i) \
        __builtin_amdgcn_global_load_lds((const unsigned*)((const char*)(gbase) + (voff)[_i]), (LAS unsigned*)(lds + (bufoff) + ldsw + _i * 8192), 16, 0, 0); } while (0)
#define G8_LDA(dst, b, h) do { _Pragma("unroll") for (int m = 0; m < 4; ++m) _Pragma("unroll") for (int k = 0; k < 2; ++k) dst[m][k] = *(const LAS bf16x8*)(lds + G8_SA(b, h) + aoff + m * 2048 + k * 1024); } while (0)
#define G8_LDB(dst, b, h) do { _Pragma("unroll") for (int n = 0; n < 2; ++n) _Pragma("unroll") for (int k = 0; k < 2; ++k) dst[n][k] = *(const LAS bf16x8*)(lds + G8_SB(b, h) + boff + n * 2048 + k * 1024); } while (0)
#define G8_MMA(ai, bj, At, Bt) do { __builtin_amdgcn_s_setprio(1); _Pragma("unroll") for (int m = 0; m < 4; ++m) _Pragma("unroll") for (int n = 0; n < 2; ++n) _Pragma("unroll") for (int k = 0; k < 2; ++k) \
        acc[ai][bj][m][n] = __builtin_amdgcn_mfma_f32_16x16x32_bf16(Bt[n][k], At[m][k], acc[ai][bj][m][n], 0, 0, 0); __builtin_amdgcn_s_setprio(0); } while (0)
#define G8_WAIT_V(n) asm volatile("s_waitcnt vmcnt(" #n ")" ::: "memory")
#define G8_WAIT_L(n) asm volatile("s_waitcnt lgkmcnt(" #n ")" ::: "memory")
#define G8_BAR __builtin_amdgcn_s_barrier()
#define G8_SCHED __builtin_amdgcn_sched_barrier(0)
    Unit cur, nxt; int ui = 0;
    if (!S.next(0, cur)) return;
    f32x4 acc[2][2][4][2];
#pragma unroll
    for (int a = 0; a < 2; ++a)
#pragma unroll
        for (int b = 0; b < 2; ++b)
#pragma unroll
            for (int m = 0; m < 4; ++m)
#pragma unroll
                for (int n = 0; n < 2; ++n) acc[a][b][m][n] = (f32x4){0.f, 0.f, 0.f, 0.f};
    bf16x8 At[4][2], B0[2][2], B1[2][2];
    unsigned vA[2][2], vN[2][2];
#pragma unroll
    for (int h = 0; h < 2; ++h)
#pragma unroll
        for (int i = 0; i < 2; ++i) { vA[h][i] = S.arow_off(cur, h * HALF + RA[i], Kb) + (unsigned)CA[i]; vN[h][i] = vA[h][i]; }
    const char* cA = cur.a; const char* cB = cur.b;
    G8_STAGE(G8_SB(0, 0), cB, voffB); G8_STAGE(G8_SB(0, 1), cB + hstep, voffB); G8_STAGE(G8_SA(0, 0), cA, vA[0]); G8_STAGE(G8_SA(0, 1), cA, vA[1]);
    if (wr == 1) G8_BAR;
    G8_WAIT_V(2); G8_BAR;
    G8_STAGE(G8_SB(1, 0), cB + kstep, voffB); G8_STAGE(G8_SA(1, 0), cA + kstep, vA[0]); G8_STAGE(G8_SB(1, 1), cB + hstep + kstep, voffB);
    G8_WAIT_V(6); G8_BAR;
    for (;;) {
        const bool has_next = S.next(ui + 1, nxt);
        const char* nA = has_next ? nxt.a : cA; const char* nB = has_next ? nxt.b : cB;
        if (GATHER && has_next) {
#pragma unroll
            for (int h = 0; h < 2; ++h)
#pragma unroll
                for (int i = 0; i < 2; ++i) vN[h][i] = S.arow_off(nxt, h * HALF + RA[i], Kb) + (unsigned)CA[i];
        }
        for (int t = 0; t < nt; t += 2) {
            const bool last = (t == nt - 2);
            if (Epi::MID_T >= 0 && t == Epi::MID_T) E.mid(acc, cur, wr, wc, fr, fq);
            const char* a1 = cA + (size_t)(t + 1) * kstep;
            const char* a2 = last ? nA : cA + (size_t)(t + 2) * kstep; const char* b2 = last ? nB : cB + (size_t)(t + 2) * kstep;
            const char* a3 = a2 + kstep; const char* b3 = b2 + kstep;
            unsigned v2[2][2];
#pragma unroll
            for (int h = 0; h < 2; ++h)
#pragma unroll
                for (int i = 0; i < 2; ++i) v2[h][i] = (GATHER && last) ? vN[h][i] : vA[h][i];
            G8_LDB(B0, 0, 0); G8_LDB(B1, 0, 1); G8_SCHED; G8_LDA(At, 0, 0); G8_STAGE(G8_SA(1, 1), a1, vA[1]);
            G8_WAIT_V(8); G8_WAIT_L(0); G8_BAR; G8_MMA(0, 0, At, B0); G8_MMA(0, 1, At, B1); G8_BAR; G8_SCHED;
            G8_LDA(At, 0, 1); G8_STAGE(G8_SB(0, 0), b2, voffB); G8_STAGE(G8_SB(0, 1), b2 + hstep, voffB); G8_STAGE(G8_SA(0, 0), a2, v2[0]);
            G8_WAIT_V(8); G8_WAIT_L(0); G8_BAR; G8_MMA(1, 0, At, B0); G8_MMA(1, 1, At, B1); G8_BAR; G8_SCHED;
            G8_LDB(B0, 1, 0); G8_LDB(B1, 1, 1); G8_SCHED; G8_LDA(At, 1, 0); G8_STAGE(G8_SA(0, 1), a2, v2[1]);
            G8_WAIT_V(8); G8_WAIT_L(0); G8_BAR; G8_MMA(0, 0, At, B0); G8_MMA(0, 1, At, B1); G8_BAR; G8_SCHED;
            G8_LDA(At, 1, 1); G8_STAGE(G8_SB(1, 0), b3, voffB); G8_STAGE(G8_SB(1, 1), b3 + hstep, voffB); G8_STAGE(G8_SA(1, 0), a3, v2[0]);
            G8_WAIT_V(8); G8_WAIT_L(0); G8_BAR; G8_MMA(1, 0, At, B0); G8_MMA(1, 1, At, B1); G8_BAR; G8_SCHED;
        }
        if (wr == 0) G8_BAR;
        E(acc, cur, wr, wc, fr, fq);
        if (!has_next) break;
#pragma unroll
        for (int a = 0; a < 2; ++a)
#pragma unroll
            for (int b = 0; b < 2; ++b)
#pragma unroll
                for (int m = 0; m < 4; ++m)
#pragma unroll
                    for (int n = 0; n < 2; ++n) acc[a][b][m][n] = (f32x4){0.f, 0.f, 0.f, 0.f};
        cur = nxt; cA = nA; cB = nB; ++ui;
#pragma unroll
        for (int h = 0; h < 2; ++h)
#pragma unroll
            for (int i = 0; i < 2; ++i) vA[h][i] = vN[h][i];
        if (wr == 1) G8_BAR;
    }
    G8_WAIT_V(0);
    G8_BAR;
#undef G8_SA
#undef G8_SB
#undef G8_STAGE
#undef G8_LDA
#undef G8_LDB
#undef G8_MMA
#undef G8_WAIT_V
#undef G8_WAIT_L
#undef G8_BAR
#undef G8_SCHED
}

struct EpiProjF { static constexpr bool PERM = true; static constexpr int MID_T = -1; bf16_t* out; const float* r1;
    __device__ __forceinline__ void mid(f32x4 (&)[2][2][4][2], const Unit&, int, int, int, int) const {}
    __device__ __forceinline__ void operator()(const f32x4 (&acc)[2][2][4][2], const Unit& u, int wr, int wc, int fr, int fq) const {
        const int row0 = u.pm * BM + wr * 64 + fr, col0 = u.pn * BM + wc * 32 + 8 * fq;
#pragma unroll
        for (int ai = 0; ai < 2; ++ai)
#pragma unroll
            for (int m = 0; m < 4; ++m) { const int row = row0 + ai * HALF + m * 16; const float s = r1[row]; bf16_t* rowp = out + (size_t)row * NPROJ + col0;
#pragma unroll
                for (int bj = 0; bj < 2; ++bj) { const f32x4 v0 = acc[ai][bj][m][0] * s, v1 = acc[ai][bj][m][1] * s; u32x4 w; w.x = cvt_pk_bf16(v0[0], v0[1]); w.y = cvt_pk_bf16(v0[2], v0[3]); w.z = cvt_pk_bf16(v1[0], v1[1]); w.w = cvt_pk_bf16(v1[2], v1[3]);
                    *(u32x4*)(rowp + bj * HALF) = w; } }
    }
};
struct EpiG2F { static constexpr bool PERM = false; static constexpr int MID_T = DATT / BK; const float* x; float* x1; bf16_t* xb1; LAS const float* tab; int G;
    __device__ __forceinline__ void mid(f32x4 (&acc)[2][2][4][2], const Unit& u, int wr, int wc, int fr, int fq) const {
        LAS const float* tb = tab + (size_t)(u.e) * 512;
#pragma unroll
        for (int ai = 0; ai < 2; ++ai)
#pragma unroll
            for (int m = 0; m < 4; ++m) { const float s = tb[(ai * HALF + wr * 64 + m * 16 + fr) * 2];
#pragma unroll
                for (int bj = 0; bj < 2; ++bj)
#pragma unroll
                    for (int n = 0; n < 2; ++n) acc[ai][bj][m][n] *= s; }
    }
    __device__ __forceinline__ void operator()(const f32x4 (&acc)[2][2][4][2], const Unit& u, int wr, int wc, int fr, int fq) const {
        LAS const float* tb = tab + (size_t)(u.e) * 512;
        const int col0 = u.pn * BM + wc * 32 + 4 * fq;
#pragma unroll
        for (int ai = 0; ai < 2; ++ai)
#pragma unroll
            for (int m = 0; m < 4; ++m) { const int r = ai * HALF + wr * 64 + m * 16 + fr; const float s = tb[r * 2 + 1]; const size_t off = (size_t)(u.pm * BM + r) * DM + col0;
#pragma unroll
                for (int bj = 0; bj < 2; ++bj)
#pragma unroll
                    for (int n = 0; n < 2; ++n) { const f32x4 xv = *(const f32x4*)(x + off + bj * HALF + n * 16); const f32x4 o = xv + acc[ai][bj][m][n] * s;
                        *(f32x4*)(x1 + off + bj * HALF + n * 16) = o; *(uint2*)(xb1 + off + bj * HALF + n * 16) = make_uint2(cvt_pk_bf16(o[0], o[1]), cvt_pk_bf16(o[2], o[3])); } }
    }
};
template <class Sched> struct EpiGUF { static constexpr bool PERM = true; static constexpr int MID_T = -1; bf16_t* Hb; const float* r2; const Sched* S;
    __device__ __forceinline__ void mid(f32x4 (&)[2][2][4][2], const Unit&, int, int, int, int) const {}
    __device__ __forceinline__ void operator()(const f32x4 (&acc)[2][2][4][2], const Unit& u, int wr, int wc, int fr, int fq) const {
        const int col0 = u.pn * HALF + wc * 32 + 8 * fq;
#pragma unroll
        for (int ai = 0; ai < 2; ++ai)
#pragma unroll
            for (int m = 0; m < 4; ++m) { const int r = ai * HALF + wr * 64 + m * 16 + fr; const int pr = S->pair_of(u, r); const float s = r2[pr >= 0 ? (pr >> 1) : 0];
                float h[8];
#pragma unroll
                for (int n = 0; n < 2; ++n)
#pragma unroll
                    for (int q = 0; q < 4; ++q) { const float gg = acc[ai][0][m][n][q] * s, uu = acc[ai][1][m][n][q] * s; h[4 * n + q] = gg * __builtin_amdgcn_rcpf(1.f + __expf(-gg)) * uu; }
                u32x4 w; w.x = cvt_pk_bf16(h[0], h[1]); w.y = cvt_pk_bf16(h[2], h[3]); w.z = cvt_pk_bf16(h[4], h[5]); w.w = cvt_pk_bf16(h[6], h[7]);
                *(u32x4*)(Hb + (size_t)(u.pm * BM + r) * DEXP + col0) = w; }
    }
};
template <class Sched> struct EpiDownF { static constexpr bool PERM = true; static constexpr int MID_T = -1; bf16_t* Y; const float* wts; const Sched* S;
    __device__ __forceinline__ void mid(f32x4 (&)[2][2][4][2], const Unit&, int, int, int, int) const {}
    __device__ __forceinline__ void operator()(const f32x4 (&acc)[2][2][4][2], const Unit& u, int wr, int wc, int fr, int fq) const {
        const int col0 = u.pn * BM + wc * 32 + 8 * fq;
#pragma unroll
        for (int ai = 0; ai < 2; ++ai)
#pragma unroll
            for (int m = 0; m < 4; ++m) { const int r = ai * HALF + wr * 64 + m * 16 + fr; const int pr = S->pair_of(u, r); if (pr < 0) continue; const float s = wts[pr]; bf16_t* rowp = Y + (size_t)pr * DM + col0;
#pragma unroll
                for (int bj = 0; bj < 2; ++bj) { const f32x4 v0 = acc[ai][bj][m][0] * s, v1 = acc[ai][bj][m][1] * s; u32x4 w; w.x = cvt_pk_bf16(v0[0], v0[1]); w.y = cvt_pk_bf16(v0[2], v0[3]); w.z = cvt_pk_bf16(v1[0], v1[1]); w.w = cvt_pk_bf16(v1[2], v1[3]);
                    *(u32x4*)(rowp + bj * HALF) = w; } }
    }
};
}


#define XB_TMO      128
#define XB_XCNT(j)  (256  + 64 * (j))
#define XB_XSUB(j)  (1280 + 64 * (j))
#define XB_XGEN(j)  (2304 + 64 * (j))
#define XB_TOP      3328
#define XB_TOPGEN   3392
#define XCD_BAR_WORDS 3456
#define XB_SPIN_CAP (1u << 20)
__device__ __forceinline__ unsigned xb_ld(unsigned* p)              { return __hip_atomic_load(p, __ATOMIC_RELAXED, __HIP_MEMORY_SCOPE_AGENT); }
__device__ __forceinline__ unsigned xb_add(unsigned* p, unsigned v) { return __hip_atomic_fetch_add(p, v, __ATOMIC_RELAXED, __HIP_MEMORY_SCOPE_AGENT); }
__device__ __forceinline__ unsigned xb_xcc_id() { return (unsigned)__builtin_amdgcn_s_getreg((3 << 11) | 20) & 0xFu; }
#define XB_SPIN(cond, bar) do { unsigned _sp = 0; while (cond) { __builtin_amdgcn_s_sleep(1); \
    if ((++_sp & 255u) == 0u) { if (xb_ld(&(bar)[XB_TMO])) break; if (_sp > XB_SPIN_CAP) { atomicAdd(&(bar)[XB_TMO], 1u); break; } } } } while (0)
struct XcdBarrier { unsigned* bar; unsigned x; volatile LAS unsigned* st; };
__device__ __forceinline__ XcdBarrier xcd_barrier_post(unsigned* bar, volatile LAS unsigned* st) {
    XcdBarrier b; b.bar = bar; b.x = xb_xcc_id(); b.st = st;
    if (threadIdx.x == 0) (void)xb_add(&bar[XB_XCNT(b.x)], 1u);
    return b;
}
__device__ __forceinline__ void xcd_barrier_complete(unsigned* bar, unsigned x, unsigned& nloc, unsigned& nx) {
    const unsigned G = gridDim.x * gridDim.y * gridDim.z;
    unsigned sum, cnt, mine, sp = 0u;
    for (;;) {
        sum = 0u; cnt = 0u; mine = 0u;
#pragma unroll
        for (unsigned j = 0; j < 16; ++j) { const unsigned c = xb_ld(&bar[XB_XCNT(j)]); sum += c; cnt += (c > 0u) ? 1u : 0u; mine = (j == x) ? c : mine; }
        if (sum == G) break;
        __builtin_amdgcn_s_sleep(1);
        if ((++sp & 255u) == 0u) { if (xb_ld(&bar[XB_TMO])) break; if (sp > XB_SPIN_CAP) { atomicAdd(&bar[XB_TMO], 1u); break; } }
    }
    nloc = mine > 0u ? mine : 1u; nx = cnt > 0u ? cnt : 1u;
}
__device__ __forceinline__ void xcd_barrier(const XcdBarrier& b) {
    asm volatile("s_waitcnt vmcnt(0)" ::: "memory");
    __syncthreads();
    if (threadIdx.x == 0) {
        unsigned* bar = b.bar;
        __builtin_amdgcn_s_waitcnt(0);
        unsigned nloc = b.st[0], nx = b.st[1];
        if (nloc == 0u) { xcd_barrier_complete(bar, b.x, nloc, nx); b.st[0] = nloc; b.st[1] = nx; }
        const unsigned old = xb_add(&bar[XB_XSUB(b.x)], 1u);
        const unsigned gen = old / nloc;
        if (old + 1u == (gen + 1u) * nloc) {
            __builtin_amdgcn_fence(__ATOMIC_RELEASE, "agent");
            asm volatile("s_waitcnt vmcnt(0)" ::: "memory");
            const unsigned og = xb_add(&bar[XB_TOP], 1u);
            const unsigned tg = og / nx;
            if (og + 1u == (tg + 1u) * nx) xb_add(&bar[XB_TOPGEN], 1u);
            else XB_SPIN(xb_ld(&bar[XB_TOPGEN]) == tg, bar);
            __builtin_amdgcn_fence(__ATOMIC_ACQUIRE, "agent");
            xb_add(&bar[XB_XGEN(b.x)], 1u);
            asm volatile("s_waitcnt vmcnt(0)" ::: "memory");
        } else {
            XB_SPIN(xb_ld(&bar[XB_XGEN(b.x)]) == gen, bar);
            __builtin_amdgcn_fence(__ATOMIC_ACQUIRE, "agent");
            asm volatile("s_waitcnt vmcnt(0)" ::: "memory");
        }
    }
    __syncthreads();
}

#ifndef PROBE
#define PROBE 0
#endif
#define PMUL(k) ((PROBE) == (k) ? 2 : 1)
__global__ void __launch_bounds__(NTHREADS, 2) mega(Params p) {
    extern __shared__ __attribute__((aligned(16))) unsigned char lds[];
    volatile LAS unsigned* bst = (volatile LAS unsigned*)(lds + LDS_PLAN_OFF + 1024);
    if (threadIdx.x < 2) bst[threadIdx.x] = 0u;
    __syncthreads();
    const XcdBarrier gbar = xcd_barrier_post((unsigned*)(p.ws + WS_BAR), bst);
    if (p.never) cg::this_grid().sync();
    Ctx c; c.tid = threadIdx.x; c.lane = c.tid & 63; c.wave = __builtin_amdgcn_readfirstlane(c.tid >> 6); c.gw = blockIdx.x * NWAVES + c.wave; c.ngw = gridDim.x * NWAVES;
    char* ws = p.ws;
    int* cnt = (int*)(ws + WS_CTL);
    float* r1 = (float*)(ws + WS_R1); float* r2 = (float*)(ws + WS_R2); float* ssC = (float*)(ws + WS_SSC);
    float* wts = (float*)(ws + WS_WTS); float* Wr = (float*)(ws + WS_WR); float* ssA = (float*)(ws + WS_SSA); int* list = (int*)(ws + WS_LIST);
    bf16_t* W2t = (bf16_t*)(ws + WS_W2T); bf16_t* W1t = (bf16_t*)(ws + WS_W1T); bf16_t* Wdt = (bf16_t*)(ws + WS_WDT); bf16_t* Wgut = (bf16_t*)(ws + WS_WGUT);
    bf16_t* xb = (bf16_t*)(ws + WS_XB); bf16_t* mix = (bf16_t*)(ws + WS_MIX); bf16_t* proj = (bf16_t*)(ws + WS_PROJ); bf16_t* Y = (bf16_t*)(ws + WS_Y); bf16_t* Hb = (bf16_t*)(ws + WS_H);

    {
        for (int row = c.gw; row < T * PMUL(10); row += c.ngw) p0_x_row(p.x, xb, r1, row % T, c.lane);
        LAS float* scr = (LAS float*)lds + c.wave * (64 * 33);
        constexpr int I_IN = (DM / 64) * (NPROJ / 32), I_OUT = (DM / 64) * (DM / 32), I_G = NE * (DM / 64) * (DEXP / 32), I_D = NE * (DEXP / 64) * (DM / 32);
        constexpr int NIT = I_IN + I_OUT + 2 * I_G + I_D;
        for (int it = c.gw; it < NIT * PMUL(10); it += c.ngw) {
            int r = it % NIT;
            if (r < I_IN) { const int nb = NPROJ / 32, kb = r / nb, n0 = (r % nb) * 32; p0_titem(p.w_in, NPROJ, p.norm1, W1t, DM, kb * 64, n0, n0, scr, c.lane, n0 < DATT ? QSCALE : 1.f); continue; } r -= I_IN;
            if (r < I_OUT) { const int nb = DM / 32, kb = r / nb, n0 = (r % nb) * 32, k0 = kb * 64;
                const float* g = k0 < DATT ? p.g_oa + k0 : p.g_oc + (k0 - DATT);
                p0_titem(p.w_out + (size_t)k0 * DM, DM, g, W2t + k0, DM, 0, n0, n0, scr, c.lane); continue; } r -= I_OUT;
            if (r < 2 * I_G) { const int up = r >= I_G; if (up) r -= I_G; const int per = (DM / 64) * (DEXP / 32), e = r / per, q = r % per, nb = DEXP / 32, kb = q / nb, n0 = (q % nb) * 32;
                p0_titem((up ? p.w_up : p.w_gate) + (size_t)e * DM * DEXP, DEXP, p.norm2, Wgut + (size_t)e * 2 * DEXP * DM, DM, kb * 64, n0, gu_row(n0, up), scr, c.lane); continue; } r -= 2 * I_G;
            { const int per = (DEXP / 64) * (DM / 32), e = r / per, q = r % per, nb = DM / 32, kb = q / nb, n0 = (q % nb) * 32;
              p0_titem(p.w_down + (size_t)e * DEXP * DM, DM, nullptr, Wdt + (size_t)e * DM * DEXP, DEXP, kb * 64, n0, n0, scr, c.lane); }
        }
        for (int i = blockIdx.x * NTHREADS + c.tid; i < 36 * DM; i += gridDim.x * NTHREADS) { const int o = i / DM, k = i % DM; Wr[i] = p.norm2[k] * (o < 4 ? p.w_rg[k * 4 + o] : p.w_re[k * 32 + (o - 4)]); }
    }
    xcd_barrier(gbar);
    {
        g8::DenseOrder S; S.init(xb, W1t, T, NPROJ, DM, (int)gridDim.x, (int)blockIdx.x); S.mul = PMUL(1);
        const g8::EpiProjF E{proj, r1};
        g8::gemm_phase<false>((LAS unsigned char*)lds, DM, S, E);
    }
    xcd_barrier(gbar);
    {
        for (int u1 = blockIdx.x; u1 < NB * NH * 4 * PMUL(2); u1 += gridDim.x) { const int u0 = u1 % (NB * NH * 4); const int bh = u0 >> 2;
            for (int i = 0; i < 4; ++i) att::attn_unit((LAS unsigned char*)lds, proj, p.relb, mix, ssA, bh >> 4, bh & 15, (u0 & 3) + 4 * i); }
        for (int it = c.gw; it < (T / 32) * 4 * PMUL(21); it += c.ngw) conv_slab(proj, p.conv_w, mix, ssC, it % ((T / 32) * 4), c.lane);
    }
    xcd_barrier(gbar);
    {
        g8::DenseOrder S; S.init(mix, W2t, T, DM, DM, (int)gridDim.x, (int)blockIdx.x); S.mul = PMUL(3);
        LAS float* tab = (LAS float*)(lds + 131072);
        g8::Unit u;
        for (int i = 0; i < 4; ++i) if (S.next(i, u) && c.tid < 256) { const int row = u.pm * 256 + c.tid; float sa = 0.f;
#pragma unroll
            for (int h = 0; h < 16; ++h) sa += ssA[row * 16 + h];
            const float4 sc4 = *(const float4*)(ssC + row * 4); const float ra = rsqrtf(sa * (1.f / DATT) + EPS), rc = rsqrtf((sc4.x + sc4.y + sc4.z + sc4.w) * (1.f / DCONV) + EPS);
            tab[(i * 256 + c.tid) * 2] = ra / rc; tab[(i * 256 + c.tid) * 2 + 1] = rc; }
        __syncthreads();
        const g8::EpiG2F E{p.x, p.out, xb, tab, (int)gridDim.x};
        g8::gemm_phase<false>((LAS unsigned char*)lds, DM, S, E);
    }
    xcd_barrier(gbar);
    for (int t = c.gw; t < T * PMUL(4); t += c.ngw) router_row(p.out, Wr, p.b_rg, p.b_re, cnt, list, wts, r2, t % T, c.lane, t < T);
    xcd_barrier(gbar);
    LAS int* pl = (LAS int*)(lds + LDS_PLAN_OFF);
    if (c.tid == 0) { int tl = 0;
        for (int e = 0; e < NE; ++e) { const int ce = cnt[e]; pl[e] = ce; pl[32 + e] = tl * 256; const int mt = (ce + 255) >> 8; for (int i = 0; i < mt; ++i) pl[64 + tl + i] = e; tl += mt; }
        for (int i = tl; i < NTILEMAX; ++i) pl[64 + i] = -1;
        pl[224] = tl; }
    __syncthreads();
    const int ntile = pl[224];
    {
        const g8::MoeOrder<true> S{(const char*)xb, (const char*)Wgut, list, pl, DM, 4, ntile * 4, (int)gridDim.x, (int)blockIdx.x, (size_t)2 * DEXP * DM * 2, PMUL(5)};
        const g8::EpiGUF<g8::MoeOrder<true>> E{Hb, r2, &S};
        g8::gemm_phase<true>((LAS unsigned char*)lds, DM, S, E);
    }
    xcd_barrier(gbar);
    {
        const g8::MoeOrder<false> S{(const char*)Hb, (const char*)Wdt, list, pl, DEXP, 8, ntile * 8, (int)gridDim.x, (int)blockIdx.x, (size_t)DM * DEXP * 2, PMUL(6)};
        const g8::EpiDownF<g8::MoeOrder<false>> E{Y, wts, &S};
        g8::gemm_phase<false>((LAS unsigned char*)lds, DEXP, S, E);
    }
    xcd_barrier(gbar);
    if (PROBE == 9) { for (int i = 0; i < 8; ++i) xcd_barrier(gbar); }
    for (int t = c.gw; t < T; t += c.ngw) final_row(p.out, Y, p.norm_f, t, c.lane);
}

extern "C" void kernel_launch(void* const* d_in, const int* in_sizes, int n_in, void* d_out, int out_size, void* d_ws, size_t ws_size, hipStream_t stream) {
    static int grid = 0;
    if (grid == 0) {
        int dev = 0, cus = 0, per_cu = 0;
        if (ws_size < WS_END || n_in != 17) { fprintf(stderr, "kernel_launch: unexpected sizes (ws %zu)\n", ws_size); grid = -1; return; }
        (void)hipGetDevice(&dev); (void)hipDeviceGetAttribute(&cus, hipDeviceAttributeMultiprocessorCount, dev);
        if (hipFuncSetAttribute((const void*)mega, hipFuncAttributeMaxDynamicSharedMemorySize, LDS_BYTES) != hipSuccess) { fprintf(stderr, "hipFuncSetAttribute failed\n"); grid = -1; return; }
        if (hipOccupancyMaxActiveBlocksPerMultiprocessor(&per_cu, (const void*)mega, NTHREADS, LDS_BYTES) != hipSuccess || per_cu < 1) { fprintf(stderr, "occupancy query failed (%d)\n", per_cu); grid = -1; return; }
        grid = cus * per_cu;
        fprintf(stderr, "kernel_launch: cus %d per_cu %d grid %d\n", cus, per_cu, grid);
    }
    if (grid < 0) return;
    if (hipMemsetAsync((char*)d_ws + WS_CTL, 0, 64 * 1024, stream) != hipSuccess) { fprintf(stderr, "memset failed\n"); return; }
    Params p{};
    p.x = (const float*)d_in[0]; p.norm1 = (const float*)d_in[1]; p.w_in = (const float*)d_in[2]; p.relb = (const float*)d_in[3];
    p.conv_w = (const float*)d_in[4]; p.g_oa = (const float*)d_in[5]; p.g_oc = (const float*)d_in[6]; p.w_out = (const float*)d_in[7];
    p.norm2 = (const float*)d_in[8]; p.w_rg = (const float*)d_in[9]; p.b_rg = (const float*)d_in[10]; p.w_re = (const float*)d_in[11];
    p.b_re = (const float*)d_in[12]; p.w_gate = (const float*)d_in[13]; p.w_up = (const float*)d_in[14]; p.w_down = (const float*)d_in[15];
    p.norm_f = (const float*)d_in[16]; p.out = (float*)d_out; p.ws = (char*)d_ws;
    void* args[] = {&p};
    hipError_t e = hipLaunchCooperativeKernel((const void*)mega, dim3(grid), dim3(NTHREADS), args, LDS_BYTES, stream);
    if (e != hipSuccess) fprintf(stderr, "cooperative launch failed: %s (grid %d)\n", hipGetErrorString(e), grid);
}
```

```cpp
#include <hip/hip_runtime.h>
#include <hip/hip_cooperative_groups.h>
#include <stdint.h>
#include <cstdio>
namespace cg = cooperative_groups;

typedef unsigned short bf16_t;
typedef short bf16x8 __attribute__((ext_vector_type(8)));
typedef float f32x4 __attribute__((ext_vector_type(4)));

constexpr int NB = 4, SEQ = 4096, T = NB * SEQ, DM = 2048, DATT = 1024, DCONV = 1024, NPROJ = 6144;
constexpr int NH = 16, HD = 64, NREL = 513, NE = 32, DEXP = 512, NPAIR = 2 * T;
constexpr int NPADMAX = 40960, NTILEMAX = NPADMAX / 256;
constexpr float EPS = 1e-6f;
constexpr float LOG2E = 1.4426950408889634f, QSCALE = 0.125f * LOG2E;

constexpr size_t MiB = 1u << 20;
constexpr size_t WS_CTL = 0;
constexpr size_t WS_BAR = 16 * 1024;
constexpr size_t WS_PLAN = 64 * 1024;
constexpr size_t WS_R1 = 128 * 1024;
constexpr size_t WS_RA = 192 * 1024;
constexpr size_t WS_RC = 256 * 1024;
constexpr size_t WS_R2 = 320 * 1024;
constexpr size_t WS_SSC = 3 * MiB;
constexpr size_t WS_WTS = 512 * 1024;
constexpr size_t WS_ROWPAIR = 640 * 1024;
constexpr size_t WS_WR = 1 * MiB;
constexpr size_t WS_SSA = 2 * MiB;
constexpr size_t WS_LIST = 5 * MiB;
constexpr size_t WS_W2T = 8 * MiB;
constexpr size_t WS_W1T = 16 * MiB;
constexpr size_t WS_WDT = 40 * MiB;
constexpr size_t WS_WGUT = 104 * MiB;
constexpr size_t WS_XB = 232 * MiB;
constexpr size_t WS_MIX = 296 * MiB;
constexpr size_t WS_PROJ = 360 * MiB;
constexpr size_t WS_Y = 360 * MiB;
constexpr size_t WS_H = 488 * MiB;
constexpr size_t WS_END = 552 * MiB;

__device__ __forceinline__ unsigned f2bf(float f) { unsigned u = __float_as_uint(f); return (u + 0x7fffu + ((u >> 16) & 1u)) >> 16; }
__device__ __forceinline__ unsigned pk2(float lo, float hi) { return f2bf(lo) | (f2bf(hi) << 16); }
__device__ __forceinline__ unsigned cvtpk2(float lo, float hi) { typedef float f2 __attribute__((ext_vector_type(2))); typedef __bf16 b2 __attribute__((ext_vector_type(2))); f2 v = {lo, hi}; b2 r = __builtin_convertvector(v, b2); return __builtin_bit_cast(unsigned, r); }
__device__ __forceinline__ float bf2f(unsigned h) { return __uint_as_float(h << 16); }
__device__ __forceinline__ float wave_sum(float v) {
#pragma unroll
    for (int o = 1; o < 64; o <<= 1) v += __shfl_xor(v, o);
    return v;
}


#define LAS __attribute__((address_space(3)))
constexpr int NWAVES = 8, NTHREADS = 512;
constexpr int LDS_BYTES = 147456;
constexpr int LDS_PLAN_OFF = 140 * 1024;

struct Params {
    const float *x, *norm1, *w_in, *relb, *conv_w, *g_oa, *g_oc, *w_out, *norm2, *w_rg, *b_rg, *w_re, *b_re, *w_gate, *w_up, *w_down, *norm_f;
    float* out; char* ws; int never; int pad;
};
struct Ctx { int tid, lane, wave, gw, ngw; };

__device__ __forceinline__ void p0_x_row(const float* __restrict__ x, bf16_t* __restrict__ xb, float* __restrict__ r1, int row, int lane) {
    const float4* xr = (const float4*)(x + (size_t)row * DM);
    uint2* o = (uint2*)(xb + (size_t)row * DM);
    float ss = 0.f;
#pragma unroll
    for (int j = 0; j < 8; ++j) { float4 v = xr[j * 64 + lane]; ss += v.x * v.x + v.y * v.y + v.z * v.z + v.w * v.w; o[j * 64 + lane] = make_uint2(cvtpk2(v.x, v.y), cvtpk2(v.z, v.w)); }
    ss = wave_sum(ss);
    if (lane == 0) r1[row] = rsqrtf(ss * (1.f / DM) + EPS);
}
__device__ __forceinline__ void p0_titem(const float* __restrict__ W, int N, const float* __restrict__ g, bf16_t* __restrict__ WT, int ldd, int k0, int n0, int drow0, LAS float* scr, int lane, float cs = 1.f) {
    const int kq = lane >> 4, n4 = (lane & 15) * 4;
    float4 v[16]; float gs[16];
#pragma unroll
    for (int i = 0; i < 16; ++i) v[i] = *(const float4*)(W + (size_t)(k0 + 4 * i + kq) * N + n0 + n4);
#pragma unroll
    for (int i = 0; i < 16; ++i) gs[i] = (g ? g[k0 + 4 * i + kq] : 1.f) * cs;
#pragma unroll
    for (int i = 0; i < 16; ++i) { LAS float* d = scr + (4 * i + kq) * 65 + n4; d[0] = v[i].x * gs[i]; d[1] = v[i].y * gs[i]; d[2] = v[i].z * gs[i]; d[3] = v[i].w * gs[i]; }
    asm volatile("s_waitcnt lgkmcnt(0)" ::: "memory");
    const int c = lane & 7;
#pragma unroll
    for (int j = 0; j < 8; ++j) { const int n = (lane >> 3) + 8 * j; const LAS float* sp = scr + (8 * c) * 65 + n;
        uint4 o; o.x = cvtpk2(sp[0 * 65], sp[1 * 65]); o.y = cvtpk2(sp[2 * 65], sp[3 * 65]); o.z = cvtpk2(sp[4 * 65], sp[5 * 65]); o.w = cvtpk2(sp[6 * 65], sp[7 * 65]);
        *(uint4*)(WT + (size_t)(drow0 + n) * ldd + k0 + 8 * c) = o; }
    asm volatile("s_waitcnt lgkmcnt(0)" ::: "memory");
}
__device__ __forceinline__ int gu_row(int n, int up) { return ((n >> 7) << 8) + (n & 127) + (up ? 128 : 0); }

template <int MODE, class Epi>
__device__ __forceinline__ void sg_tile(const bf16_t* A, int lda, const bf16_t* B, int ldb, int K, int kmid, int r0, int c0, const int (&arow)[2], int lane, const Epi& epi) {
    const int fr = lane & 15, fq = lane >> 4;
    const bf16_t* ap[2]; const bf16_t* bp[2];
#pragma unroll
    for (int i = 0; i < 2; ++i) ap[i] = A + (size_t)arow[i] * lda + 8 * fq;
#pragma unroll
    for (int j = 0; j < 2; ++j) { const int n = c0 + 16 * j + fr; const int brow = (MODE == 2) ? gu_row(n, 0) : n; bp[j] = B + (size_t)brow * ldb + 8 * fq; }
    f32x4 acc0[2][2], acc1[2][2];
#pragma unroll
    for (int i = 0; i < 2; ++i)
#pragma unroll
        for (int j = 0; j < 2; ++j) { acc0[i][j] = (f32x4){0.f, 0.f, 0.f, 0.f}; acc1[i][j] = (f32x4){0.f, 0.f, 0.f, 0.f}; }
    for (int k = 0; k < K; k += 32) {
        bf16x8 a[2], b0[2], b1[2];
#pragma unroll
        for (int i = 0; i < 2; ++i) a[i] = *(const bf16x8*)(ap[i] + k);
#pragma unroll
        for (int j = 0; j < 2; ++j) { b0[j] = *(const bf16x8*)(bp[j] + k); if (MODE == 2) b1[j] = *(const bf16x8*)(bp[j] + (size_t)128 * ldb + k); else b1[j] = b0[j]; }
        if (MODE == 1) {
            if (k < kmid) {
#pragma unroll
                for (int i = 0; i < 2; ++i)
#pragma unroll
                    for (int j = 0; j < 2; ++j) acc0[i][j] = __builtin_amdgcn_mfma_f32_16x16x32_bf16(b0[j], a[i], acc0[i][j], 0, 0, 0);
            } else {
#pragma unroll
                for (int i = 0; i < 2; ++i)
#pragma unroll
                    for (int j = 0; j < 2; ++j) acc1[i][j] = __builtin_amdgcn_mfma_f32_16x16x32_bf16(b0[j], a[i], acc1[i][j], 0, 0, 0);
            }
        } else {
#pragma unroll
            for (int i = 0; i < 2; ++i)
#pragma unroll
                for (int j = 0; j < 2; ++j) { acc0[i][j] = __builtin_amdgcn_mfma_f32_16x16x32_bf16(b0[j], a[i], acc0[i][j], 0, 0, 0);
                    if (MODE == 2) acc1[i][j] = __builtin_amdgcn_mfma_f32_16x16x32_bf16(b1[j], a[i], acc1[i][j], 0, 0, 0); }
        }
    }
#pragma unroll
    for (int i = 0; i < 2; ++i)
#pragma unroll
        for (int j = 0; j < 2; ++j) epi(acc0[i][j], acc1[i][j], i, r0 + 16 * i + fr, c0 + 16 * j + 4 * fq);
}
struct EpiProj { bf16_t* out; const float* r1;
    __device__ __forceinline__ void operator()(f32x4 a, f32x4, int, int row, int col) const { const float s = r1[row]; *(uint2*)(out + (size_t)row * NPROJ + col) = make_uint2(pk2(a[0] * s, a[1] * s), pk2(a[2] * s, a[3] * s)); } };
struct EpiG2 { const float* x; const float* ssA; const float* ssC; float* x1; bf16_t* xb1;
    __device__ __forceinline__ void operator()(f32x4 a, f32x4 c, int, int row, int col) const {
        float s = 0.f;
#pragma unroll
        for (int h = 0; h < 16; ++h) s += ssA[row * 16 + h];
        const float sa = rsqrtf(s * (1.f / DATT) + EPS), sc = rsqrtf(ssC[row] * (1.f / DCONV) + EPS);
        const float4 xv = *(const float4*)(x + (size_t)row * DM + col);
        float4 o; o.x = xv.x + sa * a[0] + sc * c[0]; o.y = xv.y + sa * a[1] + sc * c[1]; o.z = xv.z + sa * a[2] + sc * c[2]; o.w = xv.w + sa * a[3] + sc * c[3];
        *(float4*)(x1 + (size_t)row * DM + col) = o; *(uint2*)(xb1 + (size_t)row * DM + col) = make_uint2(pk2(o.x, o.y), pk2(o.z, o.w)); } };
struct EpiGU { bf16_t* Hb; const float* r2; int pr[2];
    __device__ __forceinline__ void operator()(f32x4 g, f32x4 u, int i, int row, int col) const { const float s = r2[pr[i] >= 0 ? (pr[i] >> 1) : 0]; float h[4];
#pragma unroll
        for (int q = 0; q < 4; ++q) { const float gg = g[q] * s, uu = u[q] * s; h[q] = gg / (1.f + __expf(-gg)) * uu; }
        *(uint2*)(Hb + (size_t)row * DEXP + col) = make_uint2(pk2(h[0], h[1]), pk2(h[2], h[3])); } };
struct EpiDown { bf16_t* Y; const float* wts; int pr[2];
    __device__ __forceinline__ void operator()(f32x4 a, f32x4, int i, int, int col) const { if (pr[i] < 0) return; const float s = wts[pr[i]];
        *(uint2*)(Y + (size_t)pr[i] * DM + col) = make_uint2(pk2(a[0] * s, a[1] * s), pk2(a[2] * s, a[3] * s)); } };

__device__ __forceinline__ void attn_simple(const bf16_t* __restrict__ proj, const float* __restrict__ relb, bf16_t* __restrict__ mix, float* __restrict__ ssA, int bid, int qi) {
    const int h = bid & 15, c = (bid >> 4) & 63, b = bid >> 10, t = b * SEQ + c * 64 + qi;
    float q[64], o[64];
    { const uint4* qp = (const uint4*)(proj + (size_t)t * NPROJ + h * HD);
#pragma unroll
      for (int i = 0; i < 8; ++i) { const uint4 v = qp[i]; const unsigned w[4] = {v.x, v.y, v.z, v.w};
#pragma unroll
          for (int j = 0; j < 4; ++j) { q[8 * i + 2 * j] = bf2f(w[j] & 0xffffu) * (1.f / LOG2E); q[8 * i + 2 * j + 1] = bf2f(w[j] >> 16) * (1.f / LOG2E); } } }
#pragma unroll
    for (int d = 0; d < 64; ++d) o[d] = 0.f;
    float m = -1e30f, l = 0.f;
    const float* rb = relb + h * NREL;
    const int jc0 = c - 8 < 0 ? 0 : c - 8;
    for (int jc = jc0; jc <= c; ++jc)
        for (int kj = 0; kj < 64; ++kj) {
            const int tk = b * SEQ + jc * 64 + kj;
            const uint4* kp = (const uint4*)(proj + (size_t)tk * NPROJ + DATT + h * HD);
            const uint4* vp = (const uint4*)(proj + (size_t)tk * NPROJ + 2 * DATT + h * HD);
            float s = 0.f;
#pragma unroll
            for (int i = 0; i < 8; ++i) { const uint4 v = kp[i]; const unsigned w[4] = {v.x, v.y, v.z, v.w};
#pragma unroll
                for (int j = 0; j < 4; ++j) { s += q[8 * i + 2 * j] * bf2f(w[j] & 0xffffu); s += q[8 * i + 2 * j + 1] * bf2f(w[j] >> 16); } }
            int dist = (c - jc) * 64 + qi - kj; dist = dist < -256 ? -256 : (dist > 256 ? 256 : dist);
            s += rb[dist + 256];
            const float mn = fmaxf(m, s), al = __expf(m - mn), pp = __expf(s - mn);
            l = l * al + pp; m = mn;
#pragma unroll
            for (int i = 0; i < 8; ++i) { const uint4 v = vp[i]; const unsigned w[4] = {v.x, v.y, v.z, v.w};
#pragma unroll
                for (int j = 0; j < 4; ++j) { o[8 * i + 2 * j] = o[8 * i + 2 * j] * al + pp * bf2f(w[j] & 0xffffu); o[8 * i + 2 * j + 1] = o[8 * i + 2 * j + 1] * al + pp * bf2f(w[j] >> 16); } }
        }
    const float il = 1.f / l; float ss = 0.f;
    uint4* op = (uint4*)(mix + (size_t)t * DM + h * HD);
#pragma unroll
    for (int i = 0; i < 8; ++i) { float v[8];
#pragma unroll
        for (int j = 0; j < 8; ++j) { v[j] = o[8 * i + j] * il; ss += v[j] * v[j]; }
        op[i] = make_uint4(pk2(v[0], v[1]), pk2(v[2], v[3]), pk2(v[4], v[5]), pk2(v[6], v[7])); }
    ssA[t * 16 + h] = ss;
}
__device__ __forceinline__ void conv_row(const bf16_t* __restrict__ proj, const float* __restrict__ cw, bf16_t* __restrict__ mix, float* __restrict__ ssC, int t, int lane) {
    const int s = t & (SEQ - 1); float ss = 0.f;
#pragma unroll
    for (int cc = 0; cc < 4; ++cc) { const int ch = (cc * 64 + lane) * 4;
        float y[4] = {0.f, 0.f, 0.f, 0.f};
#pragma unroll
        for (int j = 0; j < 3; ++j) { const int back = 2 - j; if (s - back < 0) continue;
            const bf16_t* pr = proj + (size_t)(t - back) * NPROJ;
            const uint2 cv = *(const uint2*)(pr + 4 * DATT + ch), uv = *(const uint2*)(pr + 5 * DATT + ch);
            const float4 wv = *(const float4*)(cw + j * DCONV + ch);
            y[0] += wv.x * bf2f(cv.x & 0xffffu) * bf2f(uv.x & 0xffffu); y[1] += wv.y * bf2f(cv.x >> 16) * bf2f(uv.x >> 16);
            y[2] += wv.z * bf2f(cv.y & 0xffffu) * bf2f(uv.y & 0xffffu); y[3] += wv.w * bf2f(cv.y >> 16) * bf2f(uv.y >> 16); }
        const uint2 bv = *(const uint2*)(proj + (size_t)t * NPROJ + 3 * DATT + ch);
        y[0] *= bf2f(bv.x & 0xffffu); y[1] *= bf2f(bv.x >> 16); y[2] *= bf2f(bv.y & 0xffffu); y[3] *= bf2f(bv.y >> 16);
        *(uint2*)(mix + (size_t)t * DM + DATT + ch) = make_uint2(pk2(y[0], y[1]), pk2(y[2], y[3]));
        ss += y[0] * y[0] + y[1] * y[1] + y[2] * y[2] + y[3] * y[3]; }
    ss = wave_sum(ss);
    if (lane == 0) ssC[t] = ss;
}
__device__ __forceinline__ void router_row(const float* __restrict__ x1, const float* __restrict__ Wr, const float* __restrict__ brg, const float* __restrict__ bre,
                                           int* __restrict__ cnt, int* __restrict__ list, float* __restrict__ wts, float* __restrict__ r2out, int t, int lane, bool commit = true) {
    const float4* xr = (const float4*)(x1 + (size_t)t * DM);
    float4 v[8]; float ss = 0.f;
#pragma unroll
    for (int j = 0; j < 8; ++j) { v[j] = xr[j * 64 + lane]; ss += v[j].x * v[j].x + v[j].y * v[j].y + v[j].z * v[j].z + v[j].w * v[j].w; }
    const float r2 = rsqrtf(wave_sum(ss) * (1.f / DM) + EPS);
    float lg[4];
#pragma unroll
    for (int o = 0; o < 4; ++o) { const float4* wr = (const float4*)(Wr + (size_t)o * DM); float p = 0.f;
#pragma unroll
        for (int j = 0; j < 8; ++j) { const float4 wv = wr[j * 64 + lane]; p += v[j].x * wv.x + v[j].y * wv.y + v[j].z * wv.z + v[j].w * wv.w; }
        lg[o] = wave_sum(p) * r2 + brg[o]; }
    int gs = 0; float gm = lg[0];
#pragma unroll
    for (int g = 1; g < 4; ++g) if (lg[g] > gm) { gm = lg[g]; gs = g; }
    float den = 0.f;
#pragma unroll
    for (int g = 0; g < 4; ++g) den += __expf(lg[g] - gm);
    const float pg = 1.f / den;
    gs = __builtin_amdgcn_readfirstlane(gs);
    float el[8];
#pragma unroll
    for (int i = 0; i < 8; ++i) { const float4* wr = (const float4*)(Wr + (size_t)(4 + gs * 8 + i) * DM); float p = 0.f;
#pragma unroll
        for (int j = 0; j < 8; ++j) { const float4 wv = wr[j * 64 + lane]; p += v[j].x * wv.x + v[j].y * wv.y + v[j].z * wv.z + v[j].w * wv.w; }
        el[i] = wave_sum(p) * r2 + bre[gs * 8 + i]; }
    int i1 = 0; float v1 = el[0];
#pragma unroll
    for (int i = 1; i < 8; ++i) if (el[i] > v1) { v1 = el[i]; i1 = i; }
    int i2 = -1; float v2 = -3.0e38f;
#pragma unroll
    for (int i = 0; i < 8; ++i) if (i != i1 && el[i] > v2) { v2 = el[i]; i2 = i; }
    const float e2 = __expf(v2 - v1), w0 = pg / (1.f + e2), w1 = pg * e2 / (1.f + e2);
    if (lane == 0 && commit) {
        r2out[t] = r2;
        const int ea = gs * 8 + i1, eb = gs * 8 + i2;
        const int sa = atomicAdd(&cnt[ea], 1); list[ea * T + sa] = 2 * t; wts[2 * t] = w0;
        const int sb = atomicAdd(&cnt[eb], 1); list[eb * T + sb] = 2 * t + 1; wts[2 * t + 1] = w1;
    }
}
__device__ __forceinline__ void router_tile(const float* __restrict__ x1, const bf16_t* __restrict__ Wrh, const bf16_t* __restrict__ Wrl, const float* __restrict__ brg, const float* __restrict__ bre,
                                            int* __restrict__ cnt, int* __restrict__ list, float* __restrict__ wts, float* __restrict__ r2out, int t0, int lane, LAS float* sc  , bool commit) {
    const int fr = lane & 15, fq = lane >> 4;
    const float* xr = x1 + (size_t)(t0 + fr) * DM + 8 * fq;
    const bf16_t* wh = Wrh + (size_t)fr * DM + 8 * fq; const bf16_t* wl = Wrl + (size_t)fr * DM + 8 * fq;
    f32x4 acc[3]; float ss = 0.f;
#pragma unroll
    for (int nb = 0; nb < 3; ++nb) acc[nb] = (f32x4){0.f, 0.f, 0.f, 0.f};
#pragma unroll 2
    for (int ks = 0; ks < DM / 32; ++ks) {
        const float4 a0 = *(const float4*)(xr + ks * 32), a1 = *(const float4*)(xr + ks * 32 + 4);
        const float xv[8] = {a0.x, a0.y, a0.z, a0.w, a1.x, a1.y, a1.z, a1.w};
        unsigned hw[4], lw[4];
#pragma unroll
        for (int q = 0; q < 4; ++q) { const unsigned h = cvtpk2(xv[2 * q], xv[2 * q + 1]); hw[q] = h;
            lw[q] = cvtpk2(xv[2 * q] - __uint_as_float(h << 16), xv[2 * q + 1] - __uint_as_float(h & 0xffff0000u)); ss += xv[2 * q] * xv[2 * q] + xv[2 * q + 1] * xv[2 * q + 1]; }
        typedef unsigned u4 __attribute__((ext_vector_type(4)));
        const bf16x8 xh = __builtin_bit_cast(bf16x8, (u4){hw[0], hw[1], hw[2], hw[3]}), xl = __builtin_bit_cast(bf16x8, (u4){lw[0], lw[1], lw[2], lw[3]});
#pragma unroll
        for (int nb = 0; nb < 3; ++nb) { const bf16x8 bh = *(const bf16x8*)(wh + (size_t)nb * 16 * DM + ks * 32), bl = *(const bf16x8*)(wl + (size_t)nb * 16 * DM + ks * 32);
            acc[nb] = __builtin_amdgcn_mfma_f32_16x16x32_bf16(bh, xh, acc[nb], 0, 0, 0);
            acc[nb] = __builtin_amdgcn_mfma_f32_16x16x32_bf16(bh, xl, acc[nb], 0, 0, 0);
            acc[nb] = __builtin_amdgcn_mfma_f32_16x16x32_bf16(bl, xh, acc[nb], 0, 0, 0); }
    }
    ss += __shfl_xor(ss, 16); ss += __shfl_xor(ss, 32);
    const float r2 = rsqrtf(ss * (1.f / DM) + EPS);
#pragma unroll
    for (int nb = 0; nb < 3; ++nb)
#pragma unroll
        for (int q = 0; q < 4; ++q) sc[fr * 49 + 16 * nb + 4 * fq + q] = acc[nb][q] * r2;
    asm volatile("s_waitcnt lgkmcnt(0)" ::: "memory");
    if (lane < 16) {
        const int t = t0 + lane; LAS const float* lr = sc + lane * 49;
        float lg[4];
#pragma unroll
        for (int g = 0; g < 4; ++g) lg[g] = lr[g] + brg[g];
        int gs = 0; float gm = lg[0];
#pragma unroll
        for (int g = 1; g < 4; ++g) if (lg[g] > gm) { gm = lg[g]; gs = g; }
        float den = 0.f;
#pragma unroll
        for (int g = 0; g < 4; ++g) den += __expf(lg[g] - gm);
        const float pg = 1.f / den;
        float el[8];
#pragma unroll
        for (int i = 0; i < 8; ++i) el[i] = lr[4 + 8 * gs + i] + bre[8 * gs + i];
        int i1 = 0; float v1 = el[0];
#pragma unroll
        for (int i = 1; i < 8; ++i) if (el[i] > v1) { v1 = el[i]; i1 = i; }
        int i2 = -1; float v2 = -3.0e38f;
#pragma unroll
        for (int i = 0; i < 8; ++i) if (i != i1 && el[i] > v2) { v2 = el[i]; i2 = i; }
        const float e2 = __expf(v2 - v1), w0 = pg / (1.f + e2), w1 = pg * e2 / (1.f + e2);
        if (commit) {
            r2out[t] = r2;
            const int ea = gs * 8 + i1, eb = gs * 8 + i2;
            const int sa = atomicAdd(&cnt[ea], 1); list[ea * T + sa] = 2 * t; wts[2 * t] = w0;
            const int sb = atomicAdd(&cnt[eb], 1); list[eb * T + sb] = 2 * t + 1; wts[2 * t + 1] = w1;
        }
    }
    asm volatile("s_waitcnt lgkmcnt(0)" ::: "memory");
}
__device__ __forceinline__ void final_row(float* __restrict__ out, const bf16_t* __restrict__ Y, const float* __restrict__ g, int t, int lane) {
    float4* xr = (float4*)(out + (size_t)t * DM);
    const uint2* y0 = (const uint2*)(Y + (size_t)(2 * t) * DM); const uint2* y1 = (const uint2*)(Y + (size_t)(2 * t + 1) * DM);
    float4 v[8]; float ss = 0.f;
#pragma unroll
    for (int j = 0; j < 8; ++j) { float4 a = xr[j * 64 + lane]; const uint2 p = y0[j * 64 + lane], q = y1[j * 64 + lane];
        a.x += bf2f(p.x & 0xffffu) + bf2f(q.x & 0xffffu); a.y += bf2f(p.x >> 16) + bf2f(q.x >> 16); a.z += bf2f(p.y & 0xffffu) + bf2f(q.y & 0xffffu); a.w += bf2f(p.y >> 16) + bf2f(q.y >> 16);
        v[j] = a; ss += a.x * a.x + a.y * a.y + a.z * a.z + a.w * a.w; }
    const float r = rsqrtf(wave_sum(ss) * (1.f / DM) + EPS);
#pragma unroll
    for (int j = 0; j < 8; ++j) { const float4 gv = ((const float4*)g)[j * 64 + lane]; float4 a = v[j]; a.x *= r * gv.x; a.y *= r * gv.y; a.z *= r * gv.z; a.w *= r * gv.w; xr[j * 64 + lane] = a; }
}


namespace att {
typedef float f32x16 __attribute__((ext_vector_type(16)));
typedef short s16x4 __attribute__((ext_vector_type(4)));
typedef short v4i16_t __attribute__((ext_vector_type(4)));
constexpr int SLOT = 8192, L_K = 0, L_V = 2 * SLOT, L_TB = 4 * SLOT, NTB = 576;
__device__ __forceinline__ float rowmax32(const f32x16& p0, const f32x16& p1) {
    float a = fmaxf(p0[0], p1[0]);
#pragma unroll
    for (int r = 1; r < 16; ++r) a = fmaxf(a, fmaxf(p0[r], p1[r]));
    auto rr = __builtin_amdgcn_permlane32_swap(__float_as_uint(a), __float_as_uint(a), false, false);
    return fmaxf(__uint_as_float(rr[0]), __uint_as_float(rr[1]));
}
__device__ __forceinline__ unsigned cvtpk(float lo, float hi) { typedef float f2 __attribute__((ext_vector_type(2))); typedef __bf16 b2 __attribute__((ext_vector_type(2))); f2 v = {lo, hi}; b2 b = __builtin_convertvector(v, b2); return __builtin_bit_cast(unsigned, b); }
__device__ __forceinline__ s16x4 vtr(LAS const unsigned char* p) { return __builtin_bit_cast(s16x4, __builtin_amdgcn_ds_read_tr16_b64_v4i16((LAS v4i16_t*)p)); }

__device__ __forceinline__ void attn_unit(LAS unsigned char* lds, const bf16_t* __restrict__ proj, const float* __restrict__ relb, bf16_t* __restrict__ mix, float* __restrict__ ssA, int b, int h, int cg) {
    const int tid = threadIdx.x, lane = tid & 63, r32 = lane & 31, hi = lane >> 5, w = __builtin_amdgcn_readfirstlane(tid >> 6);
    const int c0 = cg * 4, cq = c0 + (w >> 1), qi = 32 * (w & 1) + r32;
    const int j0 = c0 - 8 < 0 ? 0 : c0 - 8, j1 = c0 + 3;
    LAS float* tb = (LAS float*)(lds + L_TB);
    for (int i = tid; i < NTB; i += NTHREADS) tb[i] = relb[h * NREL + (i > 512 ? 512 : i)] * LOG2E;
    const size_t tq = (size_t)b * SEQ + (size_t)c0 * 64 + 32 * w + r32;
    bf16x8 qr[4];
#pragma unroll
    for (int d0 = 0; d0 < 4; ++d0) qr[d0] = *(const bf16x8*)(proj + tq * NPROJ + h * HD + d0 * 16 + hi * 8);
    const int krow = 8 * w + (lane >> 3);
    const bf16_t* ksrc = proj + ((size_t)b * SEQ + krow) * NPROJ + DATT + h * HD + (((lane & 7) ^ ((krow >> 1) & 7)) * 8);
    const bf16_t* vsrc = proj + ((size_t)b * SEQ + 16 * (w & 3) + (lane >> 2)) * NPROJ + 2 * DATT + h * HD + (w >> 2) * 32 + (lane & 3) * 8;
#define ATT_DMA(j, slot) do { __builtin_amdgcn_global_load_lds((const unsigned*)(ksrc + (size_t)(j) * 64 * NPROJ), (LAS unsigned*)(lds + L_K + (slot) * SLOT + w * 1024), 16, 0, 0); \
                              __builtin_amdgcn_global_load_lds((const unsigned*)(vsrc + (size_t)(j) * 64 * NPROJ), (LAS unsigned*)(lds + L_V + (slot) * SLOT + w * 1024), 16, 0, 0); } while (0)
    int ka[4];
#pragma unroll
    for (int d0 = 0; d0 < 4; ++d0) ka[d0] = r32 * 128 + (((2 * d0 + hi) ^ ((r32 >> 1) & 7)) * 16);
    const int va = ((lane >> 4) & 1) * 32 + (lane & 3) * 8 + (4 * hi + ((lane & 15) >> 2)) * 64;
    float m = -1e30f, l = 0.f; f32x16 o[2];
#pragma unroll
    for (int r = 0; r < 16; ++r) { o[0][r] = 0.f; o[1][r] = 0.f; }
    ATT_DMA(j0, 0);
    for (int j = j0; j <= j1; ++j) {
        const int slot = (j - j0) & 1;
        asm volatile("s_waitcnt vmcnt(0) lgkmcnt(0)\n\ts_barrier" ::: "memory");
        if (j < j1) ATT_DMA(j + 1, slot ^ 1);
        const int dl = cq - j;
        if (dl >= 0 && dl <= 8) {
            LAS const unsigned char* Ks = lds + L_K + slot * SLOT; LAS const unsigned char* Vs = lds + L_V + slot * SLOT + va;
            f32x16 p0, p1;
            if (dl <= 4) { LAS const float* tp = tb + (64 * dl + qi + 256 - 4 * hi - 59);
#pragma unroll
                for (int r = 0; r < 16; ++r) { p0[r] = tp[59 - ((r & 3) + 8 * (r >> 2))]; p1[r] = tp[27 - ((r & 3) + 8 * (r >> 2))]; } }
            else { const float bf = tb[NTB - 1];
#pragma unroll
                for (int r = 0; r < 16; ++r) { p0[r] = bf; p1[r] = bf; } }
#pragma unroll
            for (int d0 = 0; d0 < 4; ++d0) { const bf16x8 k0 = *(LAS const bf16x8*)(Ks + ka[d0]), k1 = *(LAS const bf16x8*)(Ks + ka[d0] + 4096);
                p0 = __builtin_amdgcn_mfma_f32_32x32x16_bf16(k0, qr[d0], p0, 0, 0, 0); p1 = __builtin_amdgcn_mfma_f32_32x32x16_bf16(k1, qr[d0], p1, 0, 0, 0); }
            const float mn = fmaxf(m, rowmax32(p0, p1)), al = __builtin_amdgcn_exp2f(m - mn); m = mn;
            float rs = 0.f;
#pragma unroll
            for (int r = 0; r < 16; ++r) { p0[r] = __builtin_amdgcn_exp2f(p0[r] - mn); p1[r] = __builtin_amdgcn_exp2f(p1[r] - mn); rs += p0[r] + p1[r]; }
            l = l * al + rs;
#pragma unroll
            for (int r = 0; r < 16; ++r) { o[0][r] *= al; o[1][r] *= al; }
            bf16x8 pw[4];
#pragma unroll
            for (int ks = 0; ks < 4; ++ks) { const f32x16& P = ks < 2 ? p0 : p1; const int bo = (ks & 1) * 8; typedef unsigned u4 __attribute__((ext_vector_type(4)));
                u4 t4 = {cvtpk(P[bo], P[bo + 1]), cvtpk(P[bo + 2], P[bo + 3]), cvtpk(P[bo + 4], P[bo + 5]), cvtpk(P[bo + 6], P[bo + 7])}; pw[ks] = __builtin_bit_cast(bf16x8, t4); }
#pragma unroll
            for (int d0 = 0; d0 < 2; ++d0)
#pragma unroll
                for (int ks = 0; ks < 4; ++ks) { const s16x4 lo = vtr(Vs + d0 * 4096 + ks * 1024), hh = vtr(Vs + d0 * 4096 + ks * 1024 + 512);
                    const bf16x8 vf = {lo[0], lo[1], lo[2], lo[3], hh[0], hh[1], hh[2], hh[3]};
                    o[d0] = __builtin_amdgcn_mfma_f32_32x32x16_bf16(vf, pw[ks], o[d0], 0, 0, 0); }
        }
    }
    { auto rr = __builtin_amdgcn_permlane32_swap(__float_as_uint(l), __float_as_uint(l), false, false); l = __uint_as_float(rr[0]) + __uint_as_float(rr[1]); }
    const float il = 1.f / l; float ss = 0.f;
    bf16_t* op = mix + tq * DM + h * HD + 4 * hi;
#pragma unroll
    for (int d0 = 0; d0 < 2; ++d0)
#pragma unroll
        for (int g = 0; g < 4; ++g) { const float v0 = o[d0][4 * g] * il, v1 = o[d0][4 * g + 1] * il, v2 = o[d0][4 * g + 2] * il, v3 = o[d0][4 * g + 3] * il;
            ss += v0 * v0 + v1 * v1 + v2 * v2 + v3 * v3; *(uint2*)(op + 32 * d0 + 8 * g) = make_uint2(cvtpk(v0, v1), cvtpk(v2, v3)); }
    { auto rr = __builtin_amdgcn_permlane32_swap(__float_as_uint(ss), __float_as_uint(ss), false, false); ss = __uint_as_float(rr[0]) + __uint_as_float(rr[1]); }
    if (hi == 0) ssA[tq * 16 + h] = ss;
    asm volatile("s_waitcnt vmcnt(0) lgkmcnt(0)\n\ts_barrier" ::: "memory");
#undef ATT_DMA
}
}

__device__ __forceinline__ void conv_slab(const bf16_t* __restrict__ proj, const float* __restrict__ cw, bf16_t* __restrict__ mix, float* __restrict__ ssC4, int item, int lane) {
    const int slab = item & 3, t0 = (item >> 2) * 32, ch = slab * 256 + lane * 4;
    const float4 w0 = *(const float4*)(cw + ch), w1 = *(const float4*)(cw + DCONV + ch), w2 = *(const float4*)(cw + 2 * DCONV + ch);
    float z1[4] = {0.f, 0.f, 0.f, 0.f}, z2[4] = {0.f, 0.f, 0.f, 0.f};
    if ((t0 & (SEQ - 1)) != 0) {
#pragma unroll
        for (int back = 2; back >= 1; --back) { const bf16_t* pr = proj + (size_t)(t0 - back) * NPROJ; const uint2 cv = *(const uint2*)(pr + 4 * DATT + ch), uv = *(const uint2*)(pr + 5 * DATT + ch);
            float z[4] = {bf2f(cv.x & 0xffffu) * bf2f(uv.x & 0xffffu), bf2f(cv.x >> 16) * bf2f(uv.x >> 16), bf2f(cv.y & 0xffffu) * bf2f(uv.y & 0xffffu), bf2f(cv.y >> 16) * bf2f(uv.y >> 16)};
#pragma unroll
            for (int q = 0; q < 4; ++q) { if (back == 2) z2[q] = z[q]; else z1[q] = z[q]; } }
    }
#pragma unroll 4
    for (int i = 0; i < 32; ++i) { const int t = t0 + i; const bf16_t* pr = proj + (size_t)t * NPROJ;
        const uint2 bv = *(const uint2*)(pr + 3 * DATT + ch), cv = *(const uint2*)(pr + 4 * DATT + ch), uv = *(const uint2*)(pr + 5 * DATT + ch);
        const float z[4] = {bf2f(cv.x & 0xffffu) * bf2f(uv.x & 0xffffu), bf2f(cv.x >> 16) * bf2f(uv.x >> 16), bf2f(cv.y & 0xffffu) * bf2f(uv.y & 0xffffu), bf2f(cv.y >> 16) * bf2f(uv.y >> 16)};
        const float bb[4] = {bf2f(bv.x & 0xffffu), bf2f(bv.x >> 16), bf2f(bv.y & 0xffffu), bf2f(bv.y >> 16)};
        const float wa[4] = {w0.x, w0.y, w0.z, w0.w}, wb[4] = {w1.x, w1.y, w1.z, w1.w}, wc[4] = {w2.x, w2.y, w2.z, w2.w};
        float y[4]; float ss = 0.f;
#pragma unroll
        for (int q = 0; q < 4; ++q) { y[q] = bb[q] * (wa[q] * z2[q] + wb[q] * z1[q] + wc[q] * z[q]); ss += y[q] * y[q]; z2[q] = z1[q]; z1[q] = z[q]; }
        *(uint2*)(mix + (size_t)t * DM + DATT + ch) = make_uint2(pk2(y[0], y[1]), pk2(y[2], y[3]));
        ss = wave_sum(ss);
        if (lane == 0) ssC4[t * 4 + slab] = ss; }
}

namespace g8 {
typedef unsigned u32x4 __attribute__((ext_vector_type(4)));
constexpr int BM = 256, BK = 64, HALF = 128, HTB = HALF * BK * 2, STAGE_BYTES = 8 * HTB, NXCD = 8, WGM = 8;
__device__ __forceinline__ int lds_byte(int r, int c) { const int st = (r >> 4) * 2 + (c >> 5), rr = r & 15, cc = c & 31, ob = rr * 64 + cc * 2; return st * 1024 + (ob ^ (((ob >> 9) & 1) << 5)); }
__device__ __forceinline__ void stage_rc(int b, int& R, int& C) { const int st = b / 1024, sb = b % 1024, swz = sb ^ (((sb >> 9) & 1) << 5); R = (st >> 1) * 16 + swz / 64; C = (st & 1) * 32 + (swz % 64) / 2; }
__device__ __forceinline__ int perm32(int rho) { const int n = rho >> 4, i = rho & 15; return 8 * (i >> 2) + 4 * n + (i & 3); }
__device__ __forceinline__ unsigned cvt_pk_bf16(float lo, float hi) { unsigned r; asm volatile("v_cvt_pk_bf16_f32 %0, %1, %2" : "=v"(r) : "v"(lo), "v"(hi)); return r; }
__device__ __forceinline__ int xcd_remap(int wgid, int nwg) { const int q = nwg / NXCD, r = nwg % NXCD, xcd = wgid % NXCD, off = wgid / NXCD; return (xcd < r ? xcd * (q + 1) : r * (q + 1) + (xcd - r) * q) + off; }

struct Unit { int pm, pn, e; const char* a; const char* b; };

struct DenseOrder {
    const char* A; const char* Bt; int K, nM, nN, nwg, G, c, mul = 1;
    __device__ __forceinline__ void init(const void* A_, const void* Bt_, int M, int N, int K_, int G_, int c_) { A = (const char*)A_; Bt = (const char*)Bt_; K = K_; nM = M / BM; nN = N / BM; nwg = nM * nN; G = G_; c = c_; }
    __device__ __forceinline__ bool next(int i, Unit& u) const {
        int L = i * G + c; if (L >= nwg * mul) return false; L %= nwg;
        const int wgid = xcd_remap(L, nwg);
        const int nig = WGM * nN, gid = wgid / nig, fm = gid * WGM, gsz = (nM - fm) < WGM ? (nM - fm) : WGM;
        u.pm = fm + ((wgid % nig) % gsz); u.pn = (wgid % nig) / gsz; u.e = i;
        u.a = A + (size_t)u.pm * BM * K * 2; u.b = Bt + (size_t)u.pn * BM * K * 2; return true;
    }
    __device__ __forceinline__ unsigned arow_off(const Unit&, int r, int Kb) const { return (unsigned)r * (unsigned)Kb; }
};
template <bool GATHER> struct MoeOrder {
    const char* A; const char* Bt; const int* list; LAS const int* pl; int K, NPN, nwg, G, c; size_t estride; int mul;
    __device__ __forceinline__ bool next(int i, Unit& u) const {
        int L = i * G + c; if (L >= nwg * mul) return false; L %= nwg;
        const int wgid = xcd_remap(L, nwg);
        u.pm = wgid / NPN; u.pn = wgid % NPN; u.e = pl[64 + u.pm];
        u.a = GATHER ? A : A + (size_t)u.pm * BM * K * 2; u.b = Bt + (size_t)u.e * estride + (size_t)u.pn * BM * K * 2; return true;
    }
    __device__ __forceinline__ int pair_of(const Unit& u, int r) const { const int slot = u.pm * BM + r - pl[32 + u.e]; return slot < pl[u.e] ? list[u.e * T + slot] : -1; }
    __device__ __forceinline__ unsigned arow_off(const Unit& u, int r, int Kb) const {
        if (GATHER) { const int pr = pair_of(u, r); return (unsigned)(pr >= 0 ? (pr >> 1) : 0) * (unsigned)Kb; }
        return (unsigned)r * (unsigned)Kb;
    }
};

template <bool GATHER, class Epi, class Sched>
__device__ __forceinline__ void gemm_phase(LAS unsigned char* lds, const int K, const Sched& S, const Epi& E) {
    const int tid = threadIdx.x, wid = __builtin_amdgcn_readfirstlane(tid >> 6), lane = tid & 63, wr = wid >> 2, wc = wid & 3, fr = lane & 15, fq = lane >> 4;
    const int nt = K / BK, Kb = K * 2;
    int RA[2], CA[2]; unsigned voffB[2];
#pragma unroll
    for (int i = 0; i < 2; ++i) { int R, C; stage_rc(tid * 16 + i * 8192, R, C); RA[i] = R; CA[i] = C * 2; const int Rb = Epi::PERM ? ((R & ~31) + perm32(R & 31)) : R; voffB[i] = (unsigned)(Rb * K + C) * 2u; }
    const size_t kstep = (size_t)(BK * 2);
    const size_t hstep = (size_t)HALF * K * 2;
    const unsigned ldsw = (unsigned)wid * 1024u;
    const int aoff = lds_byte(wr * 64 + fr, fq * 8), boff = lds_byte(wc * 32 + fr, fq * 8);
#define G8_SA(b, h) (((b) * 2 + (h)) * HTB)
#define G8_SB(b, h) ((4 + (b) * 2 + (h)) * HTB)
#define G8_STAGE(bufoff, gbase, voff) do { _Pragma("unroll") for (int _i = 0; _i < 2; ++_i) \
        __builtin_amdgcn_global_load_lds((const unsigned*)((const char*)(gbase) + (voff)[_i]), (LAS unsigned*)(lds + (bufoff) + ldsw + _i * 8192), 16, 0, 0); } while (0)
#define G8_LDA(dst, b, h) do { _Pragma("unroll") for (int m = 0; m < 4; ++m) _Pragma("unroll") for (int k = 0; k < 2; ++k) dst[m][k] = *(const LAS bf16x8*)(lds + G8_SA(b, h) + aoff + m * 2048 + k * 1024); } while (0)
#define G8_LDB(dst, b, h) do { _Pragma("unroll") for (int n = 0; n < 2; ++n) _Pragma("unroll") for (int k = 0; k < 2; ++k) dst[n][k] = *(const LAS bf16x8*)(lds + G8_SB(b, h) + boff + n * 2048 + k * 1024); } while (0)
#define G8_MMA(ai, bj, At, Bt) do { __builtin_amdgcn_s_setprio(1); _Pragma("unroll") for (int m = 0; m < 4; ++m) _Pragma("unroll") for (int n = 0; n < 2; ++n) _Pragma("unroll") for (int k = 0; k < 2; ++k) \
        acc[ai][bj][m][n] = __builtin_amdgcn_mfma_f32_16x16x32_bf16(Bt[n][k], At[m][k], acc[ai][bj][m][n], 0, 0, 0); __builtin_amdgcn_s_setprio(0); } while (0)
#define G8_WAIT_V(n) asm volatile("s_waitcnt vmcnt(" #n ")" ::: "memory")
#define G8_WAIT_L(n) asm volatile("s_waitcnt lgkmcnt(" #n ")" ::: "memory")
#define G8_BAR __builtin_amdgcn_s_barrier()
#define G8_SCHED __builtin_amdgcn_sched_barrier(0)
    Unit cur, nxt; int ui = 0;
    if (!S.next(0, cur)) return;
    f32x4 acc[2][2][4][2];
#pragma unroll
    for (int a = 0; a < 2; ++a)
#pragma unroll
        for (int b = 0; b < 2; ++b)
#pragma unroll
            for (int m = 0; m < 4; ++m)
#pragma unroll
                for (int n = 0; n < 2; ++n) acc[a][b][m][n] = (f32x4){0.f, 0.f, 0.f, 0.f};
    bf16x8 At[4][2], B0[2][2], B1[2][2];
    unsigned vA[2][2], vN[2][2];
#pragma unroll
    for (int h = 0; h < 2; ++h)
#pragma unroll
        for (int i = 0; i < 2; ++i) { vA[h][i] = S.arow_off(cur, h * HALF + RA[i], Kb) + (unsigned)CA[i]; vN[h][i] = vA[h][i]; }
    const char* cA = cur.a; const char* cB = cur.b;
    G8_STAGE(G8_SB(0, 0), cB, voffB); G8_STAGE(G8_SB(0, 1), cB + hstep, voffB); G8_STAGE(G8_SA(0, 0), cA, vA[0]); G8_STAGE(G8_SA(0, 1), cA, vA[1]);
    if (wr == 1) G8_BAR;
    G8_WAIT_V(2); G8_BAR;
    G8_STAGE(G8_SB(1, 0), cB + kstep, voffB); G8_STAGE(G8_SA(1, 0), cA + kstep, vA[0]); G8_STAGE(G8_SB(1, 1), cB + hstep + kstep, voffB);
    G8_WAIT_V(6); G8_BAR;
    for (;;) {
        const bool has_next = S.next(ui + 1, nxt);
        const char* nA = has_next ? nxt.a : cA; const char* nB = has_next ? nxt.b : cB;
        if (GATHER && has_next) {
#pragma unroll
            for (int h = 0; h < 2; ++h)
#pragma unroll
                for (int i = 0; i < 2; ++i) vN[h][i] = S.arow_off(nxt, h * HALF + RA[i], Kb) + (unsigned)CA[i];
        }
        for (int t = 0; t < nt; t += 2) {
            const bool last = (t == nt - 2);
            if (Epi::MID_T >= 0 && t == Epi::MID_T) E.mid(acc, cur, wr, wc, fr, fq);
            const char* a1 = cA + (size_t)(t + 1) * kstep;
            const char* a2 = last ? nA : cA + (size_t)(t + 2) * kstep; const char* b2 = last ? nB : cB + (size_t)(t + 2) * kstep;
            const char* a3 = a2 + kstep; const char* b3 = b2 + kstep;
            unsigned v2[2][2];
#pragma unroll
            for (int h = 0; h < 2; ++h)
#pragma unroll
                for (int i = 0; i < 2; ++i) v2[h][i] = (GATHER && last) ? vN[h][i] : vA[h][i];
            G8_LDB(B0, 0, 0); G8_LDB(B1, 0, 1); G8_SCHED; G8_LDA(At, 0, 0); G8_STAGE(G8_SA(1, 1), a1, vA[1]);
            G8_WAIT_V(8); G8_WAIT_L(0); G8_BAR; G8_MMA(0, 0, At, B0); G8_MMA(0, 1, At, B1); G8_BAR; G8_SCHED;
            G8_LDA(At, 0, 1); G8_STAGE(G8_SB(0, 0), b2, voffB); G8_STAGE(G8_SB(0, 1), b2 + hstep, voffB); G8_STAGE(G8_SA(0, 0), a2, v2[0]);
            G8_WAIT_V(8); G8_WAIT_L(0); G8_BAR; G8_MMA(1, 0, At, B0); G8_MMA(1, 1, At, B1); G8_BAR; G8_SCHED;
            G8_LDB(B0, 1, 0); G8_LDB(B1, 1, 1); G8_SCHED; G8_LDA(At, 1, 0); G8_STAGE(G8_SA(0, 1), a2, v2[1]);
            G8_WAIT_V(8); G8_WAIT_L(0); G8_BAR; G8_MMA(0, 0, At, B0); G8_MMA(0, 1, At, B1); G8_BAR; G8_SCHED;
            G8_LDA(At, 1, 1); G8_STAGE(G8_SB(1, 0), b3, voffB); G8_STAGE(G8_SB(1, 1), b3 + hstep, voffB); G8_STAGE(G8_SA(1, 0), a3, v2[0]);
            G8_WAIT_V(8); G8_WAIT_L(0); G8_BAR; G8_MMA(1, 0, At, B0); G8_MMA(1, 1, At, B1); G8_BAR; G8_SCHED;
        }
        if (wr == 0) G8_BAR;
        E(acc, cur, wr, wc, fr, fq);
        if (!has_next) break;
#pragma unroll
        for (int a = 0; a < 2; ++a)
#pragma unroll
            for (int b = 0; b < 2; ++b)
#pragma unroll
                for (int m = 0; m < 4; ++m)
#pragma unroll
                    for (int n = 0; n < 2; ++n) acc[a][b][m][n] = (f32x4){0.f, 0.f, 0.f, 0.f};
        cur = nxt; cA = nA; cB = nB; ++ui;
#pragma unroll
        for (int h = 0; h < 2; ++h)
#pragma unroll
            for (int i = 0; i < 2; ++i) vA[h][i] = vN[h][i];
        if (wr == 1) G8_BAR;
    }
    G8_WAIT_V(0);
    G8_BAR;
#undef G8_SA
#undef G8_SB
#undef G8_STAGE
#undef G8_LDA
#undef G8_LDB
#undef G8_MMA
#undef G8_WAIT_V
#undef G8_WAIT_L
#undef G8_BAR
#undef G8_SCHED
}

struct EpiProjF { static constexpr bool PERM = true; static constexpr int MID_T = -1; bf16_t* out; const float* r1;
    __device__ __forceinline__ void mid(f32x4 (&)[2][2][4][2], const Unit&, int, int, int, int) const {}
    __device__ __forceinline__ void operator()(const f32x4 (&acc)[2][2][4][2], const Unit& u, int wr, int wc, int fr, int fq) const {
        const int row0 = u.pm * BM + wr * 64 + fr, col0 = u.pn * BM + wc * 32 + 8 * fq;
#pragma unroll
        for (int ai = 0; ai < 2; ++ai)
#pragma unroll
            for (int m = 0; m < 4; ++m) { const int row = row0 + ai * HALF + m * 16; const float s = r1[row]; bf16_t* rowp = out + (size_t)row * NPROJ + col0;
#pragma unroll
                for (int bj = 0; bj < 2; ++bj) { const f32x4 v0 = acc[ai][bj][m][0] * s, v1 = acc[ai][bj][m][1] * s; u32x4 w; w.x = cvt_pk_bf16(v0[0], v0[1]); w.y = cvt_pk_bf16(v0[2], v0[3]); w.z = cvt_pk_bf16(v1[0], v1[1]); w.w = cvt_pk_bf16(v1[2], v1[3]);
                    *(u32x4*)(rowp + bj * HALF) = w; } }
    }
};
struct EpiG2F { static constexpr bool PERM = false; static constexpr int MID_T = DATT / BK; const float* x; float* x1; bf16_t* xb1; LAS const float* tab; int G;
    __device__ __forceinline__ void mid(f32x4 (&acc)[2][2][4][2], const Unit& u, int wr, int wc, int fr, int fq) const {
        LAS const float* tb = tab + (size_t)(u.e) * 512;
#pragma unroll
        for (int ai = 0; ai < 2; ++ai)
#pragma unroll
            for (int m = 0; m < 4; ++m) { const float s = tb[(ai * HALF + wr * 64 + m * 16 + fr) * 2];
#pragma unroll
                for (int bj = 0; bj < 2; ++bj)
#pragma unroll
                    for (int n = 0; n < 2; ++n) acc[ai][bj][m][n] *= s; }
    }
    __device__ __forceinline__ void operator()(const f32x4 (&acc)[2][2][4][2], const Unit& u, int wr, int wc, int fr, int fq) const {
        LAS const float* tb = tab + (size_t)(u.e) * 512;
        const int col0 = u.pn * BM + wc * 32 + 4 * fq;
#pragma unroll
        for (int ai = 0; ai < 2; ++ai)
#pragma unroll
            for (int m = 0; m < 4; ++m) { const int r = ai * HALF + wr * 64 + m * 16 + fr; const float s = tb[r * 2 + 1]; const size_t off = (size_t)(u.pm * BM + r) * DM + col0;
#pragma unroll
                for (int bj = 0; bj < 2; ++bj)
#pragma unroll
                    for (int n = 0; n < 2; ++n) { const f32x4 xv = *(const f32x4*)(x + off + bj * HALF + n * 16); const f32x4 o = xv + acc[ai][bj][m][n] * s;
                        *(f32x4*)(x1 + off + bj * HALF + n * 16) = o; *(uint2*)(xb1 + off + bj * HALF + n * 16) = make_uint2(cvt_pk_bf16(o[0], o[1]), cvt_pk_bf16(o[2], o[3])); } }
    }
};
template <class Sched> struct EpiGUF { static constexpr bool PERM = true; static constexpr int MID_T = -1; bf16_t* Hb; const float* r2; const Sched* S;
    __device__ __forceinline__ void mid(f32x4 (&)[2][2][4][2], const Unit&, int, int, int, int) const {}
    __device__ __forceinline__ void operator()(const f32x4 (&acc)[2][2][4][2], const Unit& u, int wr, int wc, int fr, int fq) const {
        const int col0 = u.pn * HALF + wc * 32 + 8 * fq;
#pragma unroll
        for (int ai = 0; ai < 2; ++ai)
#pragma unroll
            for (int m = 0; m < 4; ++m) { const int r = ai * HALF + wr * 64 + m * 16 + fr; const int pr = S->pair_of(u, r); const float s = r2[pr >= 0 ? (pr >> 1) : 0];
                float h[8];
#pragma unroll
                for (int n = 0; n < 2; ++n)
#pragma unroll
                    for (int q = 0; q < 4; ++q) { const float gg = acc[ai][0][m][n][q] * s, uu = acc[ai][1][m][n][q] * s; h[4 * n + q] = gg * __builtin_amdgcn_rcpf(1.f + __expf(-gg)) * uu; }
                u32x4 w; w.x = cvt_pk_bf16(h[0], h[1]); w.y = cvt_pk_bf16(h[2], h[3]); w.z = cvt_pk_bf16(h[4], h[5]); w.w = cvt_pk_bf16(h[6], h[7]);
                *(u32x4*)(Hb + (size_t)(u.pm * BM + r) * DEXP + col0) = w; }
    }
};
template <class Sched> struct EpiDownF { static constexpr bool PERM = true; static constexpr int MID_T = -1; bf16_t* Y; const float* wts; const Sched* S;
    __device__ __forceinline__ void mid(f32x4 (&)[2][2][4][2], const Unit&, int, int, int, int) const {}
    __device__ __forceinline__ void operator()(const f32x4 (&acc)[2][2][4][2], const Unit& u, int wr, int wc, int fr, int fq) const {
        const int col0 = u.pn * BM + wc * 32 + 8 * fq;
#pragma unroll
        for (int ai = 0; ai < 2; ++ai)
#pragma unroll
            for (int m = 0; m < 4; ++m) { const int r = ai * HALF + wr * 64 + m * 16 + fr; const int pr = S->pair_of(u, r); if (pr < 0) continue; const float s = wts[pr]; bf16_t* rowp = Y + (size_t)pr * DM + col0;
#pragma unroll
                for (int bj = 0; bj < 2; ++bj) { const f32x4 v0 = acc[ai][bj][m][0] * s, v1 = acc[ai][bj][m][1] * s; u32x4 w; w.x = cvt_pk_bf16(v0[0], v0[1]); w.y = cvt_pk_bf16(v0[2], v0[3]); w.z = cvt_pk_bf16(v1[0], v1[1]); w.w = cvt_pk_bf16(v1[2], v1[3]);
                    *(u32x4*)(rowp + bj * HALF) = w; } }
    }
};
}


#define XB_TMO      128
#define XB_XCNT(j)  (256  + 64 * (j))
#define XB_XSUB(j)  (1280 + 64 * (j))
#define XB_XGEN(j)  (2304 + 64 * (j))
#define XB_TOP      3328
#define XB_TOPGEN   3392
#define XCD_BAR_WORDS 3456
#define XB_SPIN_CAP (1u << 20)
__device__ __forceinline__ unsigned xb_ld(unsigned* p)              { return __hip_atomic_load(p, __ATOMIC_RELAXED, __HIP_MEMORY_SCOPE_AGENT); }
__device__ __forceinline__ unsigned xb_add(unsigned* p, unsigned v) { return __hip_atomic_fetch_add(p, v, __ATOMIC_RELAXED, __HIP_MEMORY_SCOPE_AGENT); }
__device__ __forceinline__ unsigned xb_xcc_id() { return (unsigned)__builtin_amdgcn_s_getreg((3 << 11) | 20) & 0xFu; }
#define XB_SPIN(cond, bar) do { unsigned _sp = 0; while (cond) { __builtin_amdgcn_s_sleep(1); \
    if ((++_sp & 255u) == 0u) { if (xb_ld(&(bar)[XB_TMO])) break; if (_sp > XB_SPIN_CAP) { atomicAdd(&(bar)[XB_TMO], 1u); break; } } } } while (0)
struct XcdBarrier { unsigned* bar; unsigned x; volatile LAS unsigned* st; };
__device__ __forceinline__ XcdBarrier xcd_barrier_post(unsigned* bar, volatile LAS unsigned* st) {
    XcdBarrier b; b.bar = bar; b.x = xb_xcc_id(); b.st = st;
    if (threadIdx.x == 0) (void)xb_add(&bar[XB_XCNT(b.x)], 1u);
    return b;
}
__device__ __forceinline__ void xcd_barrier_complete(unsigned* bar, unsigned x, unsigned& nloc, unsigned& nx) {
    const unsigned G = gridDim.x * gridDim.y * gridDim.z;
    unsigned sum, cnt, mine, sp = 0u;
    for (;;) {
        sum = 0u; cnt = 0u; mine = 0u;
#pragma unroll
        for (unsigned j = 0; j < 16; ++j) { const unsigned c = xb_ld(&bar[XB_XCNT(j)]); sum += c; cnt += (c > 0u) ? 1u : 0u; mine = (j == x) ? c : mine; }
        if (sum == G) break;
        __builtin_amdgcn_s_sleep(1);
        if ((++sp & 255u) == 0u) { if (xb_ld(&bar[XB_TMO])) break; if (sp > XB_SPIN_CAP) { atomicAdd(&bar[XB_TMO], 1u); break; } }
    }
    nloc = mine > 0u ? mine : 1u; nx = cnt > 0u ? cnt : 1u;
}
__device__ __forceinline__ void xcd_barrier(const XcdBarrier& b) {
    asm volatile("s_waitcnt vmcnt(0)" ::: "memory");
    __syncthreads();
    if (threadIdx.x == 0) {
        unsigned* bar = b.bar;
        __builtin_amdgcn_s_waitcnt(0);
        unsigned nloc = b.st[0], nx = b.st[1];
        if (nloc == 0u) { xcd_barrier_complete(bar, b.x, nloc, nx); b.st[0] = nloc; b.st[1] = nx; }
        const unsigned old = xb_add(&bar[XB_XSUB(b.x)], 1u);
        const unsigned gen = old / nloc;
        if (old + 1u == (gen + 1u) * nloc) {
            __builtin_amdgcn_fence(__ATOMIC_RELEASE, "agent");
            asm volatile("s_waitcnt vmcnt(0)" ::: "memory");
            const unsigned og = xb_add(&bar[XB_TOP], 1u);
            const unsigned tg = og / nx;
            if (og + 1u == (tg + 1u) * nx) xb_add(&bar[XB_TOPGEN], 1u);
            else XB_SPIN(xb_ld(&bar[XB_TOPGEN]) == tg, bar);
            __builtin_amdgcn_fence(__ATOMIC_ACQUIRE, "agent");
            xb_add(&bar[XB_XGEN(b.x)], 1u);
            asm volatile("s_waitcnt vmcnt(0)" ::: "memory");
        } else {
            XB_SPIN(xb_ld(&bar[XB_XGEN(b.x)]) == gen, bar);
            __builtin_amdgcn_fence(__ATOMIC_ACQUIRE, "agent");
            asm volatile("s_waitcnt vmcnt(0)" ::: "memory");
        }
    }
    __syncthreads();
}

#ifndef PROBE
#define PROBE 0
#endif
#define PMUL(k) ((PROBE) == (k) ? 2 : 1)
__global__ void __launch_bounds__(NTHREADS, 2) mega(Params p) {
    extern __shared__ __attribute__((aligned(16))) unsigned char lds[];
    volatile LAS unsigned* bst = (volatile LAS unsigned*)(lds + LDS_PLAN_OFF + 1024);
    if (threadIdx.x < 2) bst[threadIdx.x] = 0u;
    __syncthreads();
    const XcdBarrier gbar = xcd_barrier_post((unsigned*)(p.ws + WS_BAR), bst);
    if (p.never) cg::this_grid().sync();
    Ctx c; c.tid = threadIdx.x; c.lane = c.tid & 63; c.wave = __builtin_amdgcn_readfirstlane(c.tid >> 6); c.gw = blockIdx.x * NWAVES + c.wave; c.ngw = gridDim.x * NWAVES;
    char* ws = p.ws;
    int* cnt = (int*)(ws + WS_CTL);
    float* r1 = (float*)(ws + WS_R1); float* r2 = (float*)(ws + WS_R2); float* ssC = (float*)(ws + WS_SSC);
    float* wts = (float*)(ws + WS_WTS); bf16_t* Wrh = (bf16_t*)(ws + WS_WR); bf16_t* Wrl = (bf16_t*)(ws + WS_WR + 256 * 1024); float* ssA = (float*)(ws + WS_SSA); int* list = (int*)(ws + WS_LIST);
    bf16_t* W2t = (bf16_t*)(ws + WS_W2T); bf16_t* W1t = (bf16_t*)(ws + WS_W1T); bf16_t* Wdt = (bf16_t*)(ws + WS_WDT); bf16_t* Wgut = (bf16_t*)(ws + WS_WGUT);
    bf16_t* xb = (bf16_t*)(ws + WS_XB); bf16_t* mix = (bf16_t*)(ws + WS_MIX); bf16_t* proj = (bf16_t*)(ws + WS_PROJ); bf16_t* Y = (bf16_t*)(ws + WS_Y); bf16_t* Hb = (bf16_t*)(ws + WS_H);

    {
        for (int row = c.gw; row < T * PMUL(10); row += c.ngw) p0_x_row(p.x, xb, r1, row % T, c.lane);
        LAS float* scr = (LAS float*)lds + c.wave * (64 * 65);
        constexpr int I_IN = (DM / 64) * (NPROJ / 64), I_OUT = (DM / 64) * (DM / 64), I_G = NE * (DM / 64) * (DEXP / 64), I_D = NE * (DEXP / 64) * (DM / 64);
        constexpr int NIT = I_IN + I_OUT + 2 * I_G + I_D;
        for (int it = c.gw; it < NIT * PMUL(10); it += c.ngw) {
            int r = it % NIT;
            if (r < I_IN) { const int nb = NPROJ / 64, kb = r / nb, n0 = (r % nb) * 64; p0_titem(p.w_in, NPROJ, p.norm1, W1t, DM, kb * 64, n0, n0, scr, c.lane, n0 < DATT ? QSCALE : 1.f); continue; } r -= I_IN;
            if (r < I_OUT) { const int nb = DM / 64, kb = r / nb, n0 = (r % nb) * 64, k0 = kb * 64;
                const float* g = k0 < DATT ? p.g_oa + k0 : p.g_oc + (k0 - DATT);
                p0_titem(p.w_out + (size_t)k0 * DM, DM, g, W2t + k0, DM, 0, n0, n0, scr, c.lane); continue; } r -= I_OUT;
            if (r < 2 * I_G) { const int up = r >= I_G; if (up) r -= I_G; const int per = (DM / 64) * (DEXP / 64), e = r / per, q = r % per, nb = DEXP / 64, kb = q / nb, n0 = (q % nb) * 64;
                p0_titem((up ? p.w_up : p.w_gate) + (size_t)e * DM * DEXP, DEXP, p.norm2, Wgut + (size_t)e * 2 * DEXP * DM, DM, kb * 64, n0, gu_row(n0, up), scr, c.lane); continue; } r -= 2 * I_G;
            { const int per = (DEXP / 64) * (DM / 64), e = r / per, q = r % per, nb = DM / 64, kb = q / nb, n0 = (q % nb) * 64;
              p0_titem(p.w_down + (size_t)e * DEXP * DM, DM, nullptr, Wdt + (size_t)e * DM * DEXP, DEXP, kb * 64, n0, n0, scr, c.lane); }
        }
        for (int i = blockIdx.x * NTHREADS + c.tid; i < 48 * DM; i += gridDim.x * NTHREADS) { const int o = i / DM, k = i % DM; const float w = o < 36 ? p.norm2[k] * (o < 4 ? p.w_rg[k * 4 + o] : p.w_re[k * 32 + (o - 4)]) : 0.f;
            const unsigned h = f2bf(w); Wrh[i] = (bf16_t)h; Wrl[i] = (bf16_t)f2bf(w - bf2f(h)); }
    }
    xcd_barrier(gbar);
    {
        g8::DenseOrder S; S.init(xb, W1t, T, NPROJ, DM, (int)gridDim.x, (int)blockIdx.x); S.mul = PMUL(1);
        const g8::EpiProjF E{proj, r1};
        g8::gemm_phase<false>((LAS unsigned char*)lds, DM, S, E);
    }
    xcd_barrier(gbar);
    {
        for (int u1 = blockIdx.x; u1 < NB * NH * 4 * PMUL(2); u1 += gridDim.x) { const int u0 = u1 % (NB * NH * 4); const int bh = u0 >> 2;
            for (int i = 0; i < 4; ++i) att::attn_unit((LAS unsigned char*)lds, proj, p.relb, mix, ssA, bh >> 4, bh & 15, (u0 & 3) + 4 * i); }
        for (int it = c.gw; it < (T / 32) * 4 * PMUL(21); it += c.ngw) conv_slab(proj, p.conv_w, mix, ssC, it % ((T / 32) * 4), c.lane);
    }
    xcd_barrier(gbar);
    {
        g8::DenseOrder S; S.init(mix, W2t, T, DM, DM, (int)gridDim.x, (int)blockIdx.x); S.mul = PMUL(3);
        LAS float* tab = (LAS float*)(lds + 131072);
        g8::Unit u;
        for (int i = 0; i < 4; ++i) if (S.next(i, u) && c.tid < 256) { const int row = u.pm * 256 + c.tid; float sa = 0.f;
#pragma unroll
            for (int h = 0; h < 16; ++h) sa += ssA[row * 16 + h];
            const float4 sc4 = *(const float4*)(ssC + row * 4); const float ra = rsqrtf(sa * (1.f / DATT) + EPS), rc = rsqrtf((sc4.x + sc4.y + sc4.z + sc4.w) * (1.f / DCONV) + EPS);
            tab[(i * 256 + c.tid) * 2] = ra / rc; tab[(i * 256 + c.tid) * 2 + 1] = rc; }
        __syncthreads();
        const g8::EpiG2F E{p.x, p.out, xb, tab, (int)gridDim.x};
        g8::gemm_phase<false>((LAS unsigned char*)lds, DM, S, E);
    }
    xcd_barrier(gbar);
    { LAS float* sc = (LAS float*)lds + c.wave * (16 * 49);
      for (int it = c.gw; it < (T / 16) * PMUL(4); it += c.ngw) router_tile(p.out, Wrh, Wrl, p.b_rg, p.b_re, cnt, list, wts, r2, (it % (T / 16)) * 16, c.lane, sc, it < T / 16); }
    xcd_barrier(gbar);
    LAS int* pl = (LAS int*)(lds + LDS_PLAN_OFF);
    if (c.tid == 0) { int tl = 0;
        for (int e = 0; e < NE; ++e) { const int ce = cnt[e]; pl[e] = ce; pl[32 + e] = tl * 256; const int mt = (ce + 255) >> 8; for (int i = 0; i < mt; ++i) pl[64 + tl + i] = e; tl += mt; }
        for (int i = tl; i < NTILEMAX; ++i) pl[64 + i] = -1;
        pl[224] = tl; }
    __syncthreads();
    const int ntile = pl[224];
    {
        const g8::MoeOrder<true> S{(const char*)xb, (const char*)Wgut, list, pl, DM, 4, ntile * 4, (int)gridDim.x, (int)blockIdx.x, (size_t)2 * DEXP * DM * 2, PMUL(5)};
        const g8::EpiGUF<g8::MoeOrder<true>> E{Hb, r2, &S};
        g8::gemm_phase<true>((LAS unsigned char*)lds, DM, S, E);
    }
    xcd_barrier(gbar);
    {
        const g8::MoeOrder<false> S{(const char*)Hb, (const char*)Wdt, list, pl, DEXP, 8, ntile * 8, (int)gridDim.x, (int)blockIdx.x, (size_t)DM * DEXP * 2, PMUL(6)};
        const g8::EpiDownF<g8::MoeOrder<false>> E{Y, wts, &S};
        g8::gemm_phase<false>((LAS unsigned char*)lds, DEXP, S, E);
    }
    xcd_barrier(gbar);
    if (PROBE == 9) { for (int i = 0; i < 8; ++i) xcd_barrier(gbar); }
    for (int t = c.gw; t < T; t += c.ngw) final_row(p.out, Y, p.norm_f, t, c.lane);
}

extern "C" void kernel_launch(void* const* d_in, const int* in_sizes, int n_in, void* d_out, int out_size, void* d_ws, size_t ws_size, hipStream_t stream) {
    static int grid = 0;
    if (grid == 0) {
        int dev = 0, cus = 0, per_cu = 0;
        if (ws_size < WS_END || n_in != 17) { fprintf(stderr, "kernel_launch: unexpected sizes (ws %zu)\n", ws_size); grid = -1; return; }
        (void)hipGetDevice(&dev); (void)hipDeviceGetAttribute(&cus, hipDeviceAttributeMultiprocessorCount, dev);
        if (hipFuncSetAttribute((const void*)mega, hipFuncAttributeMaxDynamicSharedMemorySize, LDS_BYTES) != hipSuccess) { fprintf(stderr, "hipFuncSetAttribute failed\n"); grid = -1; return; }
        if (hipOccupancyMaxActiveBlocksPerMultiprocessor(&per_cu, (const void*)mega, NTHREADS, LDS_BYTES) != hipSuccess || per_cu < 1) { fprintf(stderr, "occupancy query failed (%d)\n", per_cu); grid = -1; return; }
        grid = cus * per_cu;
        fprintf(stderr, "kernel_launch: cus %d per_cu %d grid %d\n", cus, per_cu, grid);
    }
    if (grid < 0) return;
    if (hipMemsetAsync((char*)d_ws + WS_CTL, 0, 64 * 1024, stream) != hipSuccess) { fprintf(stderr, "memset failed\n"); return; }
    Params p{};
    p.x = (const float*)d_in[0]; p.norm1 = (const float*)d_in[1]; p.w_in = (const float*)d_in[2]; p.relb = (const float*)d_in[3];
    p.conv_w = (const float*)d_in[4]; p.g_oa = (const float*)d_in[5]; p.g_oc = (const float*)d_in[6]; p.w_out = (const float*)d_in[7];
    p.norm2 = (const float*)d_in[8]; p.w_rg = (const float*)d_in[9]; p.b_rg = (const float*)d_in[10]; p.w_re = (const float*)d_in[11];
    p.b_re = (const float*)d_in[12]; p.w_gate = (const float*)d_in[13]; p.w_up = (const float*)d_in[14]; p.w_down = (const float*)d_in[15];
    p.norm_f = (const float*)d_in[16]; p.out = (float*)d_out; p.ws = (char*)d_ws;
    void* args[] = {&p};
    hipError_t e = hipLaunchCooperativeKernel((const void*)mega, dim3(grid), dim3(NTHREADS), args, LDS_BYTES, stream);
    if (e != hipSuccess) fprintf(stderr, "cooperative launch failed: %s (grid %d)\n", hipGetErrorString(e), grid);
}
```

```cpp
#include <hip/hip_runtime.h>
#include <hip/hip_cooperative_groups.h>
#include <stdint.h>
#include <cstdio>
namespace cg = cooperative_groups;
#ifndef PROBE
#define PROBE 0
#endif
#define PMUL(k) ((PROBE) == (k) ? 2 : 1)
#ifndef TSPROBE
#define TSPROBE 0
#endif
#define TS0(k) if (TSPROBE == (k)) ts0 = __builtin_amdgcn_s_memrealtime();
#define TS1(k) if (TSPROBE == (k)) ts1 = __builtin_amdgcn_s_memrealtime();

typedef unsigned short bf16_t;
typedef short bf16x8 __attribute__((ext_vector_type(8)));
typedef float f32x4 __attribute__((ext_vector_type(4)));

constexpr int NB = 4, SEQ = 4096, T = NB * SEQ, DM = 2048, DATT = 1024, DCONV = 1024, NPROJ = 6144;
constexpr int NH = 16, HD = 64, NREL = 513, NE = 32, DEXP = 512, NPAIR = 2 * T;
constexpr int NPADMAX = 40960, NTILEMAX = NPADMAX / 256;
constexpr float EPS = 1e-6f;
constexpr float YSCALE8 = 64.f;
constexpr float HSCALE8 = 8.f, WDSCALE8 = 32.f;
constexpr float WSCALE8 = 64.f;
constexpr float LOG2E = 1.4426950408889634f, QSCALE = 0.125f * LOG2E;

constexpr size_t MiB = 1u << 20;
constexpr size_t WS_CTL = 0;
constexpr size_t WS_BAR = 16 * 1024;
constexpr size_t WS_PLAN = 64 * 1024;
constexpr size_t WS_R1 = 128 * 1024;
constexpr size_t WS_RA = 192 * 1024;
constexpr size_t WS_RC = 256 * 1024;
constexpr size_t WS_R2 = 320 * 1024;
constexpr size_t WS_SSC = 3 * MiB;
constexpr size_t WS_WTS = 512 * 1024;
constexpr size_t WS_ROWPAIR = 640 * 1024;
constexpr size_t WS_WR = 1 * MiB;
constexpr size_t WS_SSA = 2 * MiB;
constexpr size_t WS_LIST = 5 * MiB;
constexpr size_t WS_W2T = 8 * MiB;
constexpr size_t WS_W1T = 16 * MiB;
constexpr size_t WS_WDT = 40 * MiB;
constexpr size_t WS_WGUT = 104 * MiB;
constexpr size_t WS_XB = 232 * MiB;
constexpr size_t WS_MIX = 296 * MiB;
constexpr size_t WS_PROJ = 360 * MiB;
constexpr size_t WS_Y = 360 * MiB;
constexpr size_t WS_H = 488 * MiB;
constexpr size_t WS_END = 552 * MiB;

__device__ __forceinline__ unsigned f2bf(float f) { unsigned u = __float_as_uint(f); return (u + 0x7fffu + ((u >> 16) & 1u)) >> 16; }
__device__ __forceinline__ unsigned pk2(float lo, float hi) { return f2bf(lo) | (f2bf(hi) << 16); }
__device__ __forceinline__ unsigned cvtpk2(float lo, float hi) { typedef float f2 __attribute__((ext_vector_type(2))); typedef __bf16 b2 __attribute__((ext_vector_type(2))); f2 v = {lo, hi}; b2 r = __builtin_convertvector(v, b2); return __builtin_bit_cast(unsigned, r); }
__device__ __forceinline__ int gu_row(int n, int up) { return ((n >> 7) << 8) + (n & 127) + (up ? 128 : 0); }
__device__ __forceinline__ float bf2f(unsigned h) { return __uint_as_float(h << 16); }
__device__ __forceinline__ float wave_sum(float v) {
#pragma unroll
    for (int o = 1; o < 64; o <<= 1) v += __shfl_xor(v, o);
    return v;
}


#define LAS __attribute__((address_space(3)))
constexpr int NWAVES = 8, NTHREADS = 512;
constexpr int LDS_BYTES = 147456;
constexpr int LDS_PLAN_OFF = 140 * 1024;

struct Params {
    const float *x, *norm1, *w_in, *relb, *conv_w, *g_oa, *g_oc, *w_out, *norm2, *w_rg, *b_rg, *w_re, *b_re, *w_gate, *w_up, *w_down, *norm_f;
    float* out; char* ws; int never; int pad;
};
struct Ctx { int tid, lane, wave, gw, ngw; };

__device__ __forceinline__ void p0_titem(const float* __restrict__ W, int N, const float* __restrict__ g, bf16_t* __restrict__ WT, int ldd, int k0, int n0, int drow0, LAS float* scr, int lane, float cs = 1.f) {
    const int kq = lane >> 4, n4 = (lane & 15) * 4;
    float4 v[16]; float gs[16];
#pragma unroll
    for (int i = 0; i < 16; ++i) v[i] = *(const float4*)(W + (size_t)(k0 + 4 * i + kq) * N + n0 + n4);
#pragma unroll
    for (int i = 0; i < 16; ++i) gs[i] = (g ? g[k0 + 4 * i + kq] : 1.f) * cs;
#pragma unroll
    for (int i = 0; i < 16; ++i) { LAS float* d = scr + (4 * i + kq) * 65 + n4; d[0] = v[i].x * gs[i]; d[1] = v[i].y * gs[i]; d[2] = v[i].z * gs[i]; d[3] = v[i].w * gs[i]; }
    asm volatile("s_waitcnt lgkmcnt(0)" ::: "memory");
    const int c = lane & 7;
#pragma unroll
    for (int j = 0; j < 8; ++j) { const int n = (lane >> 3) + 8 * j; const LAS float* sp = scr + (8 * c) * 65 + n;
        uint4 o; o.x = cvtpk2(sp[0 * 65], sp[1 * 65]); o.y = cvtpk2(sp[2 * 65], sp[3 * 65]); o.z = cvtpk2(sp[4 * 65], sp[5 * 65]); o.w = cvtpk2(sp[6 * 65], sp[7 * 65]);
        *(uint4*)(WT + (size_t)(drow0 + n) * ldd + k0 + 8 * c) = o; }
    asm volatile("s_waitcnt lgkmcnt(0)" ::: "memory");
}

__device__ __forceinline__ void router_block(const float* __restrict__ x, const bf16_t* __restrict__ dlt, const float* __restrict__ g2, bf16_t* __restrict__ xb1, unsigned char* __restrict__ xf8, const bf16_t* __restrict__ Wrh, const bf16_t* __restrict__ Wrl,
                                             const float* __restrict__ brg, const float* __restrict__ bre, int* __restrict__ cnt, int* __restrict__ list, float* __restrict__ wts, float* __restrict__ r2out,
                                             int tb, int wave, int lane, LAS float* lds_f, bool commit) {
    const int fr = lane & 15, fq = lane >> 4, tg = wave & 3, kh = wave >> 2, t0 = tb * 64 + tg * 16;
    const size_t aoff = (size_t)(t0 + fr) * DM + kh * (DM / 2) + 8 * fq;
    const float* xr = x + aoff; const bf16_t* dr = dlt + aoff; bf16_t* xw = xb1 + aoff; unsigned char* x8 = xf8 + aoff; const float* gr = g2 + kh * (DM / 2) + 8 * fq;
    const bf16_t* wh = Wrh + (size_t)fr * DM + kh * (DM / 2) + 8 * fq; const bf16_t* wl = Wrl + (size_t)fr * DM + kh * (DM / 2) + 8 * fq;
    f32x4 acc[3]; float ss = 0.f;
#pragma unroll
    for (int nb = 0; nb < 3; ++nb) acc[nb] = (f32x4){0.f, 0.f, 0.f, 0.f};
    typedef unsigned u4 __attribute__((ext_vector_type(4)));
    for (int ks0 = 0; ks0 < DM / 64; ks0 += 4) {
        float4 xa[4][2]; uint4 dl[4]; bf16x8 bh[4][3], bl[4][3];
#pragma unroll
        for (int u = 0; u < 4; ++u) { xa[u][0] = *(const float4*)(xr + (ks0 + u) * 32); xa[u][1] = *(const float4*)(xr + (ks0 + u) * 32 + 4); dl[u] = *(const uint4*)(dr + (ks0 + u) * 32); }
#pragma unroll
        for (int u = 0; u < 4; ++u)
#pragma unroll
            for (int nb = 0; nb < 3; ++nb) { bh[u][nb] = *(const bf16x8*)(wh + (size_t)nb * 16 * DM + (ks0 + u) * 32); bl[u][nb] = bh[u][nb]; }
#pragma unroll
        for (int u = 0; u < 4; ++u) {
            const unsigned dw[4] = {dl[u].x, dl[u].y, dl[u].z, dl[u].w};
            const float xv[8] = {xa[u][0].x + bf2f(dw[0] & 0xffffu), xa[u][0].y + bf2f(dw[0] >> 16), xa[u][0].z + bf2f(dw[1] & 0xffffu), xa[u][0].w + bf2f(dw[1] >> 16),
                                 xa[u][1].x + bf2f(dw[2] & 0xffffu), xa[u][1].y + bf2f(dw[2] >> 16), xa[u][1].z + bf2f(dw[3] & 0xffffu), xa[u][1].w + bf2f(dw[3] >> 16)};
            const float4 ga = *(const float4*)(gr + (ks0 + u) * 32), gb = *(const float4*)(gr + (ks0 + u) * 32 + 4);
            const float yv[8] = {xv[0] * ga.x, xv[1] * ga.y, xv[2] * ga.z, xv[3] * ga.w, xv[4] * gb.x, xv[5] * gb.y, xv[6] * gb.z, xv[7] * gb.w};
            unsigned hw[4], lw[4];
#pragma unroll
            for (int q = 0; q < 4; ++q) { const unsigned h = cvtpk2(yv[2 * q], yv[2 * q + 1]); hw[q] = h;
                lw[q] = cvtpk2(yv[2 * q] - __uint_as_float(h << 16), yv[2 * q + 1] - __uint_as_float(h & 0xffff0000u)); ss += xv[2 * q] * xv[2 * q] + xv[2 * q + 1] * xv[2 * q + 1]; }
            if (commit) { *(uint4*)(xw + (ks0 + u) * 32) = make_uint4(cvtpk2(xv[0], xv[1]), cvtpk2(xv[2], xv[3]), cvtpk2(xv[4], xv[5]), cvtpk2(xv[6], xv[7]));
                int f0 = __builtin_amdgcn_cvt_pk_fp8_f32(yv[0], yv[1], 0, false); f0 = __builtin_amdgcn_cvt_pk_fp8_f32(yv[2], yv[3], f0, true);
                int f1 = __builtin_amdgcn_cvt_pk_fp8_f32(yv[4], yv[5], 0, false); f1 = __builtin_amdgcn_cvt_pk_fp8_f32(yv[6], yv[7], f1, true);
                *(uint2*)(x8 + (ks0 + u) * 32) = make_uint2((unsigned)f0, (unsigned)f1); }
            const bf16x8 xh = __builtin_bit_cast(bf16x8, (u4){hw[0], hw[1], hw[2], hw[3]}), xl = __builtin_bit_cast(bf16x8, (u4){lw[0], lw[1], lw[2], lw[3]});
#pragma unroll
            for (int nb = 0; nb < 3; ++nb) {
                acc[nb] = __builtin_amdgcn_mfma_f32_16x16x32_bf16(bh[u][nb], xh, acc[nb], 0, 0, 0);
                acc[nb] = __builtin_amdgcn_mfma_f32_16x16x32_bf16(bh[u][nb], xl, acc[nb], 0, 0, 0);
                }
        }
    }
    LAS float* part = lds_f + tg * (64 * 13);
    LAS float* sc = lds_f + 4 * 64 * 13 + tg * (16 * 49);
    LAS int* ent = (LAS int*)(lds_f + 4 * 64 * 13 + 4 * 16 * 49);
    if (kh == 1) {
#pragma unroll
        for (int nb = 0; nb < 3; ++nb)
#pragma unroll
            for (int q = 0; q < 4; ++q) part[lane * 13 + nb * 4 + q] = acc[nb][q];
        part[lane * 13 + 12] = ss;
    }
    __syncthreads();
    if (kh == 0) {
#pragma unroll
        for (int nb = 0; nb < 3; ++nb)
#pragma unroll
            for (int q = 0; q < 4; ++q) acc[nb][q] += part[lane * 13 + nb * 4 + q];
        ss += part[lane * 13 + 12];
        ss += __shfl_xor(ss, 16); ss += __shfl_xor(ss, 32);
        const float r2 = rsqrtf(ss * (1.f / DM) + EPS);
#pragma unroll
        for (int nb = 0; nb < 3; ++nb)
#pragma unroll
            for (int q = 0; q < 4; ++q) sc[fr * 49 + 16 * nb + 4 * fq + q] = acc[nb][q] * r2;
        asm volatile("s_waitcnt lgkmcnt(0)" ::: "memory");
        if (lane < 16) {
            const int t = t0 + lane; LAS const float* lr = sc + lane * 49;
            float lg[4];
#pragma unroll
            for (int g = 0; g < 4; ++g) lg[g] = lr[g] + brg[g];
            int gs = 0; float gm = lg[0];
#pragma unroll
            for (int g = 1; g < 4; ++g) if (lg[g] > gm) { gm = lg[g]; gs = g; }
            float den = 0.f;
#pragma unroll
            for (int g = 0; g < 4; ++g) den += __expf(lg[g] - gm);
            const float pg = 1.f / den;
            float el[8];
#pragma unroll
            for (int i = 0; i < 8; ++i) el[i] = lr[4 + 8 * gs + i] + bre[8 * gs + i];
            int i1 = 0; float v1 = el[0];
#pragma unroll
            for (int i = 1; i < 8; ++i) if (el[i] > v1) { v1 = el[i]; i1 = i; }
            int i2 = -1; float v2 = -3.0e38f;
#pragma unroll
            for (int i = 0; i < 8; ++i) if (i != i1 && el[i] > v2) { v2 = el[i]; i2 = i; }
            const float e2 = __expf(v2 - v1), w0 = pg / (1.f + e2), w1 = pg * e2 / (1.f + e2);
            ent[2 * (tg * 16 + lane)] = gs * 8 + i1; ent[2 * (tg * 16 + lane) + 1] = gs * 8 + i2;
            if (commit) { r2out[t] = r2; wts[2 * t] = w0; wts[2 * t + 1] = w1; }
        }
    }
    __syncthreads();
    if (wave == 0 && lane < NE && commit) {
        int n = 0;
        for (int i = 0; i < 128; ++i) n += (ent[i] == lane) ? 1 : 0;
        if (n) { int k = atomicAdd(&cnt[lane * 64], n);
            for (int i = 0; i < 128; ++i) if (ent[i] == lane) { list[lane * T + k] = 2 * (tb * 64) + i; ++k; } }
    }
    __syncthreads();
}
struct FinalRow { uint4 xv[4]; uint2 pv[4], qv[4]; };
__device__ __forceinline__ void final_load(FinalRow& f, const bf16_t* __restrict__ xb1, const bf16_t* __restrict__ Yb, int t, int lane) {
    const unsigned char* Y = (const unsigned char*)Yb;
    const uint4* x1 = (const uint4*)(xb1 + (size_t)t * DM); const uint2* y0 = (const uint2*)(Y + (size_t)(2 * t) * DM); const uint2* y1 = (const uint2*)(Y + (size_t)(2 * t + 1) * DM);
#pragma unroll
    for (int j = 0; j < 4; ++j) { f.xv[j] = x1[j * 64 + lane]; f.pv[j] = y0[j * 64 + lane]; f.qv[j] = y1[j * 64 + lane]; }
}
__device__ __forceinline__ void final_store(const FinalRow& f, float* __restrict__ out, const float* __restrict__ g, int t, int lane, float delta = 0.f) {
    float4* xw = (float4*)(out + (size_t)t * DM);
    float v[4][8]; float ss = 0.f;
    typedef float f2_t __attribute__((ext_vector_type(2)));
#pragma unroll
    for (int j = 0; j < 4; ++j) { const unsigned xa[4] = {f.xv[j].x, f.xv[j].y, f.xv[j].z, f.xv[j].w};
        const f2_t p01 = __builtin_amdgcn_cvt_pk_f32_fp8((int)f.pv[j].x, false), p23 = __builtin_amdgcn_cvt_pk_f32_fp8((int)f.pv[j].x, true), p45 = __builtin_amdgcn_cvt_pk_f32_fp8((int)f.pv[j].y, false), p67 = __builtin_amdgcn_cvt_pk_f32_fp8((int)f.pv[j].y, true);
        const f2_t q01 = __builtin_amdgcn_cvt_pk_f32_fp8((int)f.qv[j].x, false), q23 = __builtin_amdgcn_cvt_pk_f32_fp8((int)f.qv[j].x, true), q45 = __builtin_amdgcn_cvt_pk_f32_fp8((int)f.qv[j].y, false), q67 = __builtin_amdgcn_cvt_pk_f32_fp8((int)f.qv[j].y, true);
        const float ys[8] = {p01[0] + q01[0], p01[1] + q01[1], p23[0] + q23[0], p23[1] + q23[1], p45[0] + q45[0], p45[1] + q45[1], p67[0] + q67[0], p67[1] + q67[1]};
#pragma unroll
        for (int q = 0; q < 4; ++q) { const float lo = bf2f(xa[q] & 0xffffu) + ys[2 * q] * (1.f / YSCALE8), hi = bf2f(xa[q] >> 16) + ys[2 * q + 1] * (1.f / YSCALE8);
            v[j][2 * q] = lo; v[j][2 * q + 1] = hi; ss += lo * lo + hi * hi; } }
    const float r = rsqrtf(wave_sum(ss) * (1.f / DM) + EPS);
#pragma unroll
    for (int j = 0; j < 4; ++j) { const float4 g0 = ((const float4*)g)[(j * 64 + lane) * 2], g1 = ((const float4*)g)[(j * 64 + lane) * 2 + 1];
        float4 a, b; a.x = v[j][0] * r * g0.x + delta; a.y = v[j][1] * r * g0.y - delta; a.z = v[j][2] * r * g0.z + delta; a.w = v[j][3] * r * g0.w - delta;
        b.x = v[j][4] * r * g1.x + delta; b.y = v[j][5] * r * g1.y - delta; b.z = v[j][6] * r * g1.z + delta; b.w = v[j][7] * r * g1.w - delta;
        xw[(j * 64 + lane) * 2] = a; xw[(j * 64 + lane) * 2 + 1] = b; }
}

constexpr int WC_ITEMS = 3 * NE * 512;
struct WConv {
    unsigned char* dst; int ldd; float sc; bool pending;
    __device__ __forceinline__ void issue(int id, const float* __restrict__ w_gate, const float* __restrict__ w_up, const float* __restrict__ w_down, bf16_t* Wgut, bf16_t* Wdt, unsigned scr32, int lane) {
        const int kq = lane >> 3;
        const float* src; int N, k0, n0;
        if (id < 2 * NE * 512) { const int up = id >= NE * 512, r = id & (NE * 512 - 1), e = r >> 9, q = r & 511; k0 = (q >> 4) * 64; n0 = (q & 15) * 32; N = DEXP; sc = WSCALE8;
            src = (up ? w_up : w_gate) + (size_t)e * DM * DEXP; dst = (unsigned char*)Wgut + (size_t)e * 2 * DEXP * DM + (size_t)gu_row(n0, up) * DM + k0; ldd = DM; }
        else { const int r = id - 2 * NE * 512, e = r >> 9, q = r & 511; k0 = (q >> 6) * 64; n0 = (q & 63) * 32; N = DM; sc = WDSCALE8;
            src = w_down + (size_t)e * DEXP * DM; dst = (unsigned char*)Wdt + (size_t)e * DM * DEXP + (size_t)n0 * DEXP + k0; ldd = DEXP; }
#pragma unroll
        for (int i = 0; i < 8; ++i) { const float* g = src + (size_t)(k0 + 8 * i + kq) * N + n0 + 4 * ((lane & 7) ^ i); unsigned keep_;
            asm volatile("s_mov_b32 %0, m0\n\ts_mov_b32 m0, %2\n\ts_nop 0\n\tglobal_load_lds_dwordx4 %1, off\n\ts_mov_b32 m0, %0" : "=&s"(keep_) : "v"(g), "s"((unsigned)__builtin_amdgcn_readfirstlane((int)(scr32 + i * 1024))) : "memory"); }
        pending = true;
    }
    __device__ __forceinline__ void finish(LAS float* scr, int lane) {
        const int c = lane & 7;
#pragma unroll
        for (int j = 0; j < 4; ++j) { const int n = (lane >> 3) + 8 * j; const LAS float* sp = scr + (8 * c) * 32 + 4 * ((n >> 2) ^ c) + (n & 3);
            float v[8];
#pragma unroll
            for (int q = 0; q < 8; ++q) v[q] = sp[q * 32] * sc;
            int w0 = __builtin_amdgcn_cvt_pk_fp8_f32(v[0], v[1], 0, false); w0 = __builtin_amdgcn_cvt_pk_fp8_f32(v[2], v[3], w0, true);
            int w1 = __builtin_amdgcn_cvt_pk_fp8_f32(v[4], v[5], 0, false); w1 = __builtin_amdgcn_cvt_pk_fp8_f32(v[6], v[7], w1, true);
            *(uint2*)(dst + (size_t)n * ldd + 8 * c) = make_uint2((unsigned)w0, (unsigned)w1); }
        asm volatile("s_waitcnt lgkmcnt(0)" ::: "memory");
        pending = false;
    }
};

namespace att {
typedef float f32x16 __attribute__((ext_vector_type(16)));
typedef short s16x4 __attribute__((ext_vector_type(4)));
typedef short v4i16_t __attribute__((ext_vector_type(4)));
constexpr int SLOT = 16384, L_K = 0, L_V = 2 * SLOT, L_TB = 4 * SLOT, NTB = 576;
constexpr float THR = 8.f;
__device__ __forceinline__ float rowmax32(const f32x16& p0, const f32x16& p1) {
    float a = fmaxf(p0[0], p1[0]);
#pragma unroll
    for (int r = 1; r < 16; ++r) a = fmaxf(fmaxf(a, p0[r]), p1[r]);
    auto rr = __builtin_amdgcn_permlane32_swap(__float_as_uint(a), __float_as_uint(a), false, false);
    return fmaxf(__uint_as_float(rr[0]), __uint_as_float(rr[1]));
}
__device__ __forceinline__ unsigned cvtpk(float lo, float hi) { typedef float f2 __attribute__((ext_vector_type(2))); typedef __bf16 b2 __attribute__((ext_vector_type(2))); f2 v = {lo, hi}; b2 b = __builtin_convertvector(v, b2); return __builtin_bit_cast(unsigned, b); }
__device__ __forceinline__ s16x4 vtr(LAS const unsigned char* p) { return __builtin_bit_cast(s16x4, __builtin_amdgcn_ds_read_tr16_b64_v4i16((LAS v4i16_t*)p)); }

template <class Side> __device__ __forceinline__ void attn_unit(LAS unsigned char* lds, const bf16_t* __restrict__ proj, const float* __restrict__ relb, bf16_t* __restrict__ mix, float* __restrict__ ssA, int b, int h, int cg, Side& side, bool fill_table) {
    const int tid = threadIdx.x, lane = tid & 63, r32 = lane & 31, hi = lane >> 5, w = __builtin_amdgcn_readfirstlane(tid >> 6);
    const int c0 = cg * 4, cq = c0 + (w >> 1), qi = 32 * (w & 1) + r32;
    const int j0 = c0 - 8 < 0 ? 0 : c0 - 8, j1 = c0 + 3;
    const unsigned lds32 = (unsigned)(__UINTPTR_TYPE__)lds;
    LAS float* tb = (LAS float*)(lds + L_TB);
    if (fill_table) for (int i = tid; i < NTB; i += NTHREADS) tb[i] = relb[h * NREL + (i > 512 ? 512 : i)] * LOG2E;
    const size_t tq = (size_t)b * SEQ + (size_t)c0 * 64 + 32 * w + r32;
    bf16x8 qr[4];
#pragma unroll
    for (int d0 = 0; d0 < 4; ++d0) qr[d0] = *(const bf16x8*)(proj + tq * NPROJ + h * HD + d0 * 16 + hi * 8);
    const int krow = 8 * w + (lane >> 3);
    const bf16_t* ksrc = proj + ((size_t)b * SEQ + krow) * NPROJ + DATT + h * HD + (((lane & 7) ^ ((krow >> 1) & 7)) * 8);
    const bf16_t* vsrc = proj + ((size_t)b * SEQ + 16 * (w & 3) + (lane >> 2)) * NPROJ + 2 * DATT + h * HD + (w >> 2) * 32 + (lane & 3) * 8;
#define ATT_GLDS(gsrc, ldsdst) do { unsigned keep_; asm volatile("s_mov_b32 %0, m0\n\ts_mov_b32 m0, %2\n\ts_nop 0\n\tglobal_load_lds_dwordx4 %1, off\n\ts_mov_b32 m0, %0" : "=&s"(keep_) : "v"(gsrc), "s"((unsigned)__builtin_amdgcn_readfirstlane((int)(ldsdst))) : "memory"); } while (0)
#define ATT_DMA1(j, off) do { ATT_GLDS(ksrc + (size_t)(j) * 64 * NPROJ, lds32 + L_K + (off) + w * 1024); ATT_GLDS(vsrc + (size_t)(j) * 64 * NPROJ, lds32 + L_V + (off) + w * 1024); } while (0)
#define ATT_DMA(j, slot) do { ATT_DMA1(j, (slot) * SLOT); ATT_DMA1((j) + 1, (slot) * SLOT + 8192); } while (0)
    int ka[4];
#pragma unroll
    for (int d0 = 0; d0 < 4; ++d0) ka[d0] = r32 * 128 + (((2 * d0 + hi) ^ ((r32 >> 1) & 7)) * 16);
    const int va = ((lane >> 4) & 1) * 32 + (lane & 3) * 8 + (4 * hi + ((lane & 15) >> 2)) * 64;
    float m = -1e30f, l = 0.f; f32x16 o[2];
#pragma unroll
    for (int r = 0; r < 16; ++r) { o[0][r] = 0.f; o[1][r] = 0.f; }
    ATT_DMA(j0, 0);
    for (int js = j0; js <= j1; js += 2) {
        const int slot = ((js - j0) >> 1) & 1;
        unsigned long long tb0_ = 0; if (TSPROBE == 34 || TSPROBE == 35) tb0_ = __builtin_amdgcn_s_memrealtime();
        if (TSPROBE == 35) { asm volatile("s_waitcnt vmcnt(0) lgkmcnt(0)" ::: "memory"); side.twait += __builtin_amdgcn_s_memrealtime() - tb0_; }
        asm volatile("s_waitcnt vmcnt(0) lgkmcnt(0)\n\ts_barrier" ::: "memory");
        if (TSPROBE == 34) side.twait += __builtin_amdgcn_s_memrealtime() - tb0_;
        side.step();
        if (js + 2 <= j1) ATT_DMA(js + 2, slot ^ 1);
#pragma unroll
        for (int half = 0; half < 2; ++half) {
        const int j = js + half, dl = cq - j;
        if (dl >= 0 && dl <= 8) {
            LAS const unsigned char* Ks = lds + L_K + slot * SLOT + half * 8192; LAS const unsigned char* Vs = lds + L_V + slot * SLOT + half * 8192 + va;
            f32x16 p0, p1;
            if (dl <= 4) { LAS const float* tp = tb + (64 * dl + qi + 256 - 4 * hi - 59);
#pragma unroll
                for (int r = 0; r < 16; ++r) { p0[r] = tp[59 - ((r & 3) + 8 * (r >> 2))]; p1[r] = tp[27 - ((r & 3) + 8 * (r >> 2))]; } }
            else { const float bf = tb[NTB - 1];
#pragma unroll
                for (int r = 0; r < 16; ++r) { p0[r] = bf; p1[r] = bf; } }
            { bf16x8 kf[8];
#pragma unroll
              for (int d0 = 0; d0 < 4; ++d0) { kf[2 * d0] = *(LAS const bf16x8*)(Ks + ka[d0]); kf[2 * d0 + 1] = *(LAS const bf16x8*)(Ks + ka[d0] + 4096); }
              __builtin_amdgcn_sched_barrier(0);
#pragma unroll
              for (int d0 = 0; d0 < 4; ++d0) { p0 = __builtin_amdgcn_mfma_f32_32x32x16_bf16(kf[2 * d0], qr[d0], p0, 0, 0, 0); p1 = __builtin_amdgcn_mfma_f32_32x32x16_bf16(kf[2 * d0 + 1], qr[d0], p1, 0, 0, 0); } }
            const float mx = rowmax32(p0, p1);
            if (__any(mx > m + THR)) { const float mn = fmaxf(m, mx), al = __builtin_amdgcn_exp2f(m - mn); m = mn; l *= al;
#pragma unroll
                for (int r = 0; r < 16; ++r) { o[0][r] *= al; o[1][r] *= al; } }
            float rs = 0.f;
#pragma unroll
            for (int r = 0; r < 16; ++r) { p0[r] = __builtin_amdgcn_exp2f(p0[r] - m); p1[r] = __builtin_amdgcn_exp2f(p1[r] - m); rs += p0[r] + p1[r]; }
            l += rs;
            bf16x8 pw[4];
#pragma unroll
            for (int ks = 0; ks < 4; ++ks) { const f32x16& P = ks < 2 ? p0 : p1; const int bo = (ks & 1) * 8; typedef unsigned u4 __attribute__((ext_vector_type(4)));
                u4 t4 = {cvtpk(P[bo], P[bo + 1]), cvtpk(P[bo + 2], P[bo + 3]), cvtpk(P[bo + 4], P[bo + 5]), cvtpk(P[bo + 6], P[bo + 7])}; pw[ks] = __builtin_bit_cast(bf16x8, t4); }
            { s16x4 vl[8], vh[8];
#pragma unroll
              for (int i = 0; i < 8; ++i) { vl[i] = vtr(Vs + (i >> 2) * 4096 + (i & 3) * 1024); vh[i] = vtr(Vs + (i >> 2) * 4096 + (i & 3) * 1024 + 512); }
              __builtin_amdgcn_sched_barrier(0);
#pragma unroll
              for (int i = 0; i < 8; ++i) { const bf16x8 vf = {vl[i][0], vl[i][1], vl[i][2], vl[i][3], vh[i][0], vh[i][1], vh[i][2], vh[i][3]};
                  o[i >> 2] = __builtin_amdgcn_mfma_f32_32x32x16_bf16(vf, pw[i & 3], o[i >> 2], 0, 0, 0); } }
        }
        }
    }
    { auto rr = __builtin_amdgcn_permlane32_swap(__float_as_uint(l), __float_as_uint(l), false, false); l = __uint_as_float(rr[0]) + __uint_as_float(rr[1]); }
    const float il = 1.f / l; float ss = 0.f;
    bf16_t* op = mix + tq * DM + h * HD + 4 * hi;
#pragma unroll
    for (int d0 = 0; d0 < 2; ++d0)
#pragma unroll
        for (int g = 0; g < 4; ++g) { const float v0 = o[d0][4 * g] * il, v1 = o[d0][4 * g + 1] * il, v2 = o[d0][4 * g + 2] * il, v3 = o[d0][4 * g + 3] * il;
            ss += v0 * v0 + v1 * v1 + v2 * v2 + v3 * v3; *(uint2*)(op + 32 * d0 + 8 * g) = make_uint2(cvtpk(v0, v1), cvtpk(v2, v3)); }
    { auto rr = __builtin_amdgcn_permlane32_swap(__float_as_uint(ss), __float_as_uint(ss), false, false); ss = __uint_as_float(rr[0]) + __uint_as_float(rr[1]); }
    if (hi == 0) ssA[tq * 16 + h] = ss;
    asm volatile("s_waitcnt vmcnt(0) lgkmcnt(0)\n\ts_barrier" ::: "memory");
#undef ATT_DMA
#undef ATT_DMA1
#undef ATT_GLDS
}
}

__device__ __forceinline__ void conv_slab(const bf16_t* __restrict__ proj, const float* __restrict__ cw, bf16_t* __restrict__ mix, float* __restrict__ ssC2, int item, int lane) {
    const int slab = item & 1, t0 = (item >> 1) * 16, ch = slab * 512 + lane * 8;
    float w0[8], w1[8], w2[8];
#pragma unroll
    for (int q = 0; q < 2; ++q) { const float4 a = *(const float4*)(cw + ch + 4 * q), b = *(const float4*)(cw + DCONV + ch + 4 * q), c = *(const float4*)(cw + 2 * DCONV + ch + 4 * q);
        w0[4 * q] = a.x; w0[4 * q + 1] = a.y; w0[4 * q + 2] = a.z; w0[4 * q + 3] = a.w; w1[4 * q] = b.x; w1[4 * q + 1] = b.y; w1[4 * q + 2] = b.z; w1[4 * q + 3] = b.w;
        w2[4 * q] = c.x; w2[4 * q + 1] = c.y; w2[4 * q + 2] = c.z; w2[4 * q + 3] = c.w; }
    float z1[8], z2[8];
#pragma unroll
    for (int q = 0; q < 8; ++q) { z1[q] = 0.f; z2[q] = 0.f; }
    if ((t0 & (SEQ - 1)) != 0) {
        const bf16_t* p2 = proj + (size_t)(t0 - 2) * NPROJ; const bf16_t* p1 = proj + (size_t)(t0 - 1) * NPROJ;
        const uint4 c2 = *(const uint4*)(p2 + 4 * DATT + ch), u2 = *(const uint4*)(p2 + 5 * DATT + ch), c1 = *(const uint4*)(p1 + 4 * DATT + ch), u1 = *(const uint4*)(p1 + 5 * DATT + ch);
        const unsigned c2w[4] = {c2.x, c2.y, c2.z, c2.w}, u2w[4] = {u2.x, u2.y, u2.z, u2.w}, c1w[4] = {c1.x, c1.y, c1.z, c1.w}, u1w[4] = {u1.x, u1.y, u1.z, u1.w};
#pragma unroll
        for (int q = 0; q < 4; ++q) { z2[2 * q] = bf2f(c2w[q] & 0xffffu) * bf2f(u2w[q] & 0xffffu); z2[2 * q + 1] = bf2f(c2w[q] >> 16) * bf2f(u2w[q] >> 16);
            z1[2 * q] = bf2f(c1w[q] & 0xffffu) * bf2f(u1w[q] & 0xffffu); z1[2 * q + 1] = bf2f(c1w[q] >> 16) * bf2f(u1w[q] >> 16); }
    }
#pragma unroll 1
    for (int i0 = 0; i0 < 16; i0 += 8) {
    uint4 bv[8], cv[8], uv[8];
#pragma unroll
    for (int i = 0; i < 8; ++i) { const bf16_t* pr = proj + (size_t)(t0 + i0 + i) * NPROJ; bv[i] = *(const uint4*)(pr + 3 * DATT + ch); cv[i] = *(const uint4*)(pr + 4 * DATT + ch); uv[i] = *(const uint4*)(pr + 5 * DATT + ch); }
#pragma unroll
    for (int i = 0; i < 8; ++i) { const int t = t0 + i0 + i;
        const unsigned bw[4] = {bv[i].x, bv[i].y, bv[i].z, bv[i].w}, cw4[4] = {cv[i].x, cv[i].y, cv[i].z, cv[i].w}, uw[4] = {uv[i].x, uv[i].y, uv[i].z, uv[i].w};
        float y[8]; float ss = 0.f;
#pragma unroll
        for (int q = 0; q < 4; ++q) {
            const float za = bf2f(cw4[q] & 0xffffu) * bf2f(uw[q] & 0xffffu), zb = bf2f(cw4[q] >> 16) * bf2f(uw[q] >> 16);
            y[2 * q] = bf2f(bw[q] & 0xffffu) * (w0[2 * q] * z2[2 * q] + w1[2 * q] * z1[2 * q] + w2[2 * q] * za);
            y[2 * q + 1] = bf2f(bw[q] >> 16) * (w0[2 * q + 1] * z2[2 * q + 1] + w1[2 * q + 1] * z1[2 * q + 1] + w2[2 * q + 1] * zb);
            ss += y[2 * q] * y[2 * q] + y[2 * q + 1] * y[2 * q + 1];
            z2[2 * q] = z1[2 * q]; z1[2 * q] = za; z2[2 * q + 1] = z1[2 * q + 1]; z1[2 * q + 1] = zb; }
        *(uint4*)(mix + (size_t)t * DM + DATT + ch) = make_uint4(cvtpk2(y[0], y[1]), cvtpk2(y[2], y[3]), cvtpk2(y[4], y[5]), cvtpk2(y[6], y[7]));
        ss = wave_sum(ss);
        if (lane == 0) ssC2[t * 4 + slab] = ss; }
    }
}

namespace g8 {
typedef unsigned u32x4 __attribute__((ext_vector_type(4)));
typedef int v4i_t __attribute__((ext_vector_type(4)));
typedef int v8i_t __attribute__((ext_vector_type(8)));
constexpr int BM = 256, BK = 64, HALF = 128, HTB = HALF * BK * 2, STAGE_BYTES = 8 * HTB, NXCD = 8, WGM = 8;
__device__ __forceinline__ int lds_byte(int r, int c) { const int st = (r >> 4) * 2 + (c >> 5), rr = r & 15, cc = c & 31, ob = rr * 64 + cc * 2; return st * 1024 + (ob ^ (((ob >> 9) & 1) << 5)); }
__device__ __forceinline__ void stage_rc(int b, int& R, int& C) { const int st = b / 1024, sb = b % 1024, swz = sb ^ (((sb >> 9) & 1) << 5); R = (st >> 1) * 16 + swz / 64; C = (st & 1) * 32 + (swz % 64) / 2; }
__device__ __forceinline__ int perm32(int rho) { const int n = rho >> 4, i = rho & 15; return 8 * (i >> 2) + 4 * n + (i & 3); }
__device__ __forceinline__ unsigned cvt_pk_bf16(float lo, float hi) { unsigned r; asm volatile("v_cvt_pk_bf16_f32 %0, %1, %2" : "=v"(r) : "v"(lo), "v"(hi)); return r; }
__device__ __forceinline__ int xcd_remap(int wgid, int nwg) { const int q = nwg / NXCD, r = nwg % NXCD, xcd = wgid % NXCD, off = wgid / NXCD; return (xcd < r ? xcd * (q + 1) : r * (q + 1) + (xcd - r) * q) + off; }

struct Unit { int pm, pn, e, slot; const char* a; const char* b; };

struct DenseOrder {
    const char* A; const char* Bt; int K, nM, nN, nwg, G, c, mul = 1;
    __device__ __forceinline__ void init(const void* A_, const void* Bt_, int M, int N, int K_, int G_, int c_) { A = (const char*)A_; Bt = (const char*)Bt_; K = K_; nM = M / BM; nN = N / BM; nwg = nM * nN; G = G_; c = c_; }
    __device__ __forceinline__ bool next(int i, Unit& u) const {
        int L = i * G + c; if (L >= nwg * mul) return false; L %= nwg;
        const int wgid = xcd_remap(L, nwg);
        const int nig = WGM * nN, gid = wgid / nig, fm = gid * WGM, gsz = (nM - fm) < WGM ? (nM - fm) : WGM;
        u.pm = fm + ((wgid % nig) % gsz); u.pn = (wgid % nig) / gsz; u.e = i; u.slot = i % 3;
        u.a = A + (size_t)u.pm * BM * K * 2; u.b = Bt + (size_t)u.pn * BM * K * 2; return true;
    }
    __device__ __forceinline__ unsigned arow_off(const Unit&, int r, int Kb) const { return (unsigned)r * (unsigned)Kb; }
    const float* rowscale = nullptr; LAS float* rtab = nullptr;
    __device__ __forceinline__ void prefetch(const Unit& u) const { const int r = threadIdx.x; if (r < BM) rtab[u.slot * BM + r] = rowscale[u.pm * BM + r]; }
    __device__ __forceinline__ float scale_of(const Unit& u, int r) const { return rtab[u.slot * BM + r]; }
};
template <bool GATHER> struct MoeOrder {
    const char* A; const char* Bt; const int* list; LAS const int* pl; int K  , NPN, nwg, G, c; size_t estride; int mul;
    LAS int* rinfo; const float* rscale;
    __device__ __forceinline__ bool next(int i, Unit& u) const {
        int L = i * G + c; if (L >= nwg * mul) return false; L %= nwg;
        const int wgid = xcd_remap(L, nwg);
        u.pm = wgid / NPN; u.pn = wgid % NPN; u.e = pl[64 + u.pm]; u.slot = i % 3;
        u.a = GATHER ? A : A + (size_t)u.pm * BM * K; u.b = Bt + (size_t)u.e * estride + (size_t)u.pn * BM * K; return true;
    }
    __device__ __forceinline__ void prefetch(const Unit& u) const {
        const int r = threadIdx.x;
        if (r < BM) { const int slot = u.pm * BM + r - pl[32 + u.e]; int pr = -1; float sc = 0.f;
            if (slot < pl[u.e]) { pr = list[u.e * T + slot]; sc = rscale[GATHER ? (pr >> 1) : pr]; }
            rinfo[(u.slot * BM + r) * 2] = pr; rinfo[(u.slot * BM + r) * 2 + 1] = __float_as_int(sc); }
    }
    __device__ __forceinline__ int pair_of(const Unit& u, int r) const { return rinfo[(u.slot * BM + r) * 2]; }
    __device__ __forceinline__ float scale_of(const Unit& u, int r) const { return __int_as_float(rinfo[(u.slot * BM + r) * 2 + 1]); }
    __device__ __forceinline__ unsigned arow_off(const Unit& u, int r, int Kb) const {
        if (GATHER) { const int pr = pair_of(u, r); return (unsigned)(pr >= 0 ? (pr >> 1) : 0) * (unsigned)Kb; }
        return (unsigned)r * (unsigned)Kb;
    }
};

template <bool GATHER, int ES, class Epi, class Sched>
__device__ __forceinline__ void gemm_phase(LAS unsigned char* lds, const int K, const Sched& S, const Epi& E) {
    int tid_ = threadIdx.x; asm volatile("" : "+v"(tid_));
    const int tid = tid_, wid = __builtin_amdgcn_readfirstlane(tid >> 6), lane = tid & 63, wr = wid >> 2, wc = wid & 3, fr = lane & 15, fq = lane >> 4;
    const int Kb = K * ES, nt = Kb / (BK * 2);
    unsigned voffB[2];
#pragma unroll
    for (int i = 0; i < 2; ++i) { int R, C; stage_rc(tid * 16 + i * 8192, R, C); const int Rb = Epi::PERM ? ((R & ~31) + perm32(R & 31)) : R; voffB[i] = (unsigned)(Rb * Kb + C * 2); }
#define G8_AOFF(u, h, i) ([&]() { int R_, C_; stage_rc(tid * 16 + (i) * 8192, R_, C_); return S.arow_off(u, (h) * HALF + R_, Kb) + (unsigned)(C_ * 2); }())
    const size_t kstep = (size_t)(BK * 2);
    const size_t hstep = (size_t)HALF * Kb;
    const unsigned ldsw = (unsigned)wid * 1024u;
    const int aoff = lds_byte(wr * 64 + fr, fq * 8), boff = lds_byte(wc * 32 + fr, fq * 8);
#define G8_SA(b, h) (((b) * 2 + (h)) * HTB)
#define G8_SB(b, h) ((4 + (b) * 2 + (h)) * HTB)
#define G8_STAGE(bufoff, gbase, voff) do { _Pragma("unroll") for (int _i = 0; _i < 2; ++_i) \
        __builtin_amdgcn_global_load_lds((const unsigned*)((const char*)(gbase) + (voff)[_i]), (LAS unsigned*)(lds + (bufoff) + ldsw + _i * 8192), 16, 0, 0); } while (0)
#define G8_LDA(dst, b, h) do { _Pragma("unroll") for (int m = 0; m < 4; ++m) { if (ES == 2) { _Pragma("unroll") for (int k = 0; k < 2; ++k) dst[m][k] = *(const LAS bf16x8*)(lds + G8_SA(b, h) + aoff + m * 2048 + k * 1024); } \
        else dst##8[m] = __builtin_shufflevector(*(const LAS v4i_t*)(lds + G8_SA(b, h) + aoff + m * 2048), *(const LAS v4i_t*)(lds + G8_SA(b, h) + aoff + m * 2048 + 1024), 0, 1, 2, 3, 4, 5, 6, 7); } } while (0)
#define G8_LDB(dst, b, h) do { _Pragma("unroll") for (int n = 0; n < 2; ++n) { if (ES == 2) { _Pragma("unroll") for (int k = 0; k < 2; ++k) dst[n][k] = *(const LAS bf16x8*)(lds + G8_SB(b, h) + boff + n * 2048 + k * 1024); } \
        else dst##8[n] = __builtin_shufflevector(*(const LAS v4i_t*)(lds + G8_SB(b, h) + boff + n * 2048), *(const LAS v4i_t*)(lds + G8_SB(b, h) + boff + n * 2048 + 1024), 0, 1, 2, 3, 4, 5, 6, 7); } } while (0)
#define G8_CAT(x, y) __builtin_shufflevector(__builtin_bit_cast(v4i_t, x), __builtin_bit_cast(v4i_t, y), 0, 1, 2, 3, 4, 5, 6, 7)
#define G8_MMA(ai, bj, At, Bt) do { __builtin_amdgcn_s_setprio(1); _Pragma("unroll") for (int m = 0; m < 4; ++m) _Pragma("unroll") for (int n = 0; n < 2; ++n) { \
        if (ES == 2) { _Pragma("unroll") for (int k = 0; k < 2; ++k) acc[ai][bj][m][n] = __builtin_amdgcn_mfma_f32_16x16x32_bf16(Bt[n][k], At[m][k], acc[ai][bj][m][n], 0, 0, 0); } \
        else asm volatile("v_mfma_scale_f32_16x16x128_f8f6f4 %0, %1, %2, %0, %3, %3 op_sel_hi:[0,0,0]" : "+v"(acc[ai][bj][m][n]) : "v"(Bt##8[n]), "v"(At##8[m]), "v"(scale1)); } \
        __builtin_amdgcn_s_setprio(0); } while (0)
#define G8_WAIT_V(n) asm volatile("s_waitcnt vmcnt(" #n ")" ::: "memory")
#define G8_WAIT_L(n) asm volatile("s_waitcnt lgkmcnt(" #n ")" ::: "memory")
#define G8_BAR __builtin_amdgcn_s_barrier()
#define G8_SCHED __builtin_amdgcn_sched_barrier(0)
    Unit cur, nxt; int ui = 0;
    if (!S.next(0, cur)) return;
    if (GATHER || Epi::ROWINFO) { S.prefetch(cur); __syncthreads(); }
    f32x4 acc[2][2][4][2];
#pragma unroll
    for (int a = 0; a < 2; ++a)
#pragma unroll
        for (int b = 0; b < 2; ++b)
#pragma unroll
            for (int m = 0; m < 4; ++m)
#pragma unroll
                for (int n = 0; n < 2; ++n) acc[a][b][m][n] = (f32x4){0.f, 0.f, 0.f, 0.f};
    bf16x8 At[4][2], B0[2][2], B1[2][2];
    v8i_t At8[4], B08[2], B18[2];
    const int scale1 = 0x7F7F7F7F;
    unsigned vA[2][2];
#pragma unroll
    for (int h = 0; h < 2; ++h)
#pragma unroll
        for (int i = 0; i < 2; ++i) vA[h][i] = G8_AOFF(cur, h, i);
    const char* cA = cur.a; const char* cB = cur.b;
    G8_STAGE(G8_SB(0, 0), cB, voffB); G8_STAGE(G8_SB(0, 1), cB + hstep, voffB); G8_STAGE(G8_SA(0, 0), cA, vA[0]); G8_STAGE(G8_SA(0, 1), cA, vA[1]);
    if (wr == 1) G8_BAR;
    G8_WAIT_V(2); G8_BAR;
    G8_STAGE(G8_SB(1, 0), cB + kstep, voffB); G8_STAGE(G8_SA(1, 0), cA + kstep, vA[0]); G8_STAGE(G8_SB(1, 1), cB + hstep + kstep, voffB);
    G8_WAIT_V(6); G8_BAR;
    for (;;) {
        const bool has_next = S.next(ui + 1, nxt);
        const char* nA = has_next ? nxt.a : cA; const char* nB = has_next ? nxt.b : cB;
        if ((GATHER || Epi::ROWINFO) && has_next) S.prefetch(nxt);
        for (int t = 0; t < nt; t += 2) {
            const bool last = (t == nt - 2);
            if (Epi::MID_T >= 0 && t == Epi::MID_T) E.mid(acc, cur, wr, wc, fr, fq);
            const char* a1 = cA + (size_t)(t + 1) * kstep;
            const char* a2 = last ? nA : cA + (size_t)(t + 2) * kstep; const char* b2 = last ? nB : cB + (size_t)(t + 2) * kstep;
            const char* a3 = a2 + kstep; const char* b3 = b2 + kstep;
            unsigned v2[2][2];
#pragma unroll
            for (int h = 0; h < 2; ++h)
#pragma unroll
                for (int i = 0; i < 2; ++i) v2[h][i] = (GATHER && last && has_next) ? G8_AOFF(nxt, h, i) : vA[h][i];
            G8_LDB(B0, 0, 0); G8_LDB(B1, 0, 1); G8_SCHED; G8_LDA(At, 0, 0); G8_STAGE(G8_SA(1, 1), a1, vA[1]);
            G8_WAIT_V(8); G8_WAIT_L(0); G8_BAR; G8_MMA(0, 0, At, B0); G8_MMA(0, 1, At, B1); G8_BAR; G8_SCHED;
            G8_LDA(At, 0, 1); G8_STAGE(G8_SB(0, 0), b2, voffB); G8_STAGE(G8_SB(0, 1), b2 + hstep, voffB); G8_STAGE(G8_SA(0, 0), a2, v2[0]);
            G8_WAIT_V(8); G8_WAIT_L(0); G8_BAR; G8_MMA(1, 0, At, B0); G8_MMA(1, 1, At, B1); G8_BAR; G8_SCHED;
            G8_LDB(B0, 1, 0); G8_LDB(B1, 1, 1); G8_SCHED; G8_LDA(At, 1, 0); G8_STAGE(G8_SA(0, 1), a2, v2[1]);
            G8_WAIT_V(8); G8_WAIT_L(0); G8_BAR; G8_MMA(0, 0, At, B0); G8_MMA(0, 1, At, B1); G8_BAR; G8_SCHED;
            G8_LDA(At, 1, 1); G8_STAGE(G8_SB(1, 0), b3, voffB); G8_STAGE(G8_SB(1, 1), b3 + hstep, voffB); G8_STAGE(G8_SA(1, 0), a3, v2[0]);
            G8_WAIT_V(8); G8_WAIT_L(0); G8_BAR; G8_MMA(1, 0, At, B0); G8_MMA(1, 1, At, B1); G8_BAR; G8_SCHED;
        }
        if (wr == 0) G8_BAR;
        E(acc, cur, wr, wc, fr, fq);
        if (!has_next) break;
#pragma unroll
        for (int a = 0; a < 2; ++a)
#pragma unroll
            for (int b = 0; b < 2; ++b)
#pragma unroll
                for (int m = 0; m < 4; ++m)
#pragma unroll
                    for (int n = 0; n < 2; ++n) acc[a][b][m][n] = (f32x4){0.f, 0.f, 0.f, 0.f};
        cur = nxt; cA = nA; cB = nB; ++ui;
#pragma unroll
        for (int h = 0; h < 2; ++h)
#pragma unroll
            for (int i = 0; i < 2; ++i) if (GATHER) vA[h][i] = G8_AOFF(cur, h, i);
        if (wr == 1) G8_BAR;
    }
    G8_WAIT_V(0);
    G8_BAR;
#undef G8_SA
#undef G8_SB
#undef G8_STAGE
#undef G8_LDA
#undef G8_LDB
#undef G8_MMA
#undef G8_AOFF
#undef G8_CAT
#undef G8_WAIT_V
#undef G8_WAIT_L
#undef G8_BAR
#undef G8_SCHED
}

template <class Sched> struct EpiProjF { static constexpr bool PERM = true, ROWINFO = true; static constexpr int MID_T = -1; bf16_t* out; const Sched* S;
    __device__ __forceinline__ void mid(f32x4 (&)[2][2][4][2], const Unit&, int, int, int, int) const {}
    __device__ __forceinline__ void operator()(const f32x4 (&acc)[2][2][4][2], const Unit& u, int wr, int wc, int fr, int fq) const {
        const int row0 = u.pm * BM + wr * 64 + fr, col0 = u.pn * BM + wc * 32 + 8 * fq;
#pragma unroll
        for (int ai = 0; ai < 2; ++ai)
#pragma unroll
            for (int m = 0; m < 4; ++m) { const int row = row0 + ai * HALF + m * 16; const float s = S->scale_of(u, ai * HALF + wr * 64 + m * 16 + fr); bf16_t* rowp = out + (size_t)row * NPROJ + col0;
#pragma unroll
                for (int bj = 0; bj < 2; ++bj) { const f32x4 v0 = acc[ai][bj][m][0] * s, v1 = acc[ai][bj][m][1] * s; u32x4 w; w.x = cvt_pk_bf16(v0[0], v0[1]); w.y = cvt_pk_bf16(v0[2], v0[3]); w.z = cvt_pk_bf16(v1[0], v1[1]); w.w = cvt_pk_bf16(v1[2], v1[3]);
                    *(u32x4*)(rowp + bj * HALF) = w; } }
    }
};
struct EpiG2F { static constexpr bool PERM = true, ROWINFO = false; static constexpr int MID_T = DATT / BK; bf16_t* out; LAS const float* tab;
    __device__ __forceinline__ void mid(f32x4 (&acc)[2][2][4][2], const Unit& u, int wr, int wc, int fr, int fq) const {
        LAS const float* tb = tab + (size_t)(u.e) * 512;
#pragma unroll
        for (int ai = 0; ai < 2; ++ai)
#pragma unroll
            for (int m = 0; m < 4; ++m) { const float s = tb[(ai * HALF + wr * 64 + m * 16 + fr) * 2];
#pragma unroll
                for (int bj = 0; bj < 2; ++bj)
#pragma unroll
                    for (int n = 0; n < 2; ++n) acc[ai][bj][m][n] *= s; }
    }
    __device__ __forceinline__ void operator()(const f32x4 (&acc)[2][2][4][2], const Unit& u, int wr, int wc, int fr, int fq) const {
        LAS const float* tb = tab + (size_t)(u.e) * 512;
        const int col0 = u.pn * BM + wc * 32 + 8 * fq;
#pragma unroll
        for (int ai = 0; ai < 2; ++ai)
#pragma unroll
            for (int m = 0; m < 4; ++m) { const int r = ai * HALF + wr * 64 + m * 16 + fr; const float s = tb[r * 2 + 1]; bf16_t* rowp = out + (size_t)(u.pm * BM + r) * DM + col0;
#pragma unroll
                for (int bj = 0; bj < 2; ++bj) { const f32x4 v0 = acc[ai][bj][m][0] * s, v1 = acc[ai][bj][m][1] * s; u32x4 w; w.x = cvt_pk_bf16(v0[0], v0[1]); w.y = cvt_pk_bf16(v0[2], v0[3]); w.z = cvt_pk_bf16(v1[0], v1[1]); w.w = cvt_pk_bf16(v1[2], v1[3]);
                    *(u32x4*)(rowp + bj * HALF) = w; } }
    }
};
template <class Sched> struct EpiGUF { static constexpr bool PERM = true, ROWINFO = true; static constexpr int MID_T = -1; bf16_t* Hb; const Sched* S;
    __device__ __forceinline__ void mid(f32x4 (&)[2][2][4][2], const Unit&, int, int, int, int) const {}
    __device__ __forceinline__ void operator()(const f32x4 (&acc)[2][2][4][2], const Unit& u, int wr, int wc, int fr, int fq) const {
        const int col0 = u.pn * HALF + wc * 32 + 8 * fq;
#pragma unroll
        for (int ai = 0; ai < 2; ++ai)
#pragma unroll
            for (int m = 0; m < 4; ++m) { const int r = ai * HALF + wr * 64 + m * 16 + fr; const float s = S->scale_of(u, r) * (1.f / WSCALE8);
                float h[8];
#pragma unroll
                for (int n = 0; n < 2; ++n)
#pragma unroll
                    for (int q = 0; q < 4; ++q) { const float gg = acc[ai][0][m][n][q] * s, uu = acc[ai][1][m][n][q] * s; h[4 * n + q] = gg * __builtin_amdgcn_rcpf(1.f + __expf(-gg)) * uu; }
                int w0 = __builtin_amdgcn_cvt_pk_fp8_f32(h[0] * HSCALE8, h[1] * HSCALE8, 0, false); w0 = __builtin_amdgcn_cvt_pk_fp8_f32(h[2] * HSCALE8, h[3] * HSCALE8, w0, true);
                int w1 = __builtin_amdgcn_cvt_pk_fp8_f32(h[4] * HSCALE8, h[5] * HSCALE8, 0, false); w1 = __builtin_amdgcn_cvt_pk_fp8_f32(h[6] * HSCALE8, h[7] * HSCALE8, w1, true);
                *(uint2*)((unsigned char*)Hb + (size_t)(u.pm * BM + r) * DEXP + col0) = make_uint2((unsigned)w0, (unsigned)w1); }
    }
};
template <class Sched> struct EpiDownF { static constexpr bool PERM = true, ROWINFO = true; static constexpr int MID_T = -1; unsigned char* Y; const Sched* S;
    __device__ __forceinline__ void mid(f32x4 (&)[2][2][4][2], const Unit&, int, int, int, int) const {}
    __device__ __forceinline__ void operator()(const f32x4 (&acc)[2][2][4][2], const Unit& u, int wr, int wc, int fr, int fq) const {
        const int col0 = u.pn * BM + wc * 32 + 8 * fq;
#pragma unroll
        for (int ai = 0; ai < 2; ++ai)
#pragma unroll
            for (int m = 0; m < 4; ++m) { const int r = ai * HALF + wr * 64 + m * 16 + fr; const int pr = S->pair_of(u, r); if (pr < 0) continue; const float s = S->scale_of(u, r) * (YSCALE8 / (HSCALE8 * WDSCALE8)); unsigned char* rowp = Y + (size_t)pr * DM + col0;
#pragma unroll
                for (int bj = 0; bj < 2; ++bj) { const f32x4 v0 = acc[ai][bj][m][0] * s, v1 = acc[ai][bj][m][1] * s;
                    int w0 = __builtin_amdgcn_cvt_pk_fp8_f32(v0[0], v0[1], 0, false); w0 = __builtin_amdgcn_cvt_pk_fp8_f32(v0[2], v0[3], w0, true);
                    int w1 = __builtin_amdgcn_cvt_pk_fp8_f32(v1[0], v1[1], 0, false); w1 = __builtin_amdgcn_cvt_pk_fp8_f32(v1[2], v1[3], w1, true);
                    *(uint2*)(rowp + bj * HALF) = make_uint2((unsigned)w0, (unsigned)w1); } }
    }
};
}


#define XB_TMO      128
#define XB_XCNT(j)  (256  + 64 * (j))
#define XB_XSUB(j)  (1280 + 64 * (j))
#define XB_XGEN(j)  (2304 + 64 * (j))
#define XB_TOP      3328
#define XB_TOPGEN   3392
#define XCD_BAR_WORDS 3456
#define XB_SPIN_CAP (1u << 20)
__device__ __forceinline__ unsigned xb_ld(unsigned* p)              { return __hip_atomic_load(p, __ATOMIC_RELAXED, __HIP_MEMORY_SCOPE_AGENT); }
__device__ __forceinline__ unsigned xb_add(unsigned* p, unsigned v) { return __hip_atomic_fetch_add(p, v, __ATOMIC_RELAXED, __HIP_MEMORY_SCOPE_AGENT); }
__device__ __forceinline__ unsigned xb_xcc_id() { return (unsigned)__builtin_amdgcn_s_getreg((3 << 11) | 20) & 0xFu; }
#define XB_SPIN(cond, bar) do { unsigned _sp = 0; while (cond) { __builtin_amdgcn_s_sleep(1); \
    if ((++_sp & 255u) == 0u) { if (xb_ld(&(bar)[XB_TMO])) break; if (_sp > XB_SPIN_CAP) { atomicAdd(&(bar)[XB_TMO], 1u); break; } } } } while (0)
struct XcdBarrier { unsigned* bar; unsigned x; volatile LAS unsigned* st; };
__device__ __forceinline__ XcdBarrier xcd_barrier_post(unsigned* bar, volatile LAS unsigned* st) {
    XcdBarrier b; b.bar = bar; b.x = xb_xcc_id(); b.st = st;
    if (threadIdx.x == 0) (void)xb_add(&bar[XB_XCNT(b.x)], 1u);
    return b;
}
__device__ __forceinline__ void xcd_barrier_complete(unsigned* bar, unsigned x, unsigned& nloc, unsigned& nx) {
    const unsigned G = gridDim.x * gridDim.y * gridDim.z;
    unsigned sum, cnt, mine, sp = 0u;
    for (;;) {
        sum = 0u; cnt = 0u; mine = 0u;
#pragma unroll
        for (unsigned j = 0; j < 16; ++j) { const unsigned c = xb_ld(&bar[XB_XCNT(j)]); sum += c; cnt += (c > 0u) ? 1u : 0u; mine = (j == x) ? c : mine; }
        if (sum == G) break;
        __builtin_amdgcn_s_sleep(1);
        if ((++sp & 255u) == 0u) { if (xb_ld(&bar[XB_TMO])) break; if (sp > XB_SPIN_CAP) { atomicAdd(&bar[XB_TMO], 1u); break; } }
    }
    nloc = mine > 0u ? mine : 1u; nx = cnt > 0u ? cnt : 1u;
}
__device__ __forceinline__ void xcd_barrier(const XcdBarrier& b) {
    asm volatile("s_waitcnt vmcnt(0)" ::: "memory");
    __syncthreads();
    if (threadIdx.x == 0) {
        unsigned* bar = b.bar;
        __builtin_amdgcn_s_waitcnt(0);
        unsigned nloc = b.st[0], nx = b.st[1];
        if (nloc == 0u) { xcd_barrier_complete(bar, b.x, nloc, nx); b.st[0] = nloc; b.st[1] = nx; }
        const unsigned old = xb_add(&bar[XB_XSUB(b.x)], 1u);
        const unsigned gen = old / nloc;
        if (old + 1u == (gen + 1u) * nloc) {
            __builtin_amdgcn_fence(__ATOMIC_RELEASE, "agent");
            asm volatile("s_waitcnt vmcnt(0)" ::: "memory");
            const unsigned og = xb_add(&bar[XB_TOP], 1u);
            const unsigned tg = og / nx;
            if (og + 1u == (tg + 1u) * nx) xb_add(&bar[XB_TOPGEN], 1u);
            else XB_SPIN(xb_ld(&bar[XB_TOPGEN]) == tg, bar);
            __builtin_amdgcn_fence(__ATOMIC_ACQUIRE, "agent");
            xb_add(&bar[XB_XGEN(b.x)], 1u);
            asm volatile("s_waitcnt vmcnt(0)" ::: "memory");
        } else {
            XB_SPIN(xb_ld(&bar[XB_XGEN(b.x)]) == gen, bar);
            __builtin_amdgcn_fence(__ATOMIC_ACQUIRE, "agent");
            asm volatile("s_waitcnt vmcnt(0)" ::: "memory");
        }
    }
    __syncthreads();
}

__global__ void __launch_bounds__(NTHREADS, 2) mega(Params p) {
    extern __shared__ __attribute__((aligned(16))) unsigned char lds[];
    volatile LAS unsigned* bst = (volatile LAS unsigned*)(lds + LDS_PLAN_OFF + 1024);
    if (threadIdx.x < 2) bst[threadIdx.x] = 0u;
    __syncthreads();
    const XcdBarrier gbar = xcd_barrier_post((unsigned*)(p.ws + WS_BAR), bst);
    unsigned long long ts0 = 0, ts1 = 0;
    if (p.never) cg::this_grid().sync();
    Ctx c; c.tid = threadIdx.x; c.lane = c.tid & 63; c.wave = __builtin_amdgcn_readfirstlane(c.tid >> 6); c.gw = blockIdx.x * NWAVES + c.wave; c.ngw = gridDim.x * NWAVES;
    char* ws = p.ws;
    int* cnt = (int*)(ws + WS_CTL);
    float* r1 = (float*)(ws + WS_R1); float* r2 = (float*)(ws + WS_R2); float* ssC = (float*)(ws + WS_SSC);
    float* wts = (float*)(ws + WS_WTS); bf16_t* Wrh = (bf16_t*)(ws + WS_WR); bf16_t* Wrl = (bf16_t*)(ws + WS_WR + 256 * 1024); float* ssA = (float*)(ws + WS_SSA); int* list = (int*)(ws + WS_LIST);
    bf16_t* W2t = (bf16_t*)(ws + WS_W2T); bf16_t* W1t = (bf16_t*)(ws + WS_W1T); bf16_t* Wdt = (bf16_t*)(ws + WS_WDT); bf16_t* Wgut = (bf16_t*)(ws + WS_WGUT);
    bf16_t* xb = (bf16_t*)(ws + WS_XB); bf16_t* mix = (bf16_t*)(ws + WS_MIX); bf16_t* proj = (bf16_t*)(ws + WS_PROJ); bf16_t* Y = (bf16_t*)(ws + WS_Y); bf16_t* Hb = (bf16_t*)(ws + WS_H);
    unsigned char* xf8 = (unsigned char*)(ws + WS_WGUT + 64 * MiB);
    bf16_t* dlt = (bf16_t*)(ws + WS_PROJ);

    TS0(1) TS0(8)
    {
        for (int row = c.gw; row < T * PMUL(10); row += 2 * c.ngw) {
            const int ra = row % T, rb = (row + c.ngw) % T; const bool hb = row + c.ngw < T * PMUL(10);
            const float4* xa = (const float4*)(p.x + (size_t)ra * DM); const float4* xc = (const float4*)(p.x + (size_t)rb * DM);
            float4 va[8], vb[8];
#pragma unroll
            for (int j = 0; j < 8; ++j) { va[j] = xa[j * 64 + c.lane]; if (hb) vb[j] = xc[j * 64 + c.lane]; }
            float sa = 0.f, sb = 0.f; uint2* oa = (uint2*)(xb + (size_t)ra * DM); uint2* ob = (uint2*)(xb + (size_t)rb * DM);
#pragma unroll
            for (int j = 0; j < 8; ++j) { sa += va[j].x * va[j].x + va[j].y * va[j].y + va[j].z * va[j].z + va[j].w * va[j].w; oa[j * 64 + c.lane] = make_uint2(cvtpk2(va[j].x, va[j].y), cvtpk2(va[j].z, va[j].w)); }
            if (hb) {
#pragma unroll
                for (int j = 0; j < 8; ++j) { sb += vb[j].x * vb[j].x + vb[j].y * vb[j].y + vb[j].z * vb[j].z + vb[j].w * vb[j].w; ob[j * 64 + c.lane] = make_uint2(cvtpk2(vb[j].x, vb[j].y), cvtpk2(vb[j].z, vb[j].w)); } }
            sa = wave_sum(sa); sb = wave_sum(sb);
            if (c.lane == 0) { r1[ra] = rsqrtf(sa * (1.f / DM) + EPS); if (hb) r1[rb] = rsqrtf(sb * (1.f / DM) + EPS); }
        }
        LAS float* scr = (LAS float*)lds + c.wave * (64 * 65);
        constexpr int I_IN = (DM / 64) * (NPROJ / 64), I_OUT = (DM / 64) * (DM / 64);
        constexpr int NIT = I_IN + I_OUT;
        for (int it = c.gw; it < NIT * PMUL(10); it += c.ngw) {
            int r = it % NIT;
            if (r < I_IN) { const int nb = NPROJ / 64, kb = r / nb, n0 = (r % nb) * 64; p0_titem(p.w_in, NPROJ, p.norm1, W1t, DM, kb * 64, n0, n0, scr, c.lane, n0 < DATT ? QSCALE : 1.f); continue; } r -= I_IN;
            { const int nb = DM / 64, kb = r / nb, n0 = (r % nb) * 64, k0 = kb * 64;
                const float* g = k0 < DATT ? p.g_oa + k0 : p.g_oc + (k0 - DATT);
                p0_titem(p.w_out + (size_t)k0 * DM, DM, g, W2t + k0, DM, 0, n0, n0, scr, c.lane); }
        }
        for (int i = blockIdx.x * NTHREADS + c.tid; i < 48 * DM; i += gridDim.x * NTHREADS) { const int o = i / DM, k = i % DM; const float w = o < 36 ? (o < 4 ? p.w_rg[k * 4 + o] : p.w_re[k * 32 + (o - 4)]) : 0.f;
            const unsigned h = f2bf(w); Wrh[i] = (bf16_t)h; Wrl[i] = (bf16_t)f2bf(w - bf2f(h)); }
    }
    xcd_barrier(gbar);
    TS1(1) TS0(2)
    {
        g8::DenseOrder S; S.init(xb, W1t, T, NPROJ, DM, (int)gridDim.x, (int)blockIdx.x); S.mul = PMUL(1);
        S.rowscale = r1; S.rtab = (LAS float*)(lds + 131072);
        const g8::EpiProjF<g8::DenseOrder> E{proj, &S};
        g8::gemm_phase<false, 2>((LAS unsigned char*)lds, DM, S, E);
    }
    xcd_barrier(gbar);
    TS1(2) TS0(3)
    {
        struct Side { WConv wc; unsigned long long twait; int s, gw, ngw, nper, lane; LAS float* scr; unsigned scr32; const float *wg, *wu, *wd; bf16_t* Wgut; bf16_t* Wdt;
            __device__ __forceinline__ void step() { if (wc.pending) wc.finish(scr, lane);
                if (s < nper) { const int id = gw + ngw * s; ++s; if (id < WC_ITEMS) wc.issue(id, wg, wu, wd, Wgut, Wdt, scr32, lane); } }
            __device__ __forceinline__ void whole() { step(); asm volatile("s_waitcnt vmcnt(0)" ::: "memory"); } };
        Side side; side.twait = 0; side.wc.pending = false; side.s = 0; side.gw = c.gw; side.ngw = c.ngw; side.nper = (WC_ITEMS + c.ngw - 1) / c.ngw; side.lane = c.lane;
        side.scr = (LAS float*)(lds + 69632) + c.wave * (64 * 32); side.scr32 = (unsigned)(__UINTPTR_TYPE__)((LAS unsigned char*)lds + 69632) + c.wave * 8192;
        side.wg = p.w_gate; side.wu = p.w_up; side.wd = p.w_down; side.Wgut = Wgut; side.Wdt = Wdt;
        for (int u1 = blockIdx.x; u1 < NB * NH * 4 * PMUL(2); u1 += gridDim.x) { const int u0 = u1 % (NB * NH * 4); const int bh = u0 >> 2;
            for (int i = 0; i < 4; ++i) att::attn_unit((LAS unsigned char*)lds, proj, p.relb, mix, ssA, bh >> 4, bh & 15, (u0 & 3) + 4 * i, side, i == 0); }
        if (TSPROBE == 34 || TSPROBE == 35) { ts0 = 0; ts1 = side.twait; }
        while (side.wc.pending || side.s < side.nper) side.whole();
        for (int it = c.gw; it < (T / 16) * 2 * PMUL(21); it += c.ngw) conv_slab(proj, p.conv_w, mix, ssC, it % ((T / 16) * 2), c.lane);
    }
    xcd_barrier(gbar);
    TS1(3) TS0(4)
    {
        g8::DenseOrder S; S.init(mix, W2t, T, DM, DM, (int)gridDim.x, (int)blockIdx.x); S.mul = PMUL(3);
        LAS float* tab = (LAS float*)(lds + 131072);
        g8::Unit u;
        for (int i = 0; i < 4; ++i) if (S.next(i, u) && c.tid < 256) { const int row = u.pm * 256 + c.tid; float sa = 0.f;
#pragma unroll
            for (int h = 0; h < 16; ++h) sa += ssA[row * 16 + h];
            const float4 sc4 = *(const float4*)(ssC + row * 4); const float ra = rsqrtf(sa * (1.f / DATT) + EPS), rc = rsqrtf((sc4.x + sc4.y) * (1.f / DCONV) + EPS);
            tab[(i * 256 + c.tid) * 2] = ra / rc; tab[(i * 256 + c.tid) * 2 + 1] = rc; }
        __syncthreads();
        const g8::EpiG2F E{dlt, tab};
        g8::gemm_phase<false, 2>((LAS unsigned char*)lds, DM, S, E);
    }
    xcd_barrier(gbar);
    TS1(4) TS0(5)
    for (int it = blockIdx.x; it < (T / 64) * PMUL(4); it += gridDim.x) router_block(p.x, dlt, p.norm2, xb, xf8, Wrh, Wrl, p.b_rg, p.b_re, cnt, list, wts, r2, it % (T / 64), c.wave, c.lane, (LAS float*)lds, it < T / 64);
    xcd_barrier(gbar);
    TS1(5) TS0(6)
    LAS int* pl = (LAS int*)(lds + LDS_PLAN_OFF);
    if (c.tid < 64) {
        const int ce = c.tid < NE ? cnt[c.tid * 64] : 0, mt = (ce + 255) >> 8;
        int inc = mt;
#pragma unroll
        for (int o = 1; o < 32; o <<= 1) { const int v = __shfl_up(inc, o); if (c.lane >= o) inc += v; }
        if (c.tid < NE) { pl[c.tid] = ce; pl[32 + c.tid] = (inc - mt) * 256; }
        if (c.tid == NE - 1) pl[224] = inc;
    }
    __syncthreads();
    if (c.tid < NTILEMAX) { int e = -1;
        for (int q = 0; q < NE; ++q) { const int st = pl[32 + q] >> 8, mt = (pl[q] + 255) >> 8; if (c.tid >= st && c.tid < st + mt) e = q; }
        pl[64 + c.tid] = e; }
    __syncthreads();
    const int ntile = pl[224];
    {
        const g8::MoeOrder<true> S{(const char*)xf8, (const char*)Wgut, list, pl, DM  , 4, ntile * 4, (int)gridDim.x, (int)blockIdx.x, (size_t)2 * DEXP * DM, PMUL(5), (LAS int*)(lds + 131072), r2};
        const g8::EpiGUF<g8::MoeOrder<true>> E{Hb, &S};
        g8::gemm_phase<true, 1>((LAS unsigned char*)lds, DM, S, E);
    }
    xcd_barrier(gbar);
    TS1(6) TS0(7)
    {
        const g8::MoeOrder<false> S{(const char*)Hb, (const char*)Wdt, list, pl, DEXP  , 8, ntile * 8, (int)gridDim.x, (int)blockIdx.x, (size_t)DM * DEXP, PMUL(6), (LAS int*)(lds + 131072), wts};
        const g8::EpiDownF<g8::MoeOrder<false>> E{(unsigned char*)Y, &S};
        g8::gemm_phase<false, 1>((LAS unsigned char*)lds, DEXP, S, E);
    }
    xcd_barrier(gbar);
    TS1(7) TS1(8)
    if (PROBE == 9) { for (int i = 0; i < 8; ++i) xcd_barrier(gbar); }
    const float tsdelta = TSPROBE ? sqrtf((float)(ts1 - ts0) * 0.01f) * 1e-3f : 0.f;
    {
        const unsigned long long tp6 = (TSPROBE == 9) ? __builtin_amdgcn_s_memrealtime() : 0ull;
        FinalRow fa, fb;
        int t = c.gw;
        if (t < T) final_load(fa, xb, Y, t, c.lane);
        for (; t < T; t += 2 * c.ngw) {
            const int t2 = t + c.ngw, t3 = t + 2 * c.ngw;
            if (t2 < T) final_load(fb, xb, Y, t2, c.lane);
            final_store(fa, p.out, p.norm_f, t, c.lane, (TSPROBE == 9) ? sqrtf((float)(__builtin_amdgcn_s_memrealtime() - tp6) * 0.01f) * 1e-3f : tsdelta);
            if (t3 < T) final_load(fa, xb, Y, t3, c.lane);
            if (t2 < T) final_store(fb, p.out, p.norm_f, t2, c.lane, (TSPROBE == 9) ? sqrtf((float)(__builtin_amdgcn_s_memrealtime() - tp6) * 0.01f) * 1e-3f : tsdelta);
        }
    }
}

extern "C" void kernel_launch(void* const* d_in, const int* in_sizes, int n_in, void* d_out, int out_size, void* d_ws, size_t ws_size, hipStream_t stream) {
    static int grid = 0;
    if (grid == 0) {
        int dev = 0, cus = 0, per_cu = 0;
        if (ws_size < WS_END || n_in != 17) { fprintf(stderr, "kernel_launch: unexpected sizes (ws %zu)\n", ws_size); grid = -1; return; }
        (void)hipGetDevice(&dev); (void)hipDeviceGetAttribute(&cus, hipDeviceAttributeMultiprocessorCount, dev);
        if (hipFuncSetAttribute((const void*)mega, hipFuncAttributeMaxDynamicSharedMemorySize, LDS_BYTES) != hipSuccess) { fprintf(stderr, "hipFuncSetAttribute failed\n"); grid = -1; return; }
        if (hipOccupancyMaxActiveBlocksPerMultiprocessor(&per_cu, (const void*)mega, NTHREADS, LDS_BYTES) != hipSuccess || per_cu < 1) { fprintf(stderr, "occupancy query failed (%d)\n", per_cu); grid = -1; return; }
        grid = cus * per_cu;
        fprintf(stderr, "kernel_launch: cus %d per_cu %d grid %d\n", cus, per_cu, grid);
    }
    if (grid < 0) return;
    if (hipMemsetAsync((char*)d_ws + WS_CTL, 0, 64 * 1024, stream) != hipSuccess) { fprintf(stderr, "memset failed\n"); return; }
    Params p{};
    p.x = (const float*)d_in[0]; p.norm1 = (const float*)d_in[1]; p.w_in = (const float*)d_in[2]; p.relb = (const float*)d_in[3];
    p.conv_w = (const float*)d_in[4]; p.g_oa = (const float*)d_in[5]; p.g_oc = (const float*)d_in[6]; p.w_out = (const float*)d_in[7];
    p.norm2 = (const float*)d_in[8]; p.w_rg = (const float*)d_in[9]; p.b_rg = (const float*)d_in[10]; p.w_re = (const float*)d_in[11];
    p.b_re = (const float*)d_in[12]; p.w_gate = (const float*)d_in[13]; p.w_up = (const float*)d_in[14]; p.w_down = (const float*)d_in[15];
    p.norm_f = (const float*)d_in[16]; p.out = (float*)d_out; p.ws = (char*)d_ws;
    void* args[] = {&p};
    hipError_t e = hipLaunchCooperativeKernel((const void*)mega, dim3(grid), dim3(NTHREADS), args, LDS_BYTES, stream);
    if (e != hipSuccess) fprintf(stderr, "cooperative launch failed: %s (grid %d)\n", hipGetErrorString(e), grid);
}
```

```cpp
#include <hip/hip_runtime.h>
#include <hip/hip_cooperative_groups.h>
#include <stdint.h>
#include <cstdio>
namespace cg = cooperative_groups;
#ifndef PROBE
#define PROBE 0
#endif
#define PMUL(k) ((PROBE) == (k) ? 2 : 1)
#ifndef TSPROBE
#define TSPROBE 0
#endif
#define TS0(k) if (TSPROBE == (k)) ts0 = __builtin_amdgcn_s_memrealtime();
#define TS1(k) if (TSPROBE == (k)) ts1 = __builtin_amdgcn_s_memrealtime();

typedef unsigned short bf16_t;
typedef short bf16x8 __attribute__((ext_vector_type(8)));
typedef float f32x4 __attribute__((ext_vector_type(4)));

constexpr int NB = 4, SEQ = 4096, T = NB * SEQ, DM = 2048, DATT = 1024, DCONV = 1024, NPROJ = 6144;
constexpr int NH = 16, HD = 64, NREL = 513, NE = 32, DEXP = 512, NPAIR = 2 * T;
constexpr int NPADMAX = 40960, NTILEMAX = NPADMAX / 256;
constexpr float EPS = 1e-6f;
constexpr float YSCALE8 = 64.f;
constexpr float HSCALE8 = 8.f, WDSCALE8 = 32.f;
constexpr float WSCALE8 = 64.f;
constexpr float LOG2E = 1.4426950408889634f, QSCALE = 0.125f * LOG2E;

constexpr size_t MiB = 1u << 20;
constexpr size_t WS_CTL = 0;
constexpr size_t WS_BAR = 16 * 1024;
constexpr size_t WS_PLAN = 64 * 1024;
constexpr size_t WS_R1 = 128 * 1024;
constexpr size_t WS_RA = 192 * 1024;
constexpr size_t WS_RC = 256 * 1024;
constexpr size_t WS_R2 = 320 * 1024;
constexpr size_t WS_SSC = 3 * MiB;
constexpr size_t WS_WTS = 512 * 1024;
constexpr size_t WS_ROWPAIR = 640 * 1024;
constexpr size_t WS_WR = 1 * MiB;
constexpr size_t WS_SSA = 2 * MiB;
constexpr size_t WS_LIST = 5 * MiB;
constexpr size_t WS_W2T = 8 * MiB;
constexpr size_t WS_W1T = 16 * MiB;
constexpr size_t WS_WDT = 40 * MiB;
constexpr size_t WS_WGUT = 104 * MiB;
constexpr size_t WS_XB = 232 * MiB;
constexpr size_t WS_MIX = 296 * MiB;
constexpr size_t WS_PROJ = 360 * MiB;
constexpr size_t WS_Y = 360 * MiB;
constexpr size_t WS_H = 488 * MiB;
constexpr size_t WS_END = 552 * MiB;

__device__ __forceinline__ unsigned f2bf(float f) { unsigned u = __float_as_uint(f); return (u + 0x7fffu + ((u >> 16) & 1u)) >> 16; }
__device__ __forceinline__ unsigned pk2(float lo, float hi) { return f2bf(lo) | (f2bf(hi) << 16); }
__device__ __forceinline__ unsigned cvtpk2(float lo, float hi) { typedef float f2 __attribute__((ext_vector_type(2))); typedef __bf16 b2 __attribute__((ext_vector_type(2))); f2 v = {lo, hi}; b2 r = __builtin_convertvector(v, b2); return __builtin_bit_cast(unsigned, r); }
__device__ __forceinline__ int gu_row(int n, int up) { return ((n >> 7) << 8) + (n & 127) + (up ? 128 : 0); }
__device__ __forceinline__ float bf2f(unsigned h) { return __uint_as_float(h << 16); }
__device__ __forceinline__ float wave_sum(float v) {
#pragma unroll
    for (int o = 1; o < 64; o <<= 1) v += __shfl_xor(v, o);
    return v;
}


#define LAS __attribute__((address_space(3)))
constexpr int NWAVES = 8, NTHREADS = 512;
constexpr int LDS_BYTES = 147456;
constexpr int LDS_PLAN_OFF = 140 * 1024;

struct Params {
    const float *x, *norm1, *w_in, *relb, *conv_w, *g_oa, *g_oc, *w_out, *norm2, *w_rg, *b_rg, *w_re, *b_re, *w_gate, *w_up, *w_down, *norm_f;
    float* out; char* ws; int never; int pad;
};
struct Ctx { int tid, lane, wave, gw, ngw; };

__device__ __forceinline__ void p0_titem(const float* __restrict__ W, int N, const float* __restrict__ g, bf16_t* __restrict__ WT, int ldd, int k0, int n0, int drow0, LAS float* scr, int lane, float cs = 1.f) {
    const int kq = lane >> 4, n4 = (lane & 15) * 4;
    float4 v[16]; float gs[16];
#pragma unroll
    for (int i = 0; i < 16; ++i) v[i] = *(const float4*)(W + (size_t)(k0 + 4 * i + kq) * N + n0 + n4);
#pragma unroll
    for (int i = 0; i < 16; ++i) gs[i] = (g ? g[k0 + 4 * i + kq] : 1.f) * cs;
#pragma unroll
    for (int i = 0; i < 16; ++i) { LAS float* d = scr + (4 * i + kq) * 65 + n4; d[0] = v[i].x * gs[i]; d[1] = v[i].y * gs[i]; d[2] = v[i].z * gs[i]; d[3] = v[i].w * gs[i]; }
    asm volatile("s_waitcnt lgkmcnt(0)" ::: "memory");
    const int c = lane & 7;
#pragma unroll
    for (int j = 0; j < 8; ++j) { const int n = (lane >> 3) + 8 * j; const LAS float* sp = scr + (8 * c) * 65 + n;
        uint4 o; o.x = cvtpk2(sp[0 * 65], sp[1 * 65]); o.y = cvtpk2(sp[2 * 65], sp[3 * 65]); o.z = cvtpk2(sp[4 * 65], sp[5 * 65]); o.w = cvtpk2(sp[6 * 65], sp[7 * 65]);
        *(uint4*)(WT + (size_t)(drow0 + n) * ldd + k0 + 8 * c) = o; }
    asm volatile("s_waitcnt lgkmcnt(0)" ::: "memory");
}

__device__ __forceinline__ void router_block(const float* __restrict__ x, const bf16_t* __restrict__ dlt, const float* __restrict__ g2, bf16_t* __restrict__ xb1, unsigned char* __restrict__ xf8, const bf16_t* __restrict__ Wrh, const bf16_t* __restrict__ Wrl,
                                             const float* __restrict__ brg, const float* __restrict__ bre, int* __restrict__ cnt, int* __restrict__ list, float* __restrict__ wts, float* __restrict__ r2out,
                                             int tb, int wave, int lane, LAS float* lds_f, bool commit) {
    const int fr = lane & 15, fq = lane >> 4, tg = wave & 3, kh = wave >> 2, t0 = tb * 64 + tg * 16;
    const size_t aoff = (size_t)(t0 + fr) * DM + kh * (DM / 2) + 8 * fq;
    const float* xr = x + aoff; const bf16_t* dr = dlt + aoff; bf16_t* xw = xb1 + aoff; unsigned char* x8 = xf8 + aoff; const float* gr = g2 + kh * (DM / 2) + 8 * fq;
    const bf16_t* wh = Wrh + (size_t)fr * DM + kh * (DM / 2) + 8 * fq; const bf16_t* wl = Wrl + (size_t)fr * DM + kh * (DM / 2) + 8 * fq;
    f32x4 acc[3]; float ss = 0.f;
#pragma unroll
    for (int nb = 0; nb < 3; ++nb) acc[nb] = (f32x4){0.f, 0.f, 0.f, 0.f};
    typedef unsigned u4 __attribute__((ext_vector_type(4)));
    for (int ks0 = 0; ks0 < DM / 64; ks0 += 4) {
        float4 xa[4][2]; uint4 dl[4]; bf16x8 bh[4][3], bl[4][3];
#pragma unroll
        for (int u = 0; u < 4; ++u) { xa[u][0] = *(const float4*)(xr + (ks0 + u) * 32); xa[u][1] = *(const float4*)(xr + (ks0 + u) * 32 + 4); dl[u] = *(const uint4*)(dr + (ks0 + u) * 32); }
#pragma unroll
        for (int u = 0; u < 4; ++u)
#pragma unroll
            for (int nb = 0; nb < 3; ++nb) { bh[u][nb] = *(const bf16x8*)(wh + (size_t)nb * 16 * DM + (ks0 + u) * 32); bl[u][nb] = bh[u][nb]; }
#pragma unroll
        for (int u = 0; u < 4; ++u) {
            const unsigned dw[4] = {dl[u].x, dl[u].y, dl[u].z, dl[u].w};
            const float xv[8] = {xa[u][0].x + bf2f(dw[0] & 0xffffu), xa[u][0].y + bf2f(dw[0] >> 16), xa[u][0].z + bf2f(dw[1] & 0xffffu), xa[u][0].w + bf2f(dw[1] >> 16),
                                 xa[u][1].x + bf2f(dw[2] & 0xffffu), xa[u][1].y + bf2f(dw[2] >> 16), xa[u][1].z + bf2f(dw[3] & 0xffffu), xa[u][1].w + bf2f(dw[3] >> 16)};
            const float4 ga = *(const float4*)(gr + (ks0 + u) * 32), gb = *(const float4*)(gr + (ks0 + u) * 32 + 4);
            const float yv[8] = {xv[0] * ga.x, xv[1] * ga.y, xv[2] * ga.z, xv[3] * ga.w, xv[4] * gb.x, xv[5] * gb.y, xv[6] * gb.z, xv[7] * gb.w};
            unsigned hw[4], lw[4];
#pragma unroll
            for (int q = 0; q < 4; ++q) { const unsigned h = cvtpk2(yv[2 * q], yv[2 * q + 1]); hw[q] = h;
                lw[q] = cvtpk2(yv[2 * q] - __uint_as_float(h << 16), yv[2 * q + 1] - __uint_as_float(h & 0xffff0000u)); ss += xv[2 * q] * xv[2 * q] + xv[2 * q + 1] * xv[2 * q + 1]; }
            if (commit) { *(uint4*)(xw + (ks0 + u) * 32) = make_uint4(cvtpk2(xv[0], xv[1]), cvtpk2(xv[2], xv[3]), cvtpk2(xv[4], xv[5]), cvtpk2(xv[6], xv[7]));
                int f0 = __builtin_amdgcn_cvt_pk_fp8_f32(yv[0], yv[1], 0, false); f0 = __builtin_amdgcn_cvt_pk_fp8_f32(yv[2], yv[3], f0, true);
                int f1 = __builtin_amdgcn_cvt_pk_fp8_f32(yv[4], yv[5], 0, false); f1 = __builtin_amdgcn_cvt_pk_fp8_f32(yv[6], yv[7], f1, true);
                *(uint2*)(x8 + (ks0 + u) * 32) = make_uint2((unsigned)f0, (unsigned)f1); }
            const bf16x8 xh = __builtin_bit_cast(bf16x8, (u4){hw[0], hw[1], hw[2], hw[3]}), xl = __builtin_bit_cast(bf16x8, (u4){lw[0], lw[1], lw[2], lw[3]});
#pragma unroll
            for (int nb = 0; nb < 3; ++nb) {
                acc[nb] = __builtin_amdgcn_mfma_f32_16x16x32_bf16(bh[u][nb], xh, acc[nb], 0, 0, 0);
                acc[nb] = __builtin_amdgcn_mfma_f32_16x16x32_bf16(bh[u][nb], xl, acc[nb], 0, 0, 0);
                }
        }
    }
    LAS float* part = lds_f + tg * (64 * 13);
    LAS float* sc = lds_f + 4 * 64 * 13 + tg * (16 * 49);
    LAS int* ent = (LAS int*)(lds_f + 4 * 64 * 13 + 4 * 16 * 49);
    if (kh == 1) {
#pragma unroll
        for (int nb = 0; nb < 3; ++nb)
#pragma unroll
            for (int q = 0; q < 4; ++q) part[lane * 13 + nb * 4 + q] = acc[nb][q];
        part[lane * 13 + 12] = ss;
    }
    __syncthreads();
    if (kh == 0) {
#pragma unroll
        for (int nb = 0; nb < 3; ++nb)
#pragma unroll
            for (int q = 0; q < 4; ++q) acc[nb][q] += part[lane * 13 + nb * 4 + q];
        ss += part[lane * 13 + 12];
        ss += __shfl_xor(ss, 16); ss += __shfl_xor(ss, 32);
        const float r2 = rsqrtf(ss * (1.f / DM) + EPS);
#pragma unroll
        for (int nb = 0; nb < 3; ++nb)
#pragma unroll
            for (int q = 0; q < 4; ++q) sc[fr * 49 + 16 * nb + 4 * fq + q] = acc[nb][q] * r2;
        asm volatile("s_waitcnt lgkmcnt(0)" ::: "memory");
        if (lane < 16) {
            const int t = t0 + lane; LAS const float* lr = sc + lane * 49;
            float lg[4];
#pragma unroll
            for (int g = 0; g < 4; ++g) lg[g] = lr[g] + brg[g];
            int gs = 0; float gm = lg[0];
#pragma unroll
            for (int g = 1; g < 4; ++g) if (lg[g] > gm) { gm = lg[g]; gs = g; }
            float den = 0.f;
#pragma unroll
            for (int g = 0; g < 4; ++g) den += __expf(lg[g] - gm);
            const float pg = 1.f / den;
            float el[8];
#pragma unroll
            for (int i = 0; i < 8; ++i) el[i] = lr[4 + 8 * gs + i] + bre[8 * gs + i];
            int i1 = 0; float v1 = el[0];
#pragma unroll
            for (int i = 1; i < 8; ++i) if (el[i] > v1) { v1 = el[i]; i1 = i; }
            int i2 = -1; float v2 = -3.0e38f;
#pragma unroll
            for (int i = 0; i < 8; ++i) if (i != i1 && el[i] > v2) { v2 = el[i]; i2 = i; }
            const float e2 = __expf(v2 - v1), w0 = pg / (1.f + e2), w1 = pg * e2 / (1.f + e2);
            ent[2 * (tg * 16 + lane)] = gs * 8 + i1; ent[2 * (tg * 16 + lane) + 1] = gs * 8 + i2;
            if (commit) { r2out[t] = r2; wts[2 * t] = w0; wts[2 * t + 1] = w1; }
        }
    }
    __syncthreads();
    if (wave == 0 && lane < NE && commit) {
        int n = 0;
        for (int i = 0; i < 128; ++i) n += (ent[i] == lane) ? 1 : 0;
        if (n) { int k = atomicAdd(&cnt[lane * 64], n);
            for (int i = 0; i < 128; ++i) if (ent[i] == lane) { list[lane * T + k] = 2 * (tb * 64) + i; ++k; } }
    }
    __syncthreads();
}
struct FinalRow { uint4 xv[4]; uint2 pv[4], qv[4]; };
__device__ __forceinline__ void final_load(FinalRow& f, const bf16_t* __restrict__ xb1, const bf16_t* __restrict__ Yb, int t, int lane) {
    const unsigned char* Y = (const unsigned char*)Yb;
    const uint4* x1 = (const uint4*)(xb1 + (size_t)t * DM); const uint2* y0 = (const uint2*)(Y + (size_t)(2 * t) * DM); const uint2* y1 = (const uint2*)(Y + (size_t)(2 * t + 1) * DM);
#pragma unroll
    for (int j = 0; j < 4; ++j) { f.xv[j] = x1[j * 64 + lane]; f.pv[j] = y0[j * 64 + lane]; f.qv[j] = y1[j * 64 + lane]; }
}
__device__ __forceinline__ void final_store(const FinalRow& f, float* __restrict__ out, const float* __restrict__ g, int t, int lane, float delta = 0.f) {
    float4* xw = (float4*)(out + (size_t)t * DM);
    float v[4][8]; float ss = 0.f;
    typedef float f2_t __attribute__((ext_vector_type(2)));
#pragma unroll
    for (int j = 0; j < 4; ++j) { const unsigned xa[4] = {f.xv[j].x, f.xv[j].y, f.xv[j].z, f.xv[j].w};
        const f2_t p01 = __builtin_amdgcn_cvt_pk_f32_fp8((int)f.pv[j].x, false), p23 = __builtin_amdgcn_cvt_pk_f32_fp8((int)f.pv[j].x, true), p45 = __builtin_amdgcn_cvt_pk_f32_fp8((int)f.pv[j].y, false), p67 = __builtin_amdgcn_cvt_pk_f32_fp8((int)f.pv[j].y, true);
        const f2_t q01 = __builtin_amdgcn_cvt_pk_f32_fp8((int)f.qv[j].x, false), q23 = __builtin_amdgcn_cvt_pk_f32_fp8((int)f.qv[j].x, true), q45 = __builtin_amdgcn_cvt_pk_f32_fp8((int)f.qv[j].y, false), q67 = __builtin_amdgcn_cvt_pk_f32_fp8((int)f.qv[j].y, true);
        const float ys[8] = {p01[0] + q01[0], p01[1] + q01[1], p23[0] + q23[0], p23[1] + q23[1], p45[0] + q45[0], p45[1] + q45[1], p67[0] + q67[0], p67[1] + q67[1]};
#pragma unroll
        for (int q = 0; q < 4; ++q) { const float lo = bf2f(xa[q] & 0xffffu) + ys[2 * q] * (1.f / YSCALE8), hi = bf2f(xa[q] >> 16) + ys[2 * q + 1] * (1.f / YSCALE8);
            v[j][2 * q] = lo; v[j][2 * q + 1] = hi; ss += lo * lo + hi * hi; } }
    const float r = rsqrtf(wave_sum(ss) * (1.f / DM) + EPS);
#pragma unroll
    for (int j = 0; j < 4; ++j) { const float4 g0 = ((const float4*)g)[(j * 64 + lane) * 2], g1 = ((const float4*)g)[(j * 64 + lane) * 2 + 1];
        float4 a, b; a.x = v[j][0] * r * g0.x + delta; a.y = v[j][1] * r * g0.y - delta; a.z = v[j][2] * r * g0.z + delta; a.w = v[j][3] * r * g0.w - delta;
        b.x = v[j][4] * r * g1.x + delta; b.y = v[j][5] * r * g1.y - delta; b.z = v[j][6] * r * g1.z + delta; b.w = v[j][7] * r * g1.w - delta;
        xw[(j * 64 + lane) * 2] = a; xw[(j * 64 + lane) * 2 + 1] = b; }
}

constexpr int WC_ITEMS = 3 * NE * 512;
struct WConv {
    unsigned char* dst; int ldd; float sc; bool pending;
    __device__ __forceinline__ void issue(int id, const float* __restrict__ w_gate, const float* __restrict__ w_up, const float* __restrict__ w_down, bf16_t* Wgut, bf16_t* Wdt, unsigned scr32, int lane) {
        const int kq = lane >> 3;
        const float* src; int N, k0, n0;
        if (id < 2 * NE * 512) { const int up = id >= NE * 512, r = id & (NE * 512 - 1), e = r >> 9, q = r & 511; k0 = (q >> 4) * 64; n0 = (q & 15) * 32; N = DEXP; sc = WSCALE8;
            src = (up ? w_up : w_gate) + (size_t)e * DM * DEXP; dst = (unsigned char*)Wgut + (size_t)e * 2 * DEXP * DM + (size_t)gu_row(n0, up) * DM + k0; ldd = DM; }
        else { const int r = id - 2 * NE * 512, e = r >> 9, q = r & 511; k0 = (q >> 6) * 64; n0 = (q & 63) * 32; N = DM; sc = WDSCALE8;
            src = w_down + (size_t)e * DEXP * DM; dst = (unsigned char*)Wdt + (size_t)e * DM * DEXP + (size_t)n0 * DEXP + k0; ldd = DEXP; }
#pragma unroll
        for (int i = 0; i < 8; ++i) { const float* g = src + (size_t)(k0 + 8 * i + kq) * N + n0 + 4 * ((lane & 7) ^ i); unsigned keep_;
            asm volatile("s_mov_b32 %0, m0\n\ts_mov_b32 m0, %2\n\ts_nop 0\n\tglobal_load_lds_dwordx4 %1, off\n\ts_mov_b32 m0, %0" : "=&s"(keep_) : "v"(g), "s"((unsigned)__builtin_amdgcn_readfirstlane((int)(scr32 + i * 1024))) : "memory"); }
        pending = true;
    }
    __device__ __forceinline__ void finish(LAS float* scr, int lane) {
        const int c = lane & 7;
#pragma unroll
        for (int j = 0; j < 4; ++j) { const int n = (lane >> 3) + 8 * j; const LAS float* sp = scr + (8 * c) * 32 + 4 * ((n >> 2) ^ c) + (n & 3);
            float v[8];
#pragma unroll
            for (int q = 0; q < 8; ++q) v[q] = sp[q * 32] * sc;
            int w0 = __builtin_amdgcn_cvt_pk_fp8_f32(v[0], v[1], 0, false); w0 = __builtin_amdgcn_cvt_pk_fp8_f32(v[2], v[3], w0, true);
            int w1 = __builtin_amdgcn_cvt_pk_fp8_f32(v[4], v[5], 0, false); w1 = __builtin_amdgcn_cvt_pk_fp8_f32(v[6], v[7], w1, true);
            *(uint2*)(dst + (size_t)n * ldd + 8 * c) = make_uint2((unsigned)w0, (unsigned)w1); }
        asm volatile("s_waitcnt lgkmcnt(0)" ::: "memory");
        pending = false;
    }
};

namespace att {
typedef float f32x16 __attribute__((ext_vector_type(16)));
typedef short s16x4 __attribute__((ext_vector_type(4)));
typedef short v4i16_t __attribute__((ext_vector_type(4)));
constexpr int SLOT = 16384, L_K = 0, L_V = 2 * SLOT, L_TB = 4 * SLOT, NTB = 576;
constexpr float THR = 8.f;
__device__ __forceinline__ float rowmax32(const f32x16& p0, const f32x16& p1) {
    float a = fmaxf(p0[0], p1[0]);
#pragma unroll
    for (int r = 1; r < 16; ++r) a = fmaxf(fmaxf(a, p0[r]), p1[r]);
    auto rr = __builtin_amdgcn_permlane32_swap(__float_as_uint(a), __float_as_uint(a), false, false);
    return fmaxf(__uint_as_float(rr[0]), __uint_as_float(rr[1]));
}
__device__ __forceinline__ unsigned cvtpk(float lo, float hi) { typedef float f2 __attribute__((ext_vector_type(2))); typedef __bf16 b2 __attribute__((ext_vector_type(2))); f2 v = {lo, hi}; b2 b = __builtin_convertvector(v, b2); return __builtin_bit_cast(unsigned, b); }
__device__ __forceinline__ s16x4 vtr(LAS const unsigned char* p) { return __builtin_bit_cast(s16x4, __builtin_amdgcn_ds_read_tr16_b64_v4i16((LAS v4i16_t*)p)); }

template <class Side> __device__ __forceinline__ void attn_unit(LAS unsigned char* lds, const bf16_t* __restrict__ proj, const float* __restrict__ relb, bf16_t* __restrict__ mix, float* __restrict__ ssA, int b, int h, int cg, Side& side, bool fill_table) {
    const int tid = threadIdx.x, lane = tid & 63, r32 = lane & 31, hi = lane >> 5, w = __builtin_amdgcn_readfirstlane(tid >> 6);
    const int c0 = cg * 4, cq = c0 + (w >> 1), qi = 32 * (w & 1) + r32;
    const int j0 = c0 - 8 < 0 ? 0 : c0 - 8, j1 = c0 + 3;
    const unsigned lds32 = (unsigned)(__UINTPTR_TYPE__)lds;
    LAS float* tb = (LAS float*)(lds + L_TB);
    if (fill_table) for (int i = tid; i < NTB; i += NTHREADS) tb[i] = relb[h * NREL + (i > 512 ? 512 : i)] * LOG2E;
    const size_t tq = (size_t)b * SEQ + (size_t)c0 * 64 + 32 * w + r32;
    bf16x8 qr[4];
#pragma unroll
    for (int d0 = 0; d0 < 4; ++d0) qr[d0] = *(const bf16x8*)(proj + tq * NPROJ + h * HD + d0 * 16 + hi * 8);
    const int krow = 8 * w + (lane >> 3);
    const bf16_t* ksrc = proj + ((size_t)b * SEQ + krow) * NPROJ + DATT + h * HD + (((lane & 7) ^ ((krow >> 1) & 7)) * 8);
    const bf16_t* vsrc = proj + ((size_t)b * SEQ + 16 * (w & 3) + (lane >> 2)) * NPROJ + 2 * DATT + h * HD + (w >> 2) * 32 + (lane & 3) * 8;
#define ATT_GLDS(gsrc, ldsdst) do { unsigned keep_; asm volatile("s_mov_b32 %0, m0\n\ts_mov_b32 m0, %2\n\ts_nop 0\n\tglobal_load_lds_dwordx4 %1, off\n\ts_mov_b32 m0, %0" : "=&s"(keep_) : "v"(gsrc), "s"((unsigned)__builtin_amdgcn_readfirstlane((int)(ldsdst))) : "memory"); } while (0)
#define ATT_DMA1(j, off) do { ATT_GLDS(ksrc + (size_t)(j) * 64 * NPROJ, lds32 + L_K + (off) + w * 1024); ATT_GLDS(vsrc + (size_t)(j) * 64 * NPROJ, lds32 + L_V + (off) + w * 1024); } while (0)
#define ATT_DMA(j, slot) do { ATT_DMA1(j, (slot) * SLOT); ATT_DMA1((j) + 1, (slot) * SLOT + 8192); } while (0)
    int ka[4];
#pragma unroll
    for (int d0 = 0; d0 < 4; ++d0) ka[d0] = r32 * 128 + (((2 * d0 + hi) ^ ((r32 >> 1) & 7)) * 16);
    const int va = ((lane >> 4) & 1) * 32 + (lane & 3) * 8 + (4 * hi + ((lane & 15) >> 2)) * 64;
    float m = -1e30f, l = 0.f; f32x16 o[2];
#pragma unroll
    for (int r = 0; r < 16; ++r) { o[0][r] = 0.f; o[1][r] = 0.f; }
    ATT_DMA(j0, 0);
    for (int js = j0; js <= j1; js += 2) {
        const int slot = ((js - j0) >> 1) & 1;
        unsigned long long tb0_ = 0; if (TSPROBE == 34 || TSPROBE == 35) tb0_ = __builtin_amdgcn_s_memrealtime();
        if (TSPROBE == 35) { asm volatile("s_waitcnt vmcnt(0) lgkmcnt(0)" ::: "memory"); side.twait += __builtin_amdgcn_s_memrealtime() - tb0_; }
        asm volatile("s_waitcnt vmcnt(0) lgkmcnt(0)\n\ts_barrier" ::: "memory");
        if (TSPROBE == 34) side.twait += __builtin_amdgcn_s_memrealtime() - tb0_;
        side.step();
        if (js + 2 <= j1) ATT_DMA(js + 2, slot ^ 1);
#pragma unroll
        for (int half = 0; half < 2; ++half) {
        const int j = js + half, dl = cq - j;
        if (dl >= 0 && dl <= 8) {
            LAS const unsigned char* Ks = lds + L_K + slot * SLOT + half * 8192; LAS const unsigned char* Vs = lds + L_V + slot * SLOT + half * 8192 + va;
            f32x16 p0, p1;
            if (dl <= 4) { LAS const float* tp = tb + (64 * dl + qi + 256 - 4 * hi - 59);
#pragma unroll
                for (int r = 0; r < 16; ++r) { p0[r] = tp[59 - ((r & 3) + 8 * (r >> 2))]; p1[r] = tp[27 - ((r & 3) + 8 * (r >> 2))]; } }
            else { const float bf = tb[NTB - 1];
#pragma unroll
                for (int r = 0; r < 16; ++r) { p0[r] = bf; p1[r] = bf; } }
            { bf16x8 kf[8];
#pragma unroll
              for (int d0 = 0; d0 < 4; ++d0) { kf[2 * d0] = *(LAS const bf16x8*)(Ks + ka[d0]); kf[2 * d0 + 1] = *(LAS const bf16x8*)(Ks + ka[d0] + 4096); }
              __builtin_amdgcn_sched_barrier(0);
#pragma unroll
              for (int d0 = 0; d0 < 4; ++d0) { p0 = __builtin_amdgcn_mfma_f32_32x32x16_bf16(kf[2 * d0], qr[d0], p0, 0, 0, 0); p1 = __builtin_amdgcn_mfma_f32_32x32x16_bf16(kf[2 * d0 + 1], qr[d0], p1, 0, 0, 0); } }
            const float mx = rowmax32(p0, p1);
            if (__any(mx > m + THR)) { const float mn = fmaxf(m, mx), al = __builtin_amdgcn_exp2f(m - mn); m = mn; l *= al;
#pragma unroll
                for (int r = 0; r < 16; ++r) { o[0][r] *= al; o[1][r] *= al; } }
            float rs = 0.f;
#pragma unroll
            for (int r = 0; r < 16; ++r) { p0[r] = __builtin_amdgcn_exp2f(p0[r] - m); p1[r] = __builtin_amdgcn_exp2f(p1[r] - m); rs += p0[r] + p1[r]; }
            l += rs;
            bf16x8 pw[4];
#pragma unroll
            for (int ks = 0; ks < 4; ++ks) { const f32x16& P = ks < 2 ? p0 : p1; const int bo = (ks & 1) * 8; typedef unsigned u4 __attribute__((ext_vector_type(4)));
                u4 t4 = {cvtpk(P[bo], P[bo + 1]), cvtpk(P[bo + 2], P[bo + 3]), cvtpk(P[bo + 4], P[bo + 5]), cvtpk(P[bo + 6], P[bo + 7])}; pw[ks] = __builtin_bit_cast(bf16x8, t4); }
            { s16x4 vl[8], vh[8];
#pragma unroll
              for (int i = 0; i < 8; ++i) { vl[i] = vtr(Vs + (i >> 2) * 4096 + (i & 3) * 1024); vh[i] = vtr(Vs + (i >> 2) * 4096 + (i & 3) * 1024 + 512); }
              __builtin_amdgcn_sched_barrier(0);
#pragma unroll
              for (int i = 0; i < 8; ++i) { const bf16x8 vf = {vl[i][0], vl[i][1], vl[i][2], vl[i][3], vh[i][0], vh[i][1], vh[i][2], vh[i][3]};
                  o[i >> 2] = __builtin_amdgcn_mfma_f32_32x32x16_bf16(vf, pw[i & 3], o[i >> 2], 0, 0, 0); } }
        }
        }
    }
    { auto rr = __builtin_amdgcn_permlane32_swap(__float_as_uint(l), __float_as_uint(l), false, false); l = __uint_as_float(rr[0]) + __uint_as_float(rr[1]); }
    const float il = 1.f / l; float ss = 0.f;
    bf16_t* op = mix + tq * DM + h * HD + 4 * hi;
#pragma unroll
    for (int d0 = 0; d0 < 2; ++d0)
#pragma unroll
        for (int g = 0; g < 4; ++g) { const float v0 = o[d0][4 * g] * il, v1 = o[d0][4 * g + 1] * il, v2 = o[d0][4 * g + 2] * il, v3 = o[d0][4 * g + 3] * il;
            ss += v0 * v0 + v1 * v1 + v2 * v2 + v3 * v3; *(uint2*)(op + 32 * d0 + 8 * g) = make_uint2(cvtpk(v0, v1), cvtpk(v2, v3)); }
    { auto rr = __builtin_amdgcn_permlane32_swap(__float_as_uint(ss), __float_as_uint(ss), false, false); ss = __uint_as_float(rr[0]) + __uint_as_float(rr[1]); }
    if (hi == 0) ssA[tq * 16 + h] = ss;
    asm volatile("s_waitcnt vmcnt(0) lgkmcnt(0)\n\ts_barrier" ::: "memory");
#undef ATT_DMA
#undef ATT_DMA1
#undef ATT_GLDS
}
}

__device__ __forceinline__ void conv_slab(const bf16_t* __restrict__ proj, const float* __restrict__ cw, bf16_t* __restrict__ mix, float* __restrict__ ssC2, int item, int lane) {
    const int slab = item & 1, t0 = (item >> 1) * 16, ch = slab * 512 + lane * 8;
    float w0[8], w1[8], w2[8];
#pragma unroll
    for (int q = 0; q < 2; ++q) { const float4 a = *(const float4*)(cw + ch + 4 * q), b = *(const float4*)(cw + DCONV + ch + 4 * q), c = *(const float4*)(cw + 2 * DCONV + ch + 4 * q);
        w0[4 * q] = a.x; w0[4 * q + 1] = a.y; w0[4 * q + 2] = a.z; w0[4 * q + 3] = a.w; w1[4 * q] = b.x; w1[4 * q + 1] = b.y; w1[4 * q + 2] = b.z; w1[4 * q + 3] = b.w;
        w2[4 * q] = c.x; w2[4 * q + 1] = c.y; w2[4 * q + 2] = c.z; w2[4 * q + 3] = c.w; }
    float z1[8], z2[8];
#pragma unroll
    for (int q = 0; q < 8; ++q) { z1[q] = 0.f; z2[q] = 0.f; }
    if ((t0 & (SEQ - 1)) != 0) {
        const bf16_t* p2 = proj + (size_t)(t0 - 2) * NPROJ; const bf16_t* p1 = proj + (size_t)(t0 - 1) * NPROJ;
        const uint4 c2 = *(const uint4*)(p2 + 4 * DATT + ch), u2 = *(const uint4*)(p2 + 5 * DATT + ch), c1 = *(const uint4*)(p1 + 4 * DATT + ch), u1 = *(const uint4*)(p1 + 5 * DATT + ch);
        const unsigned c2w[4] = {c2.x, c2.y, c2.z, c2.w}, u2w[4] = {u2.x, u2.y, u2.z, u2.w}, c1w[4] = {c1.x, c1.y, c1.z, c1.w}, u1w[4] = {u1.x, u1.y, u1.z, u1.w};
#pragma unroll
        for (int q = 0; q < 4; ++q) { z2[2 * q] = bf2f(c2w[q] & 0xffffu) * bf2f(u2w[q] & 0xffffu); z2[2 * q + 1] = bf2f(c2w[q] >> 16) * bf2f(u2w[q] >> 16);
            z1[2 * q] = bf2f(c1w[q] & 0xffffu) * bf2f(u1w[q] & 0xffffu); z1[2 * q + 1] = bf2f(c1w[q] >> 16) * bf2f(u1w[q] >> 16); }
    }
#pragma unroll 1
    for (int i0 = 0; i0 < 16; i0 += 8) {
    uint4 bv[8], cv[8], uv[8];
#pragma unroll
    for (int i = 0; i < 8; ++i) { const bf16_t* pr = proj + (size_t)(t0 + i0 + i) * NPROJ; bv[i] = *(const uint4*)(pr + 3 * DATT + ch); cv[i] = *(const uint4*)(pr + 4 * DATT + ch); uv[i] = *(const uint4*)(pr + 5 * DATT + ch); }
#pragma unroll
    for (int i = 0; i < 8; ++i) { const int t = t0 + i0 + i;
        const unsigned bw[4] = {bv[i].x, bv[i].y, bv[i].z, bv[i].w}, cw4[4] = {cv[i].x, cv[i].y, cv[i].z, cv[i].w}, uw[4] = {uv[i].x, uv[i].y, uv[i].z, uv[i].w};
        float y[8]; float ss = 0.f;
#pragma unroll
        for (int q = 0; q < 4; ++q) {
            const float za = bf2f(cw4[q] & 0xffffu) * bf2f(uw[q] & 0xffffu), zb = bf2f(cw4[q] >> 16) * bf2f(uw[q] >> 16);
            y[2 * q] = bf2f(bw[q] & 0xffffu) * (w0[2 * q] * z2[2 * q] + w1[2 * q] * z1[2 * q] + w2[2 * q] * za);
            y[2 * q + 1] = bf2f(bw[q] >> 16) * (w0[2 * q + 1] * z2[2 * q + 1] + w1[2 * q + 1] * z1[2 * q + 1] + w2[2 * q + 1] * zb);
            ss += y[2 * q] * y[2 * q] + y[2 * q + 1] * y[2 * q + 1];
            z2[2 * q] = z1[2 * q]; z1[2 * q] = za; z2[2 * q + 1] = z1[2 * q + 1]; z1[2 * q + 1] = zb; }
        *(uint4*)(mix + (size_t)t * DM + DATT + ch) = make_uint4(cvtpk2(y[0], y[1]), cvtpk2(y[2], y[3]), cvtpk2(y[4], y[5]), cvtpk2(y[6], y[7]));
        ss = wave_sum(ss);
        if (lane == 0) ssC2[t * 4 + slab] = ss; }
    }
}

namespace g8 {
typedef unsigned u32x4 __attribute__((ext_vector_type(4)));
typedef int v4i_t __attribute__((ext_vector_type(4)));
typedef int v8i_t __attribute__((ext_vector_type(8)));
constexpr int BM = 256, BK = 64, HALF = 128, HTB = HALF * BK * 2, STAGE_BYTES = 8 * HTB, NXCD = 8, WGM = 8;
__device__ __forceinline__ int lds_byte(int r, int c) { const int st = (r >> 4) * 2 + (c >> 5), rr = r & 15, cc = c & 31, ob = rr * 64 + cc * 2; return st * 1024 + (ob ^ (((ob >> 9) & 1) << 5)); }
__device__ __forceinline__ void stage_rc(int b, int& R, int& C) { const int st = b / 1024, sb = b % 1024, swz = sb ^ (((sb >> 9) & 1) << 5); R = (st >> 1) * 16 + swz / 64; C = (st & 1) * 32 + (swz % 64) / 2; }
__device__ __forceinline__ int perm32(int rho) { const int n = rho >> 4, i = rho & 15; return 8 * (i >> 2) + 4 * n + (i & 3); }
__device__ __forceinline__ unsigned cvt_pk_bf16(float lo, float hi) { unsigned r; asm volatile("v_cvt_pk_bf16_f32 %0, %1, %2" : "=v"(r) : "v"(lo), "v"(hi)); return r; }
__device__ __forceinline__ int xcd_remap(int wgid, int nwg) { const int q = nwg / NXCD, r = nwg % NXCD, xcd = wgid % NXCD, off = wgid / NXCD; return (xcd < r ? xcd * (q + 1) : r * (q + 1) + (xcd - r) * q) + off; }

__device__ __forceinline__ void glds16s(const char* sbase, unsigned voff, unsigned lds_dst) { unsigned keep;
    asm volatile("s_mov_b32 %0, m0\n\ts_mov_b32 m0, %3\n\ts_nop 2\n\tglobal_load_lds_dwordx4 %1, %2\n\ts_mov_b32 m0, %0" : "=&s"(keep) : "v"(voff), "s"(sbase), "s"(lds_dst) : "memory"); }
__device__ __forceinline__ const char* uni64(const char* p) { const unsigned long long v = (unsigned long long)p; const unsigned lo = __builtin_amdgcn_readfirstlane((unsigned)v), hi = __builtin_amdgcn_readfirstlane((unsigned)(v >> 32)); return (const char*)(((unsigned long long)hi << 32) | lo); }
struct Unit { int pm, pn, e, slot; const char* a; const char* b; };

struct DenseOrder {
    const char* A; const char* Bt; int K, nM, nN, nwg, G, c, mul = 1;
    __device__ __forceinline__ void init(const void* A_, const void* Bt_, int M, int N, int K_, int G_, int c_) { A = (const char*)A_; Bt = (const char*)Bt_; K = K_; nM = M / BM; nN = N / BM; nwg = nM * nN; G = G_; c = c_; }
    __device__ __forceinline__ bool next(int i, Unit& u) const {
        int L = i * G + c; if (L >= nwg * mul) return false; L %= nwg;
        const int wgid = xcd_remap(L, nwg);
        const int nig = WGM * nN, gid = wgid / nig, fm = gid * WGM, gsz = (nM - fm) < WGM ? (nM - fm) : WGM;
        u.pm = fm + ((wgid % nig) % gsz); u.pn = (wgid % nig) / gsz; u.e = i; u.slot = i % 3;
        u.a = A + (size_t)u.pm * BM * K * 2; u.b = Bt + (size_t)u.pn * BM * K * 2; return true;
    }
    __device__ __forceinline__ unsigned arow_off(const Unit&, int r, int Kb) const { return (unsigned)r * (unsigned)Kb; }
    const float* rowscale = nullptr; LAS float* rtab = nullptr;
    __device__ __forceinline__ void prefetch(const Unit& u) const { const int r = threadIdx.x; if (r < BM) rtab[u.slot * BM + r] = rowscale[u.pm * BM + r]; }
    __device__ __forceinline__ float scale_of(const Unit& u, int r) const { return rtab[u.slot * BM + r]; }
};
template <bool GATHER> struct MoeOrder {
    const char* A; const char* Bt; const int* list; LAS const int* pl; int K  , NPN, nwg, G, c; size_t estride; int mul;
    LAS int* rinfo; const float* rscale;
    __device__ __forceinline__ bool next(int i, Unit& u) const {
        int L = i * G + c; if (L >= nwg * mul) return false; L %= nwg;
        const int wgid = xcd_remap(L, nwg);
        u.pm = wgid / NPN; u.pn = wgid % NPN; u.e = pl[64 + u.pm]; u.slot = i % 3;
        u.a = GATHER ? A : A + (size_t)u.pm * BM * K; u.b = Bt + (size_t)u.e * estride + (size_t)u.pn * BM * K; return true;
    }
    __device__ __forceinline__ void prefetch(const Unit& u) const {
        const int r = threadIdx.x;
        if (r < BM) { const int slot = u.pm * BM + r - pl[32 + u.e]; int pr = -1; float sc = 0.f;
            if (slot < pl[u.e]) { pr = list[u.e * T + slot]; sc = rscale[GATHER ? (pr >> 1) : pr]; }
            rinfo[(u.slot * BM + r) * 2] = pr; rinfo[(u.slot * BM + r) * 2 + 1] = __float_as_int(sc); }
    }
    __device__ __forceinline__ int pair_of(const Unit& u, int r) const { return rinfo[(u.slot * BM + r) * 2]; }
    __device__ __forceinline__ float scale_of(const Unit& u, int r) const { return __int_as_float(rinfo[(u.slot * BM + r) * 2 + 1]); }
    __device__ __forceinline__ unsigned arow_off(const Unit& u, int r, int Kb) const {
        if (GATHER) { const int pr = pair_of(u, r); return (unsigned)(pr >= 0 ? (pr >> 1) : 0) * (unsigned)Kb; }
        return (unsigned)r * (unsigned)Kb;
    }
};

template <bool GATHER, int ES, class Epi, class Sched>
__device__ __forceinline__ void gemm_phase(LAS unsigned char* lds, const int K, const Sched& S, const Epi& E) {
    int tid_ = threadIdx.x; asm volatile("" : "+v"(tid_));
    const int tid = tid_, wid = __builtin_amdgcn_readfirstlane(tid >> 6), lane = tid & 63, wr = wid >> 2, wc = wid & 3, fr = lane & 15, fq = lane >> 4;
    const int Kb = K * ES, nt = Kb / (BK * 2);
    unsigned voffB[2];
#pragma unroll
    for (int i = 0; i < 2; ++i) { int R, C; stage_rc(tid * 16 + i * 8192, R, C); const int Rb = Epi::PERM ? ((R & ~31) + perm32(R & 31)) : R; voffB[i] = (unsigned)(Rb * Kb + C * 2); }
#define G8_AOFF(u, h, i) ([&]() { int R_, C_; stage_rc(tid * 16 + (i) * 8192, R_, C_); return S.arow_off(u, (h) * HALF + R_, Kb) + (unsigned)(C_ * 2); }())
    const size_t kstep = (size_t)(BK * 2);
    const size_t hstep = (size_t)HALF * Kb;
    const unsigned ldsw = (unsigned)wid * 1024u;
    const unsigned lds32 = (unsigned)(__UINTPTR_TYPE__)lds;
    const int aoff = lds_byte(wr * 64 + fr, fq * 8), boff = lds_byte(wc * 32 + fr, fq * 8);
#define G8_SA(b, h) (((b) * 2 + (h)) * HTB)
#define G8_SB(b, h) ((4 + (b) * 2 + (h)) * HTB)
#define G8_STAGE(bufoff, gbase, voff) do { _Pragma("unroll") for (int _i = 0; _i < 2; ++_i) glds16s((const char*)(gbase), (voff)[_i], lds32 + (unsigned)((bufoff) + _i * 8192) + ldsw); } while (0)
#define G8_LDA(dst, b, h) do { _Pragma("unroll") for (int m = 0; m < 4; ++m) { if (ES == 2) { _Pragma("unroll") for (int k = 0; k < 2; ++k) dst[m][k] = *(const LAS bf16x8*)(lds + G8_SA(b, h) + aoff + m * 2048 + k * 1024); } \
        else dst##8[m] = __builtin_shufflevector(*(const LAS v4i_t*)(lds + G8_SA(b, h) + aoff + m * 2048), *(const LAS v4i_t*)(lds + G8_SA(b, h) + aoff + m * 2048 + 1024), 0, 1, 2, 3, 4, 5, 6, 7); } } while (0)
#define G8_LDB(dst, b, h) do { _Pragma("unroll") for (int n = 0; n < 2; ++n) { if (ES == 2) { _Pragma("unroll") for (int k = 0; k < 2; ++k) dst[n][k] = *(const LAS bf16x8*)(lds + G8_SB(b, h) + boff + n * 2048 + k * 1024); } \
        else dst##8[n] = __builtin_shufflevector(*(const LAS v4i_t*)(lds + G8_SB(b, h) + boff + n * 2048), *(const LAS v4i_t*)(lds + G8_SB(b, h) + boff + n * 2048 + 1024), 0, 1, 2, 3, 4, 5, 6, 7); } } while (0)
#define G8_CAT(x, y) __builtin_shufflevector(__builtin_bit_cast(v4i_t, x), __builtin_bit_cast(v4i_t, y), 0, 1, 2, 3, 4, 5, 6, 7)
#define G8_MMA(ai, bj, At, Bt) do { __builtin_amdgcn_s_setprio(1); _Pragma("unroll") for (int m = 0; m < 4; ++m) _Pragma("unroll") for (int n = 0; n < 2; ++n) { \
        if (ES == 2) { _Pragma("unroll") for (int k = 0; k < 2; ++k) acc[ai][bj][m][n] = __builtin_amdgcn_mfma_f32_16x16x32_bf16(Bt[n][k], At[m][k], acc[ai][bj][m][n], 0, 0, 0); } \
        else asm volatile("v_mfma_scale_f32_16x16x128_f8f6f4 %0, %1, %2, %0, %3, %3 op_sel_hi:[0,0,0]" : "+v"(acc[ai][bj][m][n]) : "v"(Bt##8[n]), "v"(At##8[m]), "v"(scale1)); } \
        __builtin_amdgcn_s_setprio(0); } while (0)
#define G8_WAIT_V(n) asm volatile("s_waitcnt vmcnt(" #n ")" ::: "memory")
#define G8_WAIT_L(n) asm volatile("s_waitcnt lgkmcnt(" #n ")" ::: "memory")
#define G8_BAR __builtin_amdgcn_s_barrier()
#define G8_SCHED __builtin_amdgcn_sched_barrier(0)
    Unit cur, nxt; int ui = 0;
    if (!S.next(0, cur)) return;
    if (GATHER || Epi::ROWINFO) { S.prefetch(cur); __syncthreads(); }
    f32x4 acc[2][2][4][2];
#pragma unroll
    for (int a = 0; a < 2; ++a)
#pragma unroll
        for (int b = 0; b < 2; ++b)
#pragma unroll
            for (int m = 0; m < 4; ++m)
#pragma unroll
                for (int n = 0; n < 2; ++n) acc[a][b][m][n] = (f32x4){0.f, 0.f, 0.f, 0.f};
    bf16x8 At[4][2], B0[2][2], B1[2][2];
    v8i_t At8[4], B08[2], B18[2];
    const int scale1 = 0x7F7F7F7F;
    unsigned vA[2][2];
#pragma unroll
    for (int h = 0; h < 2; ++h)
#pragma unroll
        for (int i = 0; i < 2; ++i) vA[h][i] = G8_AOFF(cur, h, i);
    const char* cA = uni64(cur.a); const char* cB = uni64(cur.b);
    G8_STAGE(G8_SB(0, 0), cB, voffB); G8_STAGE(G8_SB(0, 1), cB + hstep, voffB); G8_STAGE(G8_SA(0, 0), cA, vA[0]); G8_STAGE(G8_SA(0, 1), cA, vA[1]);
    if (wr == 1) G8_BAR;
    G8_WAIT_V(2); G8_BAR;
    G8_STAGE(G8_SB(1, 0), cB + kstep, voffB); G8_STAGE(G8_SA(1, 0), cA + kstep, vA[0]); G8_STAGE(G8_SB(1, 1), cB + hstep + kstep, voffB);
    G8_WAIT_V(6); G8_BAR;
    for (;;) {
        const bool has_next = S.next(ui + 1, nxt);
        const char* nA = has_next ? uni64(nxt.a) : cA; const char* nB = has_next ? uni64(nxt.b) : cB;
        if ((GATHER || Epi::ROWINFO) && has_next) S.prefetch(nxt);
        for (int t = 0; t < nt; t += 2) {
            const bool last = (t == nt - 2);
            if (Epi::MID_T >= 0 && t == Epi::MID_T) E.mid(acc, cur, wr, wc, fr, fq);
            const char* a1 = cA + (size_t)(t + 1) * kstep;
            const char* a2 = last ? nA : cA + (size_t)(t + 2) * kstep; const char* b2 = last ? nB : cB + (size_t)(t + 2) * kstep;
            const char* a3 = a2 + kstep; const char* b3 = b2 + kstep;
            unsigned v2[2][2];
#pragma unroll
            for (int h = 0; h < 2; ++h)
#pragma unroll
                for (int i = 0; i < 2; ++i) v2[h][i] = (GATHER && last && has_next) ? G8_AOFF(nxt, h, i) : vA[h][i];
            G8_LDB(B0, 0, 0); G8_LDB(B1, 0, 1); G8_SCHED; G8_LDA(At, 0, 0); G8_STAGE(G8_SA(1, 1), a1, vA[1]);
            G8_WAIT_V(8); G8_WAIT_L(0); G8_BAR; G8_MMA(0, 0, At, B0); G8_MMA(0, 1, At, B1); G8_BAR; G8_SCHED;
            G8_LDA(At, 0, 1); G8_STAGE(G8_SB(0, 0), b2, voffB); G8_STAGE(G8_SB(0, 1), b2 + hstep, voffB); G8_STAGE(G8_SA(0, 0), a2, v2[0]);
            G8_WAIT_V(8); G8_WAIT_L(0); G8_BAR; G8_MMA(1, 0, At, B0); G8_MMA(1, 1, At, B1); G8_BAR; G8_SCHED;
            G8_LDB(B0, 1, 0); G8_LDB(B1, 1, 1); G8_SCHED; G8_LDA(At, 1, 0); G8_STAGE(G8_SA(0, 1), a2, v2[1]);
            G8_WAIT_V(8); G8_WAIT_L(0); G8_BAR; G8_MMA(0, 0, At, B0); G8_MMA(0, 1, At, B1); G8_BAR; G8_SCHED;
            G8_LDA(At, 1, 1); G8_STAGE(G8_SB(1, 0), b3, voffB); G8_STAGE(G8_SB(1, 1), b3 + hstep, voffB); G8_STAGE(G8_SA(1, 0), a3, v2[0]);
            G8_WAIT_V(8); G8_WAIT_L(0); G8_BAR; G8_MMA(1, 0, At, B0); G8_MMA(1, 1, At, B1); G8_BAR; G8_SCHED;
        }
        if (wr == 0) G8_BAR;
        E(acc, cur, wr, wc, fr, fq);
        if (!has_next) break;
#pragma unroll
        for (int a = 0; a < 2; ++a)
#pragma unroll
            for (int b = 0; b < 2; ++b)
#pragma unroll
                for (int m = 0; m < 4; ++m)
#pragma unroll
                    for (int n = 0; n < 2; ++n) acc[a][b][m][n] = (f32x4){0.f, 0.f, 0.f, 0.f};
        cur = nxt; cA = nA; cB = nB; ++ui;
#pragma unroll
        for (int h = 0; h < 2; ++h)
#pragma unroll
            for (int i = 0; i < 2; ++i) if (GATHER) vA[h][i] = G8_AOFF(cur, h, i);
        if (wr == 1) G8_BAR;
    }
    G8_WAIT_V(0);
    G8_BAR;
#undef G8_SA
#undef G8_SB
#undef G8_STAGE
#undef G8_LDA
#undef G8_LDB
#undef G8_MMA
#undef G8_AOFF
#undef G8_CAT
#undef G8_WAIT_V
#undef G8_WAIT_L
#undef G8_BAR
#undef G8_SCHED
}

template <class Sched> struct EpiProjF { static constexpr bool PERM = true, ROWINFO = true; static constexpr int MID_T = -1; bf16_t* out; const Sched* S;
    __device__ __forceinline__ void mid(f32x4 (&)[2][2][4][2], const Unit&, int, int, int, int) const {}
    __device__ __forceinline__ void operator()(const f32x4 (&acc)[2][2][4][2], const Unit& u, int wr, int wc, int fr, int fq) const {
        const int row0 = u.pm * BM + wr * 64 + fr, col0 = u.pn * BM + wc * 32 + 8 * fq;
#pragma unroll
        for (int ai = 0; ai < 2; ++ai)
#pragma unroll
            for (int m = 0; m < 4; ++m) { const int row = row0 + ai * HALF + m * 16; const float s = S->scale_of(u, ai * HALF + wr * 64 + m * 16 + fr); bf16_t* rowp = out + (size_t)row * NPROJ + col0;
#pragma unroll
                for (int bj = 0; bj < 2; ++bj) { const f32x4 v0 = acc[ai][bj][m][0] * s, v1 = acc[ai][bj][m][1] * s; u32x4 w; w.x = cvt_pk_bf16(v0[0], v0[1]); w.y = cvt_pk_bf16(v0[2], v0[3]); w.z = cvt_pk_bf16(v1[0], v1[1]); w.w = cvt_pk_bf16(v1[2], v1[3]);
                    *(u32x4*)(rowp + bj * HALF) = w; } }
    }
};
struct EpiG2F { static constexpr bool PERM = true, ROWINFO = false; static constexpr int MID_T = DATT / BK; bf16_t* out; LAS const float* tab;
    __device__ __forceinline__ void mid(f32x4 (&acc)[2][2][4][2], const Unit& u, int wr, int wc, int fr, int fq) const {
        LAS const float* tb = tab + (size_t)(u.e) * 512;
#pragma unroll
        for (int ai = 0; ai < 2; ++ai)
#pragma unroll
            for (int m = 0; m < 4; ++m) { const float s = tb[(ai * HALF + wr * 64 + m * 16 + fr) * 2];
#pragma unroll
                for (int bj = 0; bj < 2; ++bj)
#pragma unroll
                    for (int n = 0; n < 2; ++n) acc[ai][bj][m][n] *= s; }
    }
    __device__ __forceinline__ void operator()(const f32x4 (&acc)[2][2][4][2], const Unit& u, int wr, int wc, int fr, int fq) const {
        LAS const float* tb = tab + (size_t)(u.e) * 512;
        const int col0 = u.pn * BM + wc * 32 + 8 * fq;
#pragma unroll
        for (int ai = 0; ai < 2; ++ai)
#pragma unroll
            for (int m = 0; m < 4; ++m) { const int r = ai * HALF + wr * 64 + m * 16 + fr; const float s = tb[r * 2 + 1]; bf16_t* rowp = out + (size_t)(u.pm * BM + r) * DM + col0;
#pragma unroll
                for (int bj = 0; bj < 2; ++bj) { const f32x4 v0 = acc[ai][bj][m][0] * s, v1 = acc[ai][bj][m][1] * s; u32x4 w; w.x = cvt_pk_bf16(v0[0], v0[1]); w.y = cvt_pk_bf16(v0[2], v0[3]); w.z = cvt_pk_bf16(v1[0], v1[1]); w.w = cvt_pk_bf16(v1[2], v1[3]);
                    *(u32x4*)(rowp + bj * HALF) = w; } }
    }
};
template <class Sched> struct EpiGUF { static constexpr bool PERM = true, ROWINFO = true; static constexpr int MID_T = -1; bf16_t* Hb; const Sched* S;
    __device__ __forceinline__ void mid(f32x4 (&)[2][2][4][2], const Unit&, int, int, int, int) const {}
    __device__ __forceinline__ void operator()(const f32x4 (&acc)[2][2][4][2], const Unit& u, int wr, int wc, int fr, int fq) const {
        const int col0 = u.pn * HALF + wc * 32 + 8 * fq;
#pragma unroll
        for (int ai = 0; ai < 2; ++ai)
#pragma unroll
            for (int m = 0; m < 4; ++m) { const int r = ai * HALF + wr * 64 + m * 16 + fr; const float s = S->scale_of(u, r) * (1.f / WSCALE8);
                float h[8];
#pragma unroll
                for (int n = 0; n < 2; ++n)
#pragma unroll
                    for (int q = 0; q < 4; ++q) { const float gg = acc[ai][0][m][n][q] * s, uu = acc[ai][1][m][n][q] * s; h[4 * n + q] = gg * __builtin_amdgcn_rcpf(1.f + __expf(-gg)) * uu; }
                int w0 = __builtin_amdgcn_cvt_pk_fp8_f32(h[0] * HSCALE8, h[1] * HSCALE8, 0, false); w0 = __builtin_amdgcn_cvt_pk_fp8_f32(h[2] * HSCALE8, h[3] * HSCALE8, w0, true);
                int w1 = __builtin_amdgcn_cvt_pk_fp8_f32(h[4] * HSCALE8, h[5] * HSCALE8, 0, false); w1 = __builtin_amdgcn_cvt_pk_fp8_f32(h[6] * HSCALE8, h[7] * HSCALE8, w1, true);
                *(uint2*)((unsigned char*)Hb + (size_t)(u.pm * BM + r) * DEXP + col0) = make_uint2((unsigned)w0, (unsigned)w1); }
    }
};
template <class Sched> struct EpiDownF { static constexpr bool PERM = true, ROWINFO = true; static constexpr int MID_T = -1; unsigned char* Y; const Sched* S;
    __device__ __forceinline__ void mid(f32x4 (&)[2][2][4][2], const Unit&, int, int, int, int) const {}
    __device__ __forceinline__ void operator()(const f32x4 (&acc)[2][2][4][2], const Unit& u, int wr, int wc, int fr, int fq) const {
        const int col0 = u.pn * BM + wc * 32 + 8 * fq;
#pragma unroll
        for (int ai = 0; ai < 2; ++ai)
#pragma unroll
            for (int m = 0; m < 4; ++m) { const int r = ai * HALF + wr * 64 + m * 16 + fr; const int pr = S->pair_of(u, r); if (pr < 0) continue; const float s = S->scale_of(u, r) * (YSCALE8 / (HSCALE8 * WDSCALE8)); unsigned char* rowp = Y + (size_t)pr * DM + col0;
#pragma unroll
                for (int bj = 0; bj < 2; ++bj) { const f32x4 v0 = acc[ai][bj][m][0] * s, v1 = acc[ai][bj][m][1] * s;
                    int w0 = __builtin_amdgcn_cvt_pk_fp8_f32(v0[0], v0[1], 0, false); w0 = __builtin_amdgcn_cvt_pk_fp8_f32(v0[2], v0[3], w0, true);
                    int w1 = __builtin_amdgcn_cvt_pk_fp8_f32(v1[0], v1[1], 0, false); w1 = __builtin_amdgcn_cvt_pk_fp8_f32(v1[2], v1[3], w1, true);
                    *(uint2*)(rowp + bj * HALF) = make_uint2((unsigned)w0, (unsigned)w1); } }
    }
};
}


#define XB_TMO      128
#define XB_XCNT(j)  (256  + 64 * (j))
#define XB_XSUB(j)  (1280 + 64 * (j))
#define XB_XGEN(j)  (2304 + 64 * (j))
#define XB_TOP      3328
#define XB_TOPGEN   3392
#define XCD_BAR_WORDS 3456
#define XB_SPIN_CAP (1u << 20)
__device__ __forceinline__ unsigned xb_ld(unsigned* p)              { return __hip_atomic_load(p, __ATOMIC_RELAXED, __HIP_MEMORY_SCOPE_AGENT); }
__device__ __forceinline__ unsigned xb_add(unsigned* p, unsigned v) { return __hip_atomic_fetch_add(p, v, __ATOMIC_RELAXED, __HIP_MEMORY_SCOPE_AGENT); }
__device__ __forceinline__ unsigned xb_xcc_id() { return (unsigned)__builtin_amdgcn_s_getreg((3 << 11) | 20) & 0xFu; }
#define XB_SPIN(cond, bar) do { unsigned _sp = 0; while (cond) { __builtin_amdgcn_s_sleep(1); \
    if ((++_sp & 255u) == 0u) { if (xb_ld(&(bar)[XB_TMO])) break; if (_sp > XB_SPIN_CAP) { atomicAdd(&(bar)[XB_TMO], 1u); break; } } } } while (0)
struct XcdBarrier { unsigned* bar; unsigned x; volatile LAS unsigned* st; };
__device__ __forceinline__ XcdBarrier xcd_barrier_post(unsigned* bar, volatile LAS unsigned* st) {
    XcdBarrier b; b.bar = bar; b.x = xb_xcc_id(); b.st = st;
    if (threadIdx.x == 0) (void)xb_add(&bar[XB_XCNT(b.x)], 1u);
    return b;
}
__device__ __forceinline__ void xcd_barrier_complete(unsigned* bar, unsigned x, unsigned& nloc, unsigned& nx) {
    const unsigned G = gridDim.x * gridDim.y * gridDim.z;
    unsigned sum, cnt, mine, sp = 0u;
    for (;;) {
        sum = 0u; cnt = 0u; mine = 0u;
#pragma unroll
        for (unsigned j = 0; j < 16; ++j) { const unsigned c = xb_ld(&bar[XB_XCNT(j)]); sum += c; cnt += (c > 0u) ? 1u : 0u; mine = (j == x) ? c : mine; }
        if (sum == G) break;
        __builtin_amdgcn_s_sleep(1);
        if ((++sp & 255u) == 0u) { if (xb_ld(&bar[XB_TMO])) break; if (sp > XB_SPIN_CAP) { atomicAdd(&bar[XB_TMO], 1u); break; } }
    }
    nloc = mine > 0u ? mine : 1u; nx = cnt > 0u ? cnt : 1u;
}
__device__ __forceinline__ void xcd_barrier(const XcdBarrier& b) {
    asm volatile("s_waitcnt vmcnt(0)" ::: "memory");
    __syncthreads();
    if (threadIdx.x == 0) {
        unsigned* bar = b.bar;
        __builtin_amdgcn_s_waitcnt(0);
        unsigned nloc = b.st[0], nx = b.st[1];
        if (nloc == 0u) { xcd_barrier_complete(bar, b.x, nloc, nx); b.st[0] = nloc; b.st[1] = nx; }
        const unsigned old = xb_add(&bar[XB_XSUB(b.x)], 1u);
        const unsigned gen = old / nloc;
        if (old + 1u == (gen + 1u) * nloc) {
            __builtin_amdgcn_fence(__ATOMIC_RELEASE, "agent");
            asm volatile("s_waitcnt vmcnt(0)" ::: "memory");
            const unsigned og = xb_add(&bar[XB_TOP], 1u);
            const unsigned tg = og / nx;
            if (og + 1u == (tg + 1u) * nx) xb_add(&bar[XB_TOPGEN], 1u);
            else XB_SPIN(xb_ld(&bar[XB_TOPGEN]) == tg, bar);
            __builtin_amdgcn_fence(__ATOMIC_ACQUIRE, "agent");
            xb_add(&bar[XB_XGEN(b.x)], 1u);
            asm volatile("s_waitcnt vmcnt(0)" ::: "memory");
        } else {
            XB_SPIN(xb_ld(&bar[XB_XGEN(b.x)]) == gen, bar);
            __builtin_amdgcn_fence(__ATOMIC_ACQUIRE, "agent");
            asm volatile("s_waitcnt vmcnt(0)" ::: "memory");
        }
    }
    __syncthreads();
}

__global__ void __launch_bounds__(NTHREADS, 2) mega(Params p) {
    extern __shared__ __attribute__((aligned(16))) unsigned char lds[];
    volatile LAS unsigned* bst = (volatile LAS unsigned*)(lds + LDS_PLAN_OFF + 1024);
    if (threadIdx.x < 2) bst[threadIdx.x] = 0u;
    __syncthreads();
    const XcdBarrier gbar = xcd_barrier_post((unsigned*)(p.ws + WS_BAR), bst);
    unsigned long long ts0 = 0, ts1 = 0;
    if (p.never) cg::this_grid().sync();
    Ctx c; c.tid = threadIdx.x; c.lane = c.tid & 63; c.wave = __builtin_amdgcn_readfirstlane(c.tid >> 6); c.gw = blockIdx.x * NWAVES + c.wave; c.ngw = gridDim.x * NWAVES;
    char* ws = p.ws;
    int* cnt = (int*)(ws + WS_CTL);
    float* r1 = (float*)(ws + WS_R1); float* r2 = (float*)(ws + WS_R2); float* ssC = (float*)(ws + WS_SSC);
    float* wts = (float*)(ws + WS_WTS); bf16_t* Wrh = (bf16_t*)(ws + WS_WR); bf16_t* Wrl = (bf16_t*)(ws + WS_WR + 256 * 1024); float* ssA = (float*)(ws + WS_SSA); int* list = (int*)(ws + WS_LIST);
    bf16_t* W2t = (bf16_t*)(ws + WS_W2T); bf16_t* W1t = (bf16_t*)(ws + WS_W1T); bf16_t* Wdt = (bf16_t*)(ws + WS_WDT); bf16_t* Wgut = (bf16_t*)(ws + WS_WGUT);
    bf16_t* xb = (bf16_t*)(ws + WS_XB); bf16_t* mix = (bf16_t*)(ws + WS_MIX); bf16_t* proj = (bf16_t*)(ws + WS_PROJ); bf16_t* Y = (bf16_t*)(ws + WS_Y); bf16_t* Hb = (bf16_t*)(ws + WS_H);
    unsigned char* xf8 = (unsigned char*)(ws + WS_WGUT + 64 * MiB);
    bf16_t* dlt = (bf16_t*)(ws + WS_PROJ);

    TS0(1) TS0(8)
    {
        for (int row = c.gw; row < T * PMUL(10); row += 2 * c.ngw) {
            const int ra = row % T, rb = (row + c.ngw) % T; const bool hb = row + c.ngw < T * PMUL(10);
            const float4* xa = (const float4*)(p.x + (size_t)ra * DM); const float4* xc = (const float4*)(p.x + (size_t)rb * DM);
            float4 va[8], vb[8];
#pragma unroll
            for (int j = 0; j < 8; ++j) { va[j] = xa[j * 64 + c.lane]; if (hb) vb[j] = xc[j * 64 + c.lane]; }
            float sa = 0.f, sb = 0.f; uint2* oa = (uint2*)(xb + (size_t)ra * DM); uint2* ob = (uint2*)(xb + (size_t)rb * DM);
#pragma unroll
            for (int j = 0; j < 8; ++j) { sa += va[j].x * va[j].x + va[j].y * va[j].y + va[j].z * va[j].z + va[j].w * va[j].w; oa[j * 64 + c.lane] = make_uint2(cvtpk2(va[j].x, va[j].y), cvtpk2(va[j].z, va[j].w)); }
            if (hb) {
#pragma unroll
                for (int j = 0; j < 8; ++j) { sb += vb[j].x * vb[j].x + vb[j].y * vb[j].y + vb[j].z * vb[j].z + vb[j].w * vb[j].w; ob[j * 64 + c.lane] = make_uint2(cvtpk2(vb[j].x, vb[j].y), cvtpk2(vb[j].z, vb[j].w)); } }
            sa = wave_sum(sa); sb = wave_sum(sb);
            if (c.lane == 0) { r1[ra] = rsqrtf(sa * (1.f / DM) + EPS); if (hb) r1[rb] = rsqrtf(sb * (1.f / DM) + EPS); }
        }
        LAS float* scr = (LAS float*)lds + c.wave * (64 * 65);
        constexpr int I_IN = (DM / 64) * (NPROJ / 64), I_OUT = (DM / 64) * (DM / 64);
        constexpr int NIT = I_IN + I_OUT;
        for (int it = c.gw; it < NIT * PMUL(10); it += c.ngw) {
            int r = it % NIT;
            if (r < I_IN) { const int nb = NPROJ / 64, kb = r / nb, n0 = (r % nb) * 64; p0_titem(p.w_in, NPROJ, p.norm1, W1t, DM, kb * 64, n0, n0, scr, c.lane, n0 < DATT ? QSCALE : 1.f); continue; } r -= I_IN;
            { const int nb = DM / 64, kb = r / nb, n0 = (r % nb) * 64, k0 = kb * 64;
                const float* g = k0 < DATT ? p.g_oa + k0 : p.g_oc + (k0 - DATT);
                p0_titem(p.w_out + (size_t)k0 * DM, DM, g, W2t + k0, DM, 0, n0, n0, scr, c.lane); }
        }
        for (int i = blockIdx.x * NTHREADS + c.tid; i < 48 * DM; i += gridDim.x * NTHREADS) { const int o = i / DM, k = i % DM; const float w = o < 36 ? (o < 4 ? p.w_rg[k * 4 + o] : p.w_re[k * 32 + (o - 4)]) : 0.f;
            const unsigned h = f2bf(w); Wrh[i] = (bf16_t)h; Wrl[i] = (bf16_t)f2bf(w - bf2f(h)); }
    }
    xcd_barrier(gbar);
    TS1(1) TS0(2)
    {
        g8::DenseOrder S; S.init(xb, W1t, T, NPROJ, DM, (int)gridDim.x, (int)blockIdx.x); S.mul = PMUL(1);
        S.rowscale = r1; S.rtab = (LAS float*)(lds + 131072);
        const g8::EpiProjF<g8::DenseOrder> E{proj, &S};
        g8::gemm_phase<false, 2>((LAS unsigned char*)lds, DM, S, E);
    }
    xcd_barrier(gbar);
    TS1(2) TS0(3)
    {
        struct Side { WConv wc; unsigned long long twait; int s, gw, ngw, nper, lane; LAS float* scr; unsigned scr32; const float *wg, *wu, *wd; bf16_t* Wgut; bf16_t* Wdt;
            __device__ __forceinline__ void step() { if (wc.pending) wc.finish(scr, lane);
                if (s < nper) { const int id = gw + ngw * s; ++s; if (id < WC_ITEMS) wc.issue(id, wg, wu, wd, Wgut, Wdt, scr32, lane); } }
            __device__ __forceinline__ void whole() { step(); asm volatile("s_waitcnt vmcnt(0)" ::: "memory"); } };
        Side side; side.twait = 0; side.wc.pending = false; side.s = 0; side.gw = c.gw; side.ngw = c.ngw; side.nper = (WC_ITEMS + c.ngw - 1) / c.ngw; side.lane = c.lane;
        side.scr = (LAS float*)(lds + 69632) + c.wave * (64 * 32); side.scr32 = (unsigned)(__UINTPTR_TYPE__)((LAS unsigned char*)lds + 69632) + c.wave * 8192;
        side.wg = p.w_gate; side.wu = p.w_up; side.wd = p.w_down; side.Wgut = Wgut; side.Wdt = Wdt;
        for (int u1 = blockIdx.x; u1 < NB * NH * 4 * PMUL(2); u1 += gridDim.x) { const int u0 = u1 % (NB * NH * 4); const int bh = u0 >> 2;
            for (int i = 0; i < 4; ++i) att::attn_unit((LAS unsigned char*)lds, proj, p.relb, mix, ssA, bh >> 4, bh & 15, (u0 & 3) + 4 * i, side, i == 0); }
        if (TSPROBE == 34 || TSPROBE == 35) { ts0 = 0; ts1 = side.twait; }
        while (side.wc.pending || side.s < side.nper) side.whole();
        for (int it = c.gw; it < (T / 16) * 2 * PMUL(21); it += c.ngw) conv_slab(proj, p.conv_w, mix, ssC, it % ((T / 16) * 2), c.lane);
    }
    xcd_barrier(gbar);
    TS1(3) TS0(4)
    {
        g8::DenseOrder S; S.init(mix, W2t, T, DM, DM, (int)gridDim.x, (int)blockIdx.x); S.mul = PMUL(3);
        LAS float* tab = (LAS float*)(lds + 131072);
        g8::Unit u;
        for (int i = 0; i < 4; ++i) if (S.next(i, u) && c.tid < 256) { const int row = u.pm * 256 + c.tid; float sa = 0.f;
#pragma unroll
            for (int h = 0; h < 16; ++h) sa += ssA[row * 16 + h];
            const float4 sc4 = *(const float4*)(ssC + row * 4); const float ra = rsqrtf(sa * (1.f / DATT) + EPS), rc = rsqrtf((sc4.x + sc4.y) * (1.f / DCONV) + EPS);
            tab[(i * 256 + c.tid) * 2] = ra / rc; tab[(i * 256 + c.tid) * 2 + 1] = rc; }
        __syncthreads();
        const g8::EpiG2F E{dlt, tab};
        g8::gemm_phase<false, 2>((LAS unsigned char*)lds, DM, S, E);
    }
    xcd_barrier(gbar);
    TS1(4) TS0(5)
    for (int it = blockIdx.x; it < (T / 64) * PMUL(4); it += gridDim.x) router_block(p.x, dlt, p.norm2, xb, xf8, Wrh, Wrl, p.b_rg, p.b_re, cnt, list, wts, r2, it % (T / 64), c.wave, c.lane, (LAS float*)lds, it < T / 64);
    xcd_barrier(gbar);
    TS1(5) TS0(6)
    LAS int* pl = (LAS int*)(lds + LDS_PLAN_OFF);
    if (c.tid < 64) {
        const int ce = c.tid < NE ? cnt[c.tid * 64] : 0, mt = (ce + 255) >> 8;
        int inc = mt;
#pragma unroll
        for (int o = 1; o < 32; o <<= 1) { const int v = __shfl_up(inc, o); if (c.lane >= o) inc += v; }
        if (c.tid < NE) { pl[c.tid] = ce; pl[32 + c.tid] = (inc - mt) * 256; }
        if (c.tid == NE - 1) pl[224] = inc;
    }
    __syncthreads();
    if (c.tid < NTILEMAX) { int e = -1;
        for (int q = 0; q < NE; ++q) { const int st = pl[32 + q] >> 8, mt = (pl[q] + 255) >> 8; if (c.tid >= st && c.tid < st + mt) e = q; }
        pl[64 + c.tid] = e; }
    __syncthreads();
    const int ntile = pl[224];
    {
        const g8::MoeOrder<true> S{(const char*)xf8, (const char*)Wgut, list, pl, DM  , 4, ntile * 4, (int)gridDim.x, (int)blockIdx.x, (size_t)2 * DEXP * DM, PMUL(5), (LAS int*)(lds + 131072), r2};
        const g8::EpiGUF<g8::MoeOrder<true>> E{Hb, &S};
        g8::gemm_phase<true, 1>((LAS unsigned char*)lds, DM, S, E);
    }
    xcd_barrier(gbar);
    TS1(6) TS0(7)
    {
        const g8::MoeOrder<false> S{(const char*)Hb, (const char*)Wdt, list, pl, DEXP  , 8, ntile * 8, (int)gridDim.x, (int)blockIdx.x, (size_t)DM * DEXP, PMUL(6), (LAS int*)(lds + 131072), wts};
        const g8::EpiDownF<g8::MoeOrder<false>> E{(unsigned char*)Y, &S};
        g8::gemm_phase<false, 1>((LAS unsigned char*)lds, DEXP, S, E);
    }
    xcd_barrier(gbar);
    TS1(7) TS1(8)
    if (PROBE == 9) { for (int i = 0; i < 8; ++i) xcd_barrier(gbar); }
    const float tsdelta = TSPROBE ? sqrtf((float)(ts1 - ts0) * 0.01f) * 1e-3f : 0.f;
    {
        const unsigned long long tp6 = (TSPROBE == 9) ? __builtin_amdgcn_s_memrealtime() : 0ull;
        FinalRow fa, fb;
        int t = c.gw;
        if (t < T) final_load(fa, xb, Y, t, c.lane);
        for (; t < T; t += 2 * c.ngw) {
            const int t2 = t + c.ngw, t3 = t + 2 * c.ngw;
            if (t2 < T) final_load(fb, xb, Y, t2, c.lane);
            final_store(fa, p.out, p.norm_f, t, c.lane, (TSPROBE == 9) ? sqrtf((float)(__builtin_amdgcn_s_memrealtime() - tp6) * 0.01f) * 1e-3f : tsdelta);
            if (t3 < T) final_load(fa, xb, Y, t3, c.lane);
            if (t2 < T) final_store(fb, p.out, p.norm_f, t2, c.lane, (TSPROBE == 9) ? sqrtf((float)(__builtin_amdgcn_s_memrealtime() - tp6) * 0.01f) * 1e-3f : tsdelta);
        }
    }
}

extern "C" void kernel_launch(void* const* d_in, const int* in_sizes, int n_in, void* d_out, int out_size, void* d_ws, size_t ws_size, hipStream_t stream) {
    static int grid = 0;
    if (grid == 0) {
        int dev = 0, cus = 0, per_cu = 0;
        if (ws_size < WS_END || n_in != 17) { fprintf(stderr, "kernel_launch: unexpected sizes (ws %zu)\n", ws_size); grid = -1; return; }
        (void)hipGetDevice(&dev); (void)hipDeviceGetAttribute(&cus, hipDeviceAttributeMultiprocessorCount, dev);
        if (hipFuncSetAttribute((const void*)mega, hipFuncAttributeMaxDynamicSharedMemorySize, LDS_BYTES) != hipSuccess) { fprintf(stderr, "hipFuncSetAttribute failed\n"); grid = -1; return; }
        if (hipOccupancyMaxActiveBlocksPerMultiprocessor(&per_cu, (const void*)mega, NTHREADS, LDS_BYTES) != hipSuccess || per_cu < 1) { fprintf(stderr, "occupancy query failed (%d)\n", per_cu); grid = -1; return; }
        grid = cus * per_cu;
        fprintf(stderr, "kernel_launch: cus %d per_cu %d grid %d\n", cus, per_cu, grid);
    }
    if (grid < 0) return;
    if (hipMemsetAsync((char*)d_ws + WS_CTL, 0, 64 * 1024, stream) != hipSuccess) { fprintf(stderr, "memset failed\n"); return; }
    Params p{};
    p.x = (const float*)d_in[0]; p.norm1 = (const float*)d_in[1]; p.w_in = (const float*)d_in[2]; p.relb = (const float*)d_in[3];
    p.conv_w = (const float*)d_in[4]; p.g_oa = (const float*)d_in[5]; p.g_oc = (const float*)d_in[6]; p.w_out = (const float*)d_in[7];
    p.norm2 = (const float*)d_in[8]; p.w_rg = (const float*)d_in[9]; p.b_rg = (const float*)d_in[10]; p.w_re = (const float*)d_in[11];
    p.b_re = (const float*)d_in[12]; p.w_gate = (const float*)d_in[13]; p.w_up = (const float*)d_in[14]; p.w_down = (const float*)d_in[15];
    p.norm_f = (const float*)d_in[16]; p.out = (float*)d_out; p.ws = (char*)d_ws;
    void* args[] = {&p};
    hipError_t e = hipLaunchCooperativeKernel((const void*)mega, dim3(grid), dim3(NTHREADS), args, LDS_BYTES, stream);
    if (e != hipSuccess) fprintf(stderr, "cooperative launch failed: %s (grid %d)\n", hipGetErrorString(e), grid);
}
```

```cpp
#include <hip/hip_runtime.h>
#include <hip/hip_cooperative_groups.h>
#include <stdint.h>
#include <cstdio>
namespace cg = cooperative_groups;
#ifndef PROBE
#define PROBE 0
#endif
#define PMUL(k) ((PROBE) == (k) ? 2 : 1)
#ifndef TSPROBE
#define TSPROBE 0
#endif
#define TS0(k) if (TSPROBE == (k)) ts0 = __builtin_amdgcn_s_memrealtime();
#define TS1(k) if (TSPROBE == (k)) ts1 = __builtin_amdgcn_s_memrealtime();

typedef unsigned short bf16_t;
typedef short bf16x8 __attribute__((ext_vector_type(8)));
typedef float f32x4 __attribute__((ext_vector_type(4)));

constexpr int NB = 4, SEQ = 4096, T = NB * SEQ, DM = 2048, DATT = 1024, DCONV = 1024, NPROJ = 6144;
constexpr int NH = 16, HD = 64, NREL = 513, NE = 32, DEXP = 512, NPAIR = 2 * T;
constexpr int NPADMAX = 40960, NTILEMAX = NPADMAX / 256;
constexpr float EPS = 1e-6f;
constexpr float YSCALE8 = 64.f;
constexpr float HSCALE8 = 8.f, WDSCALE8 = 32.f;
constexpr float WSCALE8 = 64.f;
constexpr float LOG2E = 1.4426950408889634f, QSCALE = 0.125f * LOG2E;

constexpr size_t MiB = 1u << 20;
constexpr size_t WS_CTL = 0;
constexpr size_t WS_BAR = 16 * 1024;
constexpr size_t WS_PLAN = 64 * 1024;
constexpr size_t WS_R1 = 128 * 1024;
constexpr size_t WS_RA = 192 * 1024;
constexpr size_t WS_RC = 256 * 1024;
constexpr size_t WS_R2 = 320 * 1024;
constexpr size_t WS_SSC = 3 * MiB;
constexpr size_t WS_WTS = 512 * 1024;
constexpr size_t WS_ROWPAIR = 640 * 1024;
constexpr size_t WS_WR = 1 * MiB;
constexpr size_t WS_SSA = 2 * MiB;
constexpr size_t WS_LIST = 5 * MiB;
constexpr size_t WS_W2T = 8 * MiB;
constexpr size_t WS_W1T = 16 * MiB;
constexpr size_t WS_WDT = 40 * MiB;
constexpr size_t WS_WGUT = 104 * MiB;
constexpr size_t WS_XB = 232 * MiB;
constexpr size_t WS_MIX = 296 * MiB;
constexpr size_t WS_PROJ = 360 * MiB;
constexpr size_t WS_Y = 360 * MiB;
constexpr size_t WS_H = 488 * MiB;
constexpr size_t WS_END = 552 * MiB;

__device__ __forceinline__ unsigned f2bf(float f) { unsigned u = __float_as_uint(f); return (u + 0x7fffu + ((u >> 16) & 1u)) >> 16; }
__device__ __forceinline__ unsigned pk2(float lo, float hi) { return f2bf(lo) | (f2bf(hi) << 16); }
__device__ __forceinline__ unsigned cvtpk2(float lo, float hi) { typedef float f2 __attribute__((ext_vector_type(2))); typedef __bf16 b2 __attribute__((ext_vector_type(2))); f2 v = {lo, hi}; b2 r = __builtin_convertvector(v, b2); return __builtin_bit_cast(unsigned, r); }
__device__ __forceinline__ int gu_row(int n, int up) { return ((n >> 7) << 8) + (n & 127) + (up ? 128 : 0); }
__device__ __forceinline__ float bf2f(unsigned h) { return __uint_as_float(h << 16); }
__device__ __forceinline__ float wave_sum(float v) {
#pragma unroll
    for (int o = 1; o < 64; o <<= 1) v += __shfl_xor(v, o);
    return v;
}


#define LAS __attribute__((address_space(3)))
constexpr int NWAVES = 8, NTHREADS = 512;
constexpr int LDS_BYTES = 147456;
constexpr int LDS_PLAN_OFF = 140 * 1024;

struct Params {
    const float *x, *norm1, *w_in, *relb, *conv_w, *g_oa, *g_oc, *w_out, *norm2, *w_rg, *b_rg, *w_re, *b_re, *w_gate, *w_up, *w_down, *norm_f;
    float* out; char* ws; int never; int pad;
};
struct Ctx { int tid, lane, wave, gw, ngw; };

__device__ __forceinline__ void p0_titem(const float* __restrict__ W, int N, const float* __restrict__ g, bf16_t* __restrict__ WT, int ldd, int k0, int n0, int drow0, LAS float* scr, int lane, float cs = 1.f) {
    const int kq = lane >> 4, n4 = (lane & 15) * 4;
    float4 v[16]; float gs[16];
#pragma unroll
    for (int i = 0; i < 16; ++i) v[i] = *(const float4*)(W + (size_t)(k0 + 4 * i + kq) * N + n0 + n4);
#pragma unroll
    for (int i = 0; i < 16; ++i) gs[i] = (g ? g[k0 + 4 * i + kq] : 1.f) * cs;
#pragma unroll
    for (int i = 0; i < 16; ++i) { LAS float* d = scr + (4 * i + kq) * 65 + n4; d[0] = v[i].x * gs[i]; d[1] = v[i].y * gs[i]; d[2] = v[i].z * gs[i]; d[3] = v[i].w * gs[i]; }
    asm volatile("s_waitcnt lgkmcnt(0)" ::: "memory");
    const int c = lane & 7;
#pragma unroll
    for (int j = 0; j < 8; ++j) { const int n = (lane >> 3) + 8 * j; const LAS float* sp = scr + (8 * c) * 65 + n;
        uint4 o; o.x = cvtpk2(sp[0 * 65], sp[1 * 65]); o.y = cvtpk2(sp[2 * 65], sp[3 * 65]); o.z = cvtpk2(sp[4 * 65], sp[5 * 65]); o.w = cvtpk2(sp[6 * 65], sp[7 * 65]);
        *(uint4*)(WT + (size_t)(drow0 + n) * ldd + k0 + 8 * c) = o; }
    asm volatile("s_waitcnt lgkmcnt(0)" ::: "memory");
}

__device__ __forceinline__ void router_block(const float* __restrict__ g2, const bf16_t* __restrict__ xb1, unsigned char* __restrict__ xf8, const bf16_t* __restrict__ Wrh, const bf16_t* __restrict__ Wrl,
                                             const float* __restrict__ brg, const float* __restrict__ bre, int* __restrict__ cnt, int* __restrict__ list, float* __restrict__ wts, float* __restrict__ r2out,
                                             int tb, int wave, int lane, LAS float* lds_f, bool commit) {
    const int fr = lane & 15, fq = lane >> 4, tg = wave & 3, kh = wave >> 2, t0 = tb * 64 + tg * 16;
    const size_t aoff = (size_t)(t0 + fr) * DM + kh * (DM / 2) + 8 * fq;
    const bf16_t* xr = xb1 + aoff; unsigned char* x8 = xf8 + aoff; const float* gr = g2 + kh * (DM / 2) + 8 * fq;
    const bf16_t* wh = Wrh + (size_t)fr * DM + kh * (DM / 2) + 8 * fq; const bf16_t* wl = Wrl + (size_t)fr * DM + kh * (DM / 2) + 8 * fq;
    f32x4 acc[3]; float ss = 0.f;
#pragma unroll
    for (int nb = 0; nb < 3; ++nb) acc[nb] = (f32x4){0.f, 0.f, 0.f, 0.f};
    typedef unsigned u4 __attribute__((ext_vector_type(4)));
    for (int ks0 = 0; ks0 < DM / 64; ks0 += 4) {
        uint4 dl[4]; bf16x8 bh[4][3];
#pragma unroll
        for (int u = 0; u < 4; ++u) dl[u] = *(const uint4*)(xr + (ks0 + u) * 32);
#pragma unroll
        for (int u = 0; u < 4; ++u)
#pragma unroll
            for (int nb = 0; nb < 3; ++nb) { bh[u][nb] = *(const bf16x8*)(wh + (size_t)nb * 16 * DM + (ks0 + u) * 32); }
#pragma unroll
        for (int u = 0; u < 4; ++u) {
            const unsigned dw[4] = {dl[u].x, dl[u].y, dl[u].z, dl[u].w};
            const float xv[8] = {bf2f(dw[0] & 0xffffu), bf2f(dw[0] >> 16), bf2f(dw[1] & 0xffffu), bf2f(dw[1] >> 16), bf2f(dw[2] & 0xffffu), bf2f(dw[2] >> 16), bf2f(dw[3] & 0xffffu), bf2f(dw[3] >> 16)};
            const float4 ga = *(const float4*)(gr + (ks0 + u) * 32), gb = *(const float4*)(gr + (ks0 + u) * 32 + 4);
            const float yv[8] = {xv[0] * ga.x, xv[1] * ga.y, xv[2] * ga.z, xv[3] * ga.w, xv[4] * gb.x, xv[5] * gb.y, xv[6] * gb.z, xv[7] * gb.w};
            unsigned hw[4], lw[4];
#pragma unroll
            for (int q = 0; q < 4; ++q) { const unsigned h = cvtpk2(yv[2 * q], yv[2 * q + 1]); hw[q] = h;
                lw[q] = cvtpk2(yv[2 * q] - __uint_as_float(h << 16), yv[2 * q + 1] - __uint_as_float(h & 0xffff0000u)); ss += xv[2 * q] * xv[2 * q] + xv[2 * q + 1] * xv[2 * q + 1]; }
            if (commit) {
                int f0 = __builtin_amdgcn_cvt_pk_fp8_f32(yv[0], yv[1], 0, false); f0 = __builtin_amdgcn_cvt_pk_fp8_f32(yv[2], yv[3], f0, true);
                int f1 = __builtin_amdgcn_cvt_pk_fp8_f32(yv[4], yv[5], 0, false); f1 = __builtin_amdgcn_cvt_pk_fp8_f32(yv[6], yv[7], f1, true);
                *(uint2*)(x8 + (ks0 + u) * 32) = make_uint2((unsigned)f0, (unsigned)f1); }
            const bf16x8 xh = __builtin_bit_cast(bf16x8, (u4){hw[0], hw[1], hw[2], hw[3]}), xl = __builtin_bit_cast(bf16x8, (u4){lw[0], lw[1], lw[2], lw[3]});
#pragma unroll
            for (int nb = 0; nb < 3; ++nb) {
                acc[nb] = __builtin_amdgcn_mfma_f32_16x16x32_bf16(bh[u][nb], xh, acc[nb], 0, 0, 0);
                acc[nb] = __builtin_amdgcn_mfma_f32_16x16x32_bf16(bh[u][nb], xl, acc[nb], 0, 0, 0);
                }
        }
    }
    LAS float* part = lds_f + tg * (64 * 13);
    LAS float* sc = lds_f + 4 * 64 * 13 + tg * (16 * 49);
    LAS int* ent = (LAS int*)(lds_f + 4 * 64 * 13 + 4 * 16 * 49);
    if (kh == 1) {
#pragma unroll
        for (int nb = 0; nb < 3; ++nb)
#pragma unroll
            for (int q = 0; q < 4; ++q) part[lane * 13 + nb * 4 + q] = acc[nb][q];
        part[lane * 13 + 12] = ss;
    }
    __syncthreads();
    if (kh == 0) {
#pragma unroll
        for (int nb = 0; nb < 3; ++nb)
#pragma unroll
            for (int q = 0; q < 4; ++q) acc[nb][q] += part[lane * 13 + nb * 4 + q];
        ss += part[lane * 13 + 12];
        ss += __shfl_xor(ss, 16); ss += __shfl_xor(ss, 32);
        const float r2 = rsqrtf(ss * (1.f / DM) + EPS);
#pragma unroll
        for (int nb = 0; nb < 3; ++nb)
#pragma unroll
            for (int q = 0; q < 4; ++q) sc[fr * 49 + 16 * nb + 4 * fq + q] = acc[nb][q] * r2;
        asm volatile("s_waitcnt lgkmcnt(0)" ::: "memory");
        if (lane < 16) {
            const int t = t0 + lane; LAS const float* lr = sc + lane * 49;
            float lg[4];
#pragma unroll
            for (int g = 0; g < 4; ++g) lg[g] = lr[g] + brg[g];
            int gs = 0; float gm = lg[0];
#pragma unroll
            for (int g = 1; g < 4; ++g) if (lg[g] > gm) { gm = lg[g]; gs = g; }
            float den = 0.f;
#pragma unroll
            for (int g = 0; g < 4; ++g) den += __expf(lg[g] - gm);
            const float pg = 1.f / den;
            float el[8];
#pragma unroll
            for (int i = 0; i < 8; ++i) el[i] = lr[4 + 8 * gs + i] + bre[8 * gs + i];
            int i1 = 0; float v1 = el[0];
#pragma unroll
            for (int i = 1; i < 8; ++i) if (el[i] > v1) { v1 = el[i]; i1 = i; }
            int i2 = -1; float v2 = -3.0e38f;
#pragma unroll
            for (int i = 0; i < 8; ++i) if (i != i1 && el[i] > v2) { v2 = el[i]; i2 = i; }
            const float e2 = __expf(v2 - v1), w0 = pg / (1.f + e2), w1 = pg * e2 / (1.f + e2);
            ent[2 * (tg * 16 + lane)] = gs * 8 + i1; ent[2 * (tg * 16 + lane) + 1] = gs * 8 + i2;
            if (commit) { r2out[t] = r2; wts[2 * t] = w0; wts[2 * t + 1] = w1; }
        }
    }
    __syncthreads();
    if (wave == 0 && lane < NE && commit) {
        int n = 0;
        for (int i = 0; i < 128; ++i) n += (ent[i] == lane) ? 1 : 0;
        if (n) { int k = atomicAdd(&cnt[lane * 64], n);
            for (int i = 0; i < 128; ++i) if (ent[i] == lane) { list[lane * T + k] = 2 * (tb * 64) + i; ++k; } }
    }
    __syncthreads();
}
struct FinalRow { uint4 xv[4]; uint2 pv[4], qv[4]; };
__device__ __forceinline__ void final_load(FinalRow& f, const bf16_t* __restrict__ xb1, const bf16_t* __restrict__ Yb, int t, int lane) {
    const unsigned char* Y = (const unsigned char*)Yb;
    const uint4* x1 = (const uint4*)(xb1 + (size_t)t * DM); const uint2* y0 = (const uint2*)(Y + (size_t)(2 * t) * DM); const uint2* y1 = (const uint2*)(Y + (size_t)(2 * t + 1) * DM);
#pragma unroll
    for (int j = 0; j < 4; ++j) { f.xv[j] = x1[j * 64 + lane]; f.pv[j] = y0[j * 64 + lane]; f.qv[j] = y1[j * 64 + lane]; }
}
__device__ __forceinline__ void final_store(const FinalRow& f, float* __restrict__ out, const float* __restrict__ g, int t, int lane, float delta = 0.f) {
    float4* xw = (float4*)(out + (size_t)t * DM);
    float v[4][8]; float ss = 0.f;
    typedef float f2_t __attribute__((ext_vector_type(2)));
#pragma unroll
    for (int j = 0; j < 4; ++j) { const unsigned xa[4] = {f.xv[j].x, f.xv[j].y, f.xv[j].z, f.xv[j].w};
        const f2_t p01 = __builtin_amdgcn_cvt_pk_f32_fp8((int)f.pv[j].x, false), p23 = __builtin_amdgcn_cvt_pk_f32_fp8((int)f.pv[j].x, true), p45 = __builtin_amdgcn_cvt_pk_f32_fp8((int)f.pv[j].y, false), p67 = __builtin_amdgcn_cvt_pk_f32_fp8((int)f.pv[j].y, true);
        const f2_t q01 = __builtin_amdgcn_cvt_pk_f32_fp8((int)f.qv[j].x, false), q23 = __builtin_amdgcn_cvt_pk_f32_fp8((int)f.qv[j].x, true), q45 = __builtin_amdgcn_cvt_pk_f32_fp8((int)f.qv[j].y, false), q67 = __builtin_amdgcn_cvt_pk_f32_fp8((int)f.qv[j].y, true);
        const float ys[8] = {p01[0] + q01[0], p01[1] + q01[1], p23[0] + q23[0], p23[1] + q23[1], p45[0] + q45[0], p45[1] + q45[1], p67[0] + q67[0], p67[1] + q67[1]};
#pragma unroll
        for (int q = 0; q < 4; ++q) { const float lo = bf2f(xa[q] & 0xffffu) + ys[2 * q] * (1.f / YSCALE8), hi = bf2f(xa[q] >> 16) + ys[2 * q + 1] * (1.f / YSCALE8);
            v[j][2 * q] = lo; v[j][2 * q + 1] = hi; ss += lo * lo + hi * hi; } }
    const float r = rsqrtf(wave_sum(ss) * (1.f / DM) + EPS);
#pragma unroll
    for (int j = 0; j < 4; ++j) { const float4 g0 = ((const float4*)g)[(j * 64 + lane) * 2], g1 = ((const float4*)g)[(j * 64 + lane) * 2 + 1];
        float4 a, b; a.x = v[j][0] * r * g0.x + delta; a.y = v[j][1] * r * g0.y - delta; a.z = v[j][2] * r * g0.z + delta; a.w = v[j][3] * r * g0.w - delta;
        b.x = v[j][4] * r * g1.x + delta; b.y = v[j][5] * r * g1.y - delta; b.z = v[j][6] * r * g1.z + delta; b.w = v[j][7] * r * g1.w - delta;
        xw[(j * 64 + lane) * 2] = a; xw[(j * 64 + lane) * 2 + 1] = b; }
}

constexpr int WC_ITEMS = 3 * NE * 512;
struct WConv {
    unsigned char* dst; int ldd; float sc; bool pending;
    __device__ __forceinline__ void issue(int id, const float* __restrict__ w_gate, const float* __restrict__ w_up, const float* __restrict__ w_down, bf16_t* Wgut, bf16_t* Wdt, unsigned scr32, int lane) {
        const int kq = lane >> 3;
        const float* src; int N, k0, n0;
        if (id < 2 * NE * 512) { const int up = id >= NE * 512, r = id & (NE * 512 - 1), e = r >> 9, q = r & 511; k0 = (q >> 4) * 64; n0 = (q & 15) * 32; N = DEXP; sc = WSCALE8;
            src = (up ? w_up : w_gate) + (size_t)e * DM * DEXP; dst = (unsigned char*)Wgut + (size_t)e * 2 * DEXP * DM + (size_t)gu_row(n0, up) * DM + k0; ldd = DM; }
        else { const int r = id - 2 * NE * 512, e = r >> 9, q = r & 511; k0 = (q >> 6) * 64; n0 = (q & 63) * 32; N = DM; sc = WDSCALE8;
            src = w_down + (size_t)e * DEXP * DM; dst = (unsigned char*)Wdt + (size_t)e * DM * DEXP + (size_t)n0 * DEXP + k0; ldd = DEXP; }
#pragma unroll
        for (int i = 0; i < 8; ++i) { const float* g = src + (size_t)(k0 + 8 * i + kq) * N + n0 + 4 * ((lane & 7) ^ i); unsigned keep_;
            asm volatile("s_mov_b32 %0, m0\n\ts_mov_b32 m0, %2\n\ts_nop 0\n\tglobal_load_lds_dwordx4 %1, off\n\ts_mov_b32 m0, %0" : "=&s"(keep_) : "v"(g), "s"((unsigned)__builtin_amdgcn_readfirstlane((int)(scr32 + i * 1024))) : "memory"); }
        pending = true;
    }
    __device__ __forceinline__ void finish(LAS float* scr, int lane) {
        const int c = lane & 7;
#pragma unroll
        for (int j = 0; j < 4; ++j) { const int n = (lane >> 3) + 8 * j; const LAS float* sp = scr + (8 * c) * 32 + 4 * ((n >> 2) ^ c) + (n & 3);
            float v[8];
#pragma unroll
            for (int q = 0; q < 8; ++q) v[q] = sp[q * 32] * sc;
            int w0 = __builtin_amdgcn_cvt_pk_fp8_f32(v[0], v[1], 0, false); w0 = __builtin_amdgcn_cvt_pk_fp8_f32(v[2], v[3], w0, true);
            int w1 = __builtin_amdgcn_cvt_pk_fp8_f32(v[4], v[5], 0, false); w1 = __builtin_amdgcn_cvt_pk_fp8_f32(v[6], v[7], w1, true);
            *(uint2*)(dst + (size_t)n * ldd + 8 * c) = make_uint2((unsigned)w0, (unsigned)w1); }
        asm volatile("s_waitcnt lgkmcnt(0)" ::: "memory");
        pending = false;
    }
};

namespace att {
typedef float f32x16 __attribute__((ext_vector_type(16)));
typedef short s16x4 __attribute__((ext_vector_type(4)));
typedef short v4i16_t __attribute__((ext_vector_type(4)));
constexpr int SLOT = 16384, L_K = 0, L_V = 2 * SLOT, L_TB = 4 * SLOT, NTB = 576;
constexpr float THR = 8.f;
__device__ __forceinline__ float rowmax32(const f32x16& p0, const f32x16& p1) {
    float a = fmaxf(p0[0], p1[0]);
#pragma unroll
    for (int r = 1; r < 16; ++r) a = fmaxf(fmaxf(a, p0[r]), p1[r]);
    auto rr = __builtin_amdgcn_permlane32_swap(__float_as_uint(a), __float_as_uint(a), false, false);
    return fmaxf(__uint_as_float(rr[0]), __uint_as_float(rr[1]));
}
__device__ __forceinline__ unsigned cvtpk(float lo, float hi) { typedef float f2 __attribute__((ext_vector_type(2))); typedef __bf16 b2 __attribute__((ext_vector_type(2))); f2 v = {lo, hi}; b2 b = __builtin_convertvector(v, b2); return __builtin_bit_cast(unsigned, b); }
__device__ __forceinline__ s16x4 vtr(LAS const unsigned char* p) { return __builtin_bit_cast(s16x4, __builtin_amdgcn_ds_read_tr16_b64_v4i16((LAS v4i16_t*)p)); }

template <class Side> __device__ __forceinline__ void attn_unit(LAS unsigned char* lds, const bf16_t* __restrict__ proj, const float* __restrict__ relb, bf16_t* __restrict__ mix, float* __restrict__ ssA, int b, int h, int cg, Side& side, bool fill_table) {
    const int tid = threadIdx.x, lane = tid & 63, r32 = lane & 31, hi = lane >> 5, w = __builtin_amdgcn_readfirstlane(tid >> 6);
    const int c0 = cg * 4, cq = c0 + (w >> 1), qi = 32 * (w & 1) + r32;
    const int j0 = c0 - 8 < 0 ? 0 : c0 - 8, j1 = c0 + 3;
    const unsigned lds32 = (unsigned)(__UINTPTR_TYPE__)lds;
    LAS float* tb = (LAS float*)(lds + L_TB);
    if (fill_table) for (int i = tid; i < NTB; i += NTHREADS) tb[i] = relb[h * NREL + (i > 512 ? 512 : i)] * LOG2E;
    const size_t tq = (size_t)b * SEQ + (size_t)c0 * 64 + 32 * w + r32;
    bf16x8 qr[4];
#pragma unroll
    for (int d0 = 0; d0 < 4; ++d0) qr[d0] = *(const bf16x8*)(proj + tq * NPROJ + h * HD + d0 * 16 + hi * 8);
    const int krow = 8 * w + (lane >> 3);
    const bf16_t* ksrc = proj + ((size_t)b * SEQ + krow) * NPROJ + DATT + h * HD + (((lane & 7) ^ ((krow >> 1) & 7)) * 8);
    const bf16_t* vsrc = proj + ((size_t)b * SEQ + 16 * (w & 3) + (lane >> 2)) * NPROJ + 2 * DATT + h * HD + (w >> 2) * 32 + (lane & 3) * 8;
#define ATT_GLDS(gsrc, ldsdst) do { unsigned keep_; asm volatile("s_mov_b32 %0, m0\n\ts_mov_b32 m0, %2\n\ts_nop 0\n\tglobal_load_lds_dwordx4 %1, off\n\ts_mov_b32 m0, %0" : "=&s"(keep_) : "v"(gsrc), "s"((unsigned)__builtin_amdgcn_readfirstlane((int)(ldsdst))) : "memory"); } while (0)
#define ATT_DMA1(j, off) do { ATT_GLDS(ksrc + (size_t)(j) * 64 * NPROJ, lds32 + L_K + (off) + w * 1024); ATT_GLDS(vsrc + (size_t)(j) * 64 * NPROJ, lds32 + L_V + (off) + w * 1024); } while (0)
#define ATT_DMA(j, slot) do { ATT_DMA1(j, (slot) * SLOT); ATT_DMA1((j) + 1, (slot) * SLOT + 8192); } while (0)
    int ka[4];
#pragma unroll
    for (int d0 = 0; d0 < 4; ++d0) ka[d0] = r32 * 128 + (((2 * d0 + hi) ^ ((r32 >> 1) & 7)) * 16);
    const int va = ((lane >> 4) & 1) * 32 + (lane & 3) * 8 + (4 * hi + ((lane & 15) >> 2)) * 64;
    float m = -1e30f, l = 0.f; f32x16 o[2];
#pragma unroll
    for (int r = 0; r < 16; ++r) { o[0][r] = 0.f; o[1][r] = 0.f; }
    ATT_DMA(j0, 0);
    for (int js = j0; js <= j1; js += 2) {
        const int slot = ((js - j0) >> 1) & 1;
        unsigned long long tb0_ = 0; if (TSPROBE == 34 || TSPROBE == 35) tb0_ = __builtin_amdgcn_s_memrealtime();
        if (TSPROBE == 35) { asm volatile("s_waitcnt vmcnt(0) lgkmcnt(0)" ::: "memory"); side.twait += __builtin_amdgcn_s_memrealtime() - tb0_; }
        asm volatile("s_waitcnt vmcnt(0) lgkmcnt(0)\n\ts_barrier" ::: "memory");
        if (TSPROBE == 34) side.twait += __builtin_amdgcn_s_memrealtime() - tb0_;
        side.step();
        if (js + 2 <= j1) ATT_DMA(js + 2, slot ^ 1);
#pragma unroll
        for (int half = 0; half < 2; ++half) {
        const int j = js + half, dl = cq - j;
        if (dl >= 0 && dl <= 8) {
            LAS const unsigned char* Ks = lds + L_K + slot * SLOT + half * 8192; LAS const unsigned char* Vs = lds + L_V + slot * SLOT + half * 8192 + va;
            f32x16 p0, p1;
            if (dl <= 4) { LAS const float* tp = tb + (64 * dl + qi + 256 - 4 * hi - 59);
#pragma unroll
                for (int r = 0; r < 16; ++r) { p0[r] = tp[59 - ((r & 3) + 8 * (r >> 2))]; p1[r] = tp[27 - ((r & 3) + 8 * (r >> 2))]; } }
            else { const float bf = tb[NTB - 1];
#pragma unroll
                for (int r = 0; r < 16; ++r) { p0[r] = bf; p1[r] = bf; } }
            { bf16x8 kf[8];
#pragma unroll
              for (int d0 = 0; d0 < 4; ++d0) { kf[2 * d0] = *(LAS const bf16x8*)(Ks + ka[d0]); kf[2 * d0 + 1] = *(LAS const bf16x8*)(Ks + ka[d0] + 4096); }
              __builtin_amdgcn_sched_barrier(0);
#pragma unroll
              for (int d0 = 0; d0 < 4; ++d0) { p0 = __builtin_amdgcn_mfma_f32_32x32x16_bf16(kf[2 * d0], qr[d0], p0, 0, 0, 0); p1 = __builtin_amdgcn_mfma_f32_32x32x16_bf16(kf[2 * d0 + 1], qr[d0], p1, 0, 0, 0); } }
            const float mx = rowmax32(p0, p1);
            if (__any(mx > m + THR)) { const float mn = fmaxf(m, mx), al = __builtin_amdgcn_exp2f(m - mn); m = mn; l *= al;
#pragma unroll
                for (int r = 0; r < 16; ++r) { o[0][r] *= al; o[1][r] *= al; } }
            float rs = 0.f;
#pragma unroll
            for (int r = 0; r < 16; ++r) { p0[r] = __builtin_amdgcn_exp2f(p0[r] - m); p1[r] = __builtin_amdgcn_exp2f(p1[r] - m); rs += p0[r] + p1[r]; }
            l += rs;
            bf16x8 pw[4];
#pragma unroll
            for (int ks = 0; ks < 4; ++ks) { const f32x16& P = ks < 2 ? p0 : p1; const int bo = (ks & 1) * 8; typedef unsigned u4 __attribute__((ext_vector_type(4)));
                u4 t4 = {cvtpk(P[bo], P[bo + 1]), cvtpk(P[bo + 2], P[bo + 3]), cvtpk(P[bo + 4], P[bo + 5]), cvtpk(P[bo + 6], P[bo + 7])}; pw[ks] = __builtin_bit_cast(bf16x8, t4); }
            { s16x4 vl[8], vh[8];
#pragma unroll
              for (int i = 0; i < 8; ++i) { vl[i] = vtr(Vs + (i >> 2) * 4096 + (i & 3) * 1024); vh[i] = vtr(Vs + (i >> 2) * 4096 + (i & 3) * 1024 + 512); }
              __builtin_amdgcn_sched_barrier(0);
#pragma unroll
              for (int i = 0; i < 8; ++i) { const bf16x8 vf = {vl[i][0], vl[i][1], vl[i][2], vl[i][3], vh[i][0], vh[i][1], vh[i][2], vh[i][3]};
                  o[i >> 2] = __builtin_amdgcn_mfma_f32_32x32x16_bf16(vf, pw[i & 3], o[i >> 2], 0, 0, 0); } }
        }
        }
    }
    { auto rr = __builtin_amdgcn_permlane32_swap(__float_as_uint(l), __float_as_uint(l), false, false); l = __uint_as_float(rr[0]) + __uint_as_float(rr[1]); }
    const float il = 1.f / l; float ss = 0.f;
    bf16_t* op = mix + tq * DM + h * HD + 4 * hi;
#pragma unroll
    for (int d0 = 0; d0 < 2; ++d0)
#pragma unroll
        for (int g = 0; g < 4; ++g) { const float v0 = o[d0][4 * g] * il, v1 = o[d0][4 * g + 1] * il, v2 = o[d0][4 * g + 2] * il, v3 = o[d0][4 * g + 3] * il;
            ss += v0 * v0 + v1 * v1 + v2 * v2 + v3 * v3; *(uint2*)(op + 32 * d0 + 8 * g) = make_uint2(cvtpk(v0, v1), cvtpk(v2, v3)); }
    { auto rr = __builtin_amdgcn_permlane32_swap(__float_as_uint(ss), __float_as_uint(ss), false, false); ss = __uint_as_float(rr[0]) + __uint_as_float(rr[1]); }
    if (hi == 0) ssA[tq * 16 + h] = ss;
    asm volatile("s_waitcnt vmcnt(0) lgkmcnt(0)\n\ts_barrier" ::: "memory");
#undef ATT_DMA
#undef ATT_DMA1
#undef ATT_GLDS
}
}

__device__ __forceinline__ void conv_slab(const bf16_t* __restrict__ proj, const float* __restrict__ cw, bf16_t* __restrict__ mix, float* __restrict__ ssC2, int item, int lane) {
    const int slab = item & 1, t0 = (item >> 1) * 16, ch = slab * 512 + lane * 8;
    float w0[8], w1[8], w2[8];
#pragma unroll
    for (int q = 0; q < 2; ++q) { const float4 a = *(const float4*)(cw + ch + 4 * q), b = *(const float4*)(cw + DCONV + ch + 4 * q), c = *(const float4*)(cw + 2 * DCONV + ch + 4 * q);
        w0[4 * q] = a.x; w0[4 * q + 1] = a.y; w0[4 * q + 2] = a.z; w0[4 * q + 3] = a.w; w1[4 * q] = b.x; w1[4 * q + 1] = b.y; w1[4 * q + 2] = b.z; w1[4 * q + 3] = b.w;
        w2[4 * q] = c.x; w2[4 * q + 1] = c.y; w2[4 * q + 2] = c.z; w2[4 * q + 3] = c.w; }
    float z1[8], z2[8];
#pragma unroll
    for (int q = 0; q < 8; ++q) { z1[q] = 0.f; z2[q] = 0.f; }
    if ((t0 & (SEQ - 1)) != 0) {
        const bf16_t* p2 = proj + (size_t)(t0 - 2) * NPROJ; const bf16_t* p1 = proj + (size_t)(t0 - 1) * NPROJ;
        const uint4 c2 = *(const uint4*)(p2 + 4 * DATT + ch), u2 = *(const uint4*)(p2 + 5 * DATT + ch), c1 = *(const uint4*)(p1 + 4 * DATT + ch), u1 = *(const uint4*)(p1 + 5 * DATT + ch);
        const unsigned c2w[4] = {c2.x, c2.y, c2.z, c2.w}, u2w[4] = {u2.x, u2.y, u2.z, u2.w}, c1w[4] = {c1.x, c1.y, c1.z, c1.w}, u1w[4] = {u1.x, u1.y, u1.z, u1.w};
#pragma unroll
        for (int q = 0; q < 4; ++q) { z2[2 * q] = bf2f(c2w[q] & 0xffffu) * bf2f(u2w[q] & 0xffffu); z2[2 * q + 1] = bf2f(c2w[q] >> 16) * bf2f(u2w[q] >> 16);
            z1[2 * q] = bf2f(c1w[q] & 0xffffu) * bf2f(u1w[q] & 0xffffu); z1[2 * q + 1] = bf2f(c1w[q] >> 16) * bf2f(u1w[q] >> 16); }
    }
#pragma unroll 1
    for (int i0 = 0; i0 < 16; i0 += 8) {
    uint4 bv[8], cv[8], uv[8];
#pragma unroll
    for (int i = 0; i < 8; ++i) { const bf16_t* pr = proj + (size_t)(t0 + i0 + i) * NPROJ; bv[i] = *(const uint4*)(pr + 3 * DATT + ch); cv[i] = *(const uint4*)(pr + 4 * DATT + ch); uv[i] = *(const uint4*)(pr + 5 * DATT + ch); }
#pragma unroll
    for (int i = 0; i < 8; ++i) { const int t = t0 + i0 + i;
        const unsigned bw[4] = {bv[i].x, bv[i].y, bv[i].z, bv[i].w}, cw4[4] = {cv[i].x, cv[i].y, cv[i].z, cv[i].w}, uw[4] = {uv[i].x, uv[i].y, uv[i].z, uv[i].w};
        float y[8]; float ss = 0.f;
#pragma unroll
        for (int q = 0; q < 4; ++q) {
            const float za = bf2f(cw4[q] & 0xffffu) * bf2f(uw[q] & 0xffffu), zb = bf2f(cw4[q] >> 16) * bf2f(uw[q] >> 16);
            y[2 * q] = bf2f(bw[q] & 0xffffu) * (w0[2 * q] * z2[2 * q] + w1[2 * q] * z1[2 * q] + w2[2 * q] * za);
            y[2 * q + 1] = bf2f(bw[q] >> 16) * (w0[2 * q + 1] * z2[2 * q + 1] + w1[2 * q + 1] * z1[2 * q + 1] + w2[2 * q + 1] * zb);
            ss += y[2 * q] * y[2 * q] + y[2 * q + 1] * y[2 * q + 1];
            z2[2 * q] = z1[2 * q]; z1[2 * q] = za; z2[2 * q + 1] = z1[2 * q + 1]; z1[2 * q + 1] = zb; }
        *(uint4*)(mix + (size_t)t * DM + DATT + ch) = make_uint4(cvtpk2(y[0], y[1]), cvtpk2(y[2], y[3]), cvtpk2(y[4], y[5]), cvtpk2(y[6], y[7]));
        ss = wave_sum(ss);
        if (lane == 0) ssC2[t * 4 + slab] = ss; }
    }
}

namespace g8 {
typedef unsigned u32x4 __attribute__((ext_vector_type(4)));
typedef int v4i_t __attribute__((ext_vector_type(4)));
typedef int v8i_t __attribute__((ext_vector_type(8)));
constexpr int BM = 256, BK = 64, HALF = 128, HTB = HALF * BK * 2, STAGE_BYTES = 8 * HTB, NXCD = 8, WGM = 8;
__device__ __forceinline__ int lds_byte(int r, int c) { const int st = (r >> 4) * 2 + (c >> 5), rr = r & 15, cc = c & 31, ob = rr * 64 + cc * 2; return st * 1024 + (ob ^ (((ob >> 9) & 1) << 5)); }
__device__ __forceinline__ void stage_rc(int b, int& R, int& C) { const int st = b / 1024, sb = b % 1024, swz = sb ^ (((sb >> 9) & 1) << 5); R = (st >> 1) * 16 + swz / 64; C = (st & 1) * 32 + (swz % 64) / 2; }
__device__ __forceinline__ int perm32(int rho) { const int n = rho >> 4, i = rho & 15; return 8 * (i >> 2) + 4 * n + (i & 3); }
__device__ __forceinline__ unsigned cvt_pk_bf16(float lo, float hi) { unsigned r; asm volatile("v_cvt_pk_bf16_f32 %0, %1, %2" : "=v"(r) : "v"(lo), "v"(hi)); return r; }
__device__ __forceinline__ int xcd_remap(int wgid, int nwg) { const int q = nwg / NXCD, r = nwg % NXCD, xcd = wgid % NXCD, off = wgid / NXCD; return (xcd < r ? xcd * (q + 1) : r * (q + 1) + (xcd - r) * q) + off; }

struct Unit { int pm, pn, e, slot; const char* a; const char* b; };

struct DenseOrder {
    const char* A; const char* Bt; int K, nM, nN, nwg, G, c, mul = 1;
    __device__ __forceinline__ void init(const void* A_, const void* Bt_, int M, int N, int K_, int G_, int c_) { A = (const char*)A_; Bt = (const char*)Bt_; K = K_; nM = M / BM; nN = N / BM; nwg = nM * nN; G = G_; c = c_; }
    __device__ __forceinline__ bool next(int i, Unit& u) const {
        int L = i * G + c; if (L >= nwg * mul) return false; L %= nwg;
        const int wgid = xcd_remap(L, nwg);
        const int nig = WGM * nN, gid = wgid / nig, fm = gid * WGM, gsz = (nM - fm) < WGM ? (nM - fm) : WGM;
        u.pm = fm + ((wgid % nig) % gsz); u.pn = (wgid % nig) / gsz; u.e = i; u.slot = i % 3;
        u.a = A + (size_t)u.pm * BM * K * 2; u.b = Bt + (size_t)u.pn * BM * K * 2; return true;
    }
    __device__ __forceinline__ unsigned arow_off(const Unit&, int r, int Kb) const { return (unsigned)r * (unsigned)Kb; }
    const float* rowscale = nullptr; LAS float* rtab = nullptr;
    __device__ __forceinline__ void prefetch(const Unit& u) const { const int r = threadIdx.x; if (r < BM) rtab[u.slot * BM + r] = rowscale[u.pm * BM + r]; }
    __device__ __forceinline__ float scale_of(const Unit& u, int r) const { return rtab[u.slot * BM + r]; }
};
template <bool GATHER> struct MoeOrder {
    const char* A; const char* Bt; const int* list; LAS const int* pl; int K  , NPN, nwg, G, c; size_t estride; int mul;
    LAS int* rinfo; const float* rscale;
    __device__ __forceinline__ bool next(int i, Unit& u) const {
        int L = i * G + c; if (L >= nwg * mul) return false; L %= nwg;
        const int wgid = xcd_remap(L, nwg);
        u.pm = wgid / NPN; u.pn = wgid % NPN; u.e = pl[64 + u.pm]; u.slot = i % 3;
        u.a = GATHER ? A : A + (size_t)u.pm * BM * K; u.b = Bt + (size_t)u.e * estride + (size_t)u.pn * BM * K; return true;
    }
    __device__ __forceinline__ void prefetch(const Unit& u) const {
        const int r = threadIdx.x;
        if (r < BM) { const int slot = u.pm * BM + r - pl[32 + u.e]; int pr = -1; float sc = 0.f;
            if (slot < pl[u.e]) { pr = list[u.e * T + slot]; sc = rscale[GATHER ? (pr >> 1) : pr]; }
            rinfo[(u.slot * BM + r) * 2] = pr; rinfo[(u.slot * BM + r) * 2 + 1] = __float_as_int(sc); }
    }
    __device__ __forceinline__ int pair_of(const Unit& u, int r) const { return rinfo[(u.slot * BM + r) * 2]; }
    __device__ __forceinline__ float scale_of(const Unit& u, int r) const { return __int_as_float(rinfo[(u.slot * BM + r) * 2 + 1]); }
    __device__ __forceinline__ unsigned arow_off(const Unit& u, int r, int Kb) const {
        if (GATHER) { const int pr = pair_of(u, r); return (unsigned)(pr >= 0 ? (pr >> 1) : 0) * (unsigned)Kb; }
        return (unsigned)r * (unsigned)Kb;
    }
};

template <bool GATHER, int ES, class Epi, class Sched>
__device__ __forceinline__ void gemm_phase(LAS unsigned char* lds, const int K, const Sched& S, const Epi& E) {
    int tid_ = threadIdx.x; asm volatile("" : "+v"(tid_));
    const int tid = tid_, wid = __builtin_amdgcn_readfirstlane(tid >> 6), lane = tid & 63, wr = wid >> 2, wc = wid & 3, fr = lane & 15, fq = lane >> 4;
    const int Kb = K * ES, nt = Kb / (BK * 2);
    unsigned voffB[2];
#pragma unroll
    for (int i = 0; i < 2; ++i) { int R, C; stage_rc(tid * 16 + i * 8192, R, C); const int Rb = Epi::PERM ? ((R & ~31) + perm32(R & 31)) : R; voffB[i] = (unsigned)(Rb * Kb + C * 2); }
#define G8_AOFF(u, h, i) ([&]() { int R_, C_; stage_rc(tid * 16 + (i) * 8192, R_, C_); return S.arow_off(u, (h) * HALF + R_, Kb) + (unsigned)(C_ * 2); }())
    const size_t kstep = (size_t)(BK * 2);
    const size_t hstep = (size_t)HALF * Kb;
    const unsigned ldsw = (unsigned)wid * 1024u;
    const int aoff = lds_byte(wr * 64 + fr, fq * 8), boff = lds_byte(wc * 32 + fr, fq * 8);
#define G8_SA(b, h) (((b) * 2 + (h)) * HTB)
#define G8_SB(b, h) ((4 + (b) * 2 + (h)) * HTB)
#define G8_STAGE(bufoff, gbase, voff) do { _Pragma("unroll") for (int _i = 0; _i < 2; ++_i) \
        __builtin_amdgcn_global_load_lds((const unsigned*)((const char*)(gbase) + (voff)[_i]), (LAS unsigned*)(lds + (bufoff) + ldsw + _i * 8192), 16, 0, 0); } while (0)
#define G8_LDA(dst, b, h) do { _Pragma("unroll") for (int m = 0; m < 4; ++m) { if (ES == 2) { _Pragma("unroll") for (int k = 0; k < 2; ++k) dst[m][k] = *(const LAS bf16x8*)(lds + G8_SA(b, h) + aoff + m * 2048 + k * 1024); } \
        else dst##8[m] = __builtin_shufflevector(*(const LAS v4i_t*)(lds + G8_SA(b, h) + aoff + m * 2048), *(const LAS v4i_t*)(lds + G8_SA(b, h) + aoff + m * 2048 + 1024), 0, 1, 2, 3, 4, 5, 6, 7); } } while (0)
#define G8_LDB(dst, b, h) do { _Pragma("unroll") for (int n = 0; n < 2; ++n) { if (ES == 2) { _Pragma("unroll") for (int k = 0; k < 2; ++k) dst[n][k] = *(const LAS bf16x8*)(lds + G8_SB(b, h) + boff + n * 2048 + k * 1024); } \
        else dst##8[n] = __builtin_shufflevector(*(const LAS v4i_t*)(lds + G8_SB(b, h) + boff + n * 2048), *(const LAS v4i_t*)(lds + G8_SB(b, h) + boff + n * 2048 + 1024), 0, 1, 2, 3, 4, 5, 6, 7); } } while (0)
#define G8_CAT(x, y) __builtin_shufflevector(__builtin_bit_cast(v4i_t, x), __builtin_bit_cast(v4i_t, y), 0, 1, 2, 3, 4, 5, 6, 7)
#define G8_MMA(ai, bj, At, Bt) do { __builtin_amdgcn_s_setprio(1); _Pragma("unroll") for (int m = 0; m < 4; ++m) _Pragma("unroll") for (int n = 0; n < 2; ++n) { \
        if (ES == 2) { _Pragma("unroll") for (int k = 0; k < 2; ++k) acc[ai][bj][m][n] = __builtin_amdgcn_mfma_f32_16x16x32_bf16(Bt[n][k], At[m][k], acc[ai][bj][m][n], 0, 0, 0); } \
        else asm volatile("v_mfma_scale_f32_16x16x128_f8f6f4 %0, %1, %2, %0, %3, %3 op_sel_hi:[0,0,0]" : "+v"(acc[ai][bj][m][n]) : "v"(Bt##8[n]), "v"(At##8[m]), "v"(scale1)); } \
        __builtin_amdgcn_s_setprio(0); } while (0)
#define G8_WAIT_V(n) asm volatile("s_waitcnt vmcnt(" #n ")" ::: "memory")
#define G8_WAIT_L(n) asm volatile("s_waitcnt lgkmcnt(" #n ")" ::: "memory")
#define G8_BAR __builtin_amdgcn_s_barrier()
#define G8_SCHED __builtin_amdgcn_sched_barrier(0)
    Unit cur, nxt; int ui = 0;
    if (!S.next(0, cur)) return;
    if (GATHER || Epi::ROWINFO) { S.prefetch(cur); __syncthreads(); }
    f32x4 acc[2][2][4][2];
#pragma unroll
    for (int a = 0; a < 2; ++a)
#pragma unroll
        for (int b = 0; b < 2; ++b)
#pragma unroll
            for (int m = 0; m < 4; ++m)
#pragma unroll
                for (int n = 0; n < 2; ++n) acc[a][b][m][n] = (f32x4){0.f, 0.f, 0.f, 0.f};
    bf16x8 At[4][2], B0[2][2], B1[2][2];
    v8i_t At8[4], B08[2], B18[2];
    const int scale1 = 0x7F7F7F7F;
    unsigned vA[2][2];
#pragma unroll
    for (int h = 0; h < 2; ++h)
#pragma unroll
        for (int i = 0; i < 2; ++i) vA[h][i] = G8_AOFF(cur, h, i);
    const char* cA = cur.a; const char* cB = cur.b;
    G8_STAGE(G8_SB(0, 0), cB, voffB); G8_STAGE(G8_SB(0, 1), cB + hstep, voffB); G8_STAGE(G8_SA(0, 0), cA, vA[0]); G8_STAGE(G8_SA(0, 1), cA, vA[1]);
    if (wr == 1) G8_BAR;
    G8_WAIT_V(2); G8_BAR;
    G8_STAGE(G8_SB(1, 0), cB + kstep, voffB); G8_STAGE(G8_SA(1, 0), cA + kstep, vA[0]); G8_STAGE(G8_SB(1, 1), cB + hstep + kstep, voffB);
    G8_WAIT_V(6); G8_BAR;
    for (;;) {
        const bool has_next = S.next(ui + 1, nxt);
        const char* nA = has_next ? nxt.a : cA; const char* nB = has_next ? nxt.b : cB;
        if ((GATHER || Epi::ROWINFO) && has_next) S.prefetch(nxt);
        for (int t = 0; t < nt; t += 2) {
            const bool last = (t == nt - 2);
            if (Epi::MID_T >= 0 && t == Epi::MID_T) E.mid(acc, cur, wr, wc, fr, fq);
            const char* a1 = cA + (size_t)(t + 1) * kstep;
            const char* a2 = last ? nA : cA + (size_t)(t + 2) * kstep; const char* b2 = last ? nB : cB + (size_t)(t + 2) * kstep;
            const char* a3 = a2 + kstep; const char* b3 = b2 + kstep;
            unsigned v2[2][2];
#pragma unroll
            for (int h = 0; h < 2; ++h)
#pragma unroll
                for (int i = 0; i < 2; ++i) v2[h][i] = (GATHER && last && has_next) ? G8_AOFF(nxt, h, i) : vA[h][i];
            G8_LDB(B0, 0, 0); G8_LDB(B1, 0, 1); G8_SCHED; G8_LDA(At, 0, 0); G8_STAGE(G8_SA(1, 1), a1, vA[1]);
            G8_WAIT_V(8); G8_WAIT_L(0); G8_BAR; G8_MMA(0, 0, At, B0); G8_MMA(0, 1, At, B1); G8_BAR; G8_SCHED;
            G8_LDA(At, 0, 1); G8_STAGE(G8_SB(0, 0), b2, voffB); G8_STAGE(G8_SB(0, 1), b2 + hstep, voffB); G8_STAGE(G8_SA(0, 0), a2, v2[0]);
            G8_WAIT_V(8); G8_WAIT_L(0); G8_BAR; G8_MMA(1, 0, At, B0); G8_MMA(1, 1, At, B1); G8_BAR; G8_SCHED;
            G8_LDB(B0, 1, 0); G8_LDB(B1, 1, 1); G8_SCHED; G8_LDA(At, 1, 0); G8_STAGE(G8_SA(0, 1), a2, v2[1]);
            G8_WAIT_V(8); G8_WAIT_L(0); G8_BAR; G8_MMA(0, 0, At, B0); G8_MMA(0, 1, At, B1); G8_BAR; G8_SCHED;
            G8_LDA(At, 1, 1); G8_STAGE(G8_SB(1, 0), b3, voffB); G8_STAGE(G8_SB(1, 1), b3 + hstep, voffB); G8_STAGE(G8_SA(1, 0), a3, v2[0]);
            G8_WAIT_V(8); G8_WAIT_L(0); G8_BAR; G8_MMA(1, 0, At, B0); G8_MMA(1, 1, At, B1); G8_BAR; G8_SCHED;
        }
        if (wr == 0) G8_BAR;
        E(acc, cur, wr, wc, fr, fq);
        if (!has_next) break;
#pragma unroll
        for (int a = 0; a < 2; ++a)
#pragma unroll
            for (int b = 0; b < 2; ++b)
#pragma unroll
                for (int m = 0; m < 4; ++m)
#pragma unroll
                    for (int n = 0; n < 2; ++n) acc[a][b][m][n] = (f32x4){0.f, 0.f, 0.f, 0.f};
        cur = nxt; cA = nA; cB = nB; ++ui;
#pragma unroll
        for (int h = 0; h < 2; ++h)
#pragma unroll
            for (int i = 0; i < 2; ++i) if (GATHER) vA[h][i] = G8_AOFF(cur, h, i);
        if (wr == 1) G8_BAR;
    }
    G8_WAIT_V(0);
    G8_BAR;
#undef G8_SA
#undef G8_SB
#undef G8_STAGE
#undef G8_LDA
#undef G8_LDB
#undef G8_MMA
#undef G8_AOFF
#undef G8_CAT
#undef G8_WAIT_V
#undef G8_WAIT_L
#undef G8_BAR
#undef G8_SCHED
}

template <class Sched> struct EpiProjF { static constexpr bool PERM = true, ROWINFO = true; static constexpr int MID_T = -1; bf16_t* out; const Sched* S;
    __device__ __forceinline__ void mid(f32x4 (&)[2][2][4][2], const Unit&, int, int, int, int) const {}
    __device__ __forceinline__ void operator()(const f32x4 (&acc)[2][2][4][2], const Unit& u, int wr, int wc, int fr, int fq) const {
        const int row0 = u.pm * BM + wr * 64 + fr, col0 = u.pn * BM + wc * 32 + 8 * fq;
#pragma unroll
        for (int ai = 0; ai < 2; ++ai)
#pragma unroll
            for (int m = 0; m < 4; ++m) { const int row = row0 + ai * HALF + m * 16; const float s = S->scale_of(u, ai * HALF + wr * 64 + m * 16 + fr); bf16_t* rowp = out + (size_t)row * NPROJ + col0;
#pragma unroll
                for (int bj = 0; bj < 2; ++bj) { const f32x4 v0 = acc[ai][bj][m][0] * s, v1 = acc[ai][bj][m][1] * s; u32x4 w; w.x = cvt_pk_bf16(v0[0], v0[1]); w.y = cvt_pk_bf16(v0[2], v0[3]); w.z = cvt_pk_bf16(v1[0], v1[1]); w.w = cvt_pk_bf16(v1[2], v1[3]);
                    *(u32x4*)(rowp + bj * HALF) = w; } }
    }
};
struct EpiG2F { static constexpr bool PERM = true, ROWINFO = false; static constexpr int MID_T = DATT / BK; bf16_t* out; LAS const float* tab;
    __device__ __forceinline__ void mid(f32x4 (&acc)[2][2][4][2], const Unit& u, int wr, int wc, int fr, int fq) const {
        LAS const float* tb = tab + (size_t)(u.e) * 512;
#pragma unroll
        for (int ai = 0; ai < 2; ++ai)
#pragma unroll
            for (int m = 0; m < 4; ++m) { const float s = tb[(ai * HALF + wr * 64 + m * 16 + fr) * 2];
#pragma unroll
                for (int bj = 0; bj < 2; ++bj)
#pragma unroll
                    for (int n = 0; n < 2; ++n) acc[ai][bj][m][n] *= s; }
    }
    __device__ __forceinline__ void operator()(const f32x4 (&acc)[2][2][4][2], const Unit& u, int wr, int wc, int fr, int fq) const {
        LAS const float* tb = tab + (size_t)(u.e) * 512;
        const int col0 = u.pn * BM + wc * 32 + 8 * fq;
#pragma unroll
        for (int ai = 0; ai < 2; ++ai)
#pragma unroll
            for (int m = 0; m < 4; ++m) { const int r = ai * HALF + wr * 64 + m * 16 + fr; const float s = tb[r * 2 + 1]; bf16_t* rowp = out + (size_t)(u.pm * BM + r) * DM + col0;
#pragma unroll
                for (int bj = 0; bj < 2; ++bj) { const f32x4 v0 = acc[ai][bj][m][0] * s, v1 = acc[ai][bj][m][1] * s; u32x4 w; w.x = cvt_pk_bf16(v0[0], v0[1]); w.y = cvt_pk_bf16(v0[2], v0[3]); w.z = cvt_pk_bf16(v1[0], v1[1]); w.w = cvt_pk_bf16(v1[2], v1[3]);
                    *(u32x4*)(rowp + bj * HALF) = w; } }
    }
};
struct EpiG2X { static constexpr bool PERM = true, ROWINFO = false; static constexpr int MID_T = DATT / BK; bf16_t* out; const float* x; LAS const float* tab;
    __device__ __forceinline__ void mid(f32x4 (&acc)[2][2][4][2], const Unit& u, int wr, int wc, int fr, int fq) const {
        LAS const float* tb = tab + (size_t)(u.e) * 512;
#pragma unroll
        for (int ai = 0; ai < 2; ++ai)
#pragma unroll
            for (int m = 0; m < 4; ++m) { const float s = tb[(ai * HALF + wr * 64 + m * 16 + fr) * 2];
#pragma unroll
                for (int bj = 0; bj < 2; ++bj)
#pragma unroll
                    for (int n = 0; n < 2; ++n) acc[ai][bj][m][n] *= s; }
    }
    __device__ __forceinline__ void operator()(const f32x4 (&acc)[2][2][4][2], const Unit& u, int wr, int wc, int fr, int fq) const {
        LAS const float* tb = tab + (size_t)(u.e) * 512;
        const int col0 = u.pn * BM + wc * 32 + 8 * fq;
#pragma unroll
        for (int ai = 0; ai < 2; ++ai) {
            f32x4 xv[4][2][2];
#pragma unroll
            for (int m = 0; m < 4; ++m) { const float* xp = x + (size_t)(u.pm * BM + ai * HALF + wr * 64 + m * 16 + fr) * DM + col0;
#pragma unroll
                for (int bj = 0; bj < 2; ++bj) { xv[m][bj][0] = *(const f32x4*)(xp + bj * HALF); xv[m][bj][1] = *(const f32x4*)(xp + bj * HALF + 4); } }
#pragma unroll
            for (int m = 0; m < 4; ++m) { const int r = ai * HALF + wr * 64 + m * 16 + fr; const float s = tb[r * 2 + 1]; bf16_t* rowp = out + (size_t)(u.pm * BM + r) * DM + col0;
#pragma unroll
                for (int bj = 0; bj < 2; ++bj) { const f32x4 v0 = acc[ai][bj][m][0] * s + xv[m][bj][0], v1 = acc[ai][bj][m][1] * s + xv[m][bj][1]; u32x4 w; w.x = cvt_pk_bf16(v0[0], v0[1]); w.y = cvt_pk_bf16(v0[2], v0[3]); w.z = cvt_pk_bf16(v1[0], v1[1]); w.w = cvt_pk_bf16(v1[2], v1[3]);
                    *(u32x4*)(rowp + bj * HALF) = w; } }
            __builtin_amdgcn_sched_barrier(0);
        }
    }
};
template <class Sched> struct EpiGUF { static constexpr bool PERM = true, ROWINFO = true; static constexpr int MID_T = -1; bf16_t* Hb; const Sched* S;
    __device__ __forceinline__ void mid(f32x4 (&)[2][2][4][2], const Unit&, int, int, int, int) const {}
    __device__ __forceinline__ void operator()(const f32x4 (&acc)[2][2][4][2], const Unit& u, int wr, int wc, int fr, int fq) const {
        const int col0 = u.pn * HALF + wc * 32 + 8 * fq;
#pragma unroll
        for (int ai = 0; ai < 2; ++ai)
#pragma unroll
            for (int m = 0; m < 4; ++m) { const int r = ai * HALF + wr * 64 + m * 16 + fr; const float s = S->scale_of(u, r) * (1.f / WSCALE8);
                float h[8];
#pragma unroll
                for (int n = 0; n < 2; ++n)
#pragma unroll
                    for (int q = 0; q < 4; ++q) { const float gg = acc[ai][0][m][n][q] * s, uu = acc[ai][1][m][n][q] * s; h[4 * n + q] = gg * __builtin_amdgcn_rcpf(1.f + __expf(-gg)) * uu; }
                int w0 = __builtin_amdgcn_cvt_pk_fp8_f32(h[0] * HSCALE8, h[1] * HSCALE8, 0, false); w0 = __builtin_amdgcn_cvt_pk_fp8_f32(h[2] * HSCALE8, h[3] * HSCALE8, w0, true);
                int w1 = __builtin_amdgcn_cvt_pk_fp8_f32(h[4] * HSCALE8, h[5] * HSCALE8, 0, false); w1 = __builtin_amdgcn_cvt_pk_fp8_f32(h[6] * HSCALE8, h[7] * HSCALE8, w1, true);
                *(uint2*)((unsigned char*)Hb + (size_t)(u.pm * BM + r) * DEXP + col0) = make_uint2((unsigned)w0, (unsigned)w1); }
    }
};
template <class Sched> struct EpiDownF { static constexpr bool PERM = true, ROWINFO = true; static constexpr int MID_T = -1; unsigned char* Y; const Sched* S;
    __device__ __forceinline__ void mid(f32x4 (&)[2][2][4][2], const Unit&, int, int, int, int) const {}
    __device__ __forceinline__ void operator()(const f32x4 (&acc)[2][2][4][2], const Unit& u, int wr, int wc, int fr, int fq) const {
        const int col0 = u.pn * BM + wc * 32 + 8 * fq;
#pragma unroll
        for (int ai = 0; ai < 2; ++ai)
#pragma unroll
            for (int m = 0; m < 4; ++m) { const int r = ai * HALF + wr * 64 + m * 16 + fr; const int pr = S->pair_of(u, r); if (pr < 0) continue; const float s = S->scale_of(u, r) * (YSCALE8 / (HSCALE8 * WDSCALE8)); unsigned char* rowp = Y + (size_t)pr * DM + col0;
#pragma unroll
                for (int bj = 0; bj < 2; ++bj) { const f32x4 v0 = acc[ai][bj][m][0] * s, v1 = acc[ai][bj][m][1] * s;
                    int w0 = __builtin_amdgcn_cvt_pk_fp8_f32(v0[0], v0[1], 0, false); w0 = __builtin_amdgcn_cvt_pk_fp8_f32(v0[2], v0[3], w0, true);
                    int w1 = __builtin_amdgcn_cvt_pk_fp8_f32(v1[0], v1[1], 0, false); w1 = __builtin_amdgcn_cvt_pk_fp8_f32(v1[2], v1[3], w1, true);
                    *(uint2*)(rowp + bj * HALF) = make_uint2((unsigned)w0, (unsigned)w1); } }
    }
};
}


#define XB_TMO      128
#define XB_XCNT(j)  (256  + 64 * (j))
#define XB_XSUB(j)  (1280 + 64 * (j))
#define XB_XGEN(j)  (2304 + 64 * (j))
#define XB_TOP      3328
#define XB_TOPGEN   3392
#define XCD_BAR_WORDS 3456
#define XB_SPIN_CAP (1u << 20)
__device__ __forceinline__ unsigned xb_ld(unsigned* p)              { return __hip_atomic_load(p, __ATOMIC_RELAXED, __HIP_MEMORY_SCOPE_AGENT); }
__device__ __forceinline__ unsigned xb_add(unsigned* p, unsigned v) { return __hip_atomic_fetch_add(p, v, __ATOMIC_RELAXED, __HIP_MEMORY_SCOPE_AGENT); }
__device__ __forceinline__ unsigned xb_xcc_id() { return (unsigned)__builtin_amdgcn_s_getreg((3 << 11) | 20) & 0xFu; }
#define XB_SPIN(cond, bar) do { unsigned _sp = 0; while (cond) { __builtin_amdgcn_s_sleep(1); \
    if ((++_sp & 255u) == 0u) { if (xb_ld(&(bar)[XB_TMO])) break; if (_sp > XB_SPIN_CAP) { atomicAdd(&(bar)[XB_TMO], 1u); break; } } } } while (0)
struct XcdBarrier { unsigned* bar; unsigned x; volatile LAS unsigned* st; };
__device__ __forceinline__ XcdBarrier xcd_barrier_post(unsigned* bar, volatile LAS unsigned* st) {
    XcdBarrier b; b.bar = bar; b.x = xb_xcc_id(); b.st = st;
    if (threadIdx.x == 0) (void)xb_add(&bar[XB_XCNT(b.x)], 1u);
    return b;
}
__device__ __forceinline__ void xcd_barrier_complete(unsigned* bar, unsigned x, unsigned& nloc, unsigned& nx) {
    const unsigned G = gridDim.x * gridDim.y * gridDim.z;
    unsigned sum, cnt, mine, sp = 0u;
    for (;;) {
        sum = 0u; cnt = 0u; mine = 0u;
#pragma unroll
        for (unsigned j = 0; j < 16; ++j) { const unsigned c = xb_ld(&bar[XB_XCNT(j)]); sum += c; cnt += (c > 0u) ? 1u : 0u; mine = (j == x) ? c : mine; }
        if (sum == G) break;
        __builtin_amdgcn_s_sleep(1);
        if ((++sp & 255u) == 0u) { if (xb_ld(&bar[XB_TMO])) break; if (sp > XB_SPIN_CAP) { atomicAdd(&bar[XB_TMO], 1u); break; } }
    }
    nloc = mine > 0u ? mine : 1u; nx = cnt > 0u ? cnt : 1u;
}
__device__ __forceinline__ void xcd_barrier(const XcdBarrier& b) {
    asm volatile("s_waitcnt vmcnt(0)" ::: "memory");
    __syncthreads();
    if (threadIdx.x == 0) {
        unsigned* bar = b.bar;
        __builtin_amdgcn_s_waitcnt(0);
        unsigned nloc = b.st[0], nx = b.st[1];
        if (nloc == 0u) { xcd_barrier_complete(bar, b.x, nloc, nx); b.st[0] = nloc; b.st[1] = nx; }
        const unsigned old = xb_add(&bar[XB_XSUB(b.x)], 1u);
        const unsigned gen = old / nloc;
        if (old + 1u == (gen + 1u) * nloc) {
            __builtin_amdgcn_fence(__ATOMIC_RELEASE, "agent");
            asm volatile("s_waitcnt vmcnt(0)" ::: "memory");
            const unsigned og = xb_add(&bar[XB_TOP], 1u);
            const unsigned tg = og / nx;
            if (og + 1u == (tg + 1u) * nx) xb_add(&bar[XB_TOPGEN], 1u);
            else XB_SPIN(xb_ld(&bar[XB_TOPGEN]) == tg, bar);
            __builtin_amdgcn_fence(__ATOMIC_ACQUIRE, "agent");
            xb_add(&bar[XB_XGEN(b.x)], 1u);
            asm volatile("s_waitcnt vmcnt(0)" ::: "memory");
        } else {
            XB_SPIN(xb_ld(&bar[XB_XGEN(b.x)]) == gen, bar);
            __builtin_amdgcn_fence(__ATOMIC_ACQUIRE, "agent");
            asm volatile("s_waitcnt vmcnt(0)" ::: "memory");
        }
    }
    __syncthreads();
}

__global__ void __launch_bounds__(NTHREADS, 2) mega(Params p) {
    extern __shared__ __attribute__((aligned(16))) unsigned char lds[];
    volatile LAS unsigned* bst = (volatile LAS unsigned*)(lds + LDS_PLAN_OFF + 1024);
    if (threadIdx.x < 2) bst[threadIdx.x] = 0u;
    __syncthreads();
    const XcdBarrier gbar = xcd_barrier_post((unsigned*)(p.ws + WS_BAR), bst);
    unsigned long long ts0 = 0, ts1 = 0;
    if (p.never) cg::this_grid().sync();
    Ctx c; c.tid = threadIdx.x; c.lane = c.tid & 63; c.wave = __builtin_amdgcn_readfirstlane(c.tid >> 6); c.gw = blockIdx.x * NWAVES + c.wave; c.ngw = gridDim.x * NWAVES;
    char* ws = p.ws;
    int* cnt = (int*)(ws + WS_CTL);
    float* r1 = (float*)(ws + WS_R1); float* r2 = (float*)(ws + WS_R2); float* ssC = (float*)(ws + WS_SSC);
    float* wts = (float*)(ws + WS_WTS); bf16_t* Wrh = (bf16_t*)(ws + WS_WR); bf16_t* Wrl = (bf16_t*)(ws + WS_WR + 256 * 1024); float* ssA = (float*)(ws + WS_SSA); int* list = (int*)(ws + WS_LIST);
    bf16_t* W2t = (bf16_t*)(ws + WS_W2T); bf16_t* W1t = (bf16_t*)(ws + WS_W1T); bf16_t* Wdt = (bf16_t*)(ws + WS_WDT); bf16_t* Wgut = (bf16_t*)(ws + WS_WGUT);
    bf16_t* xb = (bf16_t*)(ws + WS_XB); bf16_t* mix = (bf16_t*)(ws + WS_MIX); bf16_t* proj = (bf16_t*)(ws + WS_PROJ); bf16_t* Y = (bf16_t*)(ws + WS_Y); bf16_t* Hb = (bf16_t*)(ws + WS_H);
    unsigned char* xf8 = (unsigned char*)(ws + WS_WGUT + 64 * MiB);
    bf16_t* dlt = (bf16_t*)(ws + WS_PROJ);

    TS0(1) TS0(8)
    {
        for (int row = c.gw; row < T * PMUL(10); row += 2 * c.ngw) {
            const int ra = row % T, rb = (row + c.ngw) % T; const bool hb = row + c.ngw < T * PMUL(10);
            const float4* xa = (const float4*)(p.x + (size_t)ra * DM); const float4* xc = (const float4*)(p.x + (size_t)rb * DM);
            float4 va[8], vb[8];
#pragma unroll
            for (int j = 0; j < 8; ++j) { va[j] = xa[j * 64 + c.lane]; if (hb) vb[j] = xc[j * 64 + c.lane]; }
            float sa = 0.f, sb = 0.f; uint2* oa = (uint2*)(xb + (size_t)ra * DM); uint2* ob = (uint2*)(xb + (size_t)rb * DM);
#pragma unroll
            for (int j = 0; j < 8; ++j) { sa += va[j].x * va[j].x + va[j].y * va[j].y + va[j].z * va[j].z + va[j].w * va[j].w; oa[j * 64 + c.lane] = make_uint2(cvtpk2(va[j].x, va[j].y), cvtpk2(va[j].z, va[j].w)); }
            if (hb) {
#pragma unroll
                for (int j = 0; j < 8; ++j) { sb += vb[j].x * vb[j].x + vb[j].y * vb[j].y + vb[j].z * vb[j].z + vb[j].w * vb[j].w; ob[j * 64 + c.lane] = make_uint2(cvtpk2(vb[j].x, vb[j].y), cvtpk2(vb[j].z, vb[j].w)); } }
            sa = wave_sum(sa); sb = wave_sum(sb);
            if (c.lane == 0) { r1[ra] = rsqrtf(sa * (1.f / DM) + EPS); if (hb) r1[rb] = rsqrtf(sb * (1.f / DM) + EPS); }
        }
        LAS float* scr = (LAS float*)lds + c.wave * (64 * 65);
        constexpr int I_IN = (DM / 64) * (NPROJ / 64), I_OUT = (DM / 64) * (DM / 64);
        constexpr int NIT = I_IN + I_OUT;
        for (int it = c.gw; it < NIT * PMUL(10); it += c.ngw) {
            int r = it % NIT;
            if (r < I_IN) { const int nb = NPROJ / 64, kb = r / nb, n0 = (r % nb) * 64; p0_titem(p.w_in, NPROJ, p.norm1, W1t, DM, kb * 64, n0, n0, scr, c.lane, n0 < DATT ? QSCALE : 1.f); continue; } r -= I_IN;
            { const int nb = DM / 64, kb = r / nb, n0 = (r % nb) * 64, k0 = kb * 64;
                const float* g = k0 < DATT ? p.g_oa + k0 : p.g_oc + (k0 - DATT);
                p0_titem(p.w_out + (size_t)k0 * DM, DM, g, W2t + k0, DM, 0, n0, n0, scr, c.lane); }
        }
        for (int i = blockIdx.x * NTHREADS + c.tid; i < 48 * DM; i += gridDim.x * NTHREADS) { const int o = i / DM, k = i % DM; const float w = o < 36 ? (o < 4 ? p.w_rg[k * 4 + o] : p.w_re[k * 32 + (o - 4)]) : 0.f;
            const unsigned h = f2bf(w); Wrh[i] = (bf16_t)h; Wrl[i] = (bf16_t)f2bf(w - bf2f(h)); }
    }
    xcd_barrier(gbar);
    TS1(1) TS0(2)
    {
        g8::DenseOrder S; S.init(xb, W1t, T, NPROJ, DM, (int)gridDim.x, (int)blockIdx.x); S.mul = PMUL(1);
        S.rowscale = r1; S.rtab = (LAS float*)(lds + 131072);
        const g8::EpiProjF<g8::DenseOrder> E{proj, &S};
        g8::gemm_phase<false, 2>((LAS unsigned char*)lds, DM, S, E);
    }
    xcd_barrier(gbar);
    TS1(2) TS0(3)
    {
        struct Side { WConv wc; unsigned long long twait; int s, gw, ngw, nper, lane; LAS float* scr; unsigned scr32; const float *wg, *wu, *wd; bf16_t* Wgut; bf16_t* Wdt;
            __device__ __forceinline__ void step() { if (wc.pending) wc.finish(scr, lane);
                if (s < nper) { const int id = gw + ngw * s; ++s; if (id < WC_ITEMS) wc.issue(id, wg, wu, wd, Wgut, Wdt, scr32, lane); } }
            __device__ __forceinline__ void whole() { step(); asm volatile("s_waitcnt vmcnt(0)" ::: "memory"); } };
        Side side; side.twait = 0; side.wc.pending = false; side.s = 0; side.gw = c.gw; side.ngw = c.ngw; side.nper = (WC_ITEMS + c.ngw - 1) / c.ngw; side.lane = c.lane;
        side.scr = (LAS float*)(lds + 69632) + c.wave * (64 * 32); side.scr32 = (unsigned)(__UINTPTR_TYPE__)((LAS unsigned char*)lds + 69632) + c.wave * 8192;
        side.wg = p.w_gate; side.wu = p.w_up; side.wd = p.w_down; side.Wgut = Wgut; side.Wdt = Wdt;
        for (int u1 = blockIdx.x; u1 < NB * NH * 4 * PMUL(2); u1 += gridDim.x) { const int u0 = u1 % (NB * NH * 4); const int bh = u0 >> 2;
            for (int i = 0; i < 4; ++i) att::attn_unit((LAS unsigned char*)lds, proj, p.relb, mix, ssA, bh >> 4, bh & 15, (u0 & 3) + 4 * i, side, i == 0); }
        if (TSPROBE == 34 || TSPROBE == 35) { ts0 = 0; ts1 = side.twait; }
        while (side.wc.pending || side.s < side.nper) side.whole();
        for (int it = c.gw; it < (T / 16) * 2 * PMUL(21); it += c.ngw) conv_slab(proj, p.conv_w, mix, ssC, it % ((T / 16) * 2), c.lane);
    }
    xcd_barrier(gbar);
    TS1(3) TS0(4)
    {
        g8::DenseOrder S; S.init(mix, W2t, T, DM, DM, (int)gridDim.x, (int)blockIdx.x); S.mul = PMUL(3);
        LAS float* tab = (LAS float*)(lds + 131072);
        g8::Unit u;
        for (int i = 0; i < 4; ++i) if (S.next(i, u) && c.tid < 256) { const int row = u.pm * 256 + c.tid; float sa = 0.f;
#pragma unroll
            for (int h = 0; h < 16; ++h) sa += ssA[row * 16 + h];
            const float4 sc4 = *(const float4*)(ssC + row * 4); const float ra = rsqrtf(sa * (1.f / DATT) + EPS), rc = rsqrtf((sc4.x + sc4.y) * (1.f / DCONV) + EPS);
            tab[(i * 256 + c.tid) * 2] = ra / rc; tab[(i * 256 + c.tid) * 2 + 1] = rc; }
        __syncthreads();
        const g8::EpiG2X E{xb, p.x, tab};
        g8::gemm_phase<false, 2>((LAS unsigned char*)lds, DM, S, E);
    }
    xcd_barrier(gbar);
    TS1(4) TS0(5)
    for (int it = blockIdx.x; it < (T / 64) * PMUL(4); it += gridDim.x) router_block(p.norm2, xb, xf8, Wrh, Wrl, p.b_rg, p.b_re, cnt, list, wts, r2, it % (T / 64), c.wave, c.lane, (LAS float*)lds, it < T / 64);
    xcd_barrier(gbar);
    TS1(5) TS0(6)
    LAS int* pl = (LAS int*)(lds + LDS_PLAN_OFF);
    if (c.tid < 64) {
        const int ce = c.tid < NE ? cnt[c.tid * 64] : 0, mt = (ce + 255) >> 8;
        int inc = mt;
#pragma unroll
        for (int o = 1; o < 32; o <<= 1) { const int v = __shfl_up(inc, o); if (c.lane >= o) inc += v; }
        if (c.tid < NE) { pl[c.tid] = ce; pl[32 + c.tid] = (inc - mt) * 256; }
        if (c.tid == NE - 1) pl[224] = inc;
    }
    __syncthreads();
    if (c.tid < NTILEMAX) { int e = -1;
        for (int q = 0; q < NE; ++q) { const int st = pl[32 + q] >> 8, mt = (pl[q] + 255) >> 8; if (c.tid >= st && c.tid < st + mt) e = q; }
        pl[64 + c.tid] = e; }
    __syncthreads();
    const int ntile = pl[224];
    {
        const g8::MoeOrder<true> S{(const char*)xf8, (const char*)Wgut, list, pl, DM  , 4, ntile * 4, (int)gridDim.x, (int)blockIdx.x, (size_t)2 * DEXP * DM, PMUL(5), (LAS int*)(lds + 131072), r2};
        const g8::EpiGUF<g8::MoeOrder<true>> E{Hb, &S};
        g8::gemm_phase<true, 1>((LAS unsigned char*)lds, DM, S, E);
    }
    xcd_barrier(gbar);
    TS1(6) TS0(7)
    {
        const g8::MoeOrder<false> S{(const char*)Hb, (const char*)Wdt, list, pl, DEXP  , 8, ntile * 8, (int)gridDim.x, (int)blockIdx.x, (size_t)DM * DEXP, PMUL(6), (LAS int*)(lds + 131072), wts};
        const g8::EpiDownF<g8::MoeOrder<false>> E{(unsigned char*)Y, &S};
        g8::gemm_phase<false, 1>((LAS unsigned char*)lds, DEXP, S, E);
    }
    xcd_barrier(gbar);
    TS1(7) TS1(8)
    if (PROBE == 9) { for (int i = 0; i < 8; ++i) xcd_barrier(gbar); }
    const float tsdelta = TSPROBE ? sqrtf((float)(ts1 - ts0) * 0.01f) * 1e-3f : 0.f;
    {
        const unsigned long long tp6 = (TSPROBE == 9) ? __builtin_amdgcn_s_memrealtime() : 0ull;
        FinalRow fa, fb;
        int t = c.gw;
        if (t < T) final_load(fa, xb, Y, t, c.lane);
        for (; t < T; t += 2 * c.ngw) {
            const int t2 = t + c.ngw, t3 = t + 2 * c.ngw;
            if (t2 < T) final_load(fb, xb, Y, t2, c.lane);
            final_store(fa, p.out, p.norm_f, t, c.lane, (TSPROBE == 9) ? sqrtf((float)(__builtin_amdgcn_s_memrealtime() - tp6) * 0.01f) * 1e-3f : tsdelta);
            if (t3 < T) final_load(fa, xb, Y, t3, c.lane);
            if (t2 < T) final_store(fb, p.out, p.norm_f, t2, c.lane, (TSPROBE == 9) ? sqrtf((float)(__builtin_amdgcn_s_memrealtime() - tp6) * 0.01f) * 1e-3f : tsdelta);
        }
    }
}

extern "C" void kernel_launch(void* const* d_in, const int* in_sizes, int n_in, void* d_out, int out_size, void* d_ws, size_t ws_size, hipStream_t stream) {
    static int grid = 0;
    if (grid == 0) {
        int dev = 0, cus = 0, per_cu = 0;
        if (ws_size < WS_END || n_in != 17) { fprintf(stderr, "kernel_launch: unexpected sizes (ws %zu)\n", ws_size); grid = -1; return; }
        (void)hipGetDevice(&dev); (void)hipDeviceGetAttribute(&cus, hipDeviceAttributeMultiprocessorCount, dev);
        if (hipFuncSetAttribute((const void*)mega, hipFuncAttributeMaxDynamicSharedMemorySize, LDS_BYTES) != hipSuccess) { fprintf(stderr, "hipFuncSetAttribute failed\n"); grid = -1; return; }
        if (hipOccupancyMaxActiveBlocksPerMultiprocessor(&per_cu, (const void*)mega, NTHREADS, LDS_BYTES) != hipSuccess || per_cu < 1) { fprintf(stderr, "occupancy query failed (%d)\n", per_cu); grid = -1; return; }
        grid = cus * per_cu;
        fprintf(stderr, "kernel_launch: cus %d per_cu %d grid %d\n", cus, per_cu, grid);
    }
    if (grid < 0) return;
    if (hipMemsetAsync((char*)d_ws + WS_CTL, 0, 64 * 1024, stream) != hipSuccess) { fprintf(stderr, "memset failed\n"); return; }
    Params p{};
    p.x = (const float*)d_in[0]; p.norm1 = (const float*)d_in[1]; p.w_in = (const float*)d_in[2]; p.relb = (const float*)d_in[3];
    p.conv_w = (const float*)d_in[4]; p.g_oa = (const float*)d_in[5]; p.g_oc = (const float*)d_in[6]; p.w_out = (const float*)d_in[7];
    p.norm2 = (const float*)d_in[8]; p.w_rg = (const float*)d_in[9]; p.b_rg = (const float*)d_in[10]; p.w_re = (const float*)d_in[11];
    p.b_re = (const float*)d_in[12]; p.w_gate = (const float*)d_in[13]; p.w_up = (const float*)d_in[14]; p.w_down = (const float*)d_in[15];
    p.norm_f = (const float*)d_in[16]; p.out = (float*)d_out; p.ws = (char*)d_ws;
    void* args[] = {&p};
    hipError_t e = hipLaunchCooperativeKernel((const void*)mega, dim3(grid), dim3(NTHREADS), args, LDS_BYTES, stream);
    if (e != hipSuccess) fprintf(stderr, "cooperative launch failed: %s (grid %d)\n", hipGetErrorString(e), grid);
}
```

```cpp
#include <hip/hip_runtime.h>
#include <hip/hip_cooperative_groups.h>
#include <stdint.h>
#include <cstdio>
namespace cg = cooperative_groups;
#ifndef PROBE
#define PROBE 0
#endif
#define PMUL(k) ((PROBE) == (k) ? 2 : 1)
#ifndef TSPROBE
#define TSPROBE 0
#endif
#define TS0(k) if (TSPROBE == (k)) ts0 = __builtin_amdgcn_s_memrealtime();
#define TS1(k) if (TSPROBE == (k)) ts1 = __builtin_amdgcn_s_memrealtime();

typedef unsigned short bf16_t;
typedef short bf16x8 __attribute__((ext_vector_type(8)));
typedef float f32x4 __attribute__((ext_vector_type(4)));

constexpr int NB = 4, SEQ = 4096, T = NB * SEQ, DM = 2048, DATT = 1024, DCONV = 1024, NPROJ = 6144;
constexpr int NH = 16, HD = 64, NREL = 513, NE = 32, DEXP = 512, NPAIR = 2 * T;
constexpr int NPADMAX = 40960, NTILEMAX = NPADMAX / 256;
constexpr float EPS = 1e-6f;
constexpr float YSCALE8 = 64.f;
constexpr float HSCALE8 = 8.f, WDSCALE8 = 32.f;
constexpr float WSCALE8 = 64.f;
constexpr float LOG2E = 1.4426950408889634f, QSCALE = 0.125f * LOG2E;

constexpr size_t MiB = 1u << 20;
constexpr size_t WS_CTL = 0;
constexpr size_t WS_BAR = 16 * 1024;
constexpr size_t WS_PLAN = 64 * 1024;
constexpr size_t WS_R1 = 128 * 1024;
constexpr size_t WS_RA = 192 * 1024;
constexpr size_t WS_RC = 256 * 1024;
constexpr size_t WS_R2 = 320 * 1024;
constexpr size_t WS_SSC = 3 * MiB;
constexpr size_t WS_WTS = 512 * 1024;
constexpr size_t WS_ROWPAIR = 640 * 1024;
constexpr size_t WS_WR = 1 * MiB;
constexpr size_t WS_SSA = 2 * MiB;
constexpr size_t WS_LIST = 5 * MiB;
constexpr size_t WS_W2T = 8 * MiB;
constexpr size_t WS_W1T = 16 * MiB;
constexpr size_t WS_WDT = 40 * MiB;
constexpr size_t WS_WGUT = 104 * MiB;
constexpr size_t WS_XB = 232 * MiB;
constexpr size_t WS_MIX = 296 * MiB;
constexpr size_t WS_PROJ = 360 * MiB;
constexpr size_t WS_Y = 360 * MiB;
constexpr size_t WS_H = 488 * MiB;
constexpr size_t WS_END = 552 * MiB;

__device__ __forceinline__ unsigned f2bf(float f) { unsigned u = __float_as_uint(f); return (u + 0x7fffu + ((u >> 16) & 1u)) >> 16; }
__device__ __forceinline__ unsigned pk2(float lo, float hi) { return f2bf(lo) | (f2bf(hi) << 16); }
__device__ __forceinline__ unsigned cvtpk2(float lo, float hi) { typedef float f2 __attribute__((ext_vector_type(2))); typedef __bf16 b2 __attribute__((ext_vector_type(2))); f2 v = {lo, hi}; b2 r = __builtin_convertvector(v, b2); return __builtin_bit_cast(unsigned, r); }
__device__ __forceinline__ int gu_row(int n, int up) { return ((n >> 7) << 8) + (n & 127) + (up ? 128 : 0); }
__device__ __forceinline__ float bf2f(unsigned h) { return __uint_as_float(h << 16); }
__device__ __forceinline__ float wave_sum(float v) {
#pragma unroll
    for (int o = 1; o < 64; o <<= 1) v += __shfl_xor(v, o);
    return v;
}


#define LAS __attribute__((address_space(3)))
constexpr int NWAVES = 8, NTHREADS = 512;
constexpr int LDS_BYTES = 147456;
constexpr int LDS_PLAN_OFF = 140 * 1024;

struct Params {
    const float *x, *norm1, *w_in, *relb, *conv_w, *g_oa, *g_oc, *w_out, *norm2, *w_rg, *b_rg, *w_re, *b_re, *w_gate, *w_up, *w_down, *norm_f;
    float* out; char* ws; int never; int pad;
};
struct Ctx { int tid, lane, wave, gw, ngw; };

__device__ __forceinline__ void p0_titem(const float* __restrict__ W, int N, const float* __restrict__ g, bf16_t* __restrict__ WT, int ldd, int k0, int n0, int drow0, LAS float* scr, int lane, float cs = 1.f) {
    const int kq = lane >> 4, n4 = (lane & 15) * 4;
    float4 v[16]; float gs[16];
#pragma unroll
    for (int i = 0; i < 16; ++i) v[i] = *(const float4*)(W + (size_t)(k0 + 4 * i + kq) * N + n0 + n4);
#pragma unroll
    for (int i = 0; i < 16; ++i) gs[i] = (g ? g[k0 + 4 * i + kq] : 1.f) * cs;
#pragma unroll
    for (int i = 0; i < 16; ++i) { LAS float* d = scr + (4 * i + kq) * 65 + n4; d[0] = v[i].x * gs[i]; d[1] = v[i].y * gs[i]; d[2] = v[i].z * gs[i]; d[3] = v[i].w * gs[i]; }
    asm volatile("s_waitcnt lgkmcnt(0)" ::: "memory");
    const int c = lane & 7;
#pragma unroll
    for (int j = 0; j < 8; ++j) { const int n = (lane >> 3) + 8 * j; const LAS float* sp = scr + (8 * c) * 65 + n;
        uint4 o; o.x = cvtpk2(sp[0 * 65], sp[1 * 65]); o.y = cvtpk2(sp[2 * 65], sp[3 * 65]); o.z = cvtpk2(sp[4 * 65], sp[5 * 65]); o.w = cvtpk2(sp[6 * 65], sp[7 * 65]);
        *(uint4*)(WT + (size_t)(drow0 + n) * ldd + k0 + 8 * c) = o; }
    asm volatile("s_waitcnt lgkmcnt(0)" ::: "memory");
}

__device__ __forceinline__ void router_block(const float* __restrict__ g2, const bf16_t* __restrict__ xb1, unsigned char* __restrict__ xf8, const bf16_t* __restrict__ Wrh, const bf16_t* __restrict__ Wrl,
                                             const float* __restrict__ brg, const float* __restrict__ bre, int* __restrict__ cnt, int* __restrict__ list, float* __restrict__ wts, float* __restrict__ r2out,
                                             int tb, int wave, int lane, LAS float* lds_f, bool commit) {
    const int fr = lane & 15, fq = lane >> 4, tg = wave & 3, kh = wave >> 2, t0 = tb * 64 + tg * 16;
    const size_t aoff = (size_t)(t0 + fr) * DM + kh * (DM / 2) + 8 * fq;
    const bf16_t* xr = xb1 + aoff; unsigned char* x8 = xf8 + aoff; const float* gr = g2 + kh * (DM / 2) + 8 * fq;
    const bf16_t* wh = Wrh + (size_t)fr * DM + kh * (DM / 2) + 8 * fq; const bf16_t* wl = Wrl + (size_t)fr * DM + kh * (DM / 2) + 8 * fq;
    f32x4 acc[3]; float ss = 0.f;
#pragma unroll
    for (int nb = 0; nb < 3; ++nb) acc[nb] = (f32x4){0.f, 0.f, 0.f, 0.f};
    typedef unsigned u4 __attribute__((ext_vector_type(4)));
    for (int ks0 = 0; ks0 < DM / 64; ks0 += 4) {
        uint4 dl[4]; bf16x8 bh[4][3];
#pragma unroll
        for (int u = 0; u < 4; ++u) dl[u] = *(const uint4*)(xr + (ks0 + u) * 32);
#pragma unroll
        for (int u = 0; u < 4; ++u)
#pragma unroll
            for (int nb = 0; nb < 3; ++nb) { bh[u][nb] = *(const bf16x8*)(wh + (size_t)nb * 16 * DM + (ks0 + u) * 32); }
#pragma unroll
        for (int u = 0; u < 4; ++u) {
            const unsigned dw[4] = {dl[u].x, dl[u].y, dl[u].z, dl[u].w};
            const float xv[8] = {bf2f(dw[0] & 0xffffu), bf2f(dw[0] >> 16), bf2f(dw[1] & 0xffffu), bf2f(dw[1] >> 16), bf2f(dw[2] & 0xffffu), bf2f(dw[2] >> 16), bf2f(dw[3] & 0xffffu), bf2f(dw[3] >> 16)};
            const float4 ga = *(const float4*)(gr + (ks0 + u) * 32), gb = *(const float4*)(gr + (ks0 + u) * 32 + 4);
            const float yv[8] = {xv[0] * ga.x, xv[1] * ga.y, xv[2] * ga.z, xv[3] * ga.w, xv[4] * gb.x, xv[5] * gb.y, xv[6] * gb.z, xv[7] * gb.w};
            unsigned hw[4], lw[4];
#pragma unroll
            for (int q = 0; q < 4; ++q) { const unsigned h = cvtpk2(yv[2 * q], yv[2 * q + 1]); hw[q] = h;
                lw[q] = cvtpk2(yv[2 * q] - __uint_as_float(h << 16), yv[2 * q + 1] - __uint_as_float(h & 0xffff0000u)); ss += xv[2 * q] * xv[2 * q] + xv[2 * q + 1] * xv[2 * q + 1]; }
            if (commit) {
                int f0 = __builtin_amdgcn_cvt_pk_fp8_f32(yv[0], yv[1], 0, false); f0 = __builtin_amdgcn_cvt_pk_fp8_f32(yv[2], yv[3], f0, true);
                int f1 = __builtin_amdgcn_cvt_pk_fp8_f32(yv[4], yv[5], 0, false); f1 = __builtin_amdgcn_cvt_pk_fp8_f32(yv[6], yv[7], f1, true);
                *(uint2*)(x8 + (ks0 + u) * 32) = make_uint2((unsigned)f0, (unsigned)f1); }
            const bf16x8 xh = __builtin_bit_cast(bf16x8, (u4){hw[0], hw[1], hw[2], hw[3]}), xl = __builtin_bit_cast(bf16x8, (u4){lw[0], lw[1], lw[2], lw[3]});
#pragma unroll
            for (int nb = 0; nb < 3; ++nb) {
                acc[nb] = __builtin_amdgcn_mfma_f32_16x16x32_bf16(bh[u][nb], xh, acc[nb], 0, 0, 0);
                acc[nb] = __builtin_amdgcn_mfma_f32_16x16x32_bf16(bh[u][nb], xl, acc[nb], 0, 0, 0);
                }
        }
    }
    LAS float* part = lds_f + tg * (64 * 13);
    LAS float* sc = lds_f + 4 * 64 * 13 + tg * (16 * 49);
    LAS int* ent = (LAS int*)(lds_f + 4 * 64 * 13 + 4 * 16 * 49);
    if (kh == 1) {
#pragma unroll
        for (int nb = 0; nb < 3; ++nb)
#pragma unroll
            for (int q = 0; q < 4; ++q) part[lane * 13 + nb * 4 + q] = acc[nb][q];
        part[lane * 13 + 12] = ss;
    }
    __syncthreads();
    if (kh == 0) {
#pragma unroll
        for (int nb = 0; nb < 3; ++nb)
#pragma unroll
            for (int q = 0; q < 4; ++q) acc[nb][q] += part[lane * 13 + nb * 4 + q];
        ss += part[lane * 13 + 12];
        ss += __shfl_xor(ss, 16); ss += __shfl_xor(ss, 32);
        const float r2 = rsqrtf(ss * (1.f / DM) + EPS);
#pragma unroll
        for (int nb = 0; nb < 3; ++nb)
#pragma unroll
            for (int q = 0; q < 4; ++q) sc[fr * 49 + 16 * nb + 4 * fq + q] = acc[nb][q] * r2;
        asm volatile("s_waitcnt lgkmcnt(0)" ::: "memory");
        if (lane < 16) {
            const int t = t0 + lane; LAS const float* lr = sc + lane * 49;
            float lg[4];
#pragma unroll
            for (int g = 0; g < 4; ++g) lg[g] = lr[g] + brg[g];
            int gs = 0; float gm = lg[0];
#pragma unroll
            for (int g = 1; g < 4; ++g) if (lg[g] > gm) { gm = lg[g]; gs = g; }
            float den = 0.f;
#pragma unroll
            for (int g = 0; g < 4; ++g) den += __expf(lg[g] - gm);
            const float pg = 1.f / den;
            float el[8];
#pragma unroll
            for (int i = 0; i < 8; ++i) el[i] = lr[4 + 8 * gs + i] + bre[8 * gs + i];
            int i1 = 0; float v1 = el[0];
#pragma unroll
            for (int i = 1; i < 8; ++i) if (el[i] > v1) { v1 = el[i]; i1 = i; }
            int i2 = -1; float v2 = -3.0e38f;
#pragma unroll
            for (int i = 0; i < 8; ++i) if (i != i1 && el[i] > v2) { v2 = el[i]; i2 = i; }
            const float e2 = __expf(v2 - v1), w0 = pg / (1.f + e2), w1 = pg * e2 / (1.f + e2);
            ent[2 * (tg * 16 + lane)] = gs * 8 + i1; ent[2 * (tg * 16 + lane) + 1] = gs * 8 + i2;
            if (commit) { r2out[t] = r2; wts[2 * t] = w0; wts[2 * t + 1] = w1; }
        }
    }
    __syncthreads();
    if (wave == 0 && lane < NE && commit) {
        int n = 0;
        for (int i = 0; i < 128; ++i) n += (ent[i] == lane) ? 1 : 0;
        if (n) { int k = atomicAdd(&cnt[lane * 64], n);
            for (int i = 0; i < 128; ++i) if (ent[i] == lane) { list[lane * T + k] = 2 * (tb * 64) + i; ++k; } }
    }
    __syncthreads();
}
struct FinalRow { uint4 xv[4]; uint2 pv[4], qv[4]; };
__device__ __forceinline__ void final_load(FinalRow& f, const bf16_t* __restrict__ xb1, const bf16_t* __restrict__ Yb, int t, int lane) {
    const unsigned char* Y = (const unsigned char*)Yb;
    const uint4* x1 = (const uint4*)(xb1 + (size_t)t * DM); const uint2* y0 = (const uint2*)(Y + (size_t)(2 * t) * DM); const uint2* y1 = (const uint2*)(Y + (size_t)(2 * t + 1) * DM);
#pragma unroll
    for (int j = 0; j < 4; ++j) { f.xv[j] = x1[j * 64 + lane]; f.pv[j] = y0[j * 64 + lane]; f.qv[j] = y1[j * 64 + lane]; }
}
__device__ __forceinline__ void final_store(const FinalRow& f, float* __restrict__ out, const float* __restrict__ g, int t, int lane, float delta = 0.f) {
    float4* xw = (float4*)(out + (size_t)t * DM);
    float v[4][8]; float ss = 0.f;
    typedef float f2_t __attribute__((ext_vector_type(2)));
#pragma unroll
    for (int j = 0; j < 4; ++j) { const unsigned xa[4] = {f.xv[j].x, f.xv[j].y, f.xv[j].z, f.xv[j].w};
        const f2_t p01 = __builtin_amdgcn_cvt_pk_f32_fp8((int)f.pv[j].x, false), p23 = __builtin_amdgcn_cvt_pk_f32_fp8((int)f.pv[j].x, true), p45 = __builtin_amdgcn_cvt_pk_f32_fp8((int)f.pv[j].y, false), p67 = __builtin_amdgcn_cvt_pk_f32_fp8((int)f.pv[j].y, true);
        const f2_t q01 = __builtin_amdgcn_cvt_pk_f32_fp8((int)f.qv[j].x, false), q23 = __builtin_amdgcn_cvt_pk_f32_fp8((int)f.qv[j].x, true), q45 = __builtin_amdgcn_cvt_pk_f32_fp8((int)f.qv[j].y, false), q67 = __builtin_amdgcn_cvt_pk_f32_fp8((int)f.qv[j].y, true);
        const float ys[8] = {p01[0] + q01[0], p01[1] + q01[1], p23[0] + q23[0], p23[1] + q23[1], p45[0] + q45[0], p45[1] + q45[1], p67[0] + q67[0], p67[1] + q67[1]};
#pragma unroll
        for (int q = 0; q < 4; ++q) { const float lo = bf2f(xa[q] & 0xffffu) + ys[2 * q] * (1.f / YSCALE8), hi = bf2f(xa[q] >> 16) + ys[2 * q + 1] * (1.f / YSCALE8);
            v[j][2 * q] = lo; v[j][2 * q + 1] = hi; ss += lo * lo + hi * hi; } }
    const float r = rsqrtf(wave_sum(ss) * (1.f / DM) + EPS);
#pragma unroll
    for (int j = 0; j < 4; ++j) { const float4 g0 = ((const float4*)g)[(j * 64 + lane) * 2], g1 = ((const float4*)g)[(j * 64 + lane) * 2 + 1];
        float4 a, b; a.x = v[j][0] * r * g0.x + delta; a.y = v[j][1] * r * g0.y - delta; a.z = v[j][2] * r * g0.z + delta; a.w = v[j][3] * r * g0.w - delta;
        b.x = v[j][4] * r * g1.x + delta; b.y = v[j][5] * r * g1.y - delta; b.z = v[j][6] * r * g1.z + delta; b.w = v[j][7] * r * g1.w - delta;
        xw[(j * 64 + lane) * 2] = a; xw[(j * 64 + lane) * 2 + 1] = b; }
}

constexpr int WC_ITEMS = 3 * NE * 512;
struct WConv {
    unsigned char* dst; int ldd; float sc; bool pending;
    __device__ __forceinline__ void issue(int id, const float* __restrict__ w_gate, const float* __restrict__ w_up, const float* __restrict__ w_down, bf16_t* Wgut, bf16_t* Wdt, unsigned scr32, int lane) {
        const int kq = lane >> 3;
        const float* src; int N, k0, n0;
        if (id < 2 * NE * 512) { const int up = id >= NE * 512, r = id & (NE * 512 - 1), e = r >> 9, q = r & 511; k0 = (q >> 4) * 64; n0 = (q & 15) * 32; N = DEXP; sc = WSCALE8;
            src = (up ? w_up : w_gate) + (size_t)e * DM * DEXP; dst = (unsigned char*)Wgut + (size_t)e * 2 * DEXP * DM + (size_t)gu_row(n0, up) * DM + k0; ldd = DM; }
        else { const int r = id - 2 * NE * 512, e = r >> 9, q = r & 511; k0 = (q >> 6) * 64; n0 = (q & 63) * 32; N = DM; sc = WDSCALE8;
            src = w_down + (size_t)e * DEXP * DM; dst = (unsigned char*)Wdt + (size_t)e * DM * DEXP + (size_t)n0 * DEXP + k0; ldd = DEXP; }
#pragma unroll
        for (int i = 0; i < 8; ++i) { const float* g = src + (size_t)(k0 + 8 * i + kq) * N + n0 + 4 * ((lane & 7) ^ i); unsigned keep_;
            asm volatile("s_mov_b32 %0, m0\n\ts_mov_b32 m0, %2\n\ts_nop 0\n\tglobal_load_lds_dwordx4 %1, off\n\ts_mov_b32 m0, %0" : "=&s"(keep_) : "v"(g), "s"((unsigned)__builtin_amdgcn_readfirstlane((int)(scr32 + i * 1024))) : "memory"); }
        pending = true;
    }
    __device__ __forceinline__ void finish(LAS float* scr, int lane) {
        const int c = lane & 7;
#pragma unroll
        for (int j = 0; j < 4; ++j) { const int n = (lane >> 3) + 8 * j; const LAS float* sp = scr + (8 * c) * 32 + 4 * ((n >> 2) ^ c) + (n & 3);
            float v[8];
#pragma unroll
            for (int q = 0; q < 8; ++q) v[q] = sp[q * 32] * sc;
            int w0 = __builtin_amdgcn_cvt_pk_fp8_f32(v[0], v[1], 0, false); w0 = __builtin_amdgcn_cvt_pk_fp8_f32(v[2], v[3], w0, true);
            int w1 = __builtin_amdgcn_cvt_pk_fp8_f32(v[4], v[5], 0, false); w1 = __builtin_amdgcn_cvt_pk_fp8_f32(v[6], v[7], w1, true);
            *(uint2*)(dst + (size_t)n * ldd + 8 * c) = make_uint2((unsigned)w0, (unsigned)w1); }
        asm volatile("s_waitcnt lgkmcnt(0)" ::: "memory");
        pending = false;
    }
};

namespace att {
typedef float f32x16 __attribute__((ext_vector_type(16)));
typedef short s16x4 __attribute__((ext_vector_type(4)));
typedef short v4i16_t __attribute__((ext_vector_type(4)));
constexpr int SLOT = 16384, L_K = 0, L_V = 2 * SLOT, L_TB = 4 * SLOT, NTB = 576;
constexpr float THR = 8.f;
__device__ __forceinline__ float rowmax32(const f32x16& p0, const f32x16& p1) {
    float a = fmaxf(p0[0], p1[0]);
#pragma unroll
    for (int r = 1; r < 16; ++r) a = fmaxf(fmaxf(a, p0[r]), p1[r]);
    auto rr = __builtin_amdgcn_permlane32_swap(__float_as_uint(a), __float_as_uint(a), false, false);
    return fmaxf(__uint_as_float(rr[0]), __uint_as_float(rr[1]));
}
__device__ __forceinline__ unsigned cvtpk(float lo, float hi) { typedef float f2 __attribute__((ext_vector_type(2))); typedef __bf16 b2 __attribute__((ext_vector_type(2))); f2 v = {lo, hi}; b2 b = __builtin_convertvector(v, b2); return __builtin_bit_cast(unsigned, b); }
__device__ __forceinline__ s16x4 vtr(LAS const unsigned char* p) { return __builtin_bit_cast(s16x4, __builtin_amdgcn_ds_read_tr16_b64_v4i16((LAS v4i16_t*)p)); }

template <class Side> __device__ __forceinline__ void attn_unit(LAS unsigned char* lds, const bf16_t* __restrict__ proj, const float* __restrict__ relb, bf16_t* __restrict__ mix, float* __restrict__ ssA, int b, int h, int cg, Side& side, bool fill_table) {
    const int tid = threadIdx.x, lane = tid & 63, r32 = lane & 31, hi = lane >> 5, w = __builtin_amdgcn_readfirstlane(tid >> 6);
    const int c0 = cg * 4, cq = c0 + (w >> 1), qi = 32 * (w & 1) + r32;
    const int j0 = c0 - 8 < 0 ? 0 : c0 - 8, j1 = c0 + 3;
    const unsigned lds32 = (unsigned)(__UINTPTR_TYPE__)lds;
    LAS float* tb = (LAS float*)(lds + L_TB);
    if (fill_table) for (int i = tid; i < NTB; i += NTHREADS) tb[i] = relb[h * NREL + (i > 512 ? 512 : i)] * LOG2E;
    const size_t tq = (size_t)b * SEQ + (size_t)c0 * 64 + 32 * w + r32;
    bf16x8 qr[4];
#pragma unroll
    for (int d0 = 0; d0 < 4; ++d0) qr[d0] = *(const bf16x8*)(proj + tq * NPROJ + h * HD + d0 * 16 + hi * 8);
    const int krow = 8 * w + (lane >> 3);
    const bf16_t* ksrc = proj + ((size_t)b * SEQ + krow) * NPROJ + DATT + h * HD + (((lane & 7) ^ ((krow >> 1) & 7)) * 8);
    const bf16_t* vsrc = proj + ((size_t)b * SEQ + 16 * (w & 3) + (lane >> 2)) * NPROJ + 2 * DATT + h * HD + (w >> 2) * 32 + (lane & 3) * 8;
#define ATT_GLDS(gsrc, ldsdst) do { unsigned keep_; asm volatile("s_mov_b32 %0, m0\n\ts_mov_b32 m0, %2\n\ts_nop 0\n\tglobal_load_lds_dwordx4 %1, off\n\ts_mov_b32 m0, %0" : "=&s"(keep_) : "v"(gsrc), "s"((unsigned)__builtin_amdgcn_readfirstlane((int)(ldsdst))) : "memory"); } while (0)
#define ATT_DMA1(j, off) do { ATT_GLDS(ksrc + (size_t)(j) * 64 * NPROJ, lds32 + L_K + (off) + w * 1024); ATT_GLDS(vsrc + (size_t)(j) * 64 * NPROJ, lds32 + L_V + (off) + w * 1024); } while (0)
#define ATT_DMA(j, slot) do { ATT_DMA1(j, (slot) * SLOT); ATT_DMA1((j) + 1, (slot) * SLOT + 8192); } while (0)
    int ka[4];
#pragma unroll
    for (int d0 = 0; d0 < 4; ++d0) ka[d0] = r32 * 128 + (((2 * d0 + hi) ^ ((r32 >> 1) & 7)) * 16);
    const int va = ((lane >> 4) & 1) * 32 + (lane & 3) * 8 + (4 * hi + ((lane & 15) >> 2)) * 64;
    float m = -1e30f, l = 0.f; f32x16 o[2];
#pragma unroll
    for (int r = 0; r < 16; ++r) { o[0][r] = 0.f; o[1][r] = 0.f; }
    ATT_DMA(j0, 0);
    for (int js = j0; js <= j1; js += 2) {
        const int slot = ((js - j0) >> 1) & 1;
        unsigned long long tb0_ = 0; if (TSPROBE == 34 || TSPROBE == 35) tb0_ = __builtin_amdgcn_s_memrealtime();
        if (TSPROBE == 35) { asm volatile("s_waitcnt vmcnt(0) lgkmcnt(0)" ::: "memory"); side.twait += __builtin_amdgcn_s_memrealtime() - tb0_; }
        asm volatile("s_waitcnt vmcnt(0) lgkmcnt(0)\n\ts_barrier" ::: "memory");
        if (TSPROBE == 34) side.twait += __builtin_amdgcn_s_memrealtime() - tb0_;
        side.step();
        if (js + 2 <= j1) ATT_DMA(js + 2, slot ^ 1);
#pragma unroll
        for (int half = 0; half < 2; ++half) {
        const int j = js + half, dl = cq - j;
        if (dl >= 0 && dl <= 8) {
            LAS const unsigned char* Ks = lds + L_K + slot * SLOT + half * 8192; LAS const unsigned char* Vs = lds + L_V + slot * SLOT + half * 8192 + va;
            f32x16 p0, p1;
            if (dl <= 4) { LAS const float* tp = tb + (64 * dl + qi + 256 - 4 * hi - 59);
#pragma unroll
                for (int r = 0; r < 16; ++r) { p0[r] = tp[59 - ((r & 3) + 8 * (r >> 2))]; p1[r] = tp[27 - ((r & 3) + 8 * (r >> 2))]; } }
            else { const float bf = tb[NTB - 1];
#pragma unroll
                for (int r = 0; r < 16; ++r) { p0[r] = bf; p1[r] = bf; } }
            { bf16x8 kf[8];
#pragma unroll
              for (int d0 = 0; d0 < 4; ++d0) { kf[2 * d0] = *(LAS const bf16x8*)(Ks + ka[d0]); kf[2 * d0 + 1] = *(LAS const bf16x8*)(Ks + ka[d0] + 4096); }
              __builtin_amdgcn_sched_barrier(0);
#pragma unroll
              for (int d0 = 0; d0 < 4; ++d0) { p0 = __builtin_amdgcn_mfma_f32_32x32x16_bf16(kf[2 * d0], qr[d0], p0, 0, 0, 0); p1 = __builtin_amdgcn_mfma_f32_32x32x16_bf16(kf[2 * d0 + 1], qr[d0], p1, 0, 0, 0); } }
            const float mx = rowmax32(p0, p1);
            if (__any(mx > m + THR)) { const float mn = fmaxf(m, mx), al = __builtin_amdgcn_exp2f(m - mn); m = mn; l *= al;
#pragma unroll
                for (int r = 0; r < 16; ++r) { o[0][r] *= al; o[1][r] *= al; } }
            float rs = 0.f;
#pragma unroll
            for (int r = 0; r < 16; ++r) { p0[r] = __builtin_amdgcn_exp2f(p0[r] - m); p1[r] = __builtin_amdgcn_exp2f(p1[r] - m); rs += p0[r] + p1[r]; }
            l += rs;
            bf16x8 pw[4];
#pragma unroll
            for (int ks = 0; ks < 4; ++ks) { const f32x16& P = ks < 2 ? p0 : p1; const int bo = (ks & 1) * 8; typedef unsigned u4 __attribute__((ext_vector_type(4)));
                u4 t4 = {cvtpk(P[bo], P[bo + 1]), cvtpk(P[bo + 2], P[bo + 3]), cvtpk(P[bo + 4], P[bo + 5]), cvtpk(P[bo + 6], P[bo + 7])}; pw[ks] = __builtin_bit_cast(bf16x8, t4); }
            { s16x4 vl[8], vh[8];
#pragma unroll
              for (int i = 0; i < 8; ++i) { vl[i] = vtr(Vs + (i >> 2) * 4096 + (i & 3) * 1024); vh[i] = vtr(Vs + (i >> 2) * 4096 + (i & 3) * 1024 + 512); }
              __builtin_amdgcn_sched_barrier(0);
#pragma unroll
              for (int i = 0; i < 8; ++i) { const bf16x8 vf = {vl[i][0], vl[i][1], vl[i][2], vl[i][3], vh[i][0], vh[i][1], vh[i][2], vh[i][3]};
                  o[i >> 2] = __builtin_amdgcn_mfma_f32_32x32x16_bf16(vf, pw[i & 3], o[i >> 2], 0, 0, 0); } }
        }
        }
    }
    { auto rr = __builtin_amdgcn_permlane32_swap(__float_as_uint(l), __float_as_uint(l), false, false); l = __uint_as_float(rr[0]) + __uint_as_float(rr[1]); }
    const float il = 1.f / l; float ss = 0.f;
    bf16_t* op = mix + tq * DM + h * HD + 4 * hi;
#pragma unroll
    for (int d0 = 0; d0 < 2; ++d0)
#pragma unroll
        for (int g = 0; g < 4; ++g) { const float v0 = o[d0][4 * g] * il, v1 = o[d0][4 * g + 1] * il, v2 = o[d0][4 * g + 2] * il, v3 = o[d0][4 * g + 3] * il;
            ss += v0 * v0 + v1 * v1 + v2 * v2 + v3 * v3; *(uint2*)(op + 32 * d0 + 8 * g) = make_uint2(cvtpk(v0, v1), cvtpk(v2, v3)); }
    { auto rr = __builtin_amdgcn_permlane32_swap(__float_as_uint(ss), __float_as_uint(ss), false, false); ss = __uint_as_float(rr[0]) + __uint_as_float(rr[1]); }
    if (hi == 0) ssA[tq * 16 + h] = ss;
    asm volatile("s_waitcnt vmcnt(0) lgkmcnt(0)\n\ts_barrier" ::: "memory");
#undef ATT_DMA
#undef ATT_DMA1
#undef ATT_GLDS
}
}

__device__ __forceinline__ void conv_slab(const bf16_t* __restrict__ proj, const float* __restrict__ cw, bf16_t* __restrict__ mix, float* __restrict__ ssC2, int item, int lane) {
    const int slab = item & 1, t0 = (item >> 1) * 16, ch = slab * 512 + lane * 8;
    float w0[8], w1[8], w2[8];
#pragma unroll
    for (int q = 0; q < 2; ++q) { const float4 a = *(const float4*)(cw + ch + 4 * q), b = *(const float4*)(cw + DCONV + ch + 4 * q), c = *(const float4*)(cw + 2 * DCONV + ch + 4 * q);
        w0[4 * q] = a.x; w0[4 * q + 1] = a.y; w0[4 * q + 2] = a.z; w0[4 * q + 3] = a.w; w1[4 * q] = b.x; w1[4 * q + 1] = b.y; w1[4 * q + 2] = b.z; w1[4 * q + 3] = b.w;
        w2[4 * q] = c.x; w2[4 * q + 1] = c.y; w2[4 * q + 2] = c.z; w2[4 * q + 3] = c.w; }
    float z1[8], z2[8];
#pragma unroll
    for (int q = 0; q < 8; ++q) { z1[q] = 0.f; z2[q] = 0.f; }
    if ((t0 & (SEQ - 1)) != 0) {
        const bf16_t* p2 = proj + (size_t)(t0 - 2) * NPROJ; const bf16_t* p1 = proj + (size_t)(t0 - 1) * NPROJ;
        const uint4 c2 = *(const uint4*)(p2 + 4 * DATT + ch), u2 = *(const uint4*)(p2 + 5 * DATT + ch), c1 = *(const uint4*)(p1 + 4 * DATT + ch), u1 = *(const uint4*)(p1 + 5 * DATT + ch);
        const unsigned c2w[4] = {c2.x, c2.y, c2.z, c2.w}, u2w[4] = {u2.x, u2.y, u2.z, u2.w}, c1w[4] = {c1.x, c1.y, c1.z, c1.w}, u1w[4] = {u1.x, u1.y, u1.z, u1.w};
#pragma unroll
        for (int q = 0; q < 4; ++q) { z2[2 * q] = bf2f(c2w[q] & 0xffffu) * bf2f(u2w[q] & 0xffffu); z2[2 * q + 1] = bf2f(c2w[q] >> 16) * bf2f(u2w[q] >> 16);
            z1[2 * q] = bf2f(c1w[q] & 0xffffu) * bf2f(u1w[q] & 0xffffu); z1[2 * q + 1] = bf2f(c1w[q] >> 16) * bf2f(u1w[q] >> 16); }
    }
#pragma unroll 1
    for (int i0 = 0; i0 < 16; i0 += 8) {
    uint4 bv[8], cv[8], uv[8];
#pragma unroll
    for (int i = 0; i < 8; ++i) { const bf16_t* pr = proj + (size_t)(t0 + i0 + i) * NPROJ; bv[i] = *(const uint4*)(pr + 3 * DATT + ch); cv[i] = *(const uint4*)(pr + 4 * DATT + ch); uv[i] = *(const uint4*)(pr + 5 * DATT + ch); }
#pragma unroll
    for (int i = 0; i < 8; ++i) { const int t = t0 + i0 + i;
        const unsigned bw[4] = {bv[i].x, bv[i].y, bv[i].z, bv[i].w}, cw4[4] = {cv[i].x, cv[i].y, cv[i].z, cv[i].w}, uw[4] = {uv[i].x, uv[i].y, uv[i].z, uv[i].w};
        float y[8]; float ss = 0.f;
#pragma unroll
        for (int q = 0; q < 4; ++q) {
            const float za = bf2f(cw4[q] & 0xffffu) * bf2f(uw[q] & 0xffffu), zb = bf2f(cw4[q] >> 16) * bf2f(uw[q] >> 16);
            y[2 * q] = bf2f(bw[q] & 0xffffu) * (w0[2 * q] * z2[2 * q] + w1[2 * q] * z1[2 * q] + w2[2 * q] * za);
            y[2 * q + 1] = bf2f(bw[q] >> 16) * (w0[2 * q + 1] * z2[2 * q + 1] + w1[2 * q + 1] * z1[2 * q + 1] + w2[2 * q + 1] * zb);
            ss += y[2 * q] * y[2 * q] + y[2 * q + 1] * y[2 * q + 1];
            z2[2 * q] = z1[2 * q]; z1[2 * q] = za; z2[2 * q + 1] = z1[2 * q + 1]; z1[2 * q + 1] = zb; }
        *(uint4*)(mix + (size_t)t * DM + DATT + ch) = make_uint4(cvtpk2(y[0], y[1]), cvtpk2(y[2], y[3]), cvtpk2(y[4], y[5]), cvtpk2(y[6], y[7]));
        ss = wave_sum(ss);
        if (lane == 0) ssC2[t * 4 + slab] = ss; }
    }
}

namespace g8 {
typedef unsigned u32x4 __attribute__((ext_vector_type(4)));
typedef int v4i_t __attribute__((ext_vector_type(4)));
typedef int v8i_t __attribute__((ext_vector_type(8)));
constexpr int BM = 256, BK = 64, HALF = 128, HTB = HALF * BK * 2, STAGE_BYTES = 8 * HTB, NXCD = 8, WGM = 8;
__device__ __forceinline__ int lds_byte(int r, int c) { const int st = (r >> 4) * 2 + (c >> 5), rr = r & 15, cc = c & 31, ob = rr * 64 + cc * 2; return st * 1024 + (ob ^ (((ob >> 9) & 1) << 5)); }
__device__ __forceinline__ void stage_rc(int b, int& R, int& C) { const int st = b / 1024, sb = b % 1024, swz = sb ^ (((sb >> 9) & 1) << 5); R = (st >> 1) * 16 + swz / 64; C = (st & 1) * 32 + (swz % 64) / 2; }
__device__ __forceinline__ int perm32(int rho) { const int n = rho >> 4, i = rho & 15; return 8 * (i >> 2) + 4 * n + (i & 3); }
__device__ __forceinline__ unsigned cvt_pk_bf16(float lo, float hi) { unsigned r; asm volatile("v_cvt_pk_bf16_f32 %0, %1, %2" : "=v"(r) : "v"(lo), "v"(hi)); return r; }
__device__ __forceinline__ int xcd_remap(int wgid, int nwg) { const int q = nwg / NXCD, r = nwg % NXCD, xcd = wgid % NXCD, off = wgid / NXCD; return (xcd < r ? xcd * (q + 1) : r * (q + 1) + (xcd - r) * q) + off; }

struct Unit { int pm, pn, e, slot; const char* a; const char* b; };

struct DenseOrder {
    const char* A; const char* Bt; int K, nM, nN, nwg, G, c, mul = 1;
    __device__ __forceinline__ void init(const void* A_, const void* Bt_, int M, int N, int K_, int G_, int c_) { A = (const char*)A_; Bt = (const char*)Bt_; K = K_; nM = M / BM; nN = N / BM; nwg = nM * nN; G = G_; c = c_; }
    __device__ __forceinline__ bool next(int i, Unit& u) const {
        int L = i * G + c; if (L >= nwg * mul) return false; L %= nwg;
        const int wgid = xcd_remap(L, nwg);
        const int nig = WGM * nN, gid = wgid / nig, fm = gid * WGM, gsz = (nM - fm) < WGM ? (nM - fm) : WGM;
        u.pm = fm + ((wgid % nig) % gsz); u.pn = (wgid % nig) / gsz; u.e = i; u.slot = i % 3;
        u.a = A + (size_t)u.pm * BM * K * 2; u.b = Bt + (size_t)u.pn * BM * K * 2; return true;
    }
    __device__ __forceinline__ unsigned arow_off(const Unit&, int r, int Kb) const { return (unsigned)r * (unsigned)Kb; }
    const float* rowscale = nullptr; LAS float* rtab = nullptr;
    __device__ __forceinline__ void prefetch(const Unit& u) const { const int r = threadIdx.x; if (r < BM) rtab[u.slot * BM + r] = rowscale[u.pm * BM + r]; }
    __device__ __forceinline__ float scale_of(const Unit& u, int r) const { return rtab[u.slot * BM + r]; }
};
template <bool GATHER> struct MoeOrder {
    const char* A; const char* Bt; const int* list; LAS const int* pl; int K  , NPN, nwg, G, c; size_t estride; int mul;
    LAS int* rinfo; const float* rscale;
    __device__ __forceinline__ bool next(int i, Unit& u) const {
        int L = i * G + c; if (L >= nwg * mul) return false; L %= nwg;
        const int wgid = xcd_remap(L, nwg);
        u.pm = wgid / NPN; u.pn = wgid % NPN; u.e = pl[64 + u.pm]; u.slot = i % 3;
        u.a = GATHER ? A : A + (size_t)u.pm * BM * K; u.b = Bt + (size_t)u.e * estride + (size_t)u.pn * BM * K; return true;
    }
    __device__ __forceinline__ void prefetch(const Unit& u) const {
        const int r = threadIdx.x;
        if (r < BM) { const int slot = u.pm * BM + r - pl[32 + u.e]; int pr = -1; float sc = 0.f;
            if (slot < pl[u.e]) { pr = list[u.e * T + slot]; sc = rscale[GATHER ? (pr >> 1) : pr]; }
            rinfo[(u.slot * BM + r) * 2] = pr; rinfo[(u.slot * BM + r) * 2 + 1] = __float_as_int(sc); }
    }
    __device__ __forceinline__ int pair_of(const Unit& u, int r) const { return rinfo[(u.slot * BM + r) * 2]; }
    __device__ __forceinline__ float scale_of(const Unit& u, int r) const { return __int_as_float(rinfo[(u.slot * BM + r) * 2 + 1]); }
    __device__ __forceinline__ unsigned arow_off(const Unit& u, int r, int Kb) const {
        if (GATHER) { const int pr = pair_of(u, r); return (unsigned)(pr >= 0 ? (pr >> 1) : 0) * (unsigned)Kb; }
        return (unsigned)r * (unsigned)Kb;
    }
};

template <bool GATHER, int ES, class Epi, class Sched>
__device__ __forceinline__ void gemm_phase(LAS unsigned char* lds, const int K, const Sched& S, const Epi& E) {
    int tid_ = threadIdx.x; asm volatile("" : "+v"(tid_));
    const int tid = tid_, wid = __builtin_amdgcn_readfirstlane(tid >> 6), lane = tid & 63, wr = wid >> 2, wc = wid & 3, fr = lane & 15, fq = lane >> 4;
    const int Kb = K * ES, nt = Kb / (BK * 2);
    unsigned voffB[2];
#pragma unroll
    for (int i = 0; i < 2; ++i) { int R, C; stage_rc(tid * 16 + i * 8192, R, C); const int Rb = Epi::PERM ? ((R & ~31) + perm32(R & 31)) : R; voffB[i] = (unsigned)(Rb * Kb + C * 2); }
#define G8_AOFF(u, h, i) ([&]() { int R_, C_; stage_rc(tid * 16 + (i) * 8192, R_, C_); return S.arow_off(u, (h) * HALF + R_, Kb) + (unsigned)(C_ * 2); }())
    const size_t kstep = (size_t)(BK * 2);
    const size_t hstep = (size_t)HALF * Kb;
    const unsigned ldsw = (unsigned)wid * 1024u;
    const int aoff = lds_byte(wr * 64 + fr, fq * 8), boff = lds_byte(wc * 32 + fr, fq * 8);
#define G8_SA(b, h) (((b) * 2 + (h)) * HTB)
#define G8_SB(b, h) ((4 + (b) * 2 + (h)) * HTB)
#define G8_STAGE(bufoff, gbase, voff) do { _Pragma("unroll") for (int _i = 0; _i < 2; ++_i) \
        __builtin_amdgcn_global_load_lds((const unsigned*)((const char*)(gbase) + (voff)[_i]), (LAS unsigned*)(lds + (bufoff) + ldsw + _i * 8192), 16, 0, 0); } while (0)
#define G8_LDA(dst, b, h) do { _Pragma("unroll") for (int m = 0; m < 4; ++m) { if (ES == 2) { _Pragma("unroll") for (int k = 0; k < 2; ++k) dst[m][k] = *(const LAS bf16x8*)(lds + G8_SA(b, h) + aoff + m * 2048 + k * 1024); } \
        else dst##8[m] = __builtin_shufflevector(*(const LAS v4i_t*)(lds + G8_SA(b, h) + aoff + m * 2048), *(const LAS v4i_t*)(lds + G8_SA(b, h) + aoff + m * 2048 + 1024), 0, 1, 2, 3, 4, 5, 6, 7); } } while (0)
#define G8_LDB(dst, b, h) do { _Pragma("unroll") for (int n = 0; n < 2; ++n) { if (ES == 2) { _Pragma("unroll") for (int k = 0; k < 2; ++k) dst[n][k] = *(const LAS bf16x8*)(lds + G8_SB(b, h) + boff + n * 2048 + k * 1024); } \
        else dst##8[n] = __builtin_shufflevector(*(const LAS v4i_t*)(lds + G8_SB(b, h) + boff + n * 2048), *(const LAS v4i_t*)(lds + G8_SB(b, h) + boff + n * 2048 + 1024), 0, 1, 2, 3, 4, 5, 6, 7); } } while (0)
#define G8_CAT(x, y) __builtin_shufflevector(__builtin_bit_cast(v4i_t, x), __builtin_bit_cast(v4i_t, y), 0, 1, 2, 3, 4, 5, 6, 7)
#define G8_MMA(ai, bj, At, Bt) do { __builtin_amdgcn_s_setprio(1); _Pragma("unroll") for (int m = 0; m < 4; ++m) _Pragma("unroll") for (int n = 0; n < 2; ++n) { \
        if (ES == 2) { _Pragma("unroll") for (int k = 0; k < 2; ++k) acc[ai][bj][m][n] = __builtin_amdgcn_mfma_f32_16x16x32_bf16(Bt[n][k], At[m][k], acc[ai][bj][m][n], 0, 0, 0); } \
        else asm volatile("v_mfma_scale_f32_16x16x128_f8f6f4 %0, %1, %2, %0, %3, %3 op_sel_hi:[0,0,0]" : "+v"(acc[ai][bj][m][n]) : "v"(Bt##8[n]), "v"(At##8[m]), "v"(scale1)); } \
        __builtin_amdgcn_s_setprio(0); } while (0)
#define G8_WAIT_V(n) asm volatile("s_waitcnt vmcnt(" #n ")" ::: "memory")
#define G8_WAIT_L(n) asm volatile("s_waitcnt lgkmcnt(" #n ")" ::: "memory")
#define G8_BAR __builtin_amdgcn_s_barrier()
#define G8_SCHED __builtin_amdgcn_sched_barrier(0)
    Unit cur, nxt; int ui = 0;
    if (!S.next(0, cur)) return;
    if (GATHER || Epi::ROWINFO) { S.prefetch(cur); __syncthreads(); }
    f32x4 acc[2][2][4][2];
#pragma unroll
    for (int a = 0; a < 2; ++a)
#pragma unroll
        for (int b = 0; b < 2; ++b)
#pragma unroll
            for (int m = 0; m < 4; ++m)
#pragma unroll
                for (int n = 0; n < 2; ++n) acc[a][b][m][n] = (f32x4){0.f, 0.f, 0.f, 0.f};
    bf16x8 At[4][2], B0[2][2], B1[2][2];
    v8i_t At8[4], B08[2], B18[2];
    const int scale1 = 0x7F7F7F7F;
    unsigned vA[2][2];
#pragma unroll
    for (int h = 0; h < 2; ++h)
#pragma unroll
        for (int i = 0; i < 2; ++i) vA[h][i] = G8_AOFF(cur, h, i);
    const char* cA = cur.a; const char* cB = cur.b;
    G8_STAGE(G8_SB(0, 0), cB, voffB); G8_STAGE(G8_SB(0, 1), cB + hstep, voffB); G8_STAGE(G8_SA(0, 0), cA, vA[0]); G8_STAGE(G8_SA(0, 1), cA, vA[1]);
    if (wr == 1) G8_BAR;
    G8_WAIT_V(2); G8_BAR;
    G8_STAGE(G8_SB(1, 0), cB + kstep, voffB); G8_STAGE(G8_SA(1, 0), cA + kstep, vA[0]); G8_STAGE(G8_SB(1, 1), cB + hstep + kstep, voffB);
    G8_WAIT_V(6); G8_BAR;
    for (;;) {
        const bool has_next = S.next(ui + 1, nxt);
        const char* nA = has_next ? nxt.a : cA; const char* nB = has_next ? nxt.b : cB;
        if ((GATHER || Epi::ROWINFO) && has_next) S.prefetch(nxt);
        for (int t = 0; t < nt; t += 2) {
            const bool last = (t == nt - 2);
            if (Epi::MID_T >= 0 && t == Epi::MID_T) E.mid(acc, cur, wr, wc, fr, fq);
            const char* a1 = cA + (size_t)(t + 1) * kstep;
            const char* a2 = last ? nA : cA + (size_t)(t + 2) * kstep; const char* b2 = last ? nB : cB + (size_t)(t + 2) * kstep;
            const char* a3 = a2 + kstep; const char* b3 = b2 + kstep;
            unsigned v2[2][2];
#pragma unroll
            for (int h = 0; h < 2; ++h)
#pragma unroll
                for (int i = 0; i < 2; ++i) v2[h][i] = (GATHER && last && has_next) ? G8_AOFF(nxt, h, i) : vA[h][i];
            G8_LDB(B0, 0, 0); G8_LDB(B1, 0, 1); G8_SCHED; G8_LDA(At, 0, 0); G8_STAGE(G8_SA(1, 1), a1, vA[1]);
            G8_WAIT_V(8); G8_WAIT_L(0); G8_BAR; G8_MMA(0, 0, At, B0); G8_MMA(0, 1, At, B1); G8_BAR; G8_SCHED;
            G8_LDA(At, 0, 1); G8_STAGE(G8_SB(0, 0), b2, voffB); G8_STAGE(G8_SB(0, 1), b2 + hstep, voffB); G8_STAGE(G8_SA(0, 0), a2, v2[0]);
            G8_WAIT_V(8); G8_WAIT_L(0); G8_BAR; G8_MMA(1, 0, At, B0); G8_MMA(1, 1, At, B1); G8_BAR; G8_SCHED;
            G8_LDB(B0, 1, 0); G8_LDB(B1, 1, 1); G8_SCHED; G8_LDA(At, 1, 0); G8_STAGE(G8_SA(0, 1), a2, v2[1]);
            G8_WAIT_V(8); G8_WAIT_L(0); G8_BAR; G8_MMA(0, 0, At, B0); G8_MMA(0, 1, At, B1); G8_BAR; G8_SCHED;
            G8_LDA(At, 1, 1); G8_STAGE(G8_SB(1, 0), b3, voffB); G8_STAGE(G8_SB(1, 1), b3 + hstep, voffB); G8_STAGE(G8_SA(1, 0), a3, v2[0]);
            G8_WAIT_V(8); G8_WAIT_L(0); G8_BAR; G8_MMA(1, 0, At, B0); G8_MMA(1, 1, At, B1); G8_BAR; G8_SCHED;
        }
        if (wr == 0) G8_BAR;
        E(acc, cur, wr, wc, fr, fq);
        if (!has_next) break;
#pragma unroll
        for (int a = 0; a < 2; ++a)
#pragma unroll
            for (int b = 0; b < 2; ++b)
#pragma unroll
                for (int m = 0; m < 4; ++m)
#pragma unroll
                    for (int n = 0; n < 2; ++n) acc[a][b][m][n] = (f32x4){0.f, 0.f, 0.f, 0.f};
        cur = nxt; cA = nA; cB = nB; ++ui;
#pragma unroll
        for (int h = 0; h < 2; ++h)
#pragma unroll
            for (int i = 0; i < 2; ++i) if (GATHER) vA[h][i] = G8_AOFF(cur, h, i);
        if (wr == 1) G8_BAR;
    }
    G8_WAIT_V(0);
    G8_BAR;
#undef G8_SA
#undef G8_SB
#undef G8_STAGE
#undef G8_LDA
#undef G8_LDB
#undef G8_MMA
#undef G8_AOFF
#undef G8_CAT
#undef G8_WAIT_V
#undef G8_WAIT_L
#undef G8_BAR
#undef G8_SCHED
}

template <class Sched> struct EpiProjF { static constexpr bool PERM = true, ROWINFO = true; static constexpr int MID_T = -1; bf16_t* out; const Sched* S;
    __device__ __forceinline__ void mid(f32x4 (&)[2][2][4][2], const Unit&, int, int, int, int) const {}
    __device__ __forceinline__ void operator()(const f32x4 (&acc)[2][2][4][2], const Unit& u, int wr, int wc, int fr, int fq) const {
        const int row0 = u.pm * BM + wr * 64 + fr, col0 = u.pn * BM + wc * 32 + 8 * fq;
#pragma unroll
        for (int ai = 0; ai < 2; ++ai)
#pragma unroll
            for (int m = 0; m < 4; ++m) { const int row = row0 + ai * HALF + m * 16; const float s = S->scale_of(u, ai * HALF + wr * 64 + m * 16 + fr); bf16_t* rowp = out + (size_t)row * NPROJ + col0;
#pragma unroll
                for (int bj = 0; bj < 2; ++bj) { const f32x4 v0 = acc[ai][bj][m][0] * s, v1 = acc[ai][bj][m][1] * s; u32x4 w; w.x = cvt_pk_bf16(v0[0], v0[1]); w.y = cvt_pk_bf16(v0[2], v0[3]); w.z = cvt_pk_bf16(v1[0], v1[1]); w.w = cvt_pk_bf16(v1[2], v1[3]);
                    *(u32x4*)(rowp + bj * HALF) = w; } }
    }
};
struct EpiG2F { static constexpr bool PERM = true, ROWINFO = false; static constexpr int MID_T = DATT / BK; bf16_t* out; LAS const float* tab;
    __device__ __forceinline__ void mid(f32x4 (&acc)[2][2][4][2], const Unit& u, int wr, int wc, int fr, int fq) const {
        LAS const float* tb = tab + (size_t)(u.e) * 512;
#pragma unroll
        for (int ai = 0; ai < 2; ++ai)
#pragma unroll
            for (int m = 0; m < 4; ++m) { const float s = tb[(ai * HALF + wr * 64 + m * 16 + fr) * 2];
#pragma unroll
                for (int bj = 0; bj < 2; ++bj)
#pragma unroll
                    for (int n = 0; n < 2; ++n) acc[ai][bj][m][n] *= s; }
    }
    __device__ __forceinline__ void operator()(const f32x4 (&acc)[2][2][4][2], const Unit& u, int wr, int wc, int fr, int fq) const {
        LAS const float* tb = tab + (size_t)(u.e) * 512;
        const int col0 = u.pn * BM + wc * 32 + 8 * fq;
#pragma unroll
        for (int ai = 0; ai < 2; ++ai)
#pragma unroll
            for (int m = 0; m < 4; ++m) { const int r = ai * HALF + wr * 64 + m * 16 + fr; const float s = tb[r * 2 + 1]; bf16_t* rowp = out + (size_t)(u.pm * BM + r) * DM + col0;
#pragma unroll
                for (int bj = 0; bj < 2; ++bj) { const f32x4 v0 = acc[ai][bj][m][0] * s, v1 = acc[ai][bj][m][1] * s; u32x4 w; w.x = cvt_pk_bf16(v0[0], v0[1]); w.y = cvt_pk_bf16(v0[2], v0[3]); w.z = cvt_pk_bf16(v1[0], v1[1]); w.w = cvt_pk_bf16(v1[2], v1[3]);
                    *(u32x4*)(rowp + bj * HALF) = w; } }
    }
};
struct EpiG2X { static constexpr bool PERM = true, ROWINFO = false; static constexpr int MID_T = DATT / BK; bf16_t* out; LAS const float* tab;
    __device__ __forceinline__ void mid(f32x4 (&acc)[2][2][4][2], const Unit& u, int wr, int wc, int fr, int fq) const {
        LAS const float* tb = tab + (size_t)(u.e) * 512;
#pragma unroll
        for (int ai = 0; ai < 2; ++ai)
#pragma unroll
            for (int m = 0; m < 4; ++m) { const float s = tb[(ai * HALF + wr * 64 + m * 16 + fr) * 2];
#pragma unroll
                for (int bj = 0; bj < 2; ++bj)
#pragma unroll
                    for (int n = 0; n < 2; ++n) acc[ai][bj][m][n] *= s; }
    }
    __device__ __forceinline__ void operator()(const f32x4 (&acc)[2][2][4][2], const Unit& u, int wr, int wc, int fr, int fq) const {
        LAS const float* tb = tab + (size_t)(u.e) * 512;
        const int col0 = u.pn * BM + wc * 32 + 8 * fq;
        u32x4 xv[2][4][2];
#pragma unroll
        for (int ai = 0; ai < 2; ++ai)
#pragma unroll
            for (int m = 0; m < 4; ++m) { const bf16_t* xp = out + (size_t)(u.pm * BM + ai * HALF + wr * 64 + m * 16 + fr) * DM + col0;
#pragma unroll
                for (int bj = 0; bj < 2; ++bj) xv[ai][m][bj] = *(const u32x4*)(xp + bj * HALF); }
#pragma unroll
        for (int ai = 0; ai < 2; ++ai)
#pragma unroll
            for (int m = 0; m < 4; ++m) { const int r = ai * HALF + wr * 64 + m * 16 + fr; const float s = tb[r * 2 + 1]; bf16_t* rowp = out + (size_t)(u.pm * BM + r) * DM + col0;
#pragma unroll
                for (int bj = 0; bj < 2; ++bj) { const u32x4 xw = xv[ai][m][bj];
                    const f32x4 x0 = {__uint_as_float(xw.x << 16), __uint_as_float(xw.x & 0xffff0000u), __uint_as_float(xw.y << 16), __uint_as_float(xw.y & 0xffff0000u)};
                    const f32x4 x1 = {__uint_as_float(xw.z << 16), __uint_as_float(xw.z & 0xffff0000u), __uint_as_float(xw.w << 16), __uint_as_float(xw.w & 0xffff0000u)};
                    const f32x4 v0 = acc[ai][bj][m][0] * s + x0, v1 = acc[ai][bj][m][1] * s + x1; u32x4 w; w.x = cvt_pk_bf16(v0[0], v0[1]); w.y = cvt_pk_bf16(v0[2], v0[3]); w.z = cvt_pk_bf16(v1[0], v1[1]); w.w = cvt_pk_bf16(v1[2], v1[3]);
                    *(u32x4*)(rowp + bj * HALF) = w; } }
    }
};
template <class Sched> struct EpiGUF { static constexpr bool PERM = true, ROWINFO = true; static constexpr int MID_T = -1; bf16_t* Hb; const Sched* S;
    __device__ __forceinline__ void mid(f32x4 (&)[2][2][4][2], const Unit&, int, int, int, int) const {}
    __device__ __forceinline__ void operator()(const f32x4 (&acc)[2][2][4][2], const Unit& u, int wr, int wc, int fr, int fq) const {
        const int col0 = u.pn * HALF + wc * 32 + 8 * fq;
#pragma unroll
        for (int ai = 0; ai < 2; ++ai)
#pragma unroll
            for (int m = 0; m < 4; ++m) { const int r = ai * HALF + wr * 64 + m * 16 + fr; const float s = S->scale_of(u, r) * (1.f / WSCALE8);
                float h[8];
#pragma unroll
                for (int n = 0; n < 2; ++n)
#pragma unroll
                    for (int q = 0; q < 4; ++q) { const float gg = acc[ai][0][m][n][q] * s, uu = acc[ai][1][m][n][q] * s; h[4 * n + q] = gg * __builtin_amdgcn_rcpf(1.f + __expf(-gg)) * uu; }
                int w0 = __builtin_amdgcn_cvt_pk_fp8_f32(h[0] * HSCALE8, h[1] * HSCALE8, 0, false); w0 = __builtin_amdgcn_cvt_pk_fp8_f32(h[2] * HSCALE8, h[3] * HSCALE8, w0, true);
                int w1 = __builtin_amdgcn_cvt_pk_fp8_f32(h[4] * HSCALE8, h[5] * HSCALE8, 0, false); w1 = __builtin_amdgcn_cvt_pk_fp8_f32(h[6] * HSCALE8, h[7] * HSCALE8, w1, true);
                *(uint2*)((unsigned char*)Hb + (size_t)(u.pm * BM + r) * DEXP + col0) = make_uint2((unsigned)w0, (unsigned)w1); }
    }
};
template <class Sched> struct EpiDownF { static constexpr bool PERM = true, ROWINFO = true; static constexpr int MID_T = -1; unsigned char* Y; const Sched* S;
    __device__ __forceinline__ void mid(f32x4 (&)[2][2][4][2], const Unit&, int, int, int, int) const {}
    __device__ __forceinline__ void operator()(const f32x4 (&acc)[2][2][4][2], const Unit& u, int wr, int wc, int fr, int fq) const {
        const int col0 = u.pn * BM + wc * 32 + 8 * fq;
#pragma unroll
        for (int ai = 0; ai < 2; ++ai)
#pragma unroll
            for (int m = 0; m < 4; ++m) { const int r = ai * HALF + wr * 64 + m * 16 + fr; const int pr = S->pair_of(u, r); if (pr < 0) continue; const float s = S->scale_of(u, r) * (YSCALE8 / (HSCALE8 * WDSCALE8)); unsigned char* rowp = Y + (size_t)pr * DM + col0;
#pragma unroll
                for (int bj = 0; bj < 2; ++bj) { const f32x4 v0 = acc[ai][bj][m][0] * s, v1 = acc[ai][bj][m][1] * s;
                    int w0 = __builtin_amdgcn_cvt_pk_fp8_f32(v0[0], v0[1], 0, false); w0 = __builtin_amdgcn_cvt_pk_fp8_f32(v0[2], v0[3], w0, true);
                    int w1 = __builtin_amdgcn_cvt_pk_fp8_f32(v1[0], v1[1], 0, false); w1 = __builtin_amdgcn_cvt_pk_fp8_f32(v1[2], v1[3], w1, true);
                    *(uint2*)(rowp + bj * HALF) = make_uint2((unsigned)w0, (unsigned)w1); } }
    }
};
}


#define XB_TMO      128
#define XB_XCNT(j)  (256  + 64 * (j))
#define XB_XSUB(j)  (1280 + 64 * (j))
#define XB_XGEN(j)  (2304 + 64 * (j))
#define XB_TOP      3328
#define XB_TOPGEN   3392
#define XCD_BAR_WORDS 3456
#define XB_SPIN_CAP (1u << 20)
__device__ __forceinline__ unsigned xb_ld(unsigned* p)              { return __hip_atomic_load(p, __ATOMIC_RELAXED, __HIP_MEMORY_SCOPE_AGENT); }
__device__ __forceinline__ unsigned xb_add(unsigned* p, unsigned v) { return __hip_atomic_fetch_add(p, v, __ATOMIC_RELAXED, __HIP_MEMORY_SCOPE_AGENT); }
__device__ __forceinline__ unsigned xb_xcc_id() { return (unsigned)__builtin_amdgcn_s_getreg((3 << 11) | 20) & 0xFu; }
#define XB_SPIN(cond, bar) do { unsigned _sp = 0; while (cond) { __builtin_amdgcn_s_sleep(1); \
    if ((++_sp & 255u) == 0u) { if (xb_ld(&(bar)[XB_TMO])) break; if (_sp > XB_SPIN_CAP) { atomicAdd(&(bar)[XB_TMO], 1u); break; } } } } while (0)
struct XcdBarrier { unsigned* bar; unsigned x; volatile LAS unsigned* st; };
__device__ __forceinline__ XcdBarrier xcd_barrier_post(unsigned* bar, volatile LAS unsigned* st) {
    XcdBarrier b; b.bar = bar; b.x = xb_xcc_id(); b.st = st;
    if (threadIdx.x == 0) (void)xb_add(&bar[XB_XCNT(b.x)], 1u);
    return b;
}
__device__ __forceinline__ void xcd_barrier_complete(unsigned* bar, unsigned x, unsigned& nloc, unsigned& nx) {
    const unsigned G = gridDim.x * gridDim.y * gridDim.z;
    unsigned sum, cnt, mine, sp = 0u;
    for (;;) {
        sum = 0u; cnt = 0u; mine = 0u;
#pragma unroll
        for (unsigned j = 0; j < 16; ++j) { const unsigned c = xb_ld(&bar[XB_XCNT(j)]); sum += c; cnt += (c > 0u) ? 1u : 0u; mine = (j == x) ? c : mine; }
        if (sum == G) break;
        __builtin_amdgcn_s_sleep(1);
        if ((++sp & 255u) == 0u) { if (xb_ld(&bar[XB_TMO])) break; if (sp > XB_SPIN_CAP) { atomicAdd(&bar[XB_TMO], 1u); break; } }
    }
    nloc = mine > 0u ? mine : 1u; nx = cnt > 0u ? cnt : 1u;
}
__device__ __forceinline__ void xcd_barrier(const XcdBarrier& b) {
    asm volatile("s_waitcnt vmcnt(0)" ::: "memory");
    __syncthreads();
    if (threadIdx.x == 0) {
        unsigned* bar = b.bar;
        __builtin_amdgcn_s_waitcnt(0);
        unsigned nloc = b.st[0], nx = b.st[1];
        if (nloc == 0u) { xcd_barrier_complete(bar, b.x, nloc, nx); b.st[0] = nloc; b.st[1] = nx; }
        const unsigned old = xb_add(&bar[XB_XSUB(b.x)], 1u);
        const unsigned gen = old / nloc;
        if (old + 1u == (gen + 1u) * nloc) {
            __builtin_amdgcn_fence(__ATOMIC_RELEASE, "agent");
            asm volatile("s_waitcnt vmcnt(0)" ::: "memory");
            const unsigned og = xb_add(&bar[XB_TOP], 1u);
            const unsigned tg = og / nx;
            if (og + 1u == (tg + 1u) * nx) xb_add(&bar[XB_TOPGEN], 1u);
            else XB_SPIN(xb_ld(&bar[XB_TOPGEN]) == tg, bar);
            __builtin_amdgcn_fence(__ATOMIC_ACQUIRE, "agent");
            xb_add(&bar[XB_XGEN(b.x)], 1u);
            asm volatile("s_waitcnt vmcnt(0)" ::: "memory");
        } else {
            XB_SPIN(xb_ld(&bar[XB_XGEN(b.x)]) == gen, bar);
            __builtin_amdgcn_fence(__ATOMIC_ACQUIRE, "agent");
            asm volatile("s_waitcnt vmcnt(0)" ::: "memory");
        }
    }
    __syncthreads();
}

__global__ void __launch_bounds__(NTHREADS, 2) mega(Params p) {
    extern __shared__ __attribute__((aligned(16))) unsigned char lds[];
    volatile LAS unsigned* bst = (volatile LAS unsigned*)(lds + LDS_PLAN_OFF + 1024);
    if (threadIdx.x < 2) bst[threadIdx.x] = 0u;
    __syncthreads();
    const XcdBarrier gbar = xcd_barrier_post((unsigned*)(p.ws + WS_BAR), bst);
    unsigned long long ts0 = 0, ts1 = 0;
    if (p.never) cg::this_grid().sync();
    Ctx c; c.tid = threadIdx.x; c.lane = c.tid & 63; c.wave = __builtin_amdgcn_readfirstlane(c.tid >> 6); c.gw = blockIdx.x * NWAVES + c.wave; c.ngw = gridDim.x * NWAVES;
    char* ws = p.ws;
    int* cnt = (int*)(ws + WS_CTL);
    float* r1 = (float*)(ws + WS_R1); float* r2 = (float*)(ws + WS_R2); float* ssC = (float*)(ws + WS_SSC);
    float* wts = (float*)(ws + WS_WTS); bf16_t* Wrh = (bf16_t*)(ws + WS_WR); bf16_t* Wrl = (bf16_t*)(ws + WS_WR + 256 * 1024); float* ssA = (float*)(ws + WS_SSA); int* list = (int*)(ws + WS_LIST);
    bf16_t* W2t = (bf16_t*)(ws + WS_W2T); bf16_t* W1t = (bf16_t*)(ws + WS_W1T); bf16_t* Wdt = (bf16_t*)(ws + WS_WDT); bf16_t* Wgut = (bf16_t*)(ws + WS_WGUT);
    bf16_t* xb = (bf16_t*)(ws + WS_XB); bf16_t* mix = (bf16_t*)(ws + WS_MIX); bf16_t* proj = (bf16_t*)(ws + WS_PROJ); bf16_t* Y = (bf16_t*)(ws + WS_Y); bf16_t* Hb = (bf16_t*)(ws + WS_H);
    unsigned char* xf8 = (unsigned char*)(ws + WS_WGUT + 64 * MiB);
    bf16_t* dlt = (bf16_t*)(ws + WS_PROJ);

    TS0(1) TS0(8)
    {
        for (int row = c.gw; row < T * PMUL(10); row += 2 * c.ngw) {
            const int ra = row % T, rb = (row + c.ngw) % T; const bool hb = row + c.ngw < T * PMUL(10);
            const float4* xa = (const float4*)(p.x + (size_t)ra * DM); const float4* xc = (const float4*)(p.x + (size_t)rb * DM);
            float4 va[8], vb[8];
#pragma unroll
            for (int j = 0; j < 8; ++j) { va[j] = xa[j * 64 + c.lane]; if (hb) vb[j] = xc[j * 64 + c.lane]; }
            float sa = 0.f, sb = 0.f; uint2* oa = (uint2*)(xb + (size_t)ra * DM); uint2* ob = (uint2*)(xb + (size_t)rb * DM);
#pragma unroll
            for (int j = 0; j < 8; ++j) { sa += va[j].x * va[j].x + va[j].y * va[j].y + va[j].z * va[j].z + va[j].w * va[j].w; oa[j * 64 + c.lane] = make_uint2(cvtpk2(va[j].x, va[j].y), cvtpk2(va[j].z, va[j].w)); }
            if (hb) {
#pragma unroll
                for (int j = 0; j < 8; ++j) { sb += vb[j].x * vb[j].x + vb[j].y * vb[j].y + vb[j].z * vb[j].z + vb[j].w * vb[j].w; ob[j * 64 + c.lane] = make_uint2(cvtpk2(vb[j].x, vb[j].y), cvtpk2(vb[j].z, vb[j].w)); } }
            sa = wave_sum(sa); sb = wave_sum(sb);
            if (c.lane == 0) { r1[ra] = rsqrtf(sa * (1.f / DM) + EPS); if (hb) r1[rb] = rsqrtf(sb * (1.f / DM) + EPS); }
        }
        LAS float* scr = (LAS float*)lds + c.wave * (64 * 65);
        constexpr int I_IN = (DM / 64) * (NPROJ / 64), I_OUT = (DM / 64) * (DM / 64);
        constexpr int NIT = I_IN + I_OUT;
        for (int it = c.gw; it < NIT * PMUL(10); it += c.ngw) {
            int r = it % NIT;
            if (r < I_IN) { const int nb = NPROJ / 64, kb = r / nb, n0 = (r % nb) * 64; p0_titem(p.w_in, NPROJ, p.norm1, W1t, DM, kb * 64, n0, n0, scr, c.lane, n0 < DATT ? QSCALE : 1.f); continue; } r -= I_IN;
            { const int nb = DM / 64, kb = r / nb, n0 = (r % nb) * 64, k0 = kb * 64;
                const float* g = k0 < DATT ? p.g_oa + k0 : p.g_oc + (k0 - DATT);
                p0_titem(p.w_out + (size_t)k0 * DM, DM, g, W2t + k0, DM, 0, n0, n0, scr, c.lane); }
        }
        for (int i = blockIdx.x * NTHREADS + c.tid; i < 48 * DM; i += gridDim.x * NTHREADS) { const int o = i / DM, k = i % DM; const float w = o < 36 ? (o < 4 ? p.w_rg[k * 4 + o] : p.w_re[k * 32 + (o - 4)]) : 0.f;
            const unsigned h = f2bf(w); Wrh[i] = (bf16_t)h; Wrl[i] = (bf16_t)f2bf(w - bf2f(h)); }
    }
    xcd_barrier(gbar);
    TS1(1) TS0(2)
    {
        g8::DenseOrder S; S.init(xb, W1t, T, NPROJ, DM, (int)gridDim.x, (int)blockIdx.x); S.mul = PMUL(1);
        S.rowscale = r1; S.rtab = (LAS float*)(lds + 131072);
        const g8::EpiProjF<g8::DenseOrder> E{proj, &S};
        g8::gemm_phase<false, 2>((LAS unsigned char*)lds, DM, S, E);
    }
    xcd_barrier(gbar);
    TS1(2) TS0(3)
    {
        struct Side { WConv wc; unsigned long long twait; int s, gw, ngw, nper, lane; LAS float* scr; unsigned scr32; const float *wg, *wu, *wd; bf16_t* Wgut; bf16_t* Wdt;
            __device__ __forceinline__ void step() { if (wc.pending) wc.finish(scr, lane);
                if (s < nper) { const int id = gw + ngw * s; ++s; if (id < WC_ITEMS) wc.issue(id, wg, wu, wd, Wgut, Wdt, scr32, lane); } }
            __device__ __forceinline__ void whole() { step(); asm volatile("s_waitcnt vmcnt(0)" ::: "memory"); } };
        Side side; side.twait = 0; side.wc.pending = false; side.s = 0; side.gw = c.gw; side.ngw = c.ngw; side.nper = (WC_ITEMS + c.ngw - 1) / c.ngw; side.lane = c.lane;
        side.scr = (LAS float*)(lds + 69632) + c.wave * (64 * 32); side.scr32 = (unsigned)(__UINTPTR_TYPE__)((LAS unsigned char*)lds + 69632) + c.wave * 8192;
        side.wg = p.w_gate; side.wu = p.w_up; side.wd = p.w_down; side.Wgut = Wgut; side.Wdt = Wdt;
        for (int u1 = blockIdx.x; u1 < NB * NH * 4 * PMUL(2); u1 += gridDim.x) { const int u0 = u1 % (NB * NH * 4); const int bh = u0 >> 2;
            for (int i = 0; i < 4; ++i) att::attn_unit((LAS unsigned char*)lds, proj, p.relb, mix, ssA, bh >> 4, bh & 15, (u0 & 3) + 4 * i, side, i == 0); }
        if (TSPROBE == 34 || TSPROBE == 35) { ts0 = 0; ts1 = side.twait; }
        while (side.wc.pending || side.s < side.nper) side.whole();
        for (int it = c.gw; it < (T / 16) * 2 * PMUL(21); it += c.ngw) conv_slab(proj, p.conv_w, mix, ssC, it % ((T / 16) * 2), c.lane);
    }
    xcd_barrier(gbar);
    TS1(3) TS0(4)
    {
        g8::DenseOrder S; S.init(mix, W2t, T, DM, DM, (int)gridDim.x, (int)blockIdx.x); S.mul = PMUL(3);
        LAS float* tab = (LAS float*)(lds + 131072);
        g8::Unit u;
        for (int i = 0; i < 4; ++i) if (S.next(i, u) && c.tid < 256) { const int row = u.pm * 256 + c.tid; float sa = 0.f;
#pragma unroll
            for (int h = 0; h < 16; ++h) sa += ssA[row * 16 + h];
            const float4 sc4 = *(const float4*)(ssC + row * 4); const float ra = rsqrtf(sa * (1.f / DATT) + EPS), rc = rsqrtf((sc4.x + sc4.y) * (1.f / DCONV) + EPS);
            tab[(i * 256 + c.tid) * 2] = ra / rc; tab[(i * 256 + c.tid) * 2 + 1] = rc; }
        __syncthreads();
        const g8::EpiG2X E{xb, tab};
        g8::gemm_phase<false, 2>((LAS unsigned char*)lds, DM, S, E);
    }
    xcd_barrier(gbar);
    TS1(4) TS0(5)
    for (int it = blockIdx.x; it < (T / 64) * PMUL(4); it += gridDim.x) router_block(p.norm2, xb, xf8, Wrh, Wrl, p.b_rg, p.b_re, cnt, list, wts, r2, it % (T / 64), c.wave, c.lane, (LAS float*)lds, it < T / 64);
    xcd_barrier(gbar);
    TS1(5) TS0(6)
    LAS int* pl = (LAS int*)(lds + LDS_PLAN_OFF);
    if (c.tid < 64) {
        const int ce = c.tid < NE ? cnt[c.tid * 64] : 0, mt = (ce + 255) >> 8;
        int inc = mt;
#pragma unroll
        for (int o = 1; o < 32; o <<= 1) { const int v = __shfl_up(inc, o); if (c.lane >= o) inc += v; }
        if (c.tid < NE) { pl[c.tid] = ce; pl[32 + c.tid] = (inc - mt) * 256; }
        if (c.tid == NE - 1) pl[224] = inc;
    }
    __syncthreads();
    if (c.tid < NTILEMAX) { int e = -1;
        for (int q = 0; q < NE; ++q) { const int st = pl[32 + q] >> 8, mt = (pl[q] + 255) >> 8; if (c.tid >= st && c.tid < st + mt) e = q; }
        pl[64 + c.tid] = e; }
    __syncthreads();
    const int ntile = pl[224];
    {
        const g8::MoeOrder<true> S{(const char*)xf8, (const char*)Wgut, list, pl, DM  , 4, ntile * 4, (int)gridDim.x, (int)blockIdx.x, (size_t)2 * DEXP * DM, PMUL(5), (LAS int*)(lds + 131072), r2};
        const g8::EpiGUF<g8::MoeOrder<true>> E{Hb, &S};
        g8::gemm_phase<true, 1>((LAS unsigned char*)lds, DM, S, E);
    }
    xcd_barrier(gbar);
    TS1(6) TS0(7)
    {
        const g8::MoeOrder<false> S{(const char*)Hb, (const char*)Wdt, list, pl, DEXP  , 8, ntile * 8, (int)gridDim.x, (int)blockIdx.x, (size_t)DM * DEXP, PMUL(6), (LAS int*)(lds + 131072), wts};
        const g8::EpiDownF<g8::MoeOrder<false>> E{(unsigned char*)Y, &S};
        g8::gemm_phase<false, 1>((LAS unsigned char*)lds, DEXP, S, E);
    }
    xcd_barrier(gbar);
    TS1(7) TS1(8)
    if (PROBE == 9) { for (int i = 0; i < 8; ++i) xcd_barrier(gbar); }
    const float tsdelta = TSPROBE ? sqrtf((float)(ts1 - ts0) * 0.01f) * 1e-3f : 0.f;
    {
        const unsigned long long tp6 = (TSPROBE == 9) ? __builtin_amdgcn_s_memrealtime() : 0ull;
        FinalRow fa, fb;
        int t = c.gw;
        if (t < T) final_load(fa, xb, Y, t, c.lane);
        for (; t < T; t += 2 * c.ngw) {
            const int t2 = t + c.ngw, t3 = t + 2 * c.ngw;
            if (t2 < T) final_load(fb, xb, Y, t2, c.lane);
            final_store(fa, p.out, p.norm_f, t, c.lane, (TSPROBE == 9) ? sqrtf((float)(__builtin_amdgcn_s_memrealtime() - tp6) * 0.01f) * 1e-3f : tsdelta);
            if (t3 < T) final_load(fa, xb, Y, t3, c.lane);
            if (t2 < T) final_store(fb, p.out, p.norm_f, t2, c.lane, (TSPROBE == 9) ? sqrtf((float)(__builtin_amdgcn_s_memrealtime() - tp6) * 0.01f) * 1e-3f : tsdelta);
        }
    }
}

extern "C" void kernel_launch(void* const* d_in, const int* in_sizes, int n_in, void* d_out, int out_size, void* d_ws, size_t ws_size, hipStream_t stream) {
    static int grid = 0;
    if (grid == 0) {
        int dev = 0, cus = 0, per_cu = 0;
        if (ws_size < WS_END || n_in != 17) { fprintf(stderr, "kernel_launch: unexpected sizes (ws %zu)\n", ws_size); grid = -1; return; }
        (void)hipGetDevice(&dev); (void)hipDeviceGetAttribute(&cus, hipDeviceAttributeMultiprocessorCount, dev);
        if (hipFuncSetAttribute((const void*)mega, hipFuncAttributeMaxDynamicSharedMemorySize, LDS_BYTES) != hipSuccess) { fprintf(stderr, "hipFuncSetAttribute failed\n"); grid = -1; return; }
        if (hipOccupancyMaxActiveBlocksPerMultiprocessor(&per_cu, (const void*)mega, NTHREADS, LDS_BYTES) != hipSuccess || per_cu < 1) { fprintf(stderr, "occupancy query failed (%d)\n", per_cu); grid = -1; return; }
        grid = cus * per_cu;
        fprintf(stderr, "kernel_launch: cus %d per_cu %d grid %d\n", cus, per_cu, grid);
    }
    if (grid < 0) return;
    if (hipMemsetAsync((char*)d_ws + WS_CTL, 0, 64 * 1024, stream) != hipSuccess) { fprintf(stderr, "memset failed\n"); return; }
    Params p{};
    p.x = (const float*)d_in[0]; p.norm1 = (const float*)d_in[1]; p.w_in = (const float*)d_in[2]; p.relb = (const float*)d_in[3];
    p.conv_w = (const float*)d_in[4]; p.g_oa = (const float*)d_in[5]; p.g_oc = (const float*)d_in[6]; p.w_out = (const float*)d_in[7];
    p.norm2 = (const float*)d_in[8]; p.w_rg = (const float*)d_in[9]; p.b_rg = (const float*)d_in[10]; p.w_re = (const float*)d_in[11];
    p.b_re = (const float*)d_in[12]; p.w_gate = (const float*)d_in[13]; p.w_up = (const float*)d_in[14]; p.w_down = (const float*)d_in[15];
    p.norm_f = (const float*)d_in[16]; p.out = (float*)d_out; p.ws = (char*)d_ws;
    void* args[] = {&p};
    hipError_t e = hipLaunchCooperativeKernel((const void*)mega, dim3(grid), dim3(NTHREADS), args, LDS_BYTES, stream);
    if (e != hipSuccess) fprintf(stderr, "cooperative launch failed: %s (grid %d)\n", hipGetErrorString(e), grid);
}
```

```cpp
#include <hip/hip_runtime.h>
#include <hip/hip_cooperative_groups.h>
#include <stdint.h>
#include <cstdio>
namespace cg = cooperative_groups;
#ifndef PROBE
#define PROBE 0
#endif
#define PMUL(k) ((PROBE) == (k) ? 2 : 1)
#ifndef TSPROBE
#define TSPROBE 0
#endif
#define TS0(k) if (TSPROBE == (k)) ts0 = __builtin_amdgcn_s_memrealtime();
#define TS1(k) if (TSPROBE == (k)) ts1 = __builtin_amdgcn_s_memrealtime();

typedef unsigned short bf16_t;
typedef short bf16x8 __attribute__((ext_vector_type(8)));
typedef float f32x4 __attribute__((ext_vector_type(4)));

constexpr int NB = 4, SEQ = 4096, T = NB * SEQ, DM = 2048, DATT = 1024, DCONV = 1024, NPROJ = 6144;
constexpr int NH = 16, HD = 64, NREL = 513, NE = 32, DEXP = 512, NPAIR = 2 * T;
constexpr int NPADMAX = 40960, NTILEMAX = NPADMAX / 256;
constexpr float EPS = 1e-6f;
constexpr float YSCALE8 = 64.f;
constexpr float HSCALE8 = 8.f, WDSCALE8 = 32.f;
constexpr float WSCALE8 = 64.f;
constexpr float LOG2E = 1.4426950408889634f, QSCALE = 0.125f * LOG2E;

constexpr size_t MiB = 1u << 20;
constexpr size_t WS_CTL = 0;
constexpr size_t WS_BAR = 16 * 1024;
constexpr size_t WS_PLAN = 64 * 1024;
constexpr size_t WS_R1 = 128 * 1024;
constexpr size_t WS_RA = 192 * 1024;
constexpr size_t WS_RC = 256 * 1024;
constexpr size_t WS_R2 = 320 * 1024;
constexpr size_t WS_SSC = 3 * MiB;
constexpr size_t WS_WTS = 512 * 1024;
constexpr size_t WS_ROWPAIR = 640 * 1024;
constexpr size_t WS_WR = 1 * MiB;
constexpr size_t WS_SSA = 2 * MiB;
constexpr size_t WS_LIST = 5 * MiB;
constexpr size_t WS_W2T = 8 * MiB;
constexpr size_t WS_W1T = 16 * MiB;
constexpr size_t WS_WDT = 40 * MiB;
constexpr size_t WS_WGUT = 104 * MiB;
constexpr size_t WS_XB = 232 * MiB;
constexpr size_t WS_MIX = 296 * MiB;
constexpr size_t WS_PROJ = 360 * MiB;
constexpr size_t WS_Y = 360 * MiB;
constexpr size_t WS_H = 488 * MiB;
constexpr size_t WS_END = 552 * MiB;

__device__ __forceinline__ unsigned f2bf(float f) { unsigned u = __float_as_uint(f); return (u + 0x7fffu + ((u >> 16) & 1u)) >> 16; }
__device__ __forceinline__ unsigned pk2(float lo, float hi) { return f2bf(lo) | (f2bf(hi) << 16); }
__device__ __forceinline__ unsigned cvtpk2(float lo, float hi) { typedef float f2 __attribute__((ext_vector_type(2))); typedef __bf16 b2 __attribute__((ext_vector_type(2))); f2 v = {lo, hi}; b2 r = __builtin_convertvector(v, b2); return __builtin_bit_cast(unsigned, r); }
__device__ __forceinline__ int gu_row(int n, int up) { return ((n >> 7) << 8) + (n & 127) + (up ? 128 : 0); }
__device__ __forceinline__ float bf2f(unsigned h) { return __uint_as_float(h << 16); }
__device__ __forceinline__ float wave_sum(float v) {
#pragma unroll
    for (int o = 1; o < 64; o <<= 1) v += __shfl_xor(v, o);
    return v;
}


#define LAS __attribute__((address_space(3)))
constexpr int NWAVES = 8, NTHREADS = 512;
constexpr int LDS_BYTES = 147456;
constexpr int LDS_PLAN_OFF = 140 * 1024;

struct Params {
    const float *x, *norm1, *w_in, *relb, *conv_w, *g_oa, *g_oc, *w_out, *norm2, *w_rg, *b_rg, *w_re, *b_re, *w_gate, *w_up, *w_down, *norm_f;
    float* out; char* ws; int never; int pad;
};
struct Ctx { int tid, lane, wave, gw, ngw; };

__device__ __forceinline__ void p0_titem(const float* __restrict__ W, int N, const float* __restrict__ g, bf16_t* __restrict__ WT, int ldd, int k0, int n0, int drow0, LAS float* scr, int lane, float cs = 1.f) {
    const int kq = lane >> 4, n4 = (lane & 15) * 4;
    float4 v[16]; float gs[16];
#pragma unroll
    for (int i = 0; i < 16; ++i) v[i] = *(const float4*)(W + (size_t)(k0 + 4 * i + kq) * N + n0 + n4);
#pragma unroll
    for (int i = 0; i < 16; ++i) gs[i] = (g ? g[k0 + 4 * i + kq] : 1.f) * cs;
#pragma unroll
    for (int i = 0; i < 16; ++i) { LAS float* d = scr + (4 * i + kq) * 65 + n4; d[0] = v[i].x * gs[i]; d[1] = v[i].y * gs[i]; d[2] = v[i].z * gs[i]; d[3] = v[i].w * gs[i]; }
    asm volatile("s_waitcnt lgkmcnt(0)" ::: "memory");
    const int c = lane & 7;
#pragma unroll
    for (int j = 0; j < 8; ++j) { const int n = (lane >> 3) + 8 * j; const LAS float* sp = scr + (8 * c) * 65 + n;
        uint4 o; o.x = cvtpk2(sp[0 * 65], sp[1 * 65]); o.y = cvtpk2(sp[2 * 65], sp[3 * 65]); o.z = cvtpk2(sp[4 * 65], sp[5 * 65]); o.w = cvtpk2(sp[6 * 65], sp[7 * 65]);
        *(uint4*)(WT + (size_t)(drow0 + n) * ldd + k0 + 8 * c) = o; }
    asm volatile("s_waitcnt lgkmcnt(0)" ::: "memory");
}

__device__ __forceinline__ void router_block(const bf16_t* __restrict__ xb1, const bf16_t* __restrict__ Wrh,
                                             const float* __restrict__ brg, const float* __restrict__ bre, int* __restrict__ cnt, int* __restrict__ list, float* __restrict__ wts, float* __restrict__ r2out,
                                             int tb, int wave, int lane, LAS float* lds_f, bool commit) {
    const int fr = lane & 15, fq = lane >> 4;
    const bf16_t* xr = xb1 + (size_t)(tb * 64 + fr) * DM + wave * 256 + 8 * fq;
    const bf16_t* wh = Wrh + (size_t)fr * DM + wave * 256 + 8 * fq;
    f32x4 accr[4][3], gram[4];
#pragma unroll
    for (int g = 0; g < 4; ++g) { gram[g] = (f32x4){0.f, 0.f, 0.f, 0.f};
#pragma unroll
        for (int nb = 0; nb < 3; ++nb) accr[g][nb] = (f32x4){0.f, 0.f, 0.f, 0.f}; }
#pragma unroll 1
    for (int h = 0; h < 2; ++h) {
        bf16x8 xv[4][4], wv[4][3];
#pragma unroll
        for (int ks = 0; ks < 4; ++ks) {
#pragma unroll
            for (int g = 0; g < 4; ++g) xv[ks][g] = *(const bf16x8*)(xr + (size_t)g * 16 * DM + (4 * h + ks) * 32);
#pragma unroll
            for (int nb = 0; nb < 3; ++nb) wv[ks][nb] = *(const bf16x8*)(wh + (size_t)nb * 16 * DM + (4 * h + ks) * 32); }
#pragma unroll
        for (int ks = 0; ks < 4; ++ks)
#pragma unroll
            for (int g = 0; g < 4; ++g) { gram[g] = __builtin_amdgcn_mfma_f32_16x16x32_bf16(xv[ks][g], xv[ks][g], gram[g], 0, 0, 0);
#pragma unroll
                for (int nb = 0; nb < 3; ++nb) accr[g][nb] = __builtin_amdgcn_mfma_f32_16x16x32_bf16(wv[ks][nb], xv[ks][g], accr[g][nb], 0, 0, 0); }
    }
    LAS float* part8 = lds_f;
    LAS float* sc = lds_f + 32 * 64 * 13 + (wave & 3) * (16 * 49);
    LAS int* ent = (LAS int*)(lds_f + 32 * 64 * 13 + 4 * 16 * 49);
#pragma unroll
    for (int g = 0; g < 4; ++g) { LAS float* pp = part8 + ((wave * 4 + g) * 64 + lane) * 13;
#pragma unroll
        for (int nb = 0; nb < 3; ++nb)
#pragma unroll
            for (int q = 0; q < 4; ++q) pp[nb * 4 + q] = accr[g][nb][q];
        const int qd = fr & 3; const float d = qd == 0 ? gram[g][0] : qd == 1 ? gram[g][1] : qd == 2 ? gram[g][2] : gram[g][3];
        pp[12] = (fq == (fr >> 2)) ? d : 0.f; }
    __syncthreads();
    const int tg = wave, t0 = tb * 64 + tg * 16;
    if (wave < 4) {
        f32x4 acc[3]; float ss = 0.f;
#pragma unroll
        for (int nb = 0; nb < 3; ++nb) acc[nb] = (f32x4){0.f, 0.f, 0.f, 0.f};
#pragma unroll
        for (int w = 0; w < 8; ++w) { LAS const float* pp = part8 + ((w * 4 + tg) * 64 + lane) * 13;
#pragma unroll
            for (int nb = 0; nb < 3; ++nb)
#pragma unroll
                for (int q = 0; q < 4; ++q) acc[nb][q] += pp[nb * 4 + q];
            ss += pp[12]; }
        ss += __shfl_xor(ss, 16); ss += __shfl_xor(ss, 32);
        const float r2 = rsqrtf(ss * (1.f / DM) + EPS);
#pragma unroll
        for (int nb = 0; nb < 3; ++nb)
#pragma unroll
            for (int q = 0; q < 4; ++q) sc[fr * 49 + 16 * nb + 4 * fq + q] = acc[nb][q] * r2;
        asm volatile("s_waitcnt lgkmcnt(0)" ::: "memory");
        if (lane < 16) {
            const int t = t0 + lane; LAS const float* lr = sc + lane * 49;
            float lg[4];
#pragma unroll
            for (int g = 0; g < 4; ++g) lg[g] = lr[g] + brg[g];
            int gs = 0; float gm = lg[0];
#pragma unroll
            for (int g = 1; g < 4; ++g) if (lg[g] > gm) { gm = lg[g]; gs = g; }
            float den = 0.f;
#pragma unroll
            for (int g = 0; g < 4; ++g) den += __expf(lg[g] - gm);
            const float pg = 1.f / den;
            float el[8];
#pragma unroll
            for (int i = 0; i < 8; ++i) el[i] = lr[4 + 8 * gs + i] + bre[8 * gs + i];
            int i1 = 0; float v1 = el[0];
#pragma unroll
            for (int i = 1; i < 8; ++i) if (el[i] > v1) { v1 = el[i]; i1 = i; }
            int i2 = -1; float v2 = -3.0e38f;
#pragma unroll
            for (int i = 0; i < 8; ++i) if (i != i1 && el[i] > v2) { v2 = el[i]; i2 = i; }
            const float e2 = __expf(v2 - v1), w0 = pg / (1.f + e2), w1 = pg * e2 / (1.f + e2);
            ent[2 * (tg * 16 + lane)] = gs * 8 + i1; ent[2 * (tg * 16 + lane) + 1] = gs * 8 + i2;
            if (commit) { r2out[t] = r2; wts[2 * t] = w0; wts[2 * t + 1] = w1; }
        }
    }
    __syncthreads();
    if (wave == 0 && lane < NE && commit) {
        int n = 0;
        for (int i = 0; i < 128; ++i) n += (ent[i] == lane) ? 1 : 0;
        if (n) { int k = atomicAdd(&cnt[lane * 64], n);
            for (int i = 0; i < 128; ++i) if (ent[i] == lane) { list[lane * T + k] = 2 * (tb * 64) + i; ++k; } }
    }
    __syncthreads();
}
struct FinalRow { uint4 xv[4]; uint2 pv[4], qv[4]; };
__device__ __forceinline__ void final_load(FinalRow& f, const bf16_t* __restrict__ xb1, const bf16_t* __restrict__ Yb, int t, int lane) {
    const unsigned char* Y = (const unsigned char*)Yb;
    const uint4* x1 = (const uint4*)(xb1 + (size_t)t * DM); const uint2* y0 = (const uint2*)(Y + (size_t)(2 * t) * DM); const uint2* y1 = (const uint2*)(Y + (size_t)(2 * t + 1) * DM);
#pragma unroll
    for (int j = 0; j < 4; ++j) { f.xv[j] = x1[j * 64 + lane]; f.pv[j] = y0[j * 64 + lane]; f.qv[j] = y1[j * 64 + lane]; }
}
__device__ __forceinline__ void final_store(const FinalRow& f, float* __restrict__ out, const float* __restrict__ g, int t, int lane, float delta = 0.f) {
    float4* xw = (float4*)(out + (size_t)t * DM);
    float v[4][8]; float ss = 0.f;
    typedef float f2_t __attribute__((ext_vector_type(2)));
#pragma unroll
    for (int j = 0; j < 4; ++j) { const unsigned xa[4] = {f.xv[j].x, f.xv[j].y, f.xv[j].z, f.xv[j].w};
        const f2_t p01 = __builtin_amdgcn_cvt_pk_f32_fp8((int)f.pv[j].x, false), p23 = __builtin_amdgcn_cvt_pk_f32_fp8((int)f.pv[j].x, true), p45 = __builtin_amdgcn_cvt_pk_f32_fp8((int)f.pv[j].y, false), p67 = __builtin_amdgcn_cvt_pk_f32_fp8((int)f.pv[j].y, true);
        const f2_t q01 = __builtin_amdgcn_cvt_pk_f32_fp8((int)f.qv[j].x, false), q23 = __builtin_amdgcn_cvt_pk_f32_fp8((int)f.qv[j].x, true), q45 = __builtin_amdgcn_cvt_pk_f32_fp8((int)f.qv[j].y, false), q67 = __builtin_amdgcn_cvt_pk_f32_fp8((int)f.qv[j].y, true);
        const float ys[8] = {p01[0] + q01[0], p01[1] + q01[1], p23[0] + q23[0], p23[1] + q23[1], p45[0] + q45[0], p45[1] + q45[1], p67[0] + q67[0], p67[1] + q67[1]};
#pragma unroll
        for (int q = 0; q < 4; ++q) { const float lo = bf2f(xa[q] & 0xffffu) + ys[2 * q] * (1.f / YSCALE8), hi = bf2f(xa[q] >> 16) + ys[2 * q + 1] * (1.f / YSCALE8);
            v[j][2 * q] = lo; v[j][2 * q + 1] = hi; ss += lo * lo + hi * hi; } }
    const float r = rsqrtf(wave_sum(ss) * (1.f / DM) + EPS);
#pragma unroll
    for (int j = 0; j < 4; ++j) { const float4 g0 = ((const float4*)g)[(j * 64 + lane) * 2], g1 = ((const float4*)g)[(j * 64 + lane) * 2 + 1];
        float4 a, b; a.x = v[j][0] * r * g0.x + delta; a.y = v[j][1] * r * g0.y - delta; a.z = v[j][2] * r * g0.z + delta; a.w = v[j][3] * r * g0.w - delta;
        b.x = v[j][4] * r * g1.x + delta; b.y = v[j][5] * r * g1.y - delta; b.z = v[j][6] * r * g1.z + delta; b.w = v[j][7] * r * g1.w - delta;
        xw[(j * 64 + lane) * 2] = a; xw[(j * 64 + lane) * 2 + 1] = b; }
}

constexpr int WC_ITEMS = 3 * NE * 512;
struct WConv {
    unsigned char* dst; int ldd; float sc; bool pending;
    __device__ __forceinline__ void issue(int id, const float* __restrict__ w_gate, const float* __restrict__ w_up, const float* __restrict__ w_down, bf16_t* Wgut, bf16_t* Wdt, unsigned scr32, int lane) {
        const int kq = lane >> 3;
        const float* src; int N, k0, n0;
        if (id < 2 * NE * 512) { const int up = id >= NE * 512, r = id & (NE * 512 - 1), e = r >> 9, q = r & 511; k0 = (q >> 4) * 64; n0 = (q & 15) * 32; N = DEXP; sc = WSCALE8;
            src = (up ? w_up : w_gate) + (size_t)e * DM * DEXP; dst = (unsigned char*)Wgut + (size_t)e * 2 * DEXP * DM + (size_t)gu_row(n0, up) * DM + k0; ldd = DM; }
        else { const int r = id - 2 * NE * 512, e = r >> 9, q = r & 511; k0 = (q >> 6) * 64; n0 = (q & 63) * 32; N = DM; sc = WDSCALE8;
            src = w_down + (size_t)e * DEXP * DM; dst = (unsigned char*)Wdt + (size_t)e * DM * DEXP + (size_t)n0 * DEXP + k0; ldd = DEXP; }
#pragma unroll
        for (int i = 0; i < 8; ++i) { const float* g = src + (size_t)(k0 + 8 * i + kq) * N + n0 + 4 * ((lane & 7) ^ i); unsigned keep_;
            asm volatile("s_mov_b32 %0, m0\n\ts_mov_b32 m0, %2\n\ts_nop 0\n\tglobal_load_lds_dwordx4 %1, off\n\ts_mov_b32 m0, %0" : "=&s"(keep_) : "v"(g), "s"((unsigned)__builtin_amdgcn_readfirstlane((int)(scr32 + i * 1024))) : "memory"); }
        pending = true;
    }
    __device__ __forceinline__ void finish(LAS float* scr, int lane) {
        const int c = lane & 7;
#pragma unroll
        for (int j = 0; j < 4; ++j) { const int n = (lane >> 3) + 8 * j; const LAS float* sp = scr + (8 * c) * 32 + 4 * ((n >> 2) ^ c) + (n & 3);
            float v[8];
#pragma unroll
            for (int q = 0; q < 8; ++q) v[q] = sp[q * 32] * sc;
            int w0 = __builtin_amdgcn_cvt_pk_fp8_f32(v[0], v[1], 0, false); w0 = __builtin_amdgcn_cvt_pk_fp8_f32(v[2], v[3], w0, true);
            int w1 = __builtin_amdgcn_cvt_pk_fp8_f32(v[4], v[5], 0, false); w1 = __builtin_amdgcn_cvt_pk_fp8_f32(v[6], v[7], w1, true);
            *(uint2*)(dst + (size_t)n * ldd + 8 * c) = make_uint2((unsigned)w0, (unsigned)w1); }
        asm volatile("s_waitcnt lgkmcnt(0)" ::: "memory");
        pending = false;
    }
};

namespace att {
typedef float f32x16 __attribute__((ext_vector_type(16)));
typedef short s16x4 __attribute__((ext_vector_type(4)));
typedef short v4i16_t __attribute__((ext_vector_type(4)));
constexpr int SLOT = 16384, L_K = 0, L_V = 2 * SLOT, L_TB = 4 * SLOT, NTB = 576;
constexpr float THR = 8.f;
__device__ __forceinline__ float rowmax32(const f32x16& p0, const f32x16& p1) {
    float a = fmaxf(p0[0], p1[0]);
#pragma unroll
    for (int r = 1; r < 16; ++r) a = fmaxf(fmaxf(a, p0[r]), p1[r]);
    auto rr = __builtin_amdgcn_permlane32_swap(__float_as_uint(a), __float_as_uint(a), false, false);
    return fmaxf(__uint_as_float(rr[0]), __uint_as_float(rr[1]));
}
__device__ __forceinline__ unsigned cvtpk(float lo, float hi) { typedef float f2 __attribute__((ext_vector_type(2))); typedef __bf16 b2 __attribute__((ext_vector_type(2))); f2 v = {lo, hi}; b2 b = __builtin_convertvector(v, b2); return __builtin_bit_cast(unsigned, b); }
__device__ __forceinline__ s16x4 vtr(LAS const unsigned char* p) { return __builtin_bit_cast(s16x4, __builtin_amdgcn_ds_read_tr16_b64_v4i16((LAS v4i16_t*)p)); }

template <class Side> __device__ __forceinline__ void attn_unit(LAS unsigned char* lds, const bf16_t* __restrict__ proj, const float* __restrict__ relb, bf16_t* __restrict__ mix, float* __restrict__ ssA, int b, int h, int cg, Side& side, bool fill_table) {
    const int tid = threadIdx.x, lane = tid & 63, r32 = lane & 31, hi = lane >> 5, w = __builtin_amdgcn_readfirstlane(tid >> 6);
    const int c0 = cg * 4, cq = c0 + (w >> 1), qi = 32 * (w & 1) + r32;
    const int j0 = c0 - 8 < 0 ? 0 : c0 - 8, j1 = c0 + 3;
    const unsigned lds32 = (unsigned)(__UINTPTR_TYPE__)lds;
    LAS float* tb = (LAS float*)(lds + L_TB);
    if (fill_table) for (int i = tid; i < NTB; i += NTHREADS) tb[i] = relb[h * NREL + (i > 512 ? 512 : i)] * LOG2E;
    const size_t tq = (size_t)b * SEQ + (size_t)c0 * 64 + 32 * w + r32;
    bf16x8 qr[4];
#pragma unroll
    for (int d0 = 0; d0 < 4; ++d0) qr[d0] = *(const bf16x8*)(proj + tq * NPROJ + h * HD + d0 * 16 + hi * 8);
    const int krow = 8 * w + (lane >> 3);
    const bf16_t* ksrc = proj + ((size_t)b * SEQ + krow) * NPROJ + DATT + h * HD + (((lane & 7) ^ ((krow >> 1) & 7)) * 8);
    const bf16_t* vsrc = proj + ((size_t)b * SEQ + 16 * (w & 3) + (lane >> 2)) * NPROJ + 2 * DATT + h * HD + (w >> 2) * 32 + (lane & 3) * 8;
#define ATT_GLDS(gsrc, ldsdst) do { unsigned keep_; asm volatile("s_mov_b32 %0, m0\n\ts_mov_b32 m0, %2\n\ts_nop 0\n\tglobal_load_lds_dwordx4 %1, off\n\ts_mov_b32 m0, %0" : "=&s"(keep_) : "v"(gsrc), "s"((unsigned)__builtin_amdgcn_readfirstlane((int)(ldsdst))) : "memory"); } while (0)
#define ATT_DMA1(j, off) do { ATT_GLDS(ksrc + (size_t)(j) * 64 * NPROJ, lds32 + L_K + (off) + w * 1024); ATT_GLDS(vsrc + (size_t)(j) * 64 * NPROJ, lds32 + L_V + (off) + w * 1024); } while (0)
#define ATT_DMA(j, slot) do { ATT_DMA1(j, (slot) * SLOT); ATT_DMA1((j) + 1, (slot) * SLOT + 8192); } while (0)
    int ka[4];
#pragma unroll
    for (int d0 = 0; d0 < 4; ++d0) ka[d0] = r32 * 128 + (((2 * d0 + hi) ^ ((r32 >> 1) & 7)) * 16);
    const int va = ((lane >> 4) & 1) * 32 + (lane & 3) * 8 + (4 * hi + ((lane & 15) >> 2)) * 64;
    float m = -1e30f, l = 0.f; f32x16 o[2];
#pragma unroll
    for (int r = 0; r < 16; ++r) { o[0][r] = 0.f; o[1][r] = 0.f; }
    ATT_DMA(j0, 0);
    for (int js = j0; js <= j1; js += 2) {
        const int slot = ((js - j0) >> 1) & 1;
        unsigned long long tb0_ = 0; if (TSPROBE == 34 || TSPROBE == 35) tb0_ = __builtin_amdgcn_s_memrealtime();
        if (TSPROBE == 35) { asm volatile("s_waitcnt vmcnt(0) lgkmcnt(0)" ::: "memory"); side.twait += __builtin_amdgcn_s_memrealtime() - tb0_; }
        asm volatile("s_waitcnt vmcnt(0) lgkmcnt(0)\n\ts_barrier" ::: "memory");
        if (TSPROBE == 34) side.twait += __builtin_amdgcn_s_memrealtime() - tb0_;
        side.step();
        if (js + 2 <= j1) ATT_DMA(js + 2, slot ^ 1);
#pragma unroll
        for (int half = 0; half < 2; ++half) {
        const int j = js + half, dl = cq - j;
        if (dl >= 0 && dl <= 8) {
            LAS const unsigned char* Ks = lds + L_K + slot * SLOT + half * 8192; LAS const unsigned char* Vs = lds + L_V + slot * SLOT + half * 8192 + va;
            f32x16 p0, p1;
            if (dl <= 4) { LAS const float* tp = tb + (64 * dl + qi + 256 - 4 * hi - 59);
#pragma unroll
                for (int r = 0; r < 16; ++r) { p0[r] = tp[59 - ((r & 3) + 8 * (r >> 2))]; p1[r] = tp[27 - ((r & 3) + 8 * (r >> 2))]; } }
            else { const float bf = tb[NTB - 1];
#pragma unroll
                for (int r = 0; r < 16; ++r) { p0[r] = bf; p1[r] = bf; } }
            { bf16x8 kf[8];
#pragma unroll
              for (int d0 = 0; d0 < 4; ++d0) { kf[2 * d0] = *(LAS const bf16x8*)(Ks + ka[d0]); kf[2 * d0 + 1] = *(LAS const bf16x8*)(Ks + ka[d0] + 4096); }
              __builtin_amdgcn_sched_barrier(0);
#pragma unroll
              for (int d0 = 0; d0 < 4; ++d0) { p0 = __builtin_amdgcn_mfma_f32_32x32x16_bf16(kf[2 * d0], qr[d0], p0, 0, 0, 0); p1 = __builtin_amdgcn_mfma_f32_32x32x16_bf16(kf[2 * d0 + 1], qr[d0], p1, 0, 0, 0); } }
            const float mx = rowmax32(p0, p1);
            if (__any(mx > m + THR)) { const float mn = fmaxf(m, mx), al = __builtin_amdgcn_exp2f(m - mn); m = mn; l *= al;
#pragma unroll
                for (int r = 0; r < 16; ++r) { o[0][r] *= al; o[1][r] *= al; } }
            float rs = 0.f;
#pragma unroll
            for (int r = 0; r < 16; ++r) { p0[r] = __builtin_amdgcn_exp2f(p0[r] - m); p1[r] = __builtin_amdgcn_exp2f(p1[r] - m); rs += p0[r] + p1[r]; }
            l += rs;
            bf16x8 pw[4];
#pragma unroll
            for (int ks = 0; ks < 4; ++ks) { const f32x16& P = ks < 2 ? p0 : p1; const int bo = (ks & 1) * 8; typedef unsigned u4 __attribute__((ext_vector_type(4)));
                u4 t4 = {cvtpk(P[bo], P[bo + 1]), cvtpk(P[bo + 2], P[bo + 3]), cvtpk(P[bo + 4], P[bo + 5]), cvtpk(P[bo + 6], P[bo + 7])}; pw[ks] = __builtin_bit_cast(bf16x8, t4); }
            { s16x4 vl[8], vh[8];
#pragma unroll
              for (int i = 0; i < 8; ++i) { vl[i] = vtr(Vs + (i >> 2) * 4096 + (i & 3) * 1024); vh[i] = vtr(Vs + (i >> 2) * 4096 + (i & 3) * 1024 + 512); }
              __builtin_amdgcn_sched_barrier(0);
#pragma unroll
              for (int i = 0; i < 8; ++i) { const bf16x8 vf = {vl[i][0], vl[i][1], vl[i][2], vl[i][3], vh[i][0], vh[i][1], vh[i][2], vh[i][3]};
                  o[i >> 2] = __builtin_amdgcn_mfma_f32_32x32x16_bf16(vf, pw[i & 3], o[i >> 2], 0, 0, 0); } }
        }
        }
    }
    { auto rr = __builtin_amdgcn_permlane32_swap(__float_as_uint(l), __float_as_uint(l), false, false); l = __uint_as_float(rr[0]) + __uint_as_float(rr[1]); }
    const float il = 1.f / l; float ss = 0.f;
    bf16_t* op = mix + tq * DM + h * HD + 4 * hi;
#pragma unroll
    for (int d0 = 0; d0 < 2; ++d0)
#pragma unroll
        for (int g = 0; g < 4; ++g) { const float v0 = o[d0][4 * g] * il, v1 = o[d0][4 * g + 1] * il, v2 = o[d0][4 * g + 2] * il, v3 = o[d0][4 * g + 3] * il;
            ss += v0 * v0 + v1 * v1 + v2 * v2 + v3 * v3; *(uint2*)(op + 32 * d0 + 8 * g) = make_uint2(cvtpk(v0, v1), cvtpk(v2, v3)); }
    { auto rr = __builtin_amdgcn_permlane32_swap(__float_as_uint(ss), __float_as_uint(ss), false, false); ss = __uint_as_float(rr[0]) + __uint_as_float(rr[1]); }
    if (hi == 0) ssA[tq * 16 + h] = ss;
    asm volatile("s_waitcnt vmcnt(0) lgkmcnt(0)\n\ts_barrier" ::: "memory");
#undef ATT_DMA
#undef ATT_DMA1
#undef ATT_GLDS
}
}

__device__ __forceinline__ void conv_slab(const bf16_t* __restrict__ proj, const float* __restrict__ cw, bf16_t* __restrict__ mix, float* __restrict__ ssC2, int item, int lane) {
    const int slab = item & 1, t0 = (item >> 1) * 16, ch = slab * 512 + lane * 8;
    float w0[8], w1[8], w2[8];
#pragma unroll
    for (int q = 0; q < 2; ++q) { const float4 a = *(const float4*)(cw + ch + 4 * q), b = *(const float4*)(cw + DCONV + ch + 4 * q), c = *(const float4*)(cw + 2 * DCONV + ch + 4 * q);
        w0[4 * q] = a.x; w0[4 * q + 1] = a.y; w0[4 * q + 2] = a.z; w0[4 * q + 3] = a.w; w1[4 * q] = b.x; w1[4 * q + 1] = b.y; w1[4 * q + 2] = b.z; w1[4 * q + 3] = b.w;
        w2[4 * q] = c.x; w2[4 * q + 1] = c.y; w2[4 * q + 2] = c.z; w2[4 * q + 3] = c.w; }
    float z1[8], z2[8];
#pragma unroll
    for (int q = 0; q < 8; ++q) { z1[q] = 0.f; z2[q] = 0.f; }
    if ((t0 & (SEQ - 1)) != 0) {
        const bf16_t* p2 = proj + (size_t)(t0 - 2) * NPROJ; const bf16_t* p1 = proj + (size_t)(t0 - 1) * NPROJ;
        const uint4 c2 = *(const uint4*)(p2 + 4 * DATT + ch), u2 = *(const uint4*)(p2 + 5 * DATT + ch), c1 = *(const uint4*)(p1 + 4 * DATT + ch), u1 = *(const uint4*)(p1 + 5 * DATT + ch);
        const unsigned c2w[4] = {c2.x, c2.y, c2.z, c2.w}, u2w[4] = {u2.x, u2.y, u2.z, u2.w}, c1w[4] = {c1.x, c1.y, c1.z, c1.w}, u1w[4] = {u1.x, u1.y, u1.z, u1.w};
#pragma unroll
        for (int q = 0; q < 4; ++q) { z2[2 * q] = bf2f(c2w[q] & 0xffffu) * bf2f(u2w[q] & 0xffffu); z2[2 * q + 1] = bf2f(c2w[q] >> 16) * bf2f(u2w[q] >> 16);
            z1[2 * q] = bf2f(c1w[q] & 0xffffu) * bf2f(u1w[q] & 0xffffu); z1[2 * q + 1] = bf2f(c1w[q] >> 16) * bf2f(u1w[q] >> 16); }
    }
#pragma unroll 1
    for (int i0 = 0; i0 < 16; i0 += 8) {
    uint4 bv[8], cv[8], uv[8];
#pragma unroll
    for (int i = 0; i < 8; ++i) { const bf16_t* pr = proj + (size_t)(t0 + i0 + i) * NPROJ; bv[i] = *(const uint4*)(pr + 3 * DATT + ch); cv[i] = *(const uint4*)(pr + 4 * DATT + ch); uv[i] = *(const uint4*)(pr + 5 * DATT + ch); }
#pragma unroll
    for (int i = 0; i < 8; ++i) { const int t = t0 + i0 + i;
        const unsigned bw[4] = {bv[i].x, bv[i].y, bv[i].z, bv[i].w}, cw4[4] = {cv[i].x, cv[i].y, cv[i].z, cv[i].w}, uw[4] = {uv[i].x, uv[i].y, uv[i].z, uv[i].w};
        float y[8]; float ss = 0.f;
#pragma unroll
        for (int q = 0; q < 4; ++q) {
            const float za = bf2f(cw4[q] & 0xffffu) * bf2f(uw[q] & 0xffffu), zb = bf2f(cw4[q] >> 16) * bf2f(uw[q] >> 16);
            y[2 * q] = bf2f(bw[q] & 0xffffu) * (w0[2 * q] * z2[2 * q] + w1[2 * q] * z1[2 * q] + w2[2 * q] * za);
            y[2 * q + 1] = bf2f(bw[q] >> 16) * (w0[2 * q + 1] * z2[2 * q + 1] + w1[2 * q + 1] * z1[2 * q + 1] + w2[2 * q + 1] * zb);
            ss += y[2 * q] * y[2 * q] + y[2 * q + 1] * y[2 * q + 1];
            z2[2 * q] = z1[2 * q]; z1[2 * q] = za; z2[2 * q + 1] = z1[2 * q + 1]; z1[2 * q + 1] = zb; }
        *(uint4*)(mix + (size_t)t * DM + DATT + ch) = make_uint4(cvtpk2(y[0], y[1]), cvtpk2(y[2], y[3]), cvtpk2(y[4], y[5]), cvtpk2(y[6], y[7]));
        ss = wave_sum(ss);
        if (lane == 0) ssC2[t * 4 + slab] = ss; }
    }
}

namespace g8 {
typedef unsigned u32x4 __attribute__((ext_vector_type(4)));
typedef int v4i_t __attribute__((ext_vector_type(4)));
typedef int v8i_t __attribute__((ext_vector_type(8)));
constexpr int BM = 256, BK = 64, HALF = 128, HTB = HALF * BK * 2, STAGE_BYTES = 8 * HTB, NXCD = 8, WGM = 8;
__device__ __forceinline__ int lds_byte(int r, int c) { const int st = (r >> 4) * 2 + (c >> 5), rr = r & 15, cc = c & 31, ob = rr * 64 + cc * 2; return st * 1024 + (ob ^ (((ob >> 9) & 1) << 5)); }
__device__ __forceinline__ void stage_rc(int b, int& R, int& C) { const int st = b / 1024, sb = b % 1024, swz = sb ^ (((sb >> 9) & 1) << 5); R = (st >> 1) * 16 + swz / 64; C = (st & 1) * 32 + (swz % 64) / 2; }
__device__ __forceinline__ int perm32(int rho) { const int n = rho >> 4, i = rho & 15; return 8 * (i >> 2) + 4 * n + (i & 3); }
__device__ __forceinline__ unsigned cvt_pk_bf16(float lo, float hi) { unsigned r; asm volatile("v_cvt_pk_bf16_f32 %0, %1, %2" : "=v"(r) : "v"(lo), "v"(hi)); return r; }
__device__ __forceinline__ int xcd_remap(int wgid, int nwg) { const int q = nwg / NXCD, r = nwg % NXCD, xcd = wgid % NXCD, off = wgid / NXCD; return (xcd < r ? xcd * (q + 1) : r * (q + 1) + (xcd - r) * q) + off; }

struct Unit { int pm, pn, e, slot; const char* a; const char* b; };

struct DenseOrder {
    const char* A; const char* Bt; int K, nM, nN, nwg, G, c, mul = 1;
    __device__ __forceinline__ void init(const void* A_, const void* Bt_, int M, int N, int K_, int G_, int c_) { A = (const char*)A_; Bt = (const char*)Bt_; K = K_; nM = M / BM; nN = N / BM; nwg = nM * nN; G = G_; c = c_; }
    __device__ __forceinline__ bool next(int i, Unit& u) const {
        int L = i * G + c; if (L >= nwg * mul) return false; L %= nwg;
        const int wgid = xcd_remap(L, nwg);
        const int nig = WGM * nN, gid = wgid / nig, fm = gid * WGM, gsz = (nM - fm) < WGM ? (nM - fm) : WGM;
        u.pm = fm + ((wgid % nig) % gsz); u.pn = (wgid % nig) / gsz; u.e = i; u.slot = i % 3;
        u.a = A + (size_t)u.pm * BM * K * 2; u.b = Bt + (size_t)u.pn * BM * K * 2; return true;
    }
    __device__ __forceinline__ unsigned arow_off(const Unit&, int r, int Kb) const { return (unsigned)r * (unsigned)Kb; }
    const float* rowscale = nullptr; LAS float* rtab = nullptr;
    __device__ __forceinline__ void prefetch(const Unit& u) const { const int r = threadIdx.x; if (r < BM) rtab[u.slot * BM + r] = rowscale[u.pm * BM + r]; }
    __device__ __forceinline__ float scale_of(const Unit& u, int r) const { return rtab[u.slot * BM + r]; }
};
template <bool GATHER> struct MoeOrder {
    const char* A; const char* Bt; const int* list; LAS const int* pl; int K  , NPN, nwg, G, c; size_t estride; int mul;
    LAS int* rinfo; const float* rscale;
    __device__ __forceinline__ bool next(int i, Unit& u) const {
        int L = i * G + c; if (L >= nwg * mul) return false; L %= nwg;
        const int wgid = xcd_remap(L, nwg);
        u.pm = wgid / NPN; u.pn = wgid % NPN; u.e = pl[64 + u.pm]; u.slot = i % 3;
        u.a = GATHER ? A : A + (size_t)u.pm * BM * K; u.b = Bt + (size_t)u.e * estride + (size_t)u.pn * BM * K; return true;
    }
    __device__ __forceinline__ void prefetch(const Unit& u) const {
        const int r = threadIdx.x;
        if (r < BM) { const int slot = u.pm * BM + r - pl[32 + u.e]; int pr = -1; float sc = 0.f;
            if (slot < pl[u.e]) { pr = list[u.e * T + slot]; sc = rscale[GATHER ? (pr >> 1) : pr]; }
            rinfo[(u.slot * BM + r) * 2] = pr; rinfo[(u.slot * BM + r) * 2 + 1] = __float_as_int(sc); }
    }
    __device__ __forceinline__ int pair_of(const Unit& u, int r) const { return rinfo[(u.slot * BM + r) * 2]; }
    __device__ __forceinline__ float scale_of(const Unit& u, int r) const { return __int_as_float(rinfo[(u.slot * BM + r) * 2 + 1]); }
    __device__ __forceinline__ unsigned arow_off(const Unit& u, int r, int Kb) const {
        if (GATHER) { const int pr = pair_of(u, r); return (unsigned)(pr >= 0 ? (pr >> 1) : 0) * (unsigned)Kb; }
        return (unsigned)r * (unsigned)Kb;
    }
};

template <bool GATHER, int ES, class Epi, class Sched>
__device__ __forceinline__ void gemm_phase(LAS unsigned char* lds, const int K, const Sched& S, const Epi& E) {
    int tid_ = threadIdx.x; asm volatile("" : "+v"(tid_));
    const int tid = tid_, wid = __builtin_amdgcn_readfirstlane(tid >> 6), lane = tid & 63, wr = wid >> 2, wc = wid & 3, fr = lane & 15, fq = lane >> 4;
    const int Kb = K * ES, nt = Kb / (BK * 2);
    unsigned voffB[2];
#pragma unroll
    for (int i = 0; i < 2; ++i) { int R, C; stage_rc(tid * 16 + i * 8192, R, C); const int Rb = Epi::PERM ? ((R & ~31) + perm32(R & 31)) : R; voffB[i] = (unsigned)(Rb * Kb + C * 2); }
#define G8_AOFF(u, h, i) ([&]() { int R_, C_; stage_rc(tid * 16 + (i) * 8192, R_, C_); return S.arow_off(u, (h) * HALF + R_, Kb) + (unsigned)(C_ * 2); }())
    const size_t kstep = (size_t)(BK * 2);
    const size_t hstep = (size_t)HALF * Kb;
    const unsigned ldsw = (unsigned)wid * 1024u;
    const int aoff = lds_byte(wr * 64 + fr, fq * 8), boff = lds_byte(wc * 32 + fr, fq * 8);
#define G8_SA(b, h) (((b) * 2 + (h)) * HTB)
#define G8_SB(b, h) ((4 + (b) * 2 + (h)) * HTB)
#define G8_STAGE(bufoff, gbase, voff) do { _Pragma("unroll") for (int _i = 0; _i < 2; ++_i) \
        __builtin_amdgcn_global_load_lds((const unsigned*)((const char*)(gbase) + (voff)[_i]), (LAS unsigned*)(lds + (bufoff) + ldsw + _i * 8192), 16, 0, 0); } while (0)
#define G8_LDA(dst, b, h) do { _Pragma("unroll") for (int m = 0; m < 4; ++m) { if (ES == 2) { _Pragma("unroll") for (int k = 0; k < 2; ++k) dst[m][k] = *(const LAS bf16x8*)(lds + G8_SA(b, h) + aoff + m * 2048 + k * 1024); } \
        else dst##8[m] = __builtin_shufflevector(*(const LAS v4i_t*)(lds + G8_SA(b, h) + aoff + m * 2048), *(const LAS v4i_t*)(lds + G8_SA(b, h) + aoff + m * 2048 + 1024), 0, 1, 2, 3, 4, 5, 6, 7); } } while (0)
#define G8_LDB(dst, b, h) do { _Pragma("unroll") for (int n = 0; n < 2; ++n) { if (ES == 2) { _Pragma("unroll") for (int k = 0; k < 2; ++k) dst[n][k] = *(const LAS bf16x8*)(lds + G8_SB(b, h) + boff + n * 2048 + k * 1024); } \
        else dst##8[n] = __builtin_shufflevector(*(const LAS v4i_t*)(lds + G8_SB(b, h) + boff + n * 2048), *(const LAS v4i_t*)(lds + G8_SB(b, h) + boff + n * 2048 + 1024), 0, 1, 2, 3, 4, 5, 6, 7); } } while (0)
#define G8_CAT(x, y) __builtin_shufflevector(__builtin_bit_cast(v4i_t, x), __builtin_bit_cast(v4i_t, y), 0, 1, 2, 3, 4, 5, 6, 7)
#define G8_MMA(ai, bj, At, Bt) do { __builtin_amdgcn_s_setprio(1); _Pragma("unroll") for (int m = 0; m < 4; ++m) _Pragma("unroll") for (int n = 0; n < 2; ++n) { \
        if (ES == 2) { _Pragma("unroll") for (int k = 0; k < 2; ++k) acc[ai][bj][m][n] = __builtin_amdgcn_mfma_f32_16x16x32_bf16(Bt[n][k], At[m][k], acc[ai][bj][m][n], 0, 0, 0); } \
        else asm volatile("v_mfma_scale_f32_16x16x128_f8f6f4 %0, %1, %2, %0, %3, %3 op_sel_hi:[0,0,0]" : "+v"(acc[ai][bj][m][n]) : "v"(Bt##8[n]), "v"(At##8[m]), "v"(scale1)); } \
        __builtin_amdgcn_s_setprio(0); } while (0)
#define G8_WAIT_V(n) asm volatile("s_waitcnt vmcnt(" #n ")" ::: "memory")
#define G8_WAIT_L(n) asm volatile("s_waitcnt lgkmcnt(" #n ")" ::: "memory")
#define G8_BAR __builtin_amdgcn_s_barrier()
#define G8_SCHED __builtin_amdgcn_sched_barrier(0)
    Unit cur, nxt; int ui = 0;
    if (!S.next(0, cur)) return;
    if (GATHER || Epi::ROWINFO) { S.prefetch(cur); __syncthreads(); }
    f32x4 acc[2][2][4][2];
#pragma unroll
    for (int a = 0; a < 2; ++a)
#pragma unroll
        for (int b = 0; b < 2; ++b)
#pragma unroll
            for (int m = 0; m < 4; ++m)
#pragma unroll
                for (int n = 0; n < 2; ++n) acc[a][b][m][n] = (f32x4){0.f, 0.f, 0.f, 0.f};
    bf16x8 At[4][2], B0[2][2], B1[2][2];
    v8i_t At8[4], B08[2], B18[2];
    const int scale1 = 0x7F7F7F7F;
    unsigned vA[2][2];
#pragma unroll
    for (int h = 0; h < 2; ++h)
#pragma unroll
        for (int i = 0; i < 2; ++i) vA[h][i] = G8_AOFF(cur, h, i);
    const char* cA = cur.a; const char* cB = cur.b;
    G8_STAGE(G8_SB(0, 0), cB, voffB); G8_STAGE(G8_SB(0, 1), cB + hstep, voffB); G8_STAGE(G8_SA(0, 0), cA, vA[0]); G8_STAGE(G8_SA(0, 1), cA, vA[1]);
    if (wr == 1) G8_BAR;
    G8_WAIT_V(2); G8_BAR;
    G8_STAGE(G8_SB(1, 0), cB + kstep, voffB); G8_STAGE(G8_SA(1, 0), cA + kstep, vA[0]); G8_STAGE(G8_SB(1, 1), cB + hstep + kstep, voffB);
    G8_WAIT_V(6); G8_BAR;
    for (;;) {
        const bool has_next = S.next(ui + 1, nxt);
        const char* nA = has_next ? nxt.a : cA; const char* nB = has_next ? nxt.b : cB;
        if ((GATHER || Epi::ROWINFO) && has_next) S.prefetch(nxt);
        for (int t = 0; t < nt; t += 2) {
            const bool last = (t == nt - 2);
            if (Epi::MID_T >= 0 && t == Epi::MID_T) E.mid(acc, cur, wr, wc, fr, fq);
            const char* a1 = cA + (size_t)(t + 1) * kstep;
            const char* a2 = last ? nA : cA + (size_t)(t + 2) * kstep; const char* b2 = last ? nB : cB + (size_t)(t + 2) * kstep;
            const char* a3 = a2 + kstep; const char* b3 = b2 + kstep;
            unsigned v2[2][2];
#pragma unroll
            for (int h = 0; h < 2; ++h)
#pragma unroll
                for (int i = 0; i < 2; ++i) v2[h][i] = (GATHER && last && has_next) ? G8_AOFF(nxt, h, i) : vA[h][i];
            G8_LDB(B0, 0, 0); G8_LDB(B1, 0, 1); G8_SCHED; G8_LDA(At, 0, 0); G8_STAGE(G8_SA(1, 1), a1, vA[1]);
            G8_WAIT_V(8); G8_WAIT_L(0); G8_BAR; G8_MMA(0, 0, At, B0); G8_MMA(0, 1, At, B1); G8_BAR; G8_SCHED;
            G8_LDA(At, 0, 1); G8_STAGE(G8_SB(0, 0), b2, voffB); G8_STAGE(G8_SB(0, 1), b2 + hstep, voffB); G8_STAGE(G8_SA(0, 0), a2, v2[0]);
            G8_WAIT_V(8); G8_WAIT_L(0); G8_BAR; G8_MMA(1, 0, At, B0); G8_MMA(1, 1, At, B1); G8_BAR; G8_SCHED;
            G8_LDB(B0, 1, 0); G8_LDB(B1, 1, 1); G8_SCHED; G8_LDA(At, 1, 0); G8_STAGE(G8_SA(0, 1), a2, v2[1]);
            G8_WAIT_V(8); G8_WAIT_L(0); G8_BAR; G8_MMA(0, 0, At, B0); G8_MMA(0, 1, At, B1); G8_BAR; G8_SCHED;
            G8_LDA(At, 1, 1); G8_STAGE(G8_SB(1, 0), b3, voffB); G8_STAGE(G8_SB(1, 1), b3 + hstep, voffB); G8_STAGE(G8_SA(1, 0), a3, v2[0]);
            G8_WAIT_V(8); G8_WAIT_L(0); G8_BAR; G8_MMA(1, 0, At, B0); G8_MMA(1, 1, At, B1); G8_BAR; G8_SCHED;
        }
        if (wr == 0) G8_BAR;
        E(acc, cur, wr, wc, fr, fq);
        if (!has_next) break;
#pragma unroll
        for (int a = 0; a < 2; ++a)
#pragma unroll
            for (int b = 0; b < 2; ++b)
#pragma unroll
                for (int m = 0; m < 4; ++m)
#pragma unroll
                    for (int n = 0; n < 2; ++n) acc[a][b][m][n] = (f32x4){0.f, 0.f, 0.f, 0.f};
        cur = nxt; cA = nA; cB = nB; ++ui;
#pragma unroll
        for (int h = 0; h < 2; ++h)
#pragma unroll
            for (int i = 0; i < 2; ++i) if (GATHER) vA[h][i] = G8_AOFF(cur, h, i);
        if (wr == 1) G8_BAR;
    }
    G8_WAIT_V(0);
    G8_BAR;
#undef G8_SA
#undef G8_SB
#undef G8_STAGE
#undef G8_LDA
#undef G8_LDB
#undef G8_MMA
#undef G8_AOFF
#undef G8_CAT
#undef G8_WAIT_V
#undef G8_WAIT_L
#undef G8_BAR
#undef G8_SCHED
}

template <class Sched> struct EpiProjF { static constexpr bool PERM = true, ROWINFO = true; static constexpr int MID_T = -1; bf16_t* out; const Sched* S;
    __device__ __forceinline__ void mid(f32x4 (&)[2][2][4][2], const Unit&, int, int, int, int) const {}
    __device__ __forceinline__ void operator()(const f32x4 (&acc)[2][2][4][2], const Unit& u, int wr, int wc, int fr, int fq) const {
        const int row0 = u.pm * BM + wr * 64 + fr, col0 = u.pn * BM + wc * 32 + 8 * fq;
#pragma unroll
        for (int ai = 0; ai < 2; ++ai)
#pragma unroll
            for (int m = 0; m < 4; ++m) { const int row = row0 + ai * HALF + m * 16; const float s = S->scale_of(u, ai * HALF + wr * 64 + m * 16 + fr); bf16_t* rowp = out + (size_t)row * NPROJ + col0;
#pragma unroll
                for (int bj = 0; bj < 2; ++bj) { const f32x4 v0 = acc[ai][bj][m][0] * s, v1 = acc[ai][bj][m][1] * s; u32x4 w; w.x = cvt_pk_bf16(v0[0], v0[1]); w.y = cvt_pk_bf16(v0[2], v0[3]); w.z = cvt_pk_bf16(v1[0], v1[1]); w.w = cvt_pk_bf16(v1[2], v1[3]);
                    *(u32x4*)(rowp + bj * HALF) = w; } }
    }
};
struct EpiG2F { static constexpr bool PERM = true, ROWINFO = false; static constexpr int MID_T = DATT / BK; bf16_t* out; LAS const float* tab;
    __device__ __forceinline__ void mid(f32x4 (&acc)[2][2][4][2], const Unit& u, int wr, int wc, int fr, int fq) const {
        LAS const float* tb = tab + (size_t)(u.e) * 512;
#pragma unroll
        for (int ai = 0; ai < 2; ++ai)
#pragma unroll
            for (int m = 0; m < 4; ++m) { const float s = tb[(ai * HALF + wr * 64 + m * 16 + fr) * 2];
#pragma unroll
                for (int bj = 0; bj < 2; ++bj)
#pragma unroll
                    for (int n = 0; n < 2; ++n) acc[ai][bj][m][n] *= s; }
    }
    __device__ __forceinline__ void operator()(const f32x4 (&acc)[2][2][4][2], const Unit& u, int wr, int wc, int fr, int fq) const {
        LAS const float* tb = tab + (size_t)(u.e) * 512;
        const int col0 = u.pn * BM + wc * 32 + 8 * fq;
#pragma unroll
        for (int ai = 0; ai < 2; ++ai)
#pragma unroll
            for (int m = 0; m < 4; ++m) { const int r = ai * HALF + wr * 64 + m * 16 + fr; const float s = tb[r * 2 + 1]; bf16_t* rowp = out + (size_t)(u.pm * BM + r) * DM + col0;
#pragma unroll
                for (int bj = 0; bj < 2; ++bj) { const f32x4 v0 = acc[ai][bj][m][0] * s, v1 = acc[ai][bj][m][1] * s; u32x4 w; w.x = cvt_pk_bf16(v0[0], v0[1]); w.y = cvt_pk_bf16(v0[2], v0[3]); w.z = cvt_pk_bf16(v1[0], v1[1]); w.w = cvt_pk_bf16(v1[2], v1[3]);
                    *(u32x4*)(rowp + bj * HALF) = w; } }
    }
};
struct EpiG2X { static constexpr bool PERM = true, ROWINFO = false; static constexpr int MID_T = DATT / BK; bf16_t* out; unsigned char* xf8; const float* g2; LAS const float* tab;
    __device__ __forceinline__ void mid(f32x4 (&acc)[2][2][4][2], const Unit& u, int wr, int wc, int fr, int fq) const {
        LAS const float* tb = tab + (size_t)(u.e) * 512;
#pragma unroll
        for (int ai = 0; ai < 2; ++ai)
#pragma unroll
            for (int m = 0; m < 4; ++m) { const float s = tb[(ai * HALF + wr * 64 + m * 16 + fr) * 2];
#pragma unroll
                for (int bj = 0; bj < 2; ++bj)
#pragma unroll
                    for (int n = 0; n < 2; ++n) acc[ai][bj][m][n] *= s; }
    }
    __device__ __forceinline__ void operator()(const f32x4 (&acc)[2][2][4][2], const Unit& u, int wr, int wc, int fr, int fq) const {
        LAS const float* tb = tab + (size_t)(u.e) * 512;
        const int col0 = u.pn * BM + wc * 32 + 8 * fq;
        f32x4 gv[2][2];
#pragma unroll
        for (int bj = 0; bj < 2; ++bj) { gv[bj][0] = *(const f32x4*)(g2 + col0 + bj * HALF); gv[bj][1] = *(const f32x4*)(g2 + col0 + bj * HALF + 4); }
#pragma unroll
        for (int ai = 0; ai < 2; ++ai) {
            u32x4 xv[2][4][2];
#pragma unroll
            for (int m = 0; m < 4; ++m) { const bf16_t* xp = out + (size_t)(u.pm * BM + ai * HALF + wr * 64 + m * 16 + fr) * DM + col0;
#pragma unroll
                for (int bj = 0; bj < 2; ++bj) xv[ai][m][bj] = *(const u32x4*)(xp + bj * HALF); }
#pragma unroll
            for (int m = 0; m < 4; ++m) { const int r = ai * HALF + wr * 64 + m * 16 + fr; const float s = tb[r * 2 + 1]; bf16_t* rowp = out + (size_t)(u.pm * BM + r) * DM + col0;
#pragma unroll
                for (int bj = 0; bj < 2; ++bj) { const u32x4 xw = xv[ai][m][bj];
                    const f32x4 x0 = {__uint_as_float(xw.x << 16), __uint_as_float(xw.x & 0xffff0000u), __uint_as_float(xw.y << 16), __uint_as_float(xw.y & 0xffff0000u)};
                    const f32x4 x1 = {__uint_as_float(xw.z << 16), __uint_as_float(xw.z & 0xffff0000u), __uint_as_float(xw.w << 16), __uint_as_float(xw.w & 0xffff0000u)};
                    const f32x4 v0 = acc[ai][bj][m][0] * s + x0, v1 = acc[ai][bj][m][1] * s + x1; u32x4 w; w.x = cvt_pk_bf16(v0[0], v0[1]); w.y = cvt_pk_bf16(v0[2], v0[3]); w.z = cvt_pk_bf16(v1[0], v1[1]); w.w = cvt_pk_bf16(v1[2], v1[3]);
                    *(u32x4*)(rowp + bj * HALF) = w;
                    const f32x4 y0 = v0 * gv[bj][0], y1 = v1 * gv[bj][1];
                    int f0 = __builtin_amdgcn_cvt_pk_fp8_f32(y0[0], y0[1], 0, false); f0 = __builtin_amdgcn_cvt_pk_fp8_f32(y0[2], y0[3], f0, true);
                    int f1 = __builtin_amdgcn_cvt_pk_fp8_f32(y1[0], y1[1], 0, false); f1 = __builtin_amdgcn_cvt_pk_fp8_f32(y1[2], y1[3], f1, true);
                    *(uint2*)(xf8 + (size_t)(u.pm * BM + r) * DM + col0 + bj * HALF) = make_uint2((unsigned)f0, (unsigned)f1); } }
            __builtin_amdgcn_sched_barrier(0);
        }
    }
};
template <class Sched> struct EpiGUF { static constexpr bool PERM = true, ROWINFO = true; static constexpr int MID_T = -1; bf16_t* Hb; const Sched* S;
    __device__ __forceinline__ void mid(f32x4 (&)[2][2][4][2], const Unit&, int, int, int, int) const {}
    __device__ __forceinline__ void operator()(const f32x4 (&acc)[2][2][4][2], const Unit& u, int wr, int wc, int fr, int fq) const {
        const int col0 = u.pn * HALF + wc * 32 + 8 * fq;
#pragma unroll
        for (int ai = 0; ai < 2; ++ai)
#pragma unroll
            for (int m = 0; m < 4; ++m) { const int r = ai * HALF + wr * 64 + m * 16 + fr; const float s = S->scale_of(u, r) * (1.f / WSCALE8);
                float h[8];
#pragma unroll
                for (int n = 0; n < 2; ++n)
#pragma unroll
                    for (int q = 0; q < 4; ++q) { const float gg = acc[ai][0][m][n][q] * s, uu = acc[ai][1][m][n][q] * s; h[4 * n + q] = gg * __builtin_amdgcn_rcpf(1.f + __expf(-gg)) * uu; }
                int w0 = __builtin_amdgcn_cvt_pk_fp8_f32(h[0] * HSCALE8, h[1] * HSCALE8, 0, false); w0 = __builtin_amdgcn_cvt_pk_fp8_f32(h[2] * HSCALE8, h[3] * HSCALE8, w0, true);
                int w1 = __builtin_amdgcn_cvt_pk_fp8_f32(h[4] * HSCALE8, h[5] * HSCALE8, 0, false); w1 = __builtin_amdgcn_cvt_pk_fp8_f32(h[6] * HSCALE8, h[7] * HSCALE8, w1, true);
                *(uint2*)((unsigned char*)Hb + (size_t)(u.pm * BM + r) * DEXP + col0) = make_uint2((unsigned)w0, (unsigned)w1); }
    }
};
template <class Sched> struct EpiDownF { static constexpr bool PERM = true, ROWINFO = true; static constexpr int MID_T = -1; unsigned char* Y; const Sched* S;
    __device__ __forceinline__ void mid(f32x4 (&)[2][2][4][2], const Unit&, int, int, int, int) const {}
    __device__ __forceinline__ void operator()(const f32x4 (&acc)[2][2][4][2], const Unit& u, int wr, int wc, int fr, int fq) const {
        const int col0 = u.pn * BM + wc * 32 + 8 * fq;
#pragma unroll
        for (int ai = 0; ai < 2; ++ai)
#pragma unroll
            for (int m = 0; m < 4; ++m) { const int r = ai * HALF + wr * 64 + m * 16 + fr; const int pr = S->pair_of(u, r); if (pr < 0) continue; const float s = S->scale_of(u, r) * (YSCALE8 / (HSCALE8 * WDSCALE8)); unsigned char* rowp = Y + (size_t)pr * DM + col0;
#pragma unroll
                for (int bj = 0; bj < 2; ++bj) { const f32x4 v0 = acc[ai][bj][m][0] * s, v1 = acc[ai][bj][m][1] * s;
                    int w0 = __builtin_amdgcn_cvt_pk_fp8_f32(v0[0], v0[1], 0, false); w0 = __builtin_amdgcn_cvt_pk_fp8_f32(v0[2], v0[3], w0, true);
                    int w1 = __builtin_amdgcn_cvt_pk_fp8_f32(v1[0], v1[1], 0, false); w1 = __builtin_amdgcn_cvt_pk_fp8_f32(v1[2], v1[3], w1, true);
                    *(uint2*)(rowp + bj * HALF) = make_uint2((unsigned)w0, (unsigned)w1); } }
    }
};
}


#define XB_TMO      128
#define XB_XCNT(j)  (256  + 64 * (j))
#define XB_XSUB(j)  (1280 + 64 * (j))
#define XB_XGEN(j)  (2304 + 64 * (j))
#define XB_TOP      3328
#define XB_TOPGEN   3392
#define XCD_BAR_WORDS 3456
#define XB_SPIN_CAP (1u << 20)
__device__ __forceinline__ unsigned xb_ld(unsigned* p)              { return __hip_atomic_load(p, __ATOMIC_RELAXED, __HIP_MEMORY_SCOPE_AGENT); }
__device__ __forceinline__ unsigned xb_add(unsigned* p, unsigned v) { return __hip_atomic_fetch_add(p, v, __ATOMIC_RELAXED, __HIP_MEMORY_SCOPE_AGENT); }
__device__ __forceinline__ unsigned xb_xcc_id() { return (unsigned)__builtin_amdgcn_s_getreg((3 << 11) | 20) & 0xFu; }
#define XB_SPIN(cond, bar) do { unsigned _sp = 0; while (cond) { __builtin_amdgcn_s_sleep(1); \
    if ((++_sp & 255u) == 0u) { if (xb_ld(&(bar)[XB_TMO])) break; if (_sp > XB_SPIN_CAP) { atomicAdd(&(bar)[XB_TMO], 1u); break; } } } } while (0)
struct XcdBarrier { unsigned* bar; unsigned x; volatile LAS unsigned* st; };
__device__ __forceinline__ XcdBarrier xcd_barrier_post(unsigned* bar, volatile LAS unsigned* st) {
    XcdBarrier b; b.bar = bar; b.x = xb_xcc_id(); b.st = st;
    if (threadIdx.x == 0) (void)xb_add(&bar[XB_XCNT(b.x)], 1u);
    return b;
}
__device__ __forceinline__ void xcd_barrier_complete(unsigned* bar, unsigned x, unsigned& nloc, unsigned& nx) {
    const unsigned G = gridDim.x * gridDim.y * gridDim.z;
    unsigned sum, cnt, mine, sp = 0u;
    for (;;) {
        sum = 0u; cnt = 0u; mine = 0u;
#pragma unroll
        for (unsigned j = 0; j < 16; ++j) { const unsigned c = xb_ld(&bar[XB_XCNT(j)]); sum += c; cnt += (c > 0u) ? 1u : 0u; mine = (j == x) ? c : mine; }
        if (sum == G) break;
        __builtin_amdgcn_s_sleep(1);
        if ((++sp & 255u) == 0u) { if (xb_ld(&bar[XB_TMO])) break; if (sp > XB_SPIN_CAP) { atomicAdd(&bar[XB_TMO], 1u); break; } }
    }
    nloc = mine > 0u ? mine : 1u; nx = cnt > 0u ? cnt : 1u;
}
__device__ __forceinline__ void xcd_barrier(const XcdBarrier& b) {
    asm volatile("s_waitcnt vmcnt(0)" ::: "memory");
    __syncthreads();
    if (threadIdx.x == 0) {
        unsigned* bar = b.bar;
        __builtin_amdgcn_s_waitcnt(0);
        unsigned nloc = b.st[0], nx = b.st[1];
        if (nloc == 0u) { xcd_barrier_complete(bar, b.x, nloc, nx); b.st[0] = nloc; b.st[1] = nx; }
        const unsigned old = xb_add(&bar[XB_XSUB(b.x)], 1u);
        const unsigned gen = old / nloc;
        if (old + 1u == (gen + 1u) * nloc) {
            __builtin_amdgcn_fence(__ATOMIC_RELEASE, "agent");
            asm volatile("s_waitcnt vmcnt(0)" ::: "memory");
            const unsigned og = xb_add(&bar[XB_TOP], 1u);
            const unsigned tg = og / nx;
            if (og + 1u == (tg + 1u) * nx) xb_add(&bar[XB_TOPGEN], 1u);
            else XB_SPIN(xb_ld(&bar[XB_TOPGEN]) == tg, bar);
            __builtin_amdgcn_fence(__ATOMIC_ACQUIRE, "agent");
            xb_add(&bar[XB_XGEN(b.x)], 1u);
            asm volatile("s_waitcnt vmcnt(0)" ::: "memory");
        } else {
            XB_SPIN(xb_ld(&bar[XB_XGEN(b.x)]) == gen, bar);
            __builtin_amdgcn_fence(__ATOMIC_ACQUIRE, "agent");
            asm volatile("s_waitcnt vmcnt(0)" ::: "memory");
        }
    }
    __syncthreads();
}

__global__ void __launch_bounds__(NTHREADS, 2) mega(Params p) {
    extern __shared__ __attribute__((aligned(16))) unsigned char lds[];
    volatile LAS unsigned* bst = (volatile LAS unsigned*)(lds + LDS_PLAN_OFF + 1024);
    if (threadIdx.x < 2) bst[threadIdx.x] = 0u;
    __syncthreads();
    const XcdBarrier gbar = xcd_barrier_post((unsigned*)(p.ws + WS_BAR), bst);
    unsigned long long ts0 = 0, ts1 = 0;
    if (p.never) cg::this_grid().sync();
    Ctx c; c.tid = threadIdx.x; c.lane = c.tid & 63; c.wave = __builtin_amdgcn_readfirstlane(c.tid >> 6); c.gw = blockIdx.x * NWAVES + c.wave; c.ngw = gridDim.x * NWAVES;
    char* ws = p.ws;
    int* cnt = (int*)(ws + WS_CTL);
    float* r1 = (float*)(ws + WS_R1); float* r2 = (float*)(ws + WS_R2); float* ssC = (float*)(ws + WS_SSC);
    float* wts = (float*)(ws + WS_WTS); bf16_t* Wrh = (bf16_t*)(ws + WS_WR); float* ssA = (float*)(ws + WS_SSA); int* list = (int*)(ws + WS_LIST);
    bf16_t* W2t = (bf16_t*)(ws + WS_W2T); bf16_t* W1t = (bf16_t*)(ws + WS_W1T); bf16_t* Wdt = (bf16_t*)(ws + WS_WDT); bf16_t* Wgut = (bf16_t*)(ws + WS_WGUT);
    bf16_t* xb = (bf16_t*)(ws + WS_XB); bf16_t* mix = (bf16_t*)(ws + WS_MIX); bf16_t* proj = (bf16_t*)(ws + WS_PROJ); bf16_t* Y = (bf16_t*)(ws + WS_Y); bf16_t* Hb = (bf16_t*)(ws + WS_H);
    unsigned char* xf8 = (unsigned char*)(ws + WS_WGUT + 64 * MiB);
    bf16_t* dlt = (bf16_t*)(ws + WS_PROJ);

    TS0(1) TS0(8)
    {
        for (int row = c.gw; row < T * PMUL(10); row += 2 * c.ngw) {
            const int ra = row % T, rb = (row + c.ngw) % T; const bool hb = row + c.ngw < T * PMUL(10);
            const float4* xa = (const float4*)(p.x + (size_t)ra * DM); const float4* xc = (const float4*)(p.x + (size_t)rb * DM);
            float4 va[8], vb[8];
#pragma unroll
            for (int j = 0; j < 8; ++j) { va[j] = xa[j * 64 + c.lane]; if (hb) vb[j] = xc[j * 64 + c.lane]; }
            float sa = 0.f, sb = 0.f; uint2* oa = (uint2*)(xb + (size_t)ra * DM); uint2* ob = (uint2*)(xb + (size_t)rb * DM);
#pragma unroll
            for (int j = 0; j < 8; ++j) { sa += va[j].x * va[j].x + va[j].y * va[j].y + va[j].z * va[j].z + va[j].w * va[j].w; oa[j * 64 + c.lane] = make_uint2(cvtpk2(va[j].x, va[j].y), cvtpk2(va[j].z, va[j].w)); }
            if (hb) {
#pragma unroll
                for (int j = 0; j < 8; ++j) { sb += vb[j].x * vb[j].x + vb[j].y * vb[j].y + vb[j].z * vb[j].z + vb[j].w * vb[j].w; ob[j * 64 + c.lane] = make_uint2(cvtpk2(vb[j].x, vb[j].y), cvtpk2(vb[j].z, vb[j].w)); } }
            sa = wave_sum(sa); sb = wave_sum(sb);
            if (c.lane == 0) { r1[ra] = rsqrtf(sa * (1.f / DM) + EPS); if (hb) r1[rb] = rsqrtf(sb * (1.f / DM) + EPS); }
        }
        LAS float* scr = (LAS float*)lds + c.wave * (64 * 65);
        constexpr int I_IN = (DM / 64) * (NPROJ / 64), I_OUT = (DM / 64) * (DM / 64);
        constexpr int NIT = I_IN + I_OUT;
        for (int it = c.gw; it < NIT * PMUL(10); it += c.ngw) {
            int r = it % NIT;
            if (r < I_IN) { const int nb = NPROJ / 64, kb = r / nb, n0 = (r % nb) * 64; p0_titem(p.w_in, NPROJ, p.norm1, W1t, DM, kb * 64, n0, n0, scr, c.lane, n0 < DATT ? QSCALE : 1.f); continue; } r -= I_IN;
            { const int nb = DM / 64, kb = r / nb, n0 = (r % nb) * 64, k0 = kb * 64;
                const float* g = k0 < DATT ? p.g_oa + k0 : p.g_oc + (k0 - DATT);
                p0_titem(p.w_out + (size_t)k0 * DM, DM, g, W2t + k0, DM, 0, n0, n0, scr, c.lane); }
        }
        for (int i = blockIdx.x * NTHREADS + c.tid; i < 48 * DM; i += gridDim.x * NTHREADS) { const int o = i / DM, k = i % DM; const float w = o < 36 ? (o < 4 ? p.w_rg[k * 4 + o] : p.w_re[k * 32 + (o - 4)]) : 0.f;
            Wrh[i] = (bf16_t)f2bf(w * p.norm2[k]); }
    }
    xcd_barrier(gbar);
    TS1(1) TS0(2)
    {
        g8::DenseOrder S; S.init(xb, W1t, T, NPROJ, DM, (int)gridDim.x, (int)blockIdx.x); S.mul = PMUL(1);
        S.rowscale = r1; S.rtab = (LAS float*)(lds + 131072);
        const g8::EpiProjF<g8::DenseOrder> E{proj, &S};
        g8::gemm_phase<false, 2>((LAS unsigned char*)lds, DM, S, E);
    }
    xcd_barrier(gbar);
    TS1(2) TS0(3)
    {
        struct Side { WConv wc; unsigned long long twait; int s, gw, ngw, nper, lane; LAS float* scr; unsigned scr32; const float *wg, *wu, *wd; bf16_t* Wgut; bf16_t* Wdt;
            __device__ __forceinline__ void step() { if (wc.pending) wc.finish(scr, lane);
                if (s < nper) { const int id = gw + ngw * s; ++s; if (id < WC_ITEMS) wc.issue(id, wg, wu, wd, Wgut, Wdt, scr32, lane); } }
            __device__ __forceinline__ void whole() { step(); asm volatile("s_waitcnt vmcnt(0)" ::: "memory"); } };
        Side side; side.twait = 0; side.wc.pending = false; side.s = 0; side.gw = c.gw; side.ngw = c.ngw; side.nper = (WC_ITEMS + c.ngw - 1) / c.ngw; side.lane = c.lane;
        side.scr = (LAS float*)(lds + 69632) + c.wave * (64 * 32); side.scr32 = (unsigned)(__UINTPTR_TYPE__)((LAS unsigned char*)lds + 69632) + c.wave * 8192;
        side.wg = p.w_gate; side.wu = p.w_up; side.wd = p.w_down; side.Wgut = Wgut; side.Wdt = Wdt;
        for (int u1 = blockIdx.x; u1 < NB * NH * 4 * PMUL(2); u1 += gridDim.x) { const int u0 = u1 % (NB * NH * 4); const int bh = u0 >> 2;
            for (int i = 0; i < 4; ++i) att::attn_unit((LAS unsigned char*)lds, proj, p.relb, mix, ssA, bh >> 4, bh & 15, (u0 & 3) + 4 * i, side, i == 0); }
        if (TSPROBE == 34 || TSPROBE == 35) { ts0 = 0; ts1 = side.twait; }
        while (side.wc.pending || side.s < side.nper) side.whole();
        for (int it = c.gw; it < (T / 16) * 2 * PMUL(21); it += c.ngw) conv_slab(proj, p.conv_w, mix, ssC, it % ((T / 16) * 2), c.lane);
    }
    xcd_barrier(gbar);
    TS1(3) TS0(4)
    {
        g8::DenseOrder S; S.init(mix, W2t, T, DM, DM, (int)gridDim.x, (int)blockIdx.x); S.mul = PMUL(3);
        LAS float* tab = (LAS float*)(lds + 131072);
        g8::Unit u;
        for (int i = 0; i < 4; ++i) if (S.next(i, u) && c.tid < 256) { const int row = u.pm * 256 + c.tid; float sa = 0.f;
#pragma unroll
            for (int h = 0; h < 16; ++h) sa += ssA[row * 16 + h];
            const float4 sc4 = *(const float4*)(ssC + row * 4); const float ra = rsqrtf(sa * (1.f / DATT) + EPS), rc = rsqrtf((sc4.x + sc4.y) * (1.f / DCONV) + EPS);
            tab[(i * 256 + c.tid) * 2] = ra / rc; tab[(i * 256 + c.tid) * 2 + 1] = rc; }
        __syncthreads();
        const g8::EpiG2X E{xb, xf8, p.norm2, tab};
        g8::gemm_phase<false, 2>((LAS unsigned char*)lds, DM, S, E);
    }
    xcd_barrier(gbar);
    TS1(4) TS0(5)
    for (int it = blockIdx.x; it < (T / 64) * PMUL(4); it += gridDim.x) router_block(xb, Wrh, p.b_rg, p.b_re, cnt, list, wts, r2, it % (T / 64), c.wave, c.lane, (LAS float*)lds, it < T / 64);
    xcd_barrier(gbar);
    TS1(5) TS0(6)
    LAS int* pl = (LAS int*)(lds + LDS_PLAN_OFF);
    if (c.tid < 64) {
        const int ce = c.tid < NE ? cnt[c.tid * 64] : 0, mt = (ce + 255) >> 8;
        int inc = mt;
#pragma unroll
        for (int o = 1; o < 32; o <<= 1) { const int v = __shfl_up(inc, o); if (c.lane >= o) inc += v; }
        if (c.tid < NE) { pl[c.tid] = ce; pl[32 + c.tid] = (inc - mt) * 256; }
        if (c.tid == NE - 1) pl[224] = inc;
    }
    __syncthreads();
    if (c.tid < NTILEMAX) { int e = -1;
        for (int q = 0; q < NE; ++q) { const int st = pl[32 + q] >> 8, mt = (pl[q] + 255) >> 8; if (c.tid >= st && c.tid < st + mt) e = q; }
        pl[64 + c.tid] = e; }
    __syncthreads();
    const int ntile = pl[224];
    {
        const g8::MoeOrder<true> S{(const char*)xf8, (const char*)Wgut, list, pl, DM  , 4, ntile * 4, (int)gridDim.x, (int)blockIdx.x, (size_t)2 * DEXP * DM, PMUL(5), (LAS int*)(lds + 131072), r2};
        const g8::EpiGUF<g8::MoeOrder<true>> E{Hb, &S};
        g8::gemm_phase<true, 1>((LAS unsigned char*)lds, DM, S, E);
    }
    xcd_barrier(gbar);
    TS1(6) TS0(7)
    {
        const g8::MoeOrder<false> S{(const char*)Hb, (const char*)Wdt, list, pl, DEXP  , 8, ntile * 8, (int)gridDim.x, (int)blockIdx.x, (size_t)DM * DEXP, PMUL(6), (LAS int*)(lds + 131072), wts};
        const g8::EpiDownF<g8::MoeOrder<false>> E{(unsigned char*)Y, &S};
        g8::gemm_phase<false, 1>((LAS unsigned char*)lds, DEXP, S, E);
    }
    xcd_barrier(gbar);
    TS1(7) TS1(8)
    if (PROBE == 9) { for (int i = 0; i < 8; ++i) xcd_barrier(gbar); }
    const float tsdelta = TSPROBE ? sqrtf((float)(ts1 - ts0) * 0.01f) * 1e-3f : 0.f;
    {
        const unsigned long long tp6 = (TSPROBE == 9) ? __builtin_amdgcn_s_memrealtime() : 0ull;
        FinalRow fa, fb;
        int t = c.gw;
        if (t < T) final_load(fa, xb, Y, t, c.lane);
        for (; t < T; t += 2 * c.ngw) {
            const int t2 = t + c.ngw, t3 = t + 2 * c.ngw;
            if (t2 < T) final_load(fb, xb, Y, t2, c.lane);
            final_store(fa, p.out, p.norm_f, t, c.lane, (TSPROBE == 9) ? sqrtf((float)(__builtin_amdgcn_s_memrealtime() - tp6) * 0.01f) * 1e-3f : tsdelta);
            if (t3 < T) final_load(fa, xb, Y, t3, c.lane);
            if (t2 < T) final_store(fb, p.out, p.norm_f, t2, c.lane, (TSPROBE == 9) ? sqrtf((float)(__builtin_amdgcn_s_memrealtime() - tp6) * 0.01f) * 1e-3f : tsdelta);
        }
    }
}

extern "C" void kernel_launch(void* const* d_in, const int* in_sizes, int n_in, void* d_out, int out_size, void* d_ws, size_t ws_size, hipStream_t stream) {
    static int grid = 0;
    if (grid == 0) {
        int dev = 0, cus = 0, per_cu = 0;
        if (ws_size < WS_END || n_in != 17) { fprintf(stderr, "kernel_launch: unexpected sizes (ws %zu)\n", ws_size); grid = -1; return; }
        (void)hipGetDevice(&dev); (void)hipDeviceGetAttribute(&cus, hipDeviceAttributeMultiprocessorCount, dev);
        if (hipFuncSetAttribute((const void*)mega, hipFuncAttributeMaxDynamicSharedMemorySize, LDS_BYTES) != hipSuccess) { fprintf(stderr, "hipFuncSetAttribute failed\n"); grid = -1; return; }
        if (hipOccupancyMaxActiveBlocksPerMultiprocessor(&per_cu, (const void*)mega, NTHREADS, LDS_BYTES) != hipSuccess || per_cu < 1) { fprintf(stderr, "occupancy query failed (%d)\n", per_cu); grid = -1; return; }
        grid = cus * per_cu;
        fprintf(stderr, "kernel_launch: cus %d per_cu %d grid %d\n", cus, per_cu, grid);
    }
    if (grid < 0) return;
    if (hipMemsetAsync((char*)d_ws + WS_CTL, 0, 64 * 1024, stream) != hipSuccess) { fprintf(stderr, "memset failed\n"); return; }
    Params p{};
    p.x = (const float*)d_in[0]; p.norm1 = (const float*)d_in[1]; p.w_in = (const float*)d_in[2]; p.relb = (const float*)d_in[3];
    p.conv_w = (const float*)d_in[4]; p.g_oa = (const float*)d_in[5]; p.g_oc = (const float*)d_in[6]; p.w_out = (const float*)d_in[7];
    p.norm2 = (const float*)d_in[8]; p.w_rg = (const float*)d_in[9]; p.b_rg = (const float*)d_in[10]; p.w_re = (const float*)d_in[11];
    p.b_re = (const float*)d_in[12]; p.w_gate = (const float*)d_in[13]; p.w_up = (const float*)d_in[14]; p.w_down = (const float*)d_in[15];
    p.norm_f = (const float*)d_in[16]; p.out = (float*)d_out; p.ws = (char*)d_ws;
    void* args[] = {&p};
    hipError_t e = hipLaunchCooperativeKernel((const void*)mega, dim3(grid), dim3(NTHREADS), args, LDS_BYTES, stream);
    if (e != hipSuccess) fprintf(stderr, "cooperative launch failed: %s (grid %d)\n", hipGetErrorString(e), grid);
}
```

```cpp
#include <hip/hip_runtime.h>
#include <hip/hip_cooperative_groups.h>
#include <stdint.h>
#include <cstdio>
namespace cg = cooperative_groups;
#ifndef PROBE
#define PROBE 0
#endif
#define PMUL(k) ((PROBE) == (k) ? 2 : 1)
#ifndef TSPROBE
#define TSPROBE 0
#endif
#define TS0(k) if (TSPROBE == (k)) ts0 = __builtin_amdgcn_s_memrealtime();
#define TS1(k) if (TSPROBE == (k)) ts1 = __builtin_amdgcn_s_memrealtime();

typedef unsigned short bf16_t;
typedef short bf16x8 __attribute__((ext_vector_type(8)));
typedef float f32x4 __attribute__((ext_vector_type(4)));

constexpr int NB = 4, SEQ = 4096, T = NB * SEQ, DM = 2048, DATT = 1024, DCONV = 1024, NPROJ = 6144;
constexpr int NH = 16, HD = 64, NREL = 513, NE = 32, DEXP = 512, NPAIR = 2 * T;
constexpr int NPADMAX = 40960, NTILEMAX = NPADMAX / 256;
constexpr float EPS = 1e-6f;
constexpr float YSCALE8 = 64.f;
constexpr float HSCALE8 = 8.f, WDSCALE8 = 32.f;
constexpr float WSCALE8 = 64.f;
constexpr float LOG2E = 1.4426950408889634f, QSCALE = 0.125f * LOG2E;

constexpr size_t MiB = 1u << 20;
constexpr size_t WS_CTL = 0;
constexpr size_t WS_BAR = 16 * 1024;
constexpr size_t WS_PLAN = 64 * 1024;
constexpr size_t WS_R1 = 128 * 1024;
constexpr size_t WS_RA = 192 * 1024;
constexpr size_t WS_RC = 256 * 1024;
constexpr size_t WS_R2 = 320 * 1024;
constexpr size_t WS_SSC = 3 * MiB;
constexpr size_t WS_WTS = 512 * 1024;
constexpr size_t WS_ROWPAIR = 640 * 1024;
constexpr size_t WS_WR = 1 * MiB;
constexpr size_t WS_SSA = 2 * MiB;
constexpr size_t WS_LIST = 5 * MiB;
constexpr size_t WS_W2T = 8 * MiB;
constexpr size_t WS_W1T = 16 * MiB;
constexpr size_t WS_WDT = 40 * MiB;
constexpr size_t WS_WGUT = 104 * MiB;
constexpr size_t WS_XB = 232 * MiB;
constexpr size_t WS_MIX = 296 * MiB;
constexpr size_t WS_PROJ = 360 * MiB;
constexpr size_t WS_Y = 360 * MiB;
constexpr size_t WS_H = 488 * MiB;
constexpr size_t WS_END = 552 * MiB;

__device__ __forceinline__ unsigned f2bf(float f) { unsigned u = __float_as_uint(f); return (u + 0x7fffu + ((u >> 16) & 1u)) >> 16; }
__device__ __forceinline__ unsigned pk2(float lo, float hi) { return f2bf(lo) | (f2bf(hi) << 16); }
__device__ __forceinline__ unsigned cvtpk2(float lo, float hi) { typedef float f2 __attribute__((ext_vector_type(2))); typedef __bf16 b2 __attribute__((ext_vector_type(2))); f2 v = {lo, hi}; b2 r = __builtin_convertvector(v, b2); return __builtin_bit_cast(unsigned, r); }
__device__ __forceinline__ int gu_row(int n, int up) { return ((n >> 7) << 8) + (n & 127) + (up ? 128 : 0); }
__device__ __forceinline__ float bf2f(unsigned h) { return __uint_as_float(h << 16); }
__device__ __forceinline__ float wave_sum(float v) {
#pragma unroll
    for (int o = 1; o < 64; o <<= 1) v += __shfl_xor(v, o);
    return v;
}


#define LAS __attribute__((address_space(3)))
constexpr int NWAVES = 8, NTHREADS = 512;
constexpr int LDS_BYTES = 147456;
constexpr int LDS_PLAN_OFF = 140 * 1024;

struct Params {
    const float *x, *norm1, *w_in, *relb, *conv_w, *g_oa, *g_oc, *w_out, *norm2, *w_rg, *b_rg, *w_re, *b_re, *w_gate, *w_up, *w_down, *norm_f;
    float* out; char* ws; int never; int pad;
};
struct Ctx { int tid, lane, wave, gw, ngw; };

__device__ __forceinline__ void p0_titem(const float* __restrict__ W, int N, const float* __restrict__ g, bf16_t* __restrict__ WT, int ldd, int k0, int n0, int drow0, LAS float* scr, int lane, float cs = 1.f) {
    const int kq = lane >> 4, n4 = (lane & 15) * 4;
    float4 v[16]; float gs[16];
#pragma unroll
    for (int i = 0; i < 16; ++i) v[i] = *(const float4*)(W + (size_t)(k0 + 4 * i + kq) * N + n0 + n4);
#pragma unroll
    for (int i = 0; i < 16; ++i) gs[i] = (g ? g[k0 + 4 * i + kq] : 1.f) * cs;
#pragma unroll
    for (int i = 0; i < 16; ++i) { LAS float* d = scr + (4 * i + kq) * 65 + n4; d[0] = v[i].x * gs[i]; d[1] = v[i].y * gs[i]; d[2] = v[i].z * gs[i]; d[3] = v[i].w * gs[i]; }
    asm volatile("s_waitcnt lgkmcnt(0)" ::: "memory");
    const int c = lane & 7;
#pragma unroll
    for (int j = 0; j < 8; ++j) { const int n = (lane >> 3) + 8 * j; const LAS float* sp = scr + (8 * c) * 65 + n;
        uint4 o; o.x = cvtpk2(sp[0 * 65], sp[1 * 65]); o.y = cvtpk2(sp[2 * 65], sp[3 * 65]); o.z = cvtpk2(sp[4 * 65], sp[5 * 65]); o.w = cvtpk2(sp[6 * 65], sp[7 * 65]);
        *(uint4*)(WT + (size_t)(drow0 + n) * ldd + k0 + 8 * c) = o; }
    asm volatile("s_waitcnt lgkmcnt(0)" ::: "memory");
}

__device__ __forceinline__ void router_block(const bf16_t* __restrict__ xb1, const bf16_t* __restrict__ Wrh,
                                             const float* __restrict__ brg, const float* __restrict__ bre, int* __restrict__ cnt, int* __restrict__ list, float* __restrict__ wts, float* __restrict__ r2out,
                                             int tb, int wave, int lane, LAS float* lds_f, bool commit) {
    const int fr = lane & 15, fq = lane >> 4;
    const bf16_t* xr = xb1 + (size_t)(tb * 64 + fr) * DM + wave * 256 + 8 * fq;
    const bf16_t* wh = Wrh + (size_t)fr * DM + wave * 256 + 8 * fq;
    f32x4 accr[4][3], gram[4];
#pragma unroll
    for (int g = 0; g < 4; ++g) { gram[g] = (f32x4){0.f, 0.f, 0.f, 0.f};
#pragma unroll
        for (int nb = 0; nb < 3; ++nb) accr[g][nb] = (f32x4){0.f, 0.f, 0.f, 0.f}; }
#pragma unroll 1
    for (int h = 0; h < 2; ++h) {
        bf16x8 xv[4][4], wv[4][3];
#pragma unroll
        for (int ks = 0; ks < 4; ++ks) {
#pragma unroll
            for (int g = 0; g < 4; ++g) xv[ks][g] = *(const bf16x8*)(xr + (size_t)g * 16 * DM + (4 * h + ks) * 32);
#pragma unroll
            for (int nb = 0; nb < 3; ++nb) wv[ks][nb] = *(const bf16x8*)(wh + (size_t)nb * 16 * DM + (4 * h + ks) * 32); }
#pragma unroll
        for (int ks = 0; ks < 4; ++ks)
#pragma unroll
            for (int g = 0; g < 4; ++g) { gram[g] = __builtin_amdgcn_mfma_f32_16x16x32_bf16(xv[ks][g], xv[ks][g], gram[g], 0, 0, 0);
#pragma unroll
                for (int nb = 0; nb < 3; ++nb) accr[g][nb] = __builtin_amdgcn_mfma_f32_16x16x32_bf16(wv[ks][nb], xv[ks][g], accr[g][nb], 0, 0, 0); }
    }
    LAS float* part8 = lds_f;
    LAS float* sc = lds_f + 32 * 64 * 13 + (wave & 3) * (16 * 49);
    LAS int* ent = (LAS int*)(lds_f + 32 * 64 * 13 + 4 * 16 * 49);
#pragma unroll
    for (int g = 0; g < 4; ++g) { LAS float* pp = part8 + ((wave * 4 + g) * 64 + lane) * 13;
#pragma unroll
        for (int nb = 0; nb < 3; ++nb)
#pragma unroll
            for (int q = 0; q < 4; ++q) pp[nb * 4 + q] = accr[g][nb][q];
        const int qd = fr & 3; const float d = qd == 0 ? gram[g][0] : qd == 1 ? gram[g][1] : qd == 2 ? gram[g][2] : gram[g][3];
        pp[12] = (fq == (fr >> 2)) ? d : 0.f; }
    __syncthreads();
    const int tg = wave, t0 = tb * 64 + tg * 16;
    if (wave < 4) {
        f32x4 acc[3]; float ss = 0.f;
#pragma unroll
        for (int nb = 0; nb < 3; ++nb) acc[nb] = (f32x4){0.f, 0.f, 0.f, 0.f};
#pragma unroll
        for (int w = 0; w < 8; ++w) { LAS const float* pp = part8 + ((w * 4 + tg) * 64 + lane) * 13;
#pragma unroll
            for (int nb = 0; nb < 3; ++nb)
#pragma unroll
                for (int q = 0; q < 4; ++q) acc[nb][q] += pp[nb * 4 + q];
            ss += pp[12]; }
        ss += __shfl_xor(ss, 16); ss += __shfl_xor(ss, 32);
        const float r2 = rsqrtf(ss * (1.f / DM) + EPS);
#pragma unroll
        for (int nb = 0; nb < 3; ++nb)
#pragma unroll
            for (int q = 0; q < 4; ++q) sc[fr * 49 + 16 * nb + 4 * fq + q] = acc[nb][q] * r2;
        asm volatile("s_waitcnt lgkmcnt(0)" ::: "memory");
        if (lane < 16) {
            const int t = t0 + lane; LAS const float* lr = sc + lane * 49;
            float lg[4];
#pragma unroll
            for (int g = 0; g < 4; ++g) lg[g] = lr[g] + brg[g];
            int gs = 0; float gm = lg[0];
#pragma unroll
            for (int g = 1; g < 4; ++g) if (lg[g] > gm) { gm = lg[g]; gs = g; }
            float den = 0.f;
#pragma unroll
            for (int g = 0; g < 4; ++g) den += __expf(lg[g] - gm);
            const float pg = 1.f / den;
            float el[8];
#pragma unroll
            for (int i = 0; i < 8; ++i) el[i] = lr[4 + 8 * gs + i] + bre[8 * gs + i];
            int i1 = 0; float v1 = el[0];
#pragma unroll
            for (int i = 1; i < 8; ++i) if (el[i] > v1) { v1 = el[i]; i1 = i; }
            int i2 = -1; float v2 = -3.0e38f;
#pragma unroll
            for (int i = 0; i < 8; ++i) if (i != i1 && el[i] > v2) { v2 = el[i]; i2 = i; }
            const float e2 = __expf(v2 - v1), w0 = pg / (1.f + e2), w1 = pg * e2 / (1.f + e2);
            ent[2 * (tg * 16 + lane)] = gs * 8 + i1; ent[2 * (tg * 16 + lane) + 1] = gs * 8 + i2;
            if (commit) { r2out[t] = r2; wts[2 * t] = w0; wts[2 * t + 1] = w1; }
        }
    }
    __syncthreads();
    if (wave == 0 && lane < NE && commit) {
        int n = 0;
        for (int i = 0; i < 128; ++i) n += (ent[i] == lane) ? 1 : 0;
        if (n) { int k = atomicAdd(&cnt[lane * 64], n);
            for (int i = 0; i < 128; ++i) if (ent[i] == lane) { list[lane * T + k] = 2 * (tb * 64) + i; ++k; } }
    }
    __syncthreads();
}
struct FinalRow { uint4 xv[4]; uint2 pv[4], qv[4]; };
__device__ __forceinline__ void final_load(FinalRow& f, const bf16_t* __restrict__ xb1, const bf16_t* __restrict__ Yb, int t, int lane) {
    const unsigned char* Y = (const unsigned char*)Yb;
    const uint4* x1 = (const uint4*)(xb1 + (size_t)t * DM); const uint2* y0 = (const uint2*)(Y + (size_t)(2 * t) * DM); const uint2* y1 = (const uint2*)(Y + (size_t)(2 * t + 1) * DM);
#pragma unroll
    for (int j = 0; j < 4; ++j) { f.xv[j] = x1[j * 64 + lane]; f.pv[j] = y0[j * 64 + lane]; f.qv[j] = y1[j * 64 + lane]; }
}
__device__ __forceinline__ void final_store(const FinalRow& f, float* __restrict__ out, const float* __restrict__ g, int t, int lane, float delta = 0.f) {
    float4* xw = (float4*)(out + (size_t)t * DM);
    float v[4][8]; float ss = 0.f;
    typedef float f2_t __attribute__((ext_vector_type(2)));
#pragma unroll
    for (int j = 0; j < 4; ++j) { const unsigned xa[4] = {f.xv[j].x, f.xv[j].y, f.xv[j].z, f.xv[j].w};
        const f2_t p01 = __builtin_amdgcn_cvt_pk_f32_fp8((int)f.pv[j].x, false), p23 = __builtin_amdgcn_cvt_pk_f32_fp8((int)f.pv[j].x, true), p45 = __builtin_amdgcn_cvt_pk_f32_fp8((int)f.pv[j].y, false), p67 = __builtin_amdgcn_cvt_pk_f32_fp8((int)f.pv[j].y, true);
        const f2_t q01 = __builtin_amdgcn_cvt_pk_f32_fp8((int)f.qv[j].x, false), q23 = __builtin_amdgcn_cvt_pk_f32_fp8((int)f.qv[j].x, true), q45 = __builtin_amdgcn_cvt_pk_f32_fp8((int)f.qv[j].y, false), q67 = __builtin_amdgcn_cvt_pk_f32_fp8((int)f.qv[j].y, true);
        const float ys[8] = {p01[0] + q01[0], p01[1] + q01[1], p23[0] + q23[0], p23[1] + q23[1], p45[0] + q45[0], p45[1] + q45[1], p67[0] + q67[0], p67[1] + q67[1]};
#pragma unroll
        for (int q = 0; q < 4; ++q) { const float lo = bf2f(xa[q] & 0xffffu) + ys[2 * q] * (1.f / YSCALE8), hi = bf2f(xa[q] >> 16) + ys[2 * q + 1] * (1.f / YSCALE8);
            v[j][2 * q] = lo; v[j][2 * q + 1] = hi; ss += lo * lo + hi * hi; } }
    const float r = rsqrtf(wave_sum(ss) * (1.f / DM) + EPS);
#pragma unroll
    for (int j = 0; j < 4; ++j) { const float4 g0 = ((const float4*)g)[(j * 64 + lane) * 2], g1 = ((const float4*)g)[(j * 64 + lane) * 2 + 1];
        float4 a, b; a.x = v[j][0] * r * g0.x + delta; a.y = v[j][1] * r * g0.y - delta; a.z = v[j][2] * r * g0.z + delta; a.w = v[j][3] * r * g0.w - delta;
        b.x = v[j][4] * r * g1.x + delta; b.y = v[j][5] * r * g1.y - delta; b.z = v[j][6] * r * g1.z + delta; b.w = v[j][7] * r * g1.w - delta;
        xw[(j * 64 + lane) * 2] = a; xw[(j * 64 + lane) * 2 + 1] = b; }
}

constexpr int WC_ITEMS = 3 * NE * 512;
struct WConv {
    unsigned char* dst; int ldd; float sc; bool pending;
    __device__ __forceinline__ void issue(int id, const float* __restrict__ w_gate, const float* __restrict__ w_up, const float* __restrict__ w_down, bf16_t* Wgut, bf16_t* Wdt, unsigned scr32, int lane) {
        const int kq = lane >> 3;
        const float* src; int N, k0, n0;
        if (id < 2 * NE * 512) { const int up = id >= NE * 512, r = id & (NE * 512 - 1), e = r >> 9, q = r & 511; k0 = (q >> 4) * 64; n0 = (q & 15) * 32; N = DEXP; sc = WSCALE8;
            src = (up ? w_up : w_gate) + (size_t)e * DM * DEXP; dst = (unsigned char*)Wgut + (size_t)e * 2 * DEXP * DM + (size_t)gu_row(n0, up) * DM + k0; ldd = DM; }
        else { const int r = id - 2 * NE * 512, e = r >> 9, q = r & 511; k0 = (q >> 6) * 64; n0 = (q & 63) * 32; N = DM; sc = WDSCALE8;
            src = w_down + (size_t)e * DEXP * DM; dst = (unsigned char*)Wdt + (size_t)e * DM * DEXP + (size_t)n0 * DEXP + k0; ldd = DEXP; }
#pragma unroll
        for (int i = 0; i < 8; ++i) { const float* g = src + (size_t)(k0 + 8 * i + kq) * N + n0 + 4 * ((lane & 7) ^ i); unsigned keep_;
            asm volatile("s_mov_b32 %0, m0\n\ts_mov_b32 m0, %2\n\ts_nop 0\n\tglobal_load_lds_dwordx4 %1, off\n\ts_mov_b32 m0, %0" : "=&s"(keep_) : "v"(g), "s"((unsigned)__builtin_amdgcn_readfirstlane((int)(scr32 + i * 1024))) : "memory"); }
        pending = true;
    }
    __device__ __forceinline__ void finish(LAS float* scr, int lane) {
        const int c = lane & 7;
#pragma unroll
        for (int j = 0; j < 4; ++j) { const int n = (lane >> 3) + 8 * j; const LAS float* sp = scr + (8 * c) * 32 + 4 * ((n >> 2) ^ c) + (n & 3);
            float v[8];
#pragma unroll
            for (int q = 0; q < 8; ++q) v[q] = sp[q * 32] * sc;
            int w0 = __builtin_amdgcn_cvt_pk_fp8_f32(v[0], v[1], 0, false); w0 = __builtin_amdgcn_cvt_pk_fp8_f32(v[2], v[3], w0, true);
            int w1 = __builtin_amdgcn_cvt_pk_fp8_f32(v[4], v[5], 0, false); w1 = __builtin_amdgcn_cvt_pk_fp8_f32(v[6], v[7], w1, true);
            *(uint2*)(dst + (size_t)n * ldd + 8 * c) = make_uint2((unsigned)w0, (unsigned)w1); }
        asm volatile("s_waitcnt lgkmcnt(0)" ::: "memory");
        pending = false;
    }
};

namespace att {
typedef float f32x16 __attribute__((ext_vector_type(16)));
typedef short s16x4 __attribute__((ext_vector_type(4)));
typedef short v4i16_t __attribute__((ext_vector_type(4)));
constexpr int SLOT = 16384, L_K = 0, L_V = 2 * SLOT, L_TB = 4 * SLOT, NTB = 576;
constexpr float THR = 8.f;
__device__ __forceinline__ float rowmax32(const f32x16& p0, const f32x16& p1) {
    float a = fmaxf(p0[0], p1[0]);
#pragma unroll
    for (int r = 1; r < 16; ++r) a = fmaxf(fmaxf(a, p0[r]), p1[r]);
    auto rr = __builtin_amdgcn_permlane32_swap(__float_as_uint(a), __float_as_uint(a), false, false);
    return fmaxf(__uint_as_float(rr[0]), __uint_as_float(rr[1]));
}
__device__ __forceinline__ unsigned cvtpk(float lo, float hi) { typedef float f2 __attribute__((ext_vector_type(2))); typedef __bf16 b2 __attribute__((ext_vector_type(2))); f2 v = {lo, hi}; b2 b = __builtin_convertvector(v, b2); return __builtin_bit_cast(unsigned, b); }
__device__ __forceinline__ s16x4 vtr(LAS const unsigned char* p) { return __builtin_bit_cast(s16x4, __builtin_amdgcn_ds_read_tr16_b64_v4i16((LAS v4i16_t*)p)); }

template <class Side> __device__ __forceinline__ void attn_unit(LAS unsigned char* lds, const bf16_t* __restrict__ proj, const float* __restrict__ relb, bf16_t* __restrict__ mix, float* __restrict__ ssA, int b, int h, int cg, Side& side, bool fill_table) {
    const int tid = threadIdx.x, lane = tid & 63, r32 = lane & 31, hi = lane >> 5, w = __builtin_amdgcn_readfirstlane(tid >> 6);
    const int c0 = cg * 4, cq = c0 + (w >> 1), qi = 32 * (w & 1) + r32;
    const int j0 = c0 - 8 < 0 ? 0 : c0 - 8, j1 = c0 + 3;
    const unsigned lds32 = (unsigned)(__UINTPTR_TYPE__)lds;
    LAS float* tb = (LAS float*)(lds + L_TB);
    if (fill_table) for (int i = tid; i < NTB; i += NTHREADS) tb[i] = relb[h * NREL + (i > 512 ? 512 : i)] * LOG2E;
    const size_t tq = (size_t)b * SEQ + (size_t)c0 * 64 + 32 * w + r32;
    bf16x8 qr[4];
#pragma unroll
    for (int d0 = 0; d0 < 4; ++d0) qr[d0] = *(const bf16x8*)(proj + tq * NPROJ + h * HD + d0 * 16 + hi * 8);
    const int krow = 8 * w + (lane >> 3);
    const bf16_t* ksrc = proj + ((size_t)b * SEQ + krow) * NPROJ + DATT + h * HD + (((lane & 7) ^ ((krow >> 1) & 7)) * 8);
    const bf16_t* vsrc = proj + ((size_t)b * SEQ + 16 * (w & 3) + (lane >> 2)) * NPROJ + 2 * DATT + h * HD + (w >> 2) * 32 + (lane & 3) * 8;
#define ATT_GLDS(gsrc, ldsdst) do { unsigned keep_; asm volatile("s_mov_b32 %0, m0\n\ts_mov_b32 m0, %2\n\ts_nop 0\n\tglobal_load_lds_dwordx4 %1, off\n\ts_mov_b32 m0, %0" : "=&s"(keep_) : "v"(gsrc), "s"((unsigned)__builtin_amdgcn_readfirstlane((int)(ldsdst))) : "memory"); } while (0)
#define ATT_DMA1(j, off) do { ATT_GLDS(ksrc + (size_t)(j) * 64 * NPROJ, lds32 + L_K + (off) + w * 1024); ATT_GLDS(vsrc + (size_t)(j) * 64 * NPROJ, lds32 + L_V + (off) + w * 1024); } while (0)
#define ATT_DMA(j, slot) do { ATT_DMA1(j, (slot) * SLOT); ATT_DMA1((j) + 1, (slot) * SLOT + 8192); } while (0)
    int ka[4];
#pragma unroll
    for (int d0 = 0; d0 < 4; ++d0) ka[d0] = r32 * 128 + (((2 * d0 + hi) ^ ((r32 >> 1) & 7)) * 16);
    const int va = ((lane >> 4) & 1) * 32 + (lane & 3) * 8 + (4 * hi + ((lane & 15) >> 2)) * 64;
    float m = -1e30f, l = 0.f; f32x16 o[2];
#pragma unroll
    for (int r = 0; r < 16; ++r) { o[0][r] = 0.f; o[1][r] = 0.f; }
    ATT_DMA(j0, 0);
    for (int js = j0; js <= j1; js += 2) {
        const int slot = ((js - j0) >> 1) & 1;
        unsigned long long tb0_ = 0; if (TSPROBE == 34 || TSPROBE == 35) tb0_ = __builtin_amdgcn_s_memrealtime();
        if (TSPROBE == 35) { asm volatile("s_waitcnt vmcnt(0) lgkmcnt(0)" ::: "memory"); side.twait += __builtin_amdgcn_s_memrealtime() - tb0_; }
        asm volatile("s_waitcnt vmcnt(0) lgkmcnt(0)\n\ts_barrier" ::: "memory");
        if (TSPROBE == 34) side.twait += __builtin_amdgcn_s_memrealtime() - tb0_;
        side.step();
        if (js + 2 <= j1) ATT_DMA(js + 2, slot ^ 1);
#pragma unroll
        for (int half = 0; half < 2; ++half) {
        const int j = js + half, dl = cq - j;
        if (dl >= 0 && dl <= 8) {
            LAS const unsigned char* Ks = lds + L_K + slot * SLOT + half * 8192; LAS const unsigned char* Vs = lds + L_V + slot * SLOT + half * 8192 + va;
            f32x16 p0, p1;
            if (dl <= 4) { LAS const float* tp = tb + (64 * dl + qi + 256 - 4 * hi - 59);
#pragma unroll
                for (int r = 0; r < 16; ++r) { p0[r] = tp[59 - ((r & 3) + 8 * (r >> 2))]; p1[r] = tp[27 - ((r & 3) + 8 * (r >> 2))]; } }
            else { const float bf = tb[NTB - 1];
#pragma unroll
                for (int r = 0; r < 16; ++r) { p0[r] = bf; p1[r] = bf; } }
            { bf16x8 kf[8];
#pragma unroll
              for (int d0 = 0; d0 < 4; ++d0) { kf[2 * d0] = *(LAS const bf16x8*)(Ks + ka[d0]); kf[2 * d0 + 1] = *(LAS const bf16x8*)(Ks + ka[d0] + 4096); }
              __builtin_amdgcn_sched_barrier(0);
#pragma unroll
              for (int d0 = 0; d0 < 4; ++d0) { p0 = __builtin_amdgcn_mfma_f32_32x32x16_bf16(kf[2 * d0], qr[d0], p0, 0, 0, 0); p1 = __builtin_amdgcn_mfma_f32_32x32x16_bf16(kf[2 * d0 + 1], qr[d0], p1, 0, 0, 0); } }
            const float mx = rowmax32(p0, p1);
            if (__any(mx > m + THR)) { const float mn = fmaxf(m, mx), al = __builtin_amdgcn_exp2f(m - mn); m = mn; l *= al;
#pragma unroll
                for (int r = 0; r < 16; ++r) { o[0][r] *= al; o[1][r] *= al; } }
            float rs = 0.f;
#pragma unroll
            for (int r = 0; r < 16; ++r) { p0[r] = __builtin_amdgcn_exp2f(p0[r] - m); p1[r] = __builtin_amdgcn_exp2f(p1[r] - m); rs += p0[r] + p1[r]; }
            l += rs;
            bf16x8 pw[4];
#pragma unroll
            for (int ks = 0; ks < 4; ++ks) { const f32x16& P = ks < 2 ? p0 : p1; const int bo = (ks & 1) * 8; typedef unsigned u4 __attribute__((ext_vector_type(4)));
                u4 t4 = {cvtpk(P[bo], P[bo + 1]), cvtpk(P[bo + 2], P[bo + 3]), cvtpk(P[bo + 4], P[bo + 5]), cvtpk(P[bo + 6], P[bo + 7])}; pw[ks] = __builtin_bit_cast(bf16x8, t4); }
            { s16x4 vl[8], vh[8];
#pragma unroll
              for (int i = 0; i < 8; ++i) { vl[i] = vtr(Vs + (i >> 2) * 4096 + (i & 3) * 1024); vh[i] = vtr(Vs + (i >> 2) * 4096 + (i & 3) * 1024 + 512); }
              __builtin_amdgcn_sched_barrier(0);
#pragma unroll
              for (int i = 0; i < 8; ++i) { const bf16x8 vf = {vl[i][0], vl[i][1], vl[i][2], vl[i][3], vh[i][0], vh[i][1], vh[i][2], vh[i][3]};
                  o[i >> 2] = __builtin_amdgcn_mfma_f32_32x32x16_bf16(vf, pw[i & 3], o[i >> 2], 0, 0, 0); } }
        }
        }
    }
    { auto rr = __builtin_amdgcn_permlane32_swap(__float_as_uint(l), __float_as_uint(l), false, false); l = __uint_as_float(rr[0]) + __uint_as_float(rr[1]); }
    const float il = 1.f / l; float ss = 0.f;
    bf16_t* op = mix + tq * DM + h * HD + 4 * hi;
#pragma unroll
    for (int d0 = 0; d0 < 2; ++d0)
#pragma unroll
        for (int g = 0; g < 4; ++g) { const float v0 = o[d0][4 * g] * il, v1 = o[d0][4 * g + 1] * il, v2 = o[d0][4 * g + 2] * il, v3 = o[d0][4 * g + 3] * il;
            ss += v0 * v0 + v1 * v1 + v2 * v2 + v3 * v3; *(uint2*)(op + 32 * d0 + 8 * g) = make_uint2(cvtpk(v0, v1), cvtpk(v2, v3)); }
    { auto rr = __builtin_amdgcn_permlane32_swap(__float_as_uint(ss), __float_as_uint(ss), false, false); ss = __uint_as_float(rr[0]) + __uint_as_float(rr[1]); }
    if (hi == 0) ssA[tq * 16 + h] = ss;
    asm volatile("s_waitcnt vmcnt(0) lgkmcnt(0)\n\ts_barrier" ::: "memory");
#undef ATT_DMA
#undef ATT_DMA1
#undef ATT_GLDS
}
}

__device__ __forceinline__ void conv_slab(const bf16_t* __restrict__ proj, const float* __restrict__ cw, bf16_t* __restrict__ mix, float* __restrict__ ssC2, int item, int lane) {
    const int slab = item & 1, t0 = (item >> 1) * 16, ch = slab * 512 + lane * 8;
    float w0[8], w1[8], w2[8];
#pragma unroll
    for (int q = 0; q < 2; ++q) { const float4 a = *(const float4*)(cw + ch + 4 * q), b = *(const float4*)(cw + DCONV + ch + 4 * q), c = *(const float4*)(cw + 2 * DCONV + ch + 4 * q);
        w0[4 * q] = a.x; w0[4 * q + 1] = a.y; w0[4 * q + 2] = a.z; w0[4 * q + 3] = a.w; w1[4 * q] = b.x; w1[4 * q + 1] = b.y; w1[4 * q + 2] = b.z; w1[4 * q + 3] = b.w;
        w2[4 * q] = c.x; w2[4 * q + 1] = c.y; w2[4 * q + 2] = c.z; w2[4 * q + 3] = c.w; }
    float z1[8], z2[8];
#pragma unroll
    for (int q = 0; q < 8; ++q) { z1[q] = 0.f; z2[q] = 0.f; }
    if ((t0 & (SEQ - 1)) != 0) {
        const bf16_t* p2 = proj + (size_t)(t0 - 2) * NPROJ; const bf16_t* p1 = proj + (size_t)(t0 - 1) * NPROJ;
        const uint4 c2 = *(const uint4*)(p2 + 4 * DATT + ch), u2 = *(const uint4*)(p2 + 5 * DATT + ch), c1 = *(const uint4*)(p1 + 4 * DATT + ch), u1 = *(const uint4*)(p1 + 5 * DATT + ch);
        const unsigned c2w[4] = {c2.x, c2.y, c2.z, c2.w}, u2w[4] = {u2.x, u2.y, u2.z, u2.w}, c1w[4] = {c1.x, c1.y, c1.z, c1.w}, u1w[4] = {u1.x, u1.y, u1.z, u1.w};
#pragma unroll
        for (int q = 0; q < 4; ++q) { z2[2 * q] = bf2f(c2w[q] & 0xffffu) * bf2f(u2w[q] & 0xffffu); z2[2 * q + 1] = bf2f(c2w[q] >> 16) * bf2f(u2w[q] >> 16);
            z1[2 * q] = bf2f(c1w[q] & 0xffffu) * bf2f(u1w[q] & 0xffffu); z1[2 * q + 1] = bf2f(c1w[q] >> 16) * bf2f(u1w[q] >> 16); }
    }
#pragma unroll 1
    for (int i0 = 0; i0 < 16; i0 += 8) {
    uint4 bv[8], cv[8], uv[8];
#pragma unroll
    for (int i = 0; i < 8; ++i) { const bf16_t* pr = proj + (size_t)(t0 + i0 + i) * NPROJ; bv[i] = *(const uint4*)(pr + 3 * DATT + ch); cv[i] = *(const uint4*)(pr + 4 * DATT + ch); uv[i] = *(const uint4*)(pr + 5 * DATT + ch); }
#pragma unroll
    for (int i = 0; i < 8; ++i) { const int t = t0 + i0 + i;
        const unsigned bw[4] = {bv[i].x, bv[i].y, bv[i].z, bv[i].w}, cw4[4] = {cv[i].x, cv[i].y, cv[i].z, cv[i].w}, uw[4] = {uv[i].x, uv[i].y, uv[i].z, uv[i].w};
        float y[8]; float ss = 0.f;
#pragma unroll
        for (int q = 0; q < 4; ++q) {
            const float za = bf2f(cw4[q] & 0xffffu) * bf2f(uw[q] & 0xffffu), zb = bf2f(cw4[q] >> 16) * bf2f(uw[q] >> 16);
            y[2 * q] = bf2f(bw[q] & 0xffffu) * (w0[2 * q] * z2[2 * q] + w1[2 * q] * z1[2 * q] + w2[2 * q] * za);
            y[2 * q + 1] = bf2f(bw[q] >> 16) * (w0[2 * q + 1] * z2[2 * q + 1] + w1[2 * q + 1] * z1[2 * q + 1] + w2[2 * q + 1] * zb);
            ss += y[2 * q] * y[2 * q] + y[2 * q + 1] * y[2 * q + 1];
            z2[2 * q] = z1[2 * q]; z1[2 * q] = za; z2[2 * q + 1] = z1[2 * q + 1]; z1[2 * q + 1] = zb; }
        *(uint4*)(mix + (size_t)t * DM + DATT + ch) = make_uint4(cvtpk2(y[0], y[1]), cvtpk2(y[2], y[3]), cvtpk2(y[4], y[5]), cvtpk2(y[6], y[7]));
        ss = wave_sum(ss);
        if (lane == 0) ssC2[t * 4 + slab] = ss; }
    }
}

namespace g8 {
typedef unsigned u32x4 __attribute__((ext_vector_type(4)));
typedef int v4i_t __attribute__((ext_vector_type(4)));
typedef int v8i_t __attribute__((ext_vector_type(8)));
constexpr int BM = 256, BK = 64, HALF = 128, HTB = HALF * BK * 2, STAGE_BYTES = 8 * HTB, NXCD = 8, WGM = 8;
__device__ __forceinline__ int lds_byte(int r, int c) { const int st = (r >> 4) * 2 + (c >> 5), rr = r & 15, cc = c & 31, ob = rr * 64 + cc * 2; return st * 1024 + (ob ^ (((ob >> 9) & 1) << 5)); }
__device__ __forceinline__ void stage_rc(int b, int& R, int& C) { const int st = b / 1024, sb = b % 1024, swz = sb ^ (((sb >> 9) & 1) << 5); R = (st >> 1) * 16 + swz / 64; C = (st & 1) * 32 + (swz % 64) / 2; }
__device__ __forceinline__ int perm32(int rho) { const int n = rho >> 4, i = rho & 15; return 8 * (i >> 2) + 4 * n + (i & 3); }
__device__ __forceinline__ unsigned cvt_pk_bf16(float lo, float hi) { unsigned r; asm volatile("v_cvt_pk_bf16_f32 %0, %1, %2" : "=v"(r) : "v"(lo), "v"(hi)); return r; }
__device__ __forceinline__ int xcd_remap(int wgid, int nwg) { const int q = nwg / NXCD, r = nwg % NXCD, xcd = wgid % NXCD, off = wgid / NXCD; return (xcd < r ? xcd * (q + 1) : r * (q + 1) + (xcd - r) * q) + off; }

struct Unit { int pm, pn, e, slot; const char* a; const char* b; };

struct DenseOrder {
    const char* A; const char* Bt; int K, nM, nN, nwg, G, c, mul = 1;
    __device__ __forceinline__ void init(const void* A_, const void* Bt_, int M, int N, int K_, int G_, int c_) { A = (const char*)A_; Bt = (const char*)Bt_; K = K_; nM = M / BM; nN = N / BM; nwg = nM * nN; G = G_; c = c_; }
    __device__ __forceinline__ bool next(int i, Unit& u) const {
        int L = i * G + c; if (L >= nwg * mul) return false; L %= nwg;
        const int wgid = xcd_remap(L, nwg);
        const int nig = WGM * nN, gid = wgid / nig, fm = gid * WGM, gsz = (nM - fm) < WGM ? (nM - fm) : WGM;
        u.pm = fm + ((wgid % nig) % gsz); u.pn = (wgid % nig) / gsz; u.e = i; u.slot = i % 3;
        u.a = A + (size_t)u.pm * BM * K * 2; u.b = Bt + (size_t)u.pn * BM * K * 2; return true;
    }
    __device__ __forceinline__ unsigned arow_off(const Unit&, int r, int Kb) const { return (unsigned)r * (unsigned)Kb; }
    const float* rowscale = nullptr; LAS float* rtab = nullptr;
    __device__ __forceinline__ void prefetch(const Unit& u) const { const int r = threadIdx.x; if (r < BM) rtab[u.slot * BM + r] = rowscale[u.pm * BM + r]; }
    __device__ __forceinline__ float scale_of(const Unit& u, int r) const { return rtab[u.slot * BM + r]; }
};
template <bool GATHER> struct MoeOrder {
    const char* A; const char* Bt; const int* list; LAS const int* pl; int K  , NPN, nwg, G, c; size_t estride; int mul;
    LAS int* rinfo; const float* rscale;
    __device__ __forceinline__ bool next(int i, Unit& u) const {
        int L = i * G + c; if (L >= nwg * mul) return false; L %= nwg;
        const int wgid = xcd_remap(L, nwg);
        u.pm = wgid / NPN; u.pn = wgid % NPN; u.e = pl[64 + u.pm]; u.slot = i % 3;
        u.a = GATHER ? A : A + (size_t)u.pm * BM * K; u.b = Bt + (size_t)u.e * estride + (size_t)u.pn * BM * K; return true;
    }
    __device__ __forceinline__ void prefetch(const Unit& u) const {
        const int r = threadIdx.x;
        if (r < BM) { const int slot = u.pm * BM + r - pl[32 + u.e]; int pr = -1; float sc = 0.f;
            if (slot < pl[u.e]) { pr = list[u.e * T + slot]; sc = rscale[GATHER ? (pr >> 1) : pr]; }
            rinfo[(u.slot * BM + r) * 2] = pr; rinfo[(u.slot * BM + r) * 2 + 1] = __float_as_int(sc); }
    }
    __device__ __forceinline__ int pair_of(const Unit& u, int r) const { return rinfo[(u.slot * BM + r) * 2]; }
    __device__ __forceinline__ float scale_of(const Unit& u, int r) const { return __int_as_float(rinfo[(u.slot * BM + r) * 2 + 1]); }
    __device__ __forceinline__ unsigned arow_off(const Unit& u, int r, int Kb) const {
        if (GATHER) { const int pr = pair_of(u, r); return (unsigned)(pr >= 0 ? (pr >> 1) : 0) * (unsigned)Kb; }
        return (unsigned)r * (unsigned)Kb;
    }
};

template <bool GATHER, int ES, class Epi, class Sched>
__device__ __forceinline__ void gemm_phase(LAS unsigned char* lds, const int K, const Sched& S, const Epi& E) {
    int tid_ = threadIdx.x; asm volatile("" : "+v"(tid_));
    const int tid = tid_, wid = __builtin_amdgcn_readfirstlane(tid >> 6), lane = tid & 63, wr = wid >> 2, wc = wid & 3, fr = lane & 15, fq = lane >> 4;
    const int Kb = K * ES, nt = Kb / (BK * 2);
    unsigned voffB[2];
#pragma unroll
    for (int i = 0; i < 2; ++i) { int R, C; stage_rc(tid * 16 + i * 8192, R, C); const int Rb = Epi::PERM ? ((R & ~31) + perm32(R & 31)) : R; voffB[i] = (unsigned)(Rb * Kb + C * 2); }
#define G8_AOFF(u, h, i) ([&]() { int R_, C_; stage_rc(tid * 16 + (i) * 8192, R_, C_); return S.arow_off(u, (h) * HALF + R_, Kb) + (unsigned)(C_ * 2); }())
    const size_t kstep = (size_t)(BK * 2);
    const size_t hstep = (size_t)HALF * Kb;
    const unsigned ldsw = (unsigned)wid * 1024u;
    const int aoff = lds_byte(wr * 64 + fr, fq * 8), boff = lds_byte(wc * 32 + fr, fq * 8);
#define G8_SA(b, h) (((b) * 2 + (h)) * HTB)
#define G8_SB(b, h) ((4 + (b) * 2 + (h)) * HTB)
#define G8_STAGE(bufoff, gbase, voff) do { _Pragma("unroll") for (int _i = 0; _i < 2; ++_i) \
        __builtin_amdgcn_global_load_lds((const unsigned*)((const char*)(gbase) + (voff)[_i]), (LAS unsigned*)(lds + (bufoff) + ldsw + _i * 8192), 16, 0, 0); } while (0)
#define G8_LDA(dst, b, h) do { _Pragma("unroll") for (int m = 0; m < 4; ++m) { if (ES == 2) { _Pragma("unroll") for (int k = 0; k < 2; ++k) dst[m][k] = *(const LAS bf16x8*)(lds + G8_SA(b, h) + aoff + m * 2048 + k * 1024); } \
        else dst##8[m] = __builtin_shufflevector(*(const LAS v4i_t*)(lds + G8_SA(b, h) + aoff + m * 2048), *(const LAS v4i_t*)(lds + G8_SA(b, h) + aoff + m * 2048 + 1024), 0, 1, 2, 3, 4, 5, 6, 7); } } while (0)
#define G8_LDB(dst, b, h) do { _Pragma("unroll") for (int n = 0; n < 2; ++n) { if (ES == 2) { _Pragma("unroll") for (int k = 0; k < 2; ++k) dst[n][k] = *(const LAS bf16x8*)(lds + G8_SB(b, h) + boff + n * 2048 + k * 1024); } \
        else dst##8[n] = __builtin_shufflevector(*(const LAS v4i_t*)(lds + G8_SB(b, h) + boff + n * 2048), *(const LAS v4i_t*)(lds + G8_SB(b, h) + boff + n * 2048 + 1024), 0, 1, 2, 3, 4, 5, 6, 7); } } while (0)
#define G8_CAT(x, y) __builtin_shufflevector(__builtin_bit_cast(v4i_t, x), __builtin_bit_cast(v4i_t, y), 0, 1, 2, 3, 4, 5, 6, 7)
#define G8_MMA(ai, bj, At, Bt) do { __builtin_amdgcn_s_setprio(1); _Pragma("unroll") for (int m = 0; m < 4; ++m) _Pragma("unroll") for (int n = 0; n < 2; ++n) { \
        if (ES == 2) { _Pragma("unroll") for (int k = 0; k < 2; ++k) acc[ai][bj][m][n] = __builtin_amdgcn_mfma_f32_16x16x32_bf16(Bt[n][k], At[m][k], acc[ai][bj][m][n], 0, 0, 0); } \
        else asm volatile("v_mfma_scale_f32_16x16x128_f8f6f4 %0, %1, %2, %0, %3, %3 op_sel_hi:[0,0,0]" : "+v"(acc[ai][bj][m][n]) : "v"(Bt##8[n]), "v"(At##8[m]), "v"(scale1)); } \
        __builtin_amdgcn_s_setprio(0); } while (0)
#define G8_WAIT_V(n) asm volatile("s_waitcnt vmcnt(" #n ")" ::: "memory")
#define G8_WAIT_L(n) asm volatile("s_waitcnt lgkmcnt(" #n ")" ::: "memory")
#define G8_BAR __builtin_amdgcn_s_barrier()
#define G8_SCHED __builtin_amdgcn_sched_barrier(0)
    Unit cur, nxt; int ui = 0;
    if (!S.next(0, cur)) return;
    if (GATHER || Epi::ROWINFO) { S.prefetch(cur); __syncthreads(); }
    f32x4 acc[2][2][4][2];
#pragma unroll
    for (int a = 0; a < 2; ++a)
#pragma unroll
        for (int b = 0; b < 2; ++b)
#pragma unroll
            for (int m = 0; m < 4; ++m)
#pragma unroll
                for (int n = 0; n < 2; ++n) acc[a][b][m][n] = (f32x4){0.f, 0.f, 0.f, 0.f};
    bf16x8 At[4][2], B0[2][2], B1[2][2];
    v8i_t At8[4], B08[2], B18[2];
    const int scale1 = 0x7F7F7F7F;
    unsigned vA[2][2];
#pragma unroll
    for (int h = 0; h < 2; ++h)
#pragma unroll
        for (int i = 0; i < 2; ++i) vA[h][i] = G8_AOFF(cur, h, i);
    const char* cA = cur.a; const char* cB = cur.b;
    G8_STAGE(G8_SB(0, 0), cB, voffB); G8_STAGE(G8_SB(0, 1), cB + hstep, voffB); G8_STAGE(G8_SA(0, 0), cA, vA[0]); G8_STAGE(G8_SA(0, 1), cA, vA[1]);
    if (wr == 1) G8_BAR;
    G8_WAIT_V(2); G8_BAR;
    G8_STAGE(G8_SB(1, 0), cB + kstep, voffB); G8_STAGE(G8_SA(1, 0), cA + kstep, vA[0]); G8_STAGE(G8_SB(1, 1), cB + hstep + kstep, voffB);
    G8_WAIT_V(6); G8_BAR;
    for (;;) {
        const bool has_next = S.next(ui + 1, nxt);
        const char* nA = has_next ? nxt.a : cA; const char* nB = has_next ? nxt.b : cB;
        if ((GATHER || Epi::ROWINFO) && has_next) S.prefetch(nxt);
        for (int t = 0; t < nt; t += 2) {
            const bool last = (t == nt - 2);
            if (Epi::MID_T >= 0 && t == Epi::MID_T) E.mid(acc, cur, wr, wc, fr, fq);
            const char* a1 = cA + (size_t)(t + 1) * kstep;
            const char* a2 = last ? nA : cA + (size_t)(t + 2) * kstep; const char* b2 = last ? nB : cB + (size_t)(t + 2) * kstep;
            const char* a3 = a2 + kstep; const char* b3 = b2 + kstep;
            unsigned v2[2][2];
#pragma unroll
            for (int h = 0; h < 2; ++h)
#pragma unroll
                for (int i = 0; i < 2; ++i) v2[h][i] = (GATHER && last && has_next) ? G8_AOFF(nxt, h, i) : vA[h][i];
            G8_LDB(B0, 0, 0); G8_LDB(B1, 0, 1); G8_SCHED; G8_LDA(At, 0, 0); G8_STAGE(G8_SA(1, 1), a1, vA[1]);
            G8_WAIT_V(8); G8_WAIT_L(0); G8_BAR; G8_MMA(0, 0, At, B0); G8_MMA(0, 1, At, B1); G8_BAR; G8_SCHED;
            G8_LDA(At, 0, 1); G8_STAGE(G8_SB(0, 0), b2, voffB); G8_STAGE(G8_SB(0, 1), b2 + hstep, voffB); G8_STAGE(G8_SA(0, 0), a2, v2[0]);
            G8_WAIT_V(8); G8_WAIT_L(0); G8_BAR; G8_MMA(1, 0, At, B0); G8_MMA(1, 1, At, B1); G8_BAR; G8_SCHED;
            G8_LDB(B0, 1, 0); G8_LDB(B1, 1, 1); G8_SCHED; G8_LDA(At, 1, 0); G8_STAGE(G8_SA(0, 1), a2, v2[1]);
            G8_WAIT_V(8); G8_WAIT_L(0); G8_BAR; G8_MMA(0, 0, At, B0); G8_MMA(0, 1, At, B1); G8_BAR; G8_SCHED;
            G8_LDA(At, 1, 1); G8_STAGE(G8_SB(1, 0), b3, voffB); G8_STAGE(G8_SB(1, 1), b3 + hstep, voffB); G8_STAGE(G8_SA(1, 0), a3, v2[0]);
            G8_WAIT_V(8); G8_WAIT_L(0); G8_BAR; G8_MMA(1, 0, At, B0); G8_MMA(1, 1, At, B1); G8_BAR; G8_SCHED;
        }
        if (wr == 0) G8_BAR;
        E(acc, cur, wr, wc, fr, fq);
        if (!has_next) break;
#pragma unroll
        for (int a = 0; a < 2; ++a)
#pragma unroll
            for (int b = 0; b < 2; ++b)
#pragma unroll
                for (int m = 0; m < 4; ++m)
#pragma unroll
                    for (int n = 0; n < 2; ++n) acc[a][b][m][n] = (f32x4){0.f, 0.f, 0.f, 0.f};
        cur = nxt; cA = nA; cB = nB; ++ui;
#pragma unroll
        for (int h = 0; h < 2; ++h)
#pragma unroll
            for (int i = 0; i < 2; ++i) if (GATHER) vA[h][i] = G8_AOFF(cur, h, i);
        if (wr == 1) G8_BAR;
    }
    G8_WAIT_V(0);
    G8_BAR;
#undef G8_SA
#undef G8_SB
#undef G8_STAGE
#undef G8_LDA
#undef G8_LDB
#undef G8_MMA
#undef G8_AOFF
#undef G8_CAT
#undef G8_WAIT_V
#undef G8_WAIT_L
#undef G8_BAR
#undef G8_SCHED
}

template <class Sched> struct EpiProjF { static constexpr bool PERM = true, ROWINFO = true; static constexpr int MID_T = -1; bf16_t* out; const Sched* S;
    __device__ __forceinline__ void mid(f32x4 (&)[2][2][4][2], const Unit&, int, int, int, int) const {}
    __device__ __forceinline__ void operator()(const f32x4 (&acc)[2][2][4][2], const Unit& u, int wr, int wc, int fr, int fq) const {
        const int row0 = u.pm * BM + wr * 64 + fr, col0 = u.pn * BM + wc * 32 + 8 * fq;
#pragma unroll
        for (int ai = 0; ai < 2; ++ai)
#pragma unroll
            for (int m = 0; m < 4; ++m) { const int row = row0 + ai * HALF + m * 16; const float s = S->scale_of(u, ai * HALF + wr * 64 + m * 16 + fr); bf16_t* rowp = out + (size_t)row * NPROJ + col0;
#pragma unroll
                for (int bj = 0; bj < 2; ++bj) { const f32x4 v0 = acc[ai][bj][m][0] * s, v1 = acc[ai][bj][m][1] * s; u32x4 w; w.x = cvt_pk_bf16(v0[0], v0[1]); w.y = cvt_pk_bf16(v0[2], v0[3]); w.z = cvt_pk_bf16(v1[0], v1[1]); w.w = cvt_pk_bf16(v1[2], v1[3]);
                    *(u32x4*)(rowp + bj * HALF) = w; } }
    }
};
struct EpiG2F { static constexpr bool PERM = true, ROWINFO = false; static constexpr int MID_T = DATT / BK; bf16_t* out; LAS const float* tab;
    __device__ __forceinline__ void mid(f32x4 (&acc)[2][2][4][2], const Unit& u, int wr, int wc, int fr, int fq) const {
        LAS const float* tb = tab + (size_t)(u.e) * 512;
#pragma unroll
        for (int ai = 0; ai < 2; ++ai)
#pragma unroll
            for (int m = 0; m < 4; ++m) { const float s = tb[(ai * HALF + wr * 64 + m * 16 + fr) * 2];
#pragma unroll
                for (int bj = 0; bj < 2; ++bj)
#pragma unroll
                    for (int n = 0; n < 2; ++n) acc[ai][bj][m][n] *= s; }
    }
    __device__ __forceinline__ void operator()(const f32x4 (&acc)[2][2][4][2], const Unit& u, int wr, int wc, int fr, int fq) const {
        LAS const float* tb = tab + (size_t)(u.e) * 512;
        const int col0 = u.pn * BM + wc * 32 + 8 * fq;
#pragma unroll
        for (int ai = 0; ai < 2; ++ai)
#pragma unroll
            for (int m = 0; m < 4; ++m) { const int r = ai * HALF + wr * 64 + m * 16 + fr; const float s = tb[r * 2 + 1]; bf16_t* rowp = out + (size_t)(u.pm * BM + r) * DM + col0;
#pragma unroll
                for (int bj = 0; bj < 2; ++bj) { const f32x4 v0 = acc[ai][bj][m][0] * s, v1 = acc[ai][bj][m][1] * s; u32x4 w; w.x = cvt_pk_bf16(v0[0], v0[1]); w.y = cvt_pk_bf16(v0[2], v0[3]); w.z = cvt_pk_bf16(v1[0], v1[1]); w.w = cvt_pk_bf16(v1[2], v1[3]);
                    *(u32x4*)(rowp + bj * HALF) = w; } }
    }
};
struct EpiG2X { static constexpr bool PERM = true, ROWINFO = false; static constexpr int MID_T = DATT / BK; bf16_t* out; unsigned char* xf8; const float* g2; LAS const float* tab;
    __device__ __forceinline__ void mid(f32x4 (&acc)[2][2][4][2], const Unit& u, int wr, int wc, int fr, int fq) const {
        LAS const float* tb = tab + (size_t)(u.e) * 512;
#pragma unroll
        for (int ai = 0; ai < 2; ++ai)
#pragma unroll
            for (int m = 0; m < 4; ++m) { const float s = tb[(ai * HALF + wr * 64 + m * 16 + fr) * 2];
#pragma unroll
                for (int bj = 0; bj < 2; ++bj)
#pragma unroll
                    for (int n = 0; n < 2; ++n) acc[ai][bj][m][n] *= s; }
    }
    __device__ __forceinline__ void operator()(const f32x4 (&acc)[2][2][4][2], const Unit& u, int wr, int wc, int fr, int fq) const {
        LAS const float* tb = tab + (size_t)(u.e) * 512;
        const int col0 = u.pn * BM + wc * 32 + 8 * fq;
        f32x4 gv[2][2];
#pragma unroll
        for (int bj = 0; bj < 2; ++bj) { gv[bj][0] = *(const f32x4*)(g2 + col0 + bj * HALF); gv[bj][1] = *(const f32x4*)(g2 + col0 + bj * HALF + 4); }
#pragma unroll
        for (int ai = 0; ai < 2; ++ai) {
            u32x4 xv[2][4][2];
#pragma unroll
            for (int m = 0; m < 4; ++m) { const bf16_t* xp = out + (size_t)(u.pm * BM + ai * HALF + wr * 64 + m * 16 + fr) * DM + col0;
#pragma unroll
                for (int bj = 0; bj < 2; ++bj) xv[ai][m][bj] = *(const u32x4*)(xp + bj * HALF); }
#pragma unroll
            for (int m = 0; m < 4; ++m) { const int r = ai * HALF + wr * 64 + m * 16 + fr; const float s = tb[r * 2 + 1]; bf16_t* rowp = out + (size_t)(u.pm * BM + r) * DM + col0;
#pragma unroll
                for (int bj = 0; bj < 2; ++bj) { const u32x4 xw = xv[ai][m][bj];
                    const f32x4 x0 = {__uint_as_float(xw.x << 16), __uint_as_float(xw.x & 0xffff0000u), __uint_as_float(xw.y << 16), __uint_as_float(xw.y & 0xffff0000u)};
                    const f32x4 x1 = {__uint_as_float(xw.z << 16), __uint_as_float(xw.z & 0xffff0000u), __uint_as_float(xw.w << 16), __uint_as_float(xw.w & 0xffff0000u)};
                    const f32x4 v0 = acc[ai][bj][m][0] * s + x0, v1 = acc[ai][bj][m][1] * s + x1; u32x4 w; w.x = cvt_pk_bf16(v0[0], v0[1]); w.y = cvt_pk_bf16(v0[2], v0[3]); w.z = cvt_pk_bf16(v1[0], v1[1]); w.w = cvt_pk_bf16(v1[2], v1[3]);
                    *(u32x4*)(rowp + bj * HALF) = w;
                    const f32x4 y0 = v0 * gv[bj][0], y1 = v1 * gv[bj][1];
                    int f0 = __builtin_amdgcn_cvt_pk_fp8_f32(y0[0], y0[1], 0, false); f0 = __builtin_amdgcn_cvt_pk_fp8_f32(y0[2], y0[3], f0, true);
                    int f1 = __builtin_amdgcn_cvt_pk_fp8_f32(y1[0], y1[1], 0, false); f1 = __builtin_amdgcn_cvt_pk_fp8_f32(y1[2], y1[3], f1, true);
                    *(uint2*)(xf8 + (size_t)(u.pm * BM + r) * DM + col0 + bj * HALF) = make_uint2((unsigned)f0, (unsigned)f1); } }
            __builtin_amdgcn_sched_barrier(0);
        }
    }
};
template <class Sched> struct EpiGUF { static constexpr bool PERM = true, ROWINFO = true; static constexpr int MID_T = -1; bf16_t* Hb; const Sched* S;
    __device__ __forceinline__ void mid(f32x4 (&)[2][2][4][2], const Unit&, int, int, int, int) const {}
    __device__ __forceinline__ void operator()(const f32x4 (&acc)[2][2][4][2], const Unit& u, int wr, int wc, int fr, int fq) const {
        const int col0 = u.pn * HALF + wc * 32 + 8 * fq;
#pragma unroll
        for (int ai = 0; ai < 2; ++ai)
#pragma unroll
            for (int m = 0; m < 4; ++m) { const int r = ai * HALF + wr * 64 + m * 16 + fr; const float s = S->scale_of(u, r) * (1.f / WSCALE8);
                float h[8];
#pragma unroll
                for (int n = 0; n < 2; ++n)
#pragma unroll
                    for (int q = 0; q < 4; ++q) { const float gg = acc[ai][0][m][n][q] * s, uu = acc[ai][1][m][n][q] * s; h[4 * n + q] = gg * __builtin_amdgcn_rcpf(1.f + __expf(-gg)) * uu; }
                int w0 = __builtin_amdgcn_cvt_pk_fp8_f32(h[0] * HSCALE8, h[1] * HSCALE8, 0, false); w0 = __builtin_amdgcn_cvt_pk_fp8_f32(h[2] * HSCALE8, h[3] * HSCALE8, w0, true);
                int w1 = __builtin_amdgcn_cvt_pk_fp8_f32(h[4] * HSCALE8, h[5] * HSCALE8, 0, false); w1 = __builtin_amdgcn_cvt_pk_fp8_f32(h[6] * HSCALE8, h[7] * HSCALE8, w1, true);
                *(uint2*)((unsigned char*)Hb + (size_t)(u.pm * BM + r) * DEXP + col0) = make_uint2((unsigned)w0, (unsigned)w1); }
    }
};
template <class Sched> struct EpiDownF { static constexpr bool PERM = true, ROWINFO = true; static constexpr int MID_T = -1; unsigned char* Y; const Sched* S;
    __device__ __forceinline__ void mid(f32x4 (&)[2][2][4][2], const Unit&, int, int, int, int) const {}
    __device__ __forceinline__ void operator()(const f32x4 (&acc)[2][2][4][2], const Unit& u, int wr, int wc, int fr, int fq) const {
        const int col0 = u.pn * BM + wc * 32 + 8 * fq;
#pragma unroll
        for (int ai = 0; ai < 2; ++ai)
#pragma unroll
            for (int m = 0; m < 4; ++m) { const int r = ai * HALF + wr * 64 + m * 16 + fr; const int pr = S->pair_of(u, r); if (pr < 0) continue; const float s = S->scale_of(u, r) * (YSCALE8 / (HSCALE8 * WDSCALE8)); unsigned char* rowp = Y + (size_t)pr * DM + col0;
#pragma unroll
                for (int bj = 0; bj < 2; ++bj) { const f32x4 v0 = acc[ai][bj][m][0] * s, v1 = acc[ai][bj][m][1] * s;
                    int w0 = __builtin_amdgcn_cvt_pk_fp8_f32(v0[0], v0[1], 0, false); w0 = __builtin_amdgcn_cvt_pk_fp8_f32(v0[2], v0[3], w0, true);
                    int w1 = __builtin_amdgcn_cvt_pk_fp8_f32(v1[0], v1[1], 0, false); w1 = __builtin_amdgcn_cvt_pk_fp8_f32(v1[2], v1[3], w1, true);
                    *(uint2*)(rowp + bj * HALF) = make_uint2((unsigned)w0, (unsigned)w1); } }
    }
};
}


#define XB_TMO      128
#define XB_XCNT(j)  (256  + 64 * (j))
#define XB_XSUB(j)  (1280 + 64 * (j))
#define XB_XGEN(j)  (2304 + 64 * (j))
#define XB_TOP      3328
#define XB_TOPGEN   3392
#define XCD_BAR_WORDS 3456
#define XB_SPIN_CAP (1u << 20)
__device__ __forceinline__ unsigned xb_ld(unsigned* p)              { return __hip_atomic_load(p, __ATOMIC_RELAXED, __HIP_MEMORY_SCOPE_AGENT); }
__device__ __forceinline__ unsigned xb_add(unsigned* p, unsigned v) { return __hip_atomic_fetch_add(p, v, __ATOMIC_RELAXED, __HIP_MEMORY_SCOPE_AGENT); }
__device__ __forceinline__ unsigned xb_xcc_id() { return (unsigned)__builtin_amdgcn_s_getreg((3 << 11) | 20) & 0xFu; }
#define XB_SPIN(cond, bar) do { unsigned _sp = 0; while (cond) { __builtin_amdgcn_s_sleep(1); \
    if ((++_sp & 255u) == 0u) { if (xb_ld(&(bar)[XB_TMO])) break; if (_sp > XB_SPIN_CAP) { atomicAdd(&(bar)[XB_TMO], 1u); break; } } } } while (0)
struct XcdBarrier { unsigned* bar; unsigned x; volatile LAS unsigned* st; };
__device__ __forceinline__ XcdBarrier xcd_barrier_post(unsigned* bar, volatile LAS unsigned* st) {
    XcdBarrier b; b.bar = bar; b.x = xb_xcc_id(); b.st = st;
    if (threadIdx.x == 0) (void)xb_add(&bar[XB_XCNT(b.x)], 1u);
    return b;
}
__device__ __forceinline__ void xcd_barrier_complete(unsigned* bar, unsigned x, unsigned& nloc, unsigned& nx) {
    const unsigned G = gridDim.x * gridDim.y * gridDim.z;
    unsigned sum, cnt, mine, sp = 0u;
    for (;;) {
        sum = 0u; cnt = 0u; mine = 0u;
#pragma unroll
        for (unsigned j = 0; j < 16; ++j) { const unsigned c = xb_ld(&bar[XB_XCNT(j)]); sum += c; cnt += (c > 0u) ? 1u : 0u; mine = (j == x) ? c : mine; }
        if (sum == G) break;
        __builtin_amdgcn_s_sleep(1);
        if ((++sp & 255u) == 0u) { if (xb_ld(&bar[XB_TMO])) break; if (sp > XB_SPIN_CAP) { atomicAdd(&bar[XB_TMO], 1u); break; } }
    }
    nloc = mine > 0u ? mine : 1u; nx = cnt > 0u ? cnt : 1u;
}
__device__ __forceinline__ void xcd_barrier(const XcdBarrier& b) {
    asm volatile("s_waitcnt vmcnt(0)" ::: "memory");
    __syncthreads();
    if (threadIdx.x == 0) {
        unsigned* bar = b.bar;
        __builtin_amdgcn_s_waitcnt(0);
        unsigned nloc = b.st[0], nx = b.st[1];
        if (nloc == 0u) { xcd_barrier_complete(bar, b.x, nloc, nx); b.st[0] = nloc; b.st[1] = nx; }
        const unsigned old = xb_add(&bar[XB_XSUB(b.x)], 1u);
        const unsigned gen = old / nloc;
        if (old + 1u == (gen + 1u) * nloc) {
            __builtin_amdgcn_fence(__ATOMIC_RELEASE, "agent");
            asm volatile("s_waitcnt vmcnt(0)" ::: "memory");
            const unsigned og = xb_add(&bar[XB_TOP], 1u);
            const unsigned tg = og / nx;
            if (og + 1u == (tg + 1u) * nx) xb_add(&bar[XB_TOPGEN], 1u);
            else XB_SPIN(xb_ld(&bar[XB_TOPGEN]) == tg, bar);
            __builtin_amdgcn_fence(__ATOMIC_ACQUIRE, "agent");
            xb_add(&bar[XB_XGEN(b.x)], 1u);
            asm volatile("s_waitcnt vmcnt(0)" ::: "memory");
        } else {
            XB_SPIN(xb_ld(&bar[XB_XGEN(b.x)]) == gen, bar);
            __builtin_amdgcn_fence(__ATOMIC_ACQUIRE, "agent");
            asm volatile("s_waitcnt vmcnt(0)" ::: "memory");
        }
    }
    __syncthreads();
}

__global__ void __launch_bounds__(NTHREADS, 2) mega(Params p) {
    extern __shared__ __attribute__((aligned(16))) unsigned char lds[];
    volatile LAS unsigned* bst = (volatile LAS unsigned*)(lds + LDS_PLAN_OFF + 1024);
    if (threadIdx.x < 2) bst[threadIdx.x] = 0u;
    __syncthreads();
    const XcdBarrier gbar = xcd_barrier_post((unsigned*)(p.ws + WS_BAR), bst);
    unsigned long long ts0 = 0, ts1 = 0;
    if (p.never) cg::this_grid().sync();
    Ctx c; c.tid = threadIdx.x; c.lane = c.tid & 63; c.wave = __builtin_amdgcn_readfirstlane(c.tid >> 6); c.gw = blockIdx.x * NWAVES + c.wave; c.ngw = gridDim.x * NWAVES;
    char* ws = p.ws;
    int* cnt = (int*)(ws + WS_CTL);
    float* r1 = (float*)(ws + WS_R1); float* r2 = (float*)(ws + WS_R2); float* ssC = (float*)(ws + WS_SSC);
    float* wts = (float*)(ws + WS_WTS); bf16_t* Wrh = (bf16_t*)(ws + WS_WR); float* ssA = (float*)(ws + WS_SSA); int* list = (int*)(ws + WS_LIST);
    bf16_t* W2t = (bf16_t*)(ws + WS_W2T); bf16_t* W1t = (bf16_t*)(ws + WS_W1T); bf16_t* Wdt = (bf16_t*)(ws + WS_WDT); bf16_t* Wgut = (bf16_t*)(ws + WS_WGUT);
    bf16_t* xb = (bf16_t*)(ws + WS_XB); bf16_t* mix = (bf16_t*)(ws + WS_MIX); bf16_t* proj = (bf16_t*)(ws + WS_PROJ); bf16_t* Y = (bf16_t*)(ws + WS_Y); bf16_t* Hb = (bf16_t*)(ws + WS_H);
    unsigned char* xf8 = (unsigned char*)(ws + WS_WGUT + 64 * MiB);
    bf16_t* dlt = (bf16_t*)(ws + WS_PROJ);

    TS0(1) TS0(8)
    {
        for (int row = c.gw; row < T * PMUL(10); row += 2 * c.ngw) {
            const int ra = row % T, rb = (row + c.ngw) % T; const bool hb = row + c.ngw < T * PMUL(10);
            const float4* xa = (const float4*)(p.x + (size_t)ra * DM); const float4* xc = (const float4*)(p.x + (size_t)rb * DM);
            float4 va[8], vb[8];
#pragma unroll
            for (int j = 0; j < 8; ++j) { va[j] = xa[j * 64 + c.lane]; if (hb) vb[j] = xc[j * 64 + c.lane]; }
            float sa = 0.f, sb = 0.f; uint2* oa = (uint2*)(xb + (size_t)ra * DM); uint2* ob = (uint2*)(xb + (size_t)rb * DM);
#pragma unroll
            for (int j = 0; j < 8; ++j) { sa += va[j].x * va[j].x + va[j].y * va[j].y + va[j].z * va[j].z + va[j].w * va[j].w; oa[j * 64 + c.lane] = make_uint2(cvtpk2(va[j].x, va[j].y), cvtpk2(va[j].z, va[j].w)); }
            if (hb) {
#pragma unroll
                for (int j = 0; j < 8; ++j) { sb += vb[j].x * vb[j].x + vb[j].y * vb[j].y + vb[j].z * vb[j].z + vb[j].w * vb[j].w; ob[j * 64 + c.lane] = make_uint2(cvtpk2(vb[j].x, vb[j].y), cvtpk2(vb[j].z, vb[j].w)); } }
            sa = wave_sum(sa); sb = wave_sum(sb);
            if (c.lane == 0) { r1[ra] = rsqrtf(sa * (1.f / DM) + EPS); if (hb) r1[rb] = rsqrtf(sb * (1.f / DM) + EPS); }
        }
        LAS float* scr = (LAS float*)lds + c.wave * (64 * 65);
        constexpr int I_IN = (DM / 64) * (NPROJ / 64), I_OUT = (DM / 64) * (DM / 64);
        constexpr int NIT = I_IN + I_OUT;
        for (int it = c.gw; it < NIT * PMUL(10); it += c.ngw) {
            int r = it % NIT;
            if (r < I_IN) { const int nb = NPROJ / 64, kb = r / nb, n0 = (r % nb) * 64; p0_titem(p.w_in, NPROJ, p.norm1, W1t, DM, kb * 64, n0, n0, scr, c.lane, n0 < DATT ? QSCALE : 1.f); continue; } r -= I_IN;
            { const int nb = DM / 64, kb = r / nb, n0 = (r % nb) * 64, k0 = kb * 64;
                const float* g = k0 < DATT ? p.g_oa + k0 : p.g_oc + (k0 - DATT);
                p0_titem(p.w_out + (size_t)k0 * DM, DM, g, W2t + k0, DM, 0, n0, n0, scr, c.lane); }
        }
        for (int i = blockIdx.x * NTHREADS + c.tid; i < 48 * DM; i += gridDim.x * NTHREADS) { const int o = i / DM, k = i % DM; const float w = o < 36 ? (o < 4 ? p.w_rg[k * 4 + o] : p.w_re[k * 32 + (o - 4)]) : 0.f;
            Wrh[i] = (bf16_t)f2bf(w * p.norm2[k]); }
    }
    xcd_barrier(gbar);
    TS1(1) TS0(2)
    {
        g8::DenseOrder S; S.init(xb, W1t, T, NPROJ, DM, (int)gridDim.x, (int)blockIdx.x); S.mul = PMUL(1);
        S.rowscale = r1; S.rtab = (LAS float*)(lds + 131072);
        const g8::EpiProjF<g8::DenseOrder> E{proj, &S};
        g8::gemm_phase<false, 2>((LAS unsigned char*)lds, DM, S, E);
    }
    xcd_barrier(gbar);
    TS1(2) TS0(3)
    {
        struct Side { WConv wc; unsigned long long twait; int s, gw, ngw, nper, lane; LAS float* scr; unsigned scr32; const float *wg, *wu, *wd; bf16_t* Wgut; bf16_t* Wdt;
            __device__ __forceinline__ void step() { if (wc.pending) wc.finish(scr, lane);
                if (s < nper) { const int id = gw + ngw * s; ++s; if (id < WC_ITEMS) wc.issue(id, wg, wu, wd, Wgut, Wdt, scr32, lane); } }
            __device__ __forceinline__ void whole() { step(); asm volatile("s_waitcnt vmcnt(0)" ::: "memory"); } };
        Side side; side.twait = 0; side.wc.pending = false; side.s = 0; side.gw = c.gw; side.ngw = c.ngw; side.nper = (WC_ITEMS + c.ngw - 1) / c.ngw; side.lane = c.lane;
        side.scr = (LAS float*)(lds + 69632) + c.wave * (64 * 32); side.scr32 = (unsigned)(__UINTPTR_TYPE__)((LAS unsigned char*)lds + 69632) + c.wave * 8192;
        side.wg = p.w_gate; side.wu = p.w_up; side.wd = p.w_down; side.Wgut = Wgut; side.Wdt = Wdt;
        const int vblk = (gridDim.x & 7) == 0 ? (int)((blockIdx.x & 7) * (gridDim.x >> 3) + (blockIdx.x >> 3)) : (int)blockIdx.x;
        for (int u1 = vblk; u1 < NB * NH * 4 * PMUL(2); u1 += gridDim.x) { const int u0 = u1 % (NB * NH * 4); const int bh = u0 >> 2;
            for (int i = 0; i < 4; ++i) att::attn_unit((LAS unsigned char*)lds, proj, p.relb, mix, ssA, bh >> 4, bh & 15, (u0 & 3) + 4 * i, side, i == 0); }
        if (TSPROBE == 34 || TSPROBE == 35) { ts0 = 0; ts1 = side.twait; }
        while (side.wc.pending || side.s < side.nper) side.whole();
        for (int it = c.gw; it < (T / 16) * 2 * PMUL(21); it += c.ngw) conv_slab(proj, p.conv_w, mix, ssC, it % ((T / 16) * 2), c.lane);
    }
    xcd_barrier(gbar);
    TS1(3) TS0(4)
    {
        g8::DenseOrder S; S.init(mix, W2t, T, DM, DM, (int)gridDim.x, (int)blockIdx.x); S.mul = PMUL(3);
        LAS float* tab = (LAS float*)(lds + 131072);
        g8::Unit u;
        for (int i = 0; i < 4; ++i) if (S.next(i, u) && c.tid < 256) { const int row = u.pm * 256 + c.tid; float sa = 0.f;
#pragma unroll
            for (int h = 0; h < 16; ++h) sa += ssA[row * 16 + h];
            const float4 sc4 = *(const float4*)(ssC + row * 4); const float ra = rsqrtf(sa * (1.f / DATT) + EPS), rc = rsqrtf((sc4.x + sc4.y) * (1.f / DCONV) + EPS);
            tab[(i * 256 + c.tid) * 2] = ra / rc; tab[(i * 256 + c.tid) * 2 + 1] = rc; }
        __syncthreads();
        const g8::EpiG2X E{xb, xf8, p.norm2, tab};
        g8::gemm_phase<false, 2>((LAS unsigned char*)lds, DM, S, E);
    }
    xcd_barrier(gbar);
    TS1(4) TS0(5)
    for (int it = blockIdx.x; it < (T / 64) * PMUL(4); it += gridDim.x) router_block(xb, Wrh, p.b_rg, p.b_re, cnt, list, wts, r2, it % (T / 64), c.wave, c.lane, (LAS float*)lds, it < T / 64);
    xcd_barrier(gbar);
    TS1(5) TS0(6)
    LAS int* pl = (LAS int*)(lds + LDS_PLAN_OFF);
    if (c.tid < 64) {
        const int ce = c.tid < NE ? cnt[c.tid * 64] : 0, mt = (ce + 255) >> 8;
        int inc = mt;
#pragma unroll
        for (int o = 1; o < 32; o <<= 1) { const int v = __shfl_up(inc, o); if (c.lane >= o) inc += v; }
        if (c.tid < NE) { pl[c.tid] = ce; pl[32 + c.tid] = (inc - mt) * 256; }
        if (c.tid == NE - 1) pl[224] = inc;
    }
    __syncthreads();
    if (c.tid < NTILEMAX) { int e = -1;
        for (int q = 0; q < NE; ++q) { const int st = pl[32 + q] >> 8, mt = (pl[q] + 255) >> 8; if (c.tid >= st && c.tid < st + mt) e = q; }
        pl[64 + c.tid] = e; }
    __syncthreads();
    const int ntile = pl[224];
    {
        const g8::MoeOrder<true> S{(const char*)xf8, (const char*)Wgut, list, pl, DM  , 4, ntile * 4, (int)gridDim.x, (int)blockIdx.x, (size_t)2 * DEXP * DM, PMUL(5), (LAS int*)(lds + 131072), r2};
        const g8::EpiGUF<g8::MoeOrder<true>> E{Hb, &S};
        g8::gemm_phase<true, 1>((LAS unsigned char*)lds, DM, S, E);
    }
    xcd_barrier(gbar);
    TS1(6) TS0(7)
    {
        const g8::MoeOrder<false> S{(const char*)Hb, (const char*)Wdt, list, pl, DEXP  , 8, ntile * 8, (int)gridDim.x, (int)blockIdx.x, (size_t)DM * DEXP, PMUL(6), (LAS int*)(lds + 131072), wts};
        const g8::EpiDownF<g8::MoeOrder<false>> E{(unsigned char*)Y, &S};
        g8::gemm_phase<false, 1>((LAS unsigned char*)lds, DEXP, S, E);
    }
    xcd_barrier(gbar);
    TS1(7) TS1(8)
    if (PROBE == 9) { for (int i = 0; i < 8; ++i) xcd_barrier(gbar); }
    const float tsdelta = TSPROBE ? sqrtf((float)(ts1 - ts0) * 0.01f) * 1e-3f : 0.f;
    {
        const unsigned long long tp6 = (TSPROBE == 9) ? __builtin_amdgcn_s_memrealtime() : 0ull;
        FinalRow fa, fb;
        int t = c.gw;
        if (t < T) final_load(fa, xb, Y, t, c.lane);
        for (; t < T; t += 2 * c.ngw) {
            const int t2 = t + c.ngw, t3 = t + 2 * c.ngw;
            if (t2 < T) final_load(fb, xb, Y, t2, c.lane);
            final_store(fa, p.out, p.norm_f, t, c.lane, (TSPROBE == 9) ? sqrtf((float)(__builtin_amdgcn_s_memrealtime() - tp6) * 0.01f) * 1e-3f : tsdelta);
            if (t3 < T) final_load(fa, xb, Y, t3, c.lane);
            if (t2 < T) final_store(fb, p.out, p.norm_f, t2, c.lane, (TSPROBE == 9) ? sqrtf((float)(__builtin_amdgcn_s_memrealtime() - tp6) * 0.01f) * 1e-3f : tsdelta);
        }
    }
}

extern "C" void kernel_launch(void* const* d_in, const int* in_sizes, int n_in, void* d_out, int out_size, void* d_ws, size_t ws_size, hipStream_t stream) {
    static int grid = 0;
    if (grid == 0) {
        int dev = 0, cus = 0, per_cu = 0;
        if (ws_size < WS_END || n_in != 17) { fprintf(stderr, "kernel_launch: unexpected sizes (ws %zu)\n", ws_size); grid = -1; return; }
        (void)hipGetDevice(&dev); (void)hipDeviceGetAttribute(&cus, hipDeviceAttributeMultiprocessorCount, dev);
        if (hipFuncSetAttribute((const void*)mega, hipFuncAttributeMaxDynamicSharedMemorySize, LDS_BYTES) != hipSuccess) { fprintf(stderr, "hipFuncSetAttribute failed\n"); grid = -1; return; }
        if (hipOccupancyMaxActiveBlocksPerMultiprocessor(&per_cu, (const void*)mega, NTHREADS, LDS_BYTES) != hipSuccess || per_cu < 1) { fprintf(stderr, "occupancy query failed (%d)\n", per_cu); grid = -1; return; }
        grid = cus * per_cu;
        fprintf(stderr, "kernel_launch: cus %d per_cu %d grid %d\n", cus, per_cu, grid);
    }
    if (grid < 0) return;
    if (hipMemsetAsync((char*)d_ws + WS_CTL, 0, 64 * 1024, stream) != hipSuccess) { fprintf(stderr, "memset failed\n"); return; }
    Params p{};
    p.x = (const float*)d_in[0]; p.norm1 = (const float*)d_in[1]; p.w_in = (const float*)d_in[2]; p.relb = (const float*)d_in[3];
    p.conv_w = (const float*)d_in[4]; p.g_oa = (const float*)d_in[5]; p.g_oc = (const float*)d_in[6]; p.w_out = (const float*)d_in[7];
    p.norm2 = (const float*)d_in[8]; p.w_rg = (const float*)d_in[9]; p.b_rg = (const float*)d_in[10]; p.w_re = (const float*)d_in[11];
    p.b_re = (const float*)d_in[12]; p.w_gate = (const float*)d_in[13]; p.w_up = (const float*)d_in[14]; p.w_down = (const float*)d_in[15];
    p.norm_f = (const float*)d_in[16]; p.out = (float*)d_out; p.ws = (char*)d_ws;
    void* args[] = {&p};
    hipError_t e = hipLaunchCooperativeKernel((const void*)mega, dim3(grid), dim3(NTHREADS), args, LDS_BYTES, stream);
    if (e != hipSuccess) fprintf(stderr, "cooperative launch failed: %s (grid %d)\n", hipGetErrorString(e), grid);
}
```

```cpp
#include <hip/hip_runtime.h>
#include <hip/hip_cooperative_groups.h>
#include <stdint.h>
#include <cstdio>
namespace cg = cooperative_groups;
#ifndef PROBE
#define PROBE 0
#endif
#define PMUL(k) ((PROBE) == (k) ? 2 : 1)
#ifndef TSPROBE
#define TSPROBE 0
#endif
#define TS0(k) if (TSPROBE == (k)) ts0 = __builtin_amdgcn_s_memrealtime();
#define TS1(k) if (TSPROBE == (k)) ts1 = __builtin_amdgcn_s_memrealtime();

typedef unsigned short bf16_t;
typedef short bf16x8 __attribute__((ext_vector_type(8)));
typedef float f32x4 __attribute__((ext_vector_type(4)));

constexpr int NB = 4, SEQ = 4096, T = NB * SEQ, DM = 2048, DATT = 1024, DCONV = 1024, NPROJ = 6144;
constexpr int NH = 16, HD = 64, NREL = 513, NE = 32, DEXP = 512, NPAIR = 2 * T;
constexpr int NPADMAX = 40960, NTILEMAX = NPADMAX / 256;
constexpr float EPS = 1e-6f;
constexpr float YSCALE8 = 64.f;
constexpr float HSCALE8 = 8.f, WDSCALE8 = 32.f;
constexpr float WSCALE8 = 64.f;
constexpr float LOG2E = 1.4426950408889634f, QSCALE = 0.125f * LOG2E;

constexpr size_t MiB = 1u << 20;
constexpr size_t WS_CTL = 0;
constexpr size_t WS_BAR = 16 * 1024;
constexpr size_t WS_PLAN = 64 * 1024;
constexpr size_t WS_R1 = 128 * 1024;
constexpr size_t WS_RA = 192 * 1024;
constexpr size_t WS_RC = 256 * 1024;
constexpr size_t WS_R2 = 320 * 1024;
constexpr size_t WS_SSC = 3 * MiB;
constexpr size_t WS_WTS = 512 * 1024;
constexpr size_t WS_ROWPAIR = 640 * 1024;
constexpr size_t WS_WR = 1 * MiB;
constexpr size_t WS_SSA = 2 * MiB;
constexpr size_t WS_LIST = 5 * MiB;
constexpr size_t WS_W2T = 8 * MiB;
constexpr size_t WS_W1T = 16 * MiB;
constexpr size_t WS_WDT = 40 * MiB;
constexpr size_t WS_WGUT = 104 * MiB;
constexpr size_t WS_XB = 232 * MiB;
constexpr size_t WS_MIX = 296 * MiB;
constexpr size_t WS_PROJ = 360 * MiB;
constexpr size_t WS_Y = 360 * MiB;
constexpr size_t WS_H = 488 * MiB;
constexpr size_t WS_END = 552 * MiB;

__device__ __forceinline__ unsigned f2bf(float f) { unsigned u = __float_as_uint(f); return (u + 0x7fffu + ((u >> 16) & 1u)) >> 16; }
__device__ __forceinline__ unsigned pk2(float lo, float hi) { return f2bf(lo) | (f2bf(hi) << 16); }
__device__ __forceinline__ unsigned cvtpk2(float lo, float hi) { typedef float f2 __attribute__((ext_vector_type(2))); typedef __bf16 b2 __attribute__((ext_vector_type(2))); f2 v = {lo, hi}; b2 r = __builtin_convertvector(v, b2); return __builtin_bit_cast(unsigned, r); }
__device__ __forceinline__ int gu_row(int n, int up) { return ((n >> 7) << 8) + (n & 127) + (up ? 128 : 0); }
__device__ __forceinline__ float bf2f(unsigned h) { return __uint_as_float(h << 16); }
__device__ __forceinline__ float wave_sum(float v) {
#pragma unroll
    for (int o = 1; o < 64; o <<= 1) v += __shfl_xor(v, o);
    return v;
}


#define LAS __attribute__((address_space(3)))
constexpr int NWAVES = 8, NTHREADS = 512;
constexpr int LDS_BYTES = 147456;
constexpr int LDS_PLAN_OFF = 140 * 1024;

struct Params {
    const float *x, *norm1, *w_in, *relb, *conv_w, *g_oa, *g_oc, *w_out, *norm2, *w_rg, *b_rg, *w_re, *b_re, *w_gate, *w_up, *w_down, *norm_f;
    float* out; char* ws; int never; int pad;
};
struct Ctx { int tid, lane, wave, gw, ngw; };

__device__ __forceinline__ void p0_titem(const float* __restrict__ W, int N, const float* __restrict__ g, bf16_t* __restrict__ WT, int ldd, int k0, int n0, int drow0, LAS float* scr, int lane, float cs = 1.f) {
    const int kq = lane >> 4, n4 = (lane & 15) * 4;
    float4 v[16]; float gs[16];
#pragma unroll
    for (int i = 0; i < 16; ++i) v[i] = *(const float4*)(W + (size_t)(k0 + 4 * i + kq) * N + n0 + n4);
#pragma unroll
    for (int i = 0; i < 16; ++i) gs[i] = (g ? g[k0 + 4 * i + kq] : 1.f) * cs;
#pragma unroll
    for (int i = 0; i < 16; ++i) { LAS float* d = scr + (4 * i + kq) * 65 + n4; d[0] = v[i].x * gs[i]; d[1] = v[i].y * gs[i]; d[2] = v[i].z * gs[i]; d[3] = v[i].w * gs[i]; }
    asm volatile("s_waitcnt lgkmcnt(0)" ::: "memory");
    const int c = lane & 7;
#pragma unroll
    for (int j = 0; j < 8; ++j) { const int n = (lane >> 3) + 8 * j; const LAS float* sp = scr + (8 * c) * 65 + n;
        uint4 o; o.x = cvtpk2(sp[0 * 65], sp[1 * 65]); o.y = cvtpk2(sp[2 * 65], sp[3 * 65]); o.z = cvtpk2(sp[4 * 65], sp[5 * 65]); o.w = cvtpk2(sp[6 * 65], sp[7 * 65]);
        *(uint4*)(WT + (size_t)(drow0 + n) * ldd + k0 + 8 * c) = o; }
    asm volatile("s_waitcnt lgkmcnt(0)" ::: "memory");
}

__device__ __forceinline__ void router_block(const bf16_t* __restrict__ xb1, const bf16_t* __restrict__ Wrh,
                                             const float* __restrict__ brg, const float* __restrict__ bre, int* __restrict__ cnt, int* __restrict__ list, float* __restrict__ wts, float* __restrict__ r2out,
                                             int tb, int wave, int lane, LAS float* lds_f, bool commit) {
    const int fr = lane & 15, fq = lane >> 4;
    const bf16_t* xr = xb1 + (size_t)(tb * 64 + fr) * DM + wave * 256 + 8 * fq;
    const bf16_t* wh = Wrh + (size_t)fr * DM + wave * 256 + 8 * fq;
    f32x4 accr[4][3], gram[4];
#pragma unroll
    for (int g = 0; g < 4; ++g) { gram[g] = (f32x4){0.f, 0.f, 0.f, 0.f};
#pragma unroll
        for (int nb = 0; nb < 3; ++nb) accr[g][nb] = (f32x4){0.f, 0.f, 0.f, 0.f}; }
#pragma unroll 1
    for (int h = 0; h < 2; ++h) {
        bf16x8 xv[4][4], wv[4][3];
#pragma unroll
        for (int ks = 0; ks < 4; ++ks) {
#pragma unroll
            for (int g = 0; g < 4; ++g) xv[ks][g] = *(const bf16x8*)(xr + (size_t)g * 16 * DM + (4 * h + ks) * 32);
#pragma unroll
            for (int nb = 0; nb < 3; ++nb) wv[ks][nb] = *(const bf16x8*)(wh + (size_t)nb * 16 * DM + (4 * h + ks) * 32); }
#pragma unroll
        for (int ks = 0; ks < 4; ++ks)
#pragma unroll
            for (int g = 0; g < 4; ++g) { gram[g] = __builtin_amdgcn_mfma_f32_16x16x32_bf16(xv[ks][g], xv[ks][g], gram[g], 0, 0, 0);
#pragma unroll
                for (int nb = 0; nb < 3; ++nb) accr[g][nb] = __builtin_amdgcn_mfma_f32_16x16x32_bf16(wv[ks][nb], xv[ks][g], accr[g][nb], 0, 0, 0); }
    }
    LAS float* part8 = lds_f;
    LAS float* sc = lds_f + 32 * 64 * 13 + (wave & 3) * (16 * 49);
    LAS int* ent = (LAS int*)(lds_f + 32 * 64 * 13 + 4 * 16 * 49);
#pragma unroll
    for (int g = 0; g < 4; ++g) { LAS float* pp = part8 + ((wave * 4 + g) * 64 + lane) * 13;
#pragma unroll
        for (int nb = 0; nb < 3; ++nb)
#pragma unroll
            for (int q = 0; q < 4; ++q) pp[nb * 4 + q] = accr[g][nb][q];
        const int qd = fr & 3; const float d = qd == 0 ? gram[g][0] : qd == 1 ? gram[g][1] : qd == 2 ? gram[g][2] : gram[g][3];
        pp[12] = (fq == (fr >> 2)) ? d : 0.f; }
    __syncthreads();
    const int tg = wave, t0 = tb * 64 + tg * 16;
    if (wave < 4) {
        f32x4 acc[3]; float ss = 0.f;
#pragma unroll
        for (int nb = 0; nb < 3; ++nb) acc[nb] = (f32x4){0.f, 0.f, 0.f, 0.f};
#pragma unroll
        for (int w = 0; w < 8; ++w) { LAS const float* pp = part8 + ((w * 4 + tg) * 64 + lane) * 13;
#pragma unroll
            for (int nb = 0; nb < 3; ++nb)
#pragma unroll
                for (int q = 0; q < 4; ++q) acc[nb][q] += pp[nb * 4 + q];
            ss += pp[12]; }
        ss += __shfl_xor(ss, 16); ss += __shfl_xor(ss, 32);
        const float r2 = rsqrtf(ss * (1.f / DM) + EPS);
#pragma unroll
        for (int nb = 0; nb < 3; ++nb)
#pragma unroll
            for (int q = 0; q < 4; ++q) sc[fr * 49 + 16 * nb + 4 * fq + q] = acc[nb][q] * r2;
        asm volatile("s_waitcnt lgkmcnt(0)" ::: "memory");
        if (lane < 16) {
            const int t = t0 + lane; LAS const float* lr = sc + lane * 49;
            float lg[4];
#pragma unroll
            for (int g = 0; g < 4; ++g) lg[g] = lr[g] + brg[g];
            int gs = 0; float gm = lg[0];
#pragma unroll
            for (int g = 1; g < 4; ++g) if (lg[g] > gm) { gm = lg[g]; gs = g; }
            float den = 0.f;
#pragma unroll
            for (int g = 0; g < 4; ++g) den += __expf(lg[g] - gm);
            const float pg = 1.f / den;
            float el[8];
#pragma unroll
            for (int i = 0; i < 8; ++i) el[i] = lr[4 + 8 * gs + i] + bre[8 * gs + i];
            int i1 = 0; float v1 = el[0];
#pragma unroll
            for (int i = 1; i < 8; ++i) if (el[i] > v1) { v1 = el[i]; i1 = i; }
            int i2 = -1; float v2 = -3.0e38f;
#pragma unroll
            for (int i = 0; i < 8; ++i) if (i != i1 && el[i] > v2) { v2 = el[i]; i2 = i; }
            const float e2 = __expf(v2 - v1), w0 = pg / (1.f + e2), w1 = pg * e2 / (1.f + e2);
            ent[2 * (tg * 16 + lane)] = gs * 8 + i1; ent[2 * (tg * 16 + lane) + 1] = gs * 8 + i2;
            if (commit) { r2out[t] = r2; wts[2 * t] = w0; wts[2 * t + 1] = w1; }
        }
    }
    __syncthreads();
    if (wave == 0 && lane < NE && commit) {
        int n = 0;
        for (int i = 0; i < 128; ++i) n += (ent[i] == lane) ? 1 : 0;
        if (n) { int k = atomicAdd(&cnt[lane * 64], n);
            for (int i = 0; i < 128; ++i) if (ent[i] == lane) { list[lane * T + k] = 2 * (tb * 64) + i; ++k; } }
    }
    __syncthreads();
}
struct FinalRow { uint4 xv[4]; uint2 pv[4], qv[4]; };
__device__ __forceinline__ void final_load(FinalRow& f, const bf16_t* __restrict__ xb1, const bf16_t* __restrict__ Yb, int t, int lane) {
    const unsigned char* Y = (const unsigned char*)Yb;
    const uint4* x1 = (const uint4*)(xb1 + (size_t)t * DM); const uint2* y0 = (const uint2*)(Y + (size_t)(2 * t) * DM); const uint2* y1 = (const uint2*)(Y + (size_t)(2 * t + 1) * DM);
#pragma unroll
    for (int j = 0; j < 4; ++j) { f.xv[j] = x1[j * 64 + lane]; f.pv[j] = y0[j * 64 + lane]; f.qv[j] = y1[j * 64 + lane]; }
}
__device__ __forceinline__ void final_store(const FinalRow& f, float* __restrict__ out, const float* __restrict__ g, int t, int lane, float delta = 0.f) {
    float4* xw = (float4*)(out + (size_t)t * DM);
    float v[4][8]; float ss = 0.f;
    typedef float f2_t __attribute__((ext_vector_type(2)));
#pragma unroll
    for (int j = 0; j < 4; ++j) { const unsigned xa[4] = {f.xv[j].x, f.xv[j].y, f.xv[j].z, f.xv[j].w};
        const f2_t p01 = __builtin_amdgcn_cvt_pk_f32_fp8((int)f.pv[j].x, false), p23 = __builtin_amdgcn_cvt_pk_f32_fp8((int)f.pv[j].x, true), p45 = __builtin_amdgcn_cvt_pk_f32_fp8((int)f.pv[j].y, false), p67 = __builtin_amdgcn_cvt_pk_f32_fp8((int)f.pv[j].y, true);
        const f2_t q01 = __builtin_amdgcn_cvt_pk_f32_fp8((int)f.qv[j].x, false), q23 = __builtin_amdgcn_cvt_pk_f32_fp8((int)f.qv[j].x, true), q45 = __builtin_amdgcn_cvt_pk_f32_fp8((int)f.qv[j].y, false), q67 = __builtin_amdgcn_cvt_pk_f32_fp8((int)f.qv[j].y, true);
        const float ys[8] = {p01[0] + q01[0], p01[1] + q01[1], p23[0] + q23[0], p23[1] + q23[1], p45[0] + q45[0], p45[1] + q45[1], p67[0] + q67[0], p67[1] + q67[1]};
#pragma unroll
        for (int q = 0; q < 4; ++q) { const float lo = bf2f(xa[q] & 0xffffu) + ys[2 * q] * (1.f / YSCALE8), hi = bf2f(xa[q] >> 16) + ys[2 * q + 1] * (1.f / YSCALE8);
            v[j][2 * q] = lo; v[j][2 * q + 1] = hi; ss += lo * lo + hi * hi; } }
    const float r = rsqrtf(wave_sum(ss) * (1.f / DM) + EPS);
#pragma unroll
    for (int j = 0; j < 4; ++j) { const float4 g0 = ((const float4*)g)[(j * 64 + lane) * 2], g1 = ((const float4*)g)[(j * 64 + lane) * 2 + 1];
        float4 a, b; a.x = v[j][0] * r * g0.x + delta; a.y = v[j][1] * r * g0.y - delta; a.z = v[j][2] * r * g0.z + delta; a.w = v[j][3] * r * g0.w - delta;
        b.x = v[j][4] * r * g1.x + delta; b.y = v[j][5] * r * g1.y - delta; b.z = v[j][6] * r * g1.z + delta; b.w = v[j][7] * r * g1.w - delta;
        xw[(j * 64 + lane) * 2] = a; xw[(j * 64 + lane) * 2 + 1] = b; }
}

constexpr int WC_ITEMS = 3 * NE * 512, WC_GU = 2 * NE * 512;
struct WConv {
    unsigned char* dst; int ldd; float sc; bool pending;
    __device__ __forceinline__ void issue(int id, const float* __restrict__ w_gate, const float* __restrict__ w_up, const float* __restrict__ w_down, bf16_t* Wgut, bf16_t* Wdt, unsigned scr32, int lane) {
        const int kq = lane >> 3;
        const float* src; int N, k0, n0;
        if (id < 2 * NE * 512) { const int up = id >= NE * 512, r = id & (NE * 512 - 1), e = r >> 9, q = r & 511; k0 = (q >> 4) * 64; n0 = (q & 15) * 32; N = DEXP; sc = WSCALE8;
            src = (up ? w_up : w_gate) + (size_t)e * DM * DEXP; dst = (unsigned char*)Wgut + (size_t)e * 2 * DEXP * DM + (size_t)gu_row(n0, up) * DM + k0; ldd = DM; }
        else { const int r = id - 2 * NE * 512, e = r >> 9, q = r & 511; k0 = (q >> 6) * 64; n0 = (q & 63) * 32; N = DM; sc = WDSCALE8;
            src = w_down + (size_t)e * DEXP * DM; dst = (unsigned char*)Wdt + (size_t)e * DM * DEXP + (size_t)n0 * DEXP + k0; ldd = DEXP; }
#pragma unroll
        for (int i = 0; i < 8; ++i) { const float* g = src + (size_t)(k0 + 8 * i + kq) * N + n0 + 4 * ((lane & 7) ^ i); unsigned keep_;
            asm volatile("s_mov_b32 %0, m0\n\ts_mov_b32 m0, %2\n\ts_nop 0\n\tglobal_load_lds_dwordx4 %1, off\n\ts_mov_b32 m0, %0" : "=&s"(keep_) : "v"(g), "s"((unsigned)__builtin_amdgcn_readfirstlane((int)(scr32 + i * 1024))) : "memory"); }
        pending = true;
    }
    __device__ __forceinline__ void finish(LAS float* scr, int lane) {
        const int c = lane & 7;
#pragma unroll
        for (int j = 0; j < 4; ++j) { const int n = (lane >> 3) + 8 * j; const LAS float* sp = scr + (8 * c) * 32 + 4 * ((n >> 2) ^ c) + (n & 3);
            float v[8];
#pragma unroll
            for (int q = 0; q < 8; ++q) v[q] = sp[q * 32] * sc;
            int w0 = __builtin_amdgcn_cvt_pk_fp8_f32(v[0], v[1], 0, false); w0 = __builtin_amdgcn_cvt_pk_fp8_f32(v[2], v[3], w0, true);
            int w1 = __builtin_amdgcn_cvt_pk_fp8_f32(v[4], v[5], 0, false); w1 = __builtin_amdgcn_cvt_pk_fp8_f32(v[6], v[7], w1, true);
            *(uint2*)(dst + (size_t)n * ldd + 8 * c) = make_uint2((unsigned)w0, (unsigned)w1); }
        asm volatile("s_waitcnt lgkmcnt(0)" ::: "memory");
        pending = false;
    }
};

namespace att {
typedef float f32x16 __attribute__((ext_vector_type(16)));
typedef short s16x4 __attribute__((ext_vector_type(4)));
typedef short v4i16_t __attribute__((ext_vector_type(4)));
constexpr int SLOT = 16384, L_K = 0, L_V = 2 * SLOT, L_TB = 4 * SLOT, NTB = 576;
constexpr float THR = 8.f;
__device__ __forceinline__ float rowmax32(const f32x16& p0, const f32x16& p1) {
    float a = fmaxf(p0[0], p1[0]);
#pragma unroll
    for (int r = 1; r < 16; ++r) a = fmaxf(fmaxf(a, p0[r]), p1[r]);
    auto rr = __builtin_amdgcn_permlane32_swap(__float_as_uint(a), __float_as_uint(a), false, false);
    return fmaxf(__uint_as_float(rr[0]), __uint_as_float(rr[1]));
}
__device__ __forceinline__ unsigned cvtpk(float lo, float hi) { typedef float f2 __attribute__((ext_vector_type(2))); typedef __bf16 b2 __attribute__((ext_vector_type(2))); f2 v = {lo, hi}; b2 b = __builtin_convertvector(v, b2); return __builtin_bit_cast(unsigned, b); }
__device__ __forceinline__ s16x4 vtr(LAS const unsigned char* p) { return __builtin_bit_cast(s16x4, __builtin_amdgcn_ds_read_tr16_b64_v4i16((LAS v4i16_t*)p)); }

template <class Side> __device__ __forceinline__ void attn_unit(LAS unsigned char* lds, const bf16_t* __restrict__ proj, const float* __restrict__ relb, bf16_t* __restrict__ mix, float* __restrict__ ssA, int b, int h, int cg, Side& side, bool fill_table) {
    const int tid = threadIdx.x, lane = tid & 63, r32 = lane & 31, hi = lane >> 5, w = __builtin_amdgcn_readfirstlane(tid >> 6);
    const int c0 = cg * 4, cq = c0 + (w >> 1), qi = 32 * (w & 1) + r32;
    const int j0 = c0 - 8 < 0 ? 0 : c0 - 8, j1 = c0 + 3;
    const unsigned lds32 = (unsigned)(__UINTPTR_TYPE__)lds;
    LAS float* tb = (LAS float*)(lds + L_TB);
    if (fill_table) for (int i = tid; i < NTB; i += NTHREADS) tb[i] = relb[h * NREL + (i > 512 ? 512 : i)] * LOG2E;
    const size_t tq = (size_t)b * SEQ + (size_t)c0 * 64 + 32 * w + r32;
    bf16x8 qr[4];
#pragma unroll
    for (int d0 = 0; d0 < 4; ++d0) qr[d0] = *(const bf16x8*)(proj + tq * NPROJ + h * HD + d0 * 16 + hi * 8);
    const int krow = 8 * w + (lane >> 3);
    const bf16_t* ksrc = proj + ((size_t)b * SEQ + krow) * NPROJ + DATT + h * HD + (((lane & 7) ^ ((krow >> 1) & 7)) * 8);
    const bf16_t* vsrc = proj + ((size_t)b * SEQ + 16 * (w & 3) + (lane >> 2)) * NPROJ + 2 * DATT + h * HD + (w >> 2) * 32 + (lane & 3) * 8;
#define ATT_GLDS(gsrc, ldsdst) do { unsigned keep_; asm volatile("s_mov_b32 %0, m0\n\ts_mov_b32 m0, %2\n\ts_nop 0\n\tglobal_load_lds_dwordx4 %1, off\n\ts_mov_b32 m0, %0" : "=&s"(keep_) : "v"(gsrc), "s"((unsigned)__builtin_amdgcn_readfirstlane((int)(ldsdst))) : "memory"); } while (0)
#define ATT_DMA1(j, off) do { ATT_GLDS(ksrc + (size_t)(j) * 64 * NPROJ, lds32 + L_K + (off) + w * 1024); ATT_GLDS(vsrc + (size_t)(j) * 64 * NPROJ, lds32 + L_V + (off) + w * 1024); } while (0)
#define ATT_DMA(j, slot) do { ATT_DMA1(j, (slot) * SLOT); ATT_DMA1((j) + 1, (slot) * SLOT + 8192); } while (0)
    int ka[4];
#pragma unroll
    for (int d0 = 0; d0 < 4; ++d0) ka[d0] = r32 * 128 + (((2 * d0 + hi) ^ ((r32 >> 1) & 7)) * 16);
    const int va = ((lane >> 4) & 1) * 32 + (lane & 3) * 8 + (4 * hi + ((lane & 15) >> 2)) * 64;
    float m = -1e30f, l = 0.f; f32x16 o[2];
#pragma unroll
    for (int r = 0; r < 16; ++r) { o[0][r] = 0.f; o[1][r] = 0.f; }
    ATT_DMA(j0, 0);
    for (int js = j0; js <= j1; js += 2) {
        const int slot = ((js - j0) >> 1) & 1;
        unsigned long long tb0_ = 0; if (TSPROBE == 34 || TSPROBE == 35) tb0_ = __builtin_amdgcn_s_memrealtime();
        if (TSPROBE == 35) { asm volatile("s_waitcnt vmcnt(0) lgkmcnt(0)" ::: "memory"); side.twait += __builtin_amdgcn_s_memrealtime() - tb0_; }
        asm volatile("s_waitcnt vmcnt(0) lgkmcnt(0)\n\ts_barrier" ::: "memory");
        if (TSPROBE == 34) side.twait += __builtin_amdgcn_s_memrealtime() - tb0_;
        side.step();
        if (js + 2 <= j1) ATT_DMA(js + 2, slot ^ 1);
#pragma unroll
        for (int half = 0; half < 2; ++half) {
        const int j = js + half, dl = cq - j;
        if (dl >= 0 && dl <= 8) {
            LAS const unsigned char* Ks = lds + L_K + slot * SLOT + half * 8192; LAS const unsigned char* Vs = lds + L_V + slot * SLOT + half * 8192 + va;
            f32x16 p0, p1;
            if (dl <= 4) { LAS const float* tp = tb + (64 * dl + qi + 256 - 4 * hi - 59);
#pragma unroll
                for (int r = 0; r < 16; ++r) { p0[r] = tp[59 - ((r & 3) + 8 * (r >> 2))]; p1[r] = tp[27 - ((r & 3) + 8 * (r >> 2))]; } }
            else { const float bf = tb[NTB - 1];
#pragma unroll
                for (int r = 0; r < 16; ++r) { p0[r] = bf; p1[r] = bf; } }
            { bf16x8 kf[8];
#pragma unroll
              for (int d0 = 0; d0 < 4; ++d0) { kf[2 * d0] = *(LAS const bf16x8*)(Ks + ka[d0]); kf[2 * d0 + 1] = *(LAS const bf16x8*)(Ks + ka[d0] + 4096); }
              __builtin_amdgcn_sched_barrier(0);
#pragma unroll
              for (int d0 = 0; d0 < 4; ++d0) { p0 = __builtin_amdgcn_mfma_f32_32x32x16_bf16(kf[2 * d0], qr[d0], p0, 0, 0, 0); p1 = __builtin_amdgcn_mfma_f32_32x32x16_bf16(kf[2 * d0 + 1], qr[d0], p1, 0, 0, 0); } }
            const float mx = rowmax32(p0, p1);
            if (__any(mx > m + THR)) { const float mn = fmaxf(m, mx), al = __builtin_amdgcn_exp2f(m - mn); m = mn; l *= al;
#pragma unroll
                for (int r = 0; r < 16; ++r) { o[0][r] *= al; o[1][r] *= al; } }
            float rs = 0.f;
#pragma unroll
            for (int r = 0; r < 16; ++r) { p0[r] = __builtin_amdgcn_exp2f(p0[r] - m); p1[r] = __builtin_amdgcn_exp2f(p1[r] - m); rs += p0[r] + p1[r]; }
            l += rs;
            bf16x8 pw[4];
#pragma unroll
            for (int ks = 0; ks < 4; ++ks) { const f32x16& P = ks < 2 ? p0 : p1; const int bo = (ks & 1) * 8; typedef unsigned u4 __attribute__((ext_vector_type(4)));
                u4 t4 = {cvtpk(P[bo], P[bo + 1]), cvtpk(P[bo + 2], P[bo + 3]), cvtpk(P[bo + 4], P[bo + 5]), cvtpk(P[bo + 6], P[bo + 7])}; pw[ks] = __builtin_bit_cast(bf16x8, t4); }
            { s16x4 vl[8], vh[8];
#pragma unroll
              for (int i = 0; i < 8; ++i) { vl[i] = vtr(Vs + (i >> 2) * 4096 + (i & 3) * 1024); vh[i] = vtr(Vs + (i >> 2) * 4096 + (i & 3) * 1024 + 512); }
              __builtin_amdgcn_sched_barrier(0);
#pragma unroll
              for (int i = 0; i < 8; ++i) { const bf16x8 vf = {vl[i][0], vl[i][1], vl[i][2], vl[i][3], vh[i][0], vh[i][1], vh[i][2], vh[i][3]};
                  o[i >> 2] = __builtin_amdgcn_mfma_f32_32x32x16_bf16(vf, pw[i & 3], o[i >> 2], 0, 0, 0); } }
        }
        }
    }
    { auto rr = __builtin_amdgcn_permlane32_swap(__float_as_uint(l), __float_as_uint(l), false, false); l = __uint_as_float(rr[0]) + __uint_as_float(rr[1]); }
    const float il = 1.f / l; float ss = 0.f;
    bf16_t* op = mix + tq * DM + h * HD + 4 * hi;
#pragma unroll
    for (int d0 = 0; d0 < 2; ++d0)
#pragma unroll
        for (int g = 0; g < 4; ++g) { const float v0 = o[d0][4 * g] * il, v1 = o[d0][4 * g + 1] * il, v2 = o[d0][4 * g + 2] * il, v3 = o[d0][4 * g + 3] * il;
            ss += v0 * v0 + v1 * v1 + v2 * v2 + v3 * v3; *(uint2*)(op + 32 * d0 + 8 * g) = make_uint2(cvtpk(v0, v1), cvtpk(v2, v3)); }
    { auto rr = __builtin_amdgcn_permlane32_swap(__float_as_uint(ss), __float_as_uint(ss), false, false); ss = __uint_as_float(rr[0]) + __uint_as_float(rr[1]); }
    if (hi == 0) ssA[tq * 16 + h] = ss;
    asm volatile("s_waitcnt vmcnt(0) lgkmcnt(0)\n\ts_barrier" ::: "memory");
#undef ATT_DMA
#undef ATT_DMA1
#undef ATT_GLDS
}
}

__device__ __forceinline__ void conv_slab(const bf16_t* __restrict__ proj, const float* __restrict__ cw, bf16_t* __restrict__ mix, float* __restrict__ ssC2, int item, int lane) {
    const int slab = item & 1, t0 = (item >> 1) * 16, ch = slab * 512 + lane * 8;
    float w0[8], w1[8], w2[8];
#pragma unroll
    for (int q = 0; q < 2; ++q) { const float4 a = *(const float4*)(cw + ch + 4 * q), b = *(const float4*)(cw + DCONV + ch + 4 * q), c = *(const float4*)(cw + 2 * DCONV + ch + 4 * q);
        w0[4 * q] = a.x; w0[4 * q + 1] = a.y; w0[4 * q + 2] = a.z; w0[4 * q + 3] = a.w; w1[4 * q] = b.x; w1[4 * q + 1] = b.y; w1[4 * q + 2] = b.z; w1[4 * q + 3] = b.w;
        w2[4 * q] = c.x; w2[4 * q + 1] = c.y; w2[4 * q + 2] = c.z; w2[4 * q + 3] = c.w; }
    float z1[8], z2[8];
#pragma unroll
    for (int q = 0; q < 8; ++q) { z1[q] = 0.f; z2[q] = 0.f; }
    if ((t0 & (SEQ - 1)) != 0) {
        const bf16_t* p2 = proj + (size_t)(t0 - 2) * NPROJ; const bf16_t* p1 = proj + (size_t)(t0 - 1) * NPROJ;
        const uint4 c2 = *(const uint4*)(p2 + 4 * DATT + ch), u2 = *(const uint4*)(p2 + 5 * DATT + ch), c1 = *(const uint4*)(p1 + 4 * DATT + ch), u1 = *(const uint4*)(p1 + 5 * DATT + ch);
        const unsigned c2w[4] = {c2.x, c2.y, c2.z, c2.w}, u2w[4] = {u2.x, u2.y, u2.z, u2.w}, c1w[4] = {c1.x, c1.y, c1.z, c1.w}, u1w[4] = {u1.x, u1.y, u1.z, u1.w};
#pragma unroll
        for (int q = 0; q < 4; ++q) { z2[2 * q] = bf2f(c2w[q] & 0xffffu) * bf2f(u2w[q] & 0xffffu); z2[2 * q + 1] = bf2f(c2w[q] >> 16) * bf2f(u2w[q] >> 16);
            z1[2 * q] = bf2f(c1w[q] & 0xffffu) * bf2f(u1w[q] & 0xffffu); z1[2 * q + 1] = bf2f(c1w[q] >> 16) * bf2f(u1w[q] >> 16); }
    }
#pragma unroll 1
    for (int i0 = 0; i0 < 16; i0 += 8) {
    uint4 bv[8], cv[8], uv[8];
#pragma unroll
    for (int i = 0; i < 8; ++i) { const bf16_t* pr = proj + (size_t)(t0 + i0 + i) * NPROJ; bv[i] = *(const uint4*)(pr + 3 * DATT + ch); cv[i] = *(const uint4*)(pr + 4 * DATT + ch); uv[i] = *(const uint4*)(pr + 5 * DATT + ch); }
#pragma unroll
    for (int i = 0; i < 8; ++i) { const int t = t0 + i0 + i;
        const unsigned bw[4] = {bv[i].x, bv[i].y, bv[i].z, bv[i].w}, cw4[4] = {cv[i].x, cv[i].y, cv[i].z, cv[i].w}, uw[4] = {uv[i].x, uv[i].y, uv[i].z, uv[i].w};
        float y[8]; float ss = 0.f;
#pragma unroll
        for (int q = 0; q < 4; ++q) {
            const float za = bf2f(cw4[q] & 0xffffu) * bf2f(uw[q] & 0xffffu), zb = bf2f(cw4[q] >> 16) * bf2f(uw[q] >> 16);
            y[2 * q] = bf2f(bw[q] & 0xffffu) * (w0[2 * q] * z2[2 * q] + w1[2 * q] * z1[2 * q] + w2[2 * q] * za);
            y[2 * q + 1] = bf2f(bw[q] >> 16) * (w0[2 * q + 1] * z2[2 * q + 1] + w1[2 * q + 1] * z1[2 * q + 1] + w2[2 * q + 1] * zb);
            ss += y[2 * q] * y[2 * q] + y[2 * q + 1] * y[2 * q + 1];
            z2[2 * q] = z1[2 * q]; z1[2 * q] = za; z2[2 * q + 1] = z1[2 * q + 1]; z1[2 * q + 1] = zb; }
        *(uint4*)(mix + (size_t)t * DM + DATT + ch) = make_uint4(cvtpk2(y[0], y[1]), cvtpk2(y[2], y[3]), cvtpk2(y[4], y[5]), cvtpk2(y[6], y[7]));
        ss = wave_sum(ss);
        if (lane == 0) ssC2[t * 4 + slab] = ss; }
    }
}

namespace g8 {
typedef unsigned u32x4 __attribute__((ext_vector_type(4)));
typedef int v4i_t __attribute__((ext_vector_type(4)));
typedef int v8i_t __attribute__((ext_vector_type(8)));
constexpr int BM = 256, BK = 64, HALF = 128, HTB = HALF * BK * 2, STAGE_BYTES = 8 * HTB, NXCD = 8, WGM = 8;
__device__ __forceinline__ int lds_byte(int r, int c) { const int st = (r >> 4) * 2 + (c >> 5), rr = r & 15, cc = c & 31, ob = rr * 64 + cc * 2; return st * 1024 + (ob ^ (((ob >> 9) & 1) << 5)); }
__device__ __forceinline__ void stage_rc(int b, int& R, int& C) { const int st = b / 1024, sb = b % 1024, swz = sb ^ (((sb >> 9) & 1) << 5); R = (st >> 1) * 16 + swz / 64; C = (st & 1) * 32 + (swz % 64) / 2; }
__device__ __forceinline__ int perm32(int rho) { const int n = rho >> 4, i = rho & 15; return 8 * (i >> 2) + 4 * n + (i & 3); }
__device__ __forceinline__ unsigned cvt_pk_bf16(float lo, float hi) { unsigned r; asm volatile("v_cvt_pk_bf16_f32 %0, %1, %2" : "=v"(r) : "v"(lo), "v"(hi)); return r; }
__device__ __forceinline__ int xcd_remap(int wgid, int nwg) { const int q = nwg / NXCD, r = nwg % NXCD, xcd = wgid % NXCD, off = wgid / NXCD; return (xcd < r ? xcd * (q + 1) : r * (q + 1) + (xcd - r) * q) + off; }

struct Unit { int pm, pn, e, slot; const char* a; const char* b; };

struct DenseOrder {
    const char* A; const char* Bt; int K, nM, nN, nwg, G, c, mul = 1;
    __device__ __forceinline__ void init(const void* A_, const void* Bt_, int M, int N, int K_, int G_, int c_) { A = (const char*)A_; Bt = (const char*)Bt_; K = K_; nM = M / BM; nN = N / BM; nwg = nM * nN; G = G_; c = c_; }
    __device__ __forceinline__ bool next(int i, Unit& u) const {
        int L = i * G + c; if (L >= nwg * mul) return false; L %= nwg;
        const int wgid = xcd_remap(L, nwg);
        const int nig = WGM * nN, gid = wgid / nig, fm = gid * WGM, gsz = (nM - fm) < WGM ? (nM - fm) : WGM;
        u.pm = fm + ((wgid % nig) % gsz); u.pn = (wgid % nig) / gsz; u.e = i; u.slot = i % 3;
        u.a = A + (size_t)u.pm * BM * K * 2; u.b = Bt + (size_t)u.pn * BM * K * 2; return true;
    }
    __device__ __forceinline__ unsigned arow_off(const Unit&, int r, int Kb) const { return (unsigned)r * (unsigned)Kb; }
    const float* rowscale = nullptr; LAS float* rtab = nullptr;
    __device__ __forceinline__ void prefetch(const Unit& u) const { const int r = threadIdx.x; if (r < BM) rtab[u.slot * BM + r] = rowscale[u.pm * BM + r]; }
    __device__ __forceinline__ float scale_of(const Unit& u, int r) const { return rtab[u.slot * BM + r]; }
};
template <bool GATHER> struct MoeOrder {
    const char* A; const char* Bt; const int* list; LAS const int* pl; int K  , NPN, nwg, G, c; size_t estride; int mul;
    LAS int* rinfo; const float* rscale;
    __device__ __forceinline__ bool next(int i, Unit& u) const {
        int L = i * G + c; if (L >= nwg * mul) return false; L %= nwg;
        const int wgid = xcd_remap(L, nwg);
        u.pm = wgid / NPN; u.pn = wgid % NPN; u.e = pl[64 + u.pm]; u.slot = i % 3;
        u.a = GATHER ? A : A + (size_t)u.pm * BM * K; u.b = Bt + (size_t)u.e * estride + (size_t)u.pn * BM * K; return true;
    }
    __device__ __forceinline__ void prefetch(const Unit& u) const {
        const int r = threadIdx.x;
        if (r < BM) { const int slot = u.pm * BM + r - pl[32 + u.e]; int pr = -1; float sc = 0.f;
            if (slot < pl[u.e]) { pr = list[u.e * T + slot]; sc = rscale[GATHER ? (pr >> 1) : pr]; }
            rinfo[(u.slot * BM + r) * 2] = pr; rinfo[(u.slot * BM + r) * 2 + 1] = __float_as_int(sc); }
    }
    __device__ __forceinline__ int pair_of(const Unit& u, int r) const { return rinfo[(u.slot * BM + r) * 2]; }
    __device__ __forceinline__ float scale_of(const Unit& u, int r) const { return __int_as_float(rinfo[(u.slot * BM + r) * 2 + 1]); }
    __device__ __forceinline__ unsigned arow_off(const Unit& u, int r, int Kb) const {
        if (GATHER) { const int pr = pair_of(u, r); return (unsigned)(pr >= 0 ? (pr >> 1) : 0) * (unsigned)Kb; }
        return (unsigned)r * (unsigned)Kb;
    }
};

template <bool GATHER, int ES, class Epi, class Sched>
__device__ __forceinline__ void gemm_phase(LAS unsigned char* lds, const int K, const Sched& S, const Epi& E) {
    int tid_ = threadIdx.x; asm volatile("" : "+v"(tid_));
    const int tid = tid_, wid = __builtin_amdgcn_readfirstlane(tid >> 6), lane = tid & 63, wr = wid >> 2, wc = wid & 3, fr = lane & 15, fq = lane >> 4;
    const int Kb = K * ES, nt = Kb / (BK * 2);
    unsigned voffB[2];
#pragma unroll
    for (int i = 0; i < 2; ++i) { int R, C; stage_rc(tid * 16 + i * 8192, R, C); const int Rb = Epi::PERM ? ((R & ~31) + perm32(R & 31)) : R; voffB[i] = (unsigned)(Rb * Kb + C * 2); }
#define G8_AOFF(u, h, i) ([&]() { int R_, C_; stage_rc(tid * 16 + (i) * 8192, R_, C_); return S.arow_off(u, (h) * HALF + R_, Kb) + (unsigned)(C_ * 2); }())
    const size_t kstep = (size_t)(BK * 2);
    const size_t hstep = (size_t)HALF * Kb;
    const unsigned ldsw = (unsigned)wid * 1024u;
    const int aoff = lds_byte(wr * 64 + fr, fq * 8), boff = lds_byte(wc * 32 + fr, fq * 8);
#define G8_SA(b, h) (((b) * 2 + (h)) * HTB)
#define G8_SB(b, h) ((4 + (b) * 2 + (h)) * HTB)
#define G8_STAGE(bufoff, gbase, voff) do { _Pragma("unroll") for (int _i = 0; _i < 2; ++_i) \
        __builtin_amdgcn_global_load_lds((const unsigned*)((const char*)(gbase) + (voff)[_i]), (LAS unsigned*)(lds + (bufoff) + ldsw + _i * 8192), 16, 0, 0); } while (0)
#define G8_LDA(dst, b, h) do { _Pragma("unroll") for (int m = 0; m < 4; ++m) { if (ES == 2) { _Pragma("unroll") for (int k = 0; k < 2; ++k) dst[m][k] = *(const LAS bf16x8*)(lds + G8_SA(b, h) + aoff + m * 2048 + k * 1024); } \
        else dst##8[m] = __builtin_shufflevector(*(const LAS v4i_t*)(lds + G8_SA(b, h) + aoff + m * 2048), *(const LAS v4i_t*)(lds + G8_SA(b, h) + aoff + m * 2048 + 1024), 0, 1, 2, 3, 4, 5, 6, 7); } } while (0)
#define G8_LDB(dst, b, h) do { _Pragma("unroll") for (int n = 0; n < 2; ++n) { if (ES == 2) { _Pragma("unroll") for (int k = 0; k < 2; ++k) dst[n][k] = *(const LAS bf16x8*)(lds + G8_SB(b, h) + boff + n * 2048 + k * 1024); } \
        else dst##8[n] = __builtin_shufflevector(*(const LAS v4i_t*)(lds + G8_SB(b, h) + boff + n * 2048), *(const LAS v4i_t*)(lds + G8_SB(b, h) + boff + n * 2048 + 1024), 0, 1, 2, 3, 4, 5, 6, 7); } } while (0)
#define G8_CAT(x, y) __builtin_shufflevector(__builtin_bit_cast(v4i_t, x), __builtin_bit_cast(v4i_t, y), 0, 1, 2, 3, 4, 5, 6, 7)
#define G8_MMA(ai, bj, At, Bt) do { __builtin_amdgcn_s_setprio(1); _Pragma("unroll") for (int m = 0; m < 4; ++m) _Pragma("unroll") for (int n = 0; n < 2; ++n) { \
        if (ES == 2) { _Pragma("unroll") for (int k = 0; k < 2; ++k) acc[ai][bj][m][n] = __builtin_amdgcn_mfma_f32_16x16x32_bf16(Bt[n][k], At[m][k], acc[ai][bj][m][n], 0, 0, 0); } \
        else asm volatile("v_mfma_scale_f32_16x16x128_f8f6f4 %0, %1, %2, %0, %3, %3 op_sel_hi:[0,0,0]" : "+v"(acc[ai][bj][m][n]) : "v"(Bt##8[n]), "v"(At##8[m]), "v"(scale1)); } \
        __builtin_amdgcn_s_setprio(0); } while (0)
#define G8_WAIT_V(n) asm volatile("s_waitcnt vmcnt(" #n ")" ::: "memory")
#define G8_WAIT_L(n) asm volatile("s_waitcnt lgkmcnt(" #n ")" ::: "memory")
#define G8_BAR __builtin_amdgcn_s_barrier()
#define G8_SCHED __builtin_amdgcn_sched_barrier(0)
    Unit cur, nxt; int ui = 0;
    if (!S.next(0, cur)) return;
    if (GATHER || Epi::ROWINFO) { S.prefetch(cur); __syncthreads(); }
    f32x4 acc[2][2][4][2];
#pragma unroll
    for (int a = 0; a < 2; ++a)
#pragma unroll
        for (int b = 0; b < 2; ++b)
#pragma unroll
            for (int m = 0; m < 4; ++m)
#pragma unroll
                for (int n = 0; n < 2; ++n) acc[a][b][m][n] = (f32x4){0.f, 0.f, 0.f, 0.f};
    bf16x8 At[4][2], B0[2][2], B1[2][2];
    v8i_t At8[4], B08[2], B18[2];
    const int scale1 = 0x7F7F7F7F;
    unsigned vA[2][2];
#pragma unroll
    for (int h = 0; h < 2; ++h)
#pragma unroll
        for (int i = 0; i < 2; ++i) vA[h][i] = G8_AOFF(cur, h, i);
    const char* cA = cur.a; const char* cB = cur.b;
    G8_STAGE(G8_SB(0, 0), cB, voffB); G8_STAGE(G8_SB(0, 1), cB + hstep, voffB); G8_STAGE(G8_SA(0, 0), cA, vA[0]); G8_STAGE(G8_SA(0, 1), cA, vA[1]);
    if (wr == 1) G8_BAR;
    G8_WAIT_V(2); G8_BAR;
    G8_STAGE(G8_SB(1, 0), cB + kstep, voffB); G8_STAGE(G8_SA(1, 0), cA + kstep, vA[0]); G8_STAGE(G8_SB(1, 1), cB + hstep + kstep, voffB);
    G8_WAIT_V(6); G8_BAR;
    for (;;) {
        const bool has_next = S.next(ui + 1, nxt);
        const char* nA = has_next ? nxt.a : cA; const char* nB = has_next ? nxt.b : cB;
        if ((GATHER || Epi::ROWINFO) && has_next) S.prefetch(nxt);
        for (int t = 0; t < nt; t += 2) {
            const bool last = (t == nt - 2);
            if (Epi::MID_T >= 0 && t == Epi::MID_T) E.mid(acc, cur, wr, wc, fr, fq);
            const char* a1 = cA + (size_t)(t + 1) * kstep;
            const char* a2 = last ? nA : cA + (size_t)(t + 2) * kstep; const char* b2 = last ? nB : cB + (size_t)(t + 2) * kstep;
            const char* a3 = a2 + kstep; const char* b3 = b2 + kstep;
            unsigned v2[2][2];
#pragma unroll
            for (int h = 0; h < 2; ++h)
#pragma unroll
                for (int i = 0; i < 2; ++i) v2[h][i] = (GATHER && last && has_next) ? G8_AOFF(nxt, h, i) : vA[h][i];
            G8_LDB(B0, 0, 0); G8_LDB(B1, 0, 1); G8_SCHED; G8_LDA(At, 0, 0); G8_STAGE(G8_SA(1, 1), a1, vA[1]);
            G8_WAIT_V(8); G8_WAIT_L(0); G8_BAR; G8_MMA(0, 0, At, B0); G8_MMA(0, 1, At, B1); G8_BAR; G8_SCHED;
            G8_LDA(At, 0, 1); G8_STAGE(G8_SB(0, 0), b2, voffB); G8_STAGE(G8_SB(0, 1), b2 + hstep, voffB); G8_STAGE(G8_SA(0, 0), a2, v2[0]);
            G8_WAIT_V(8); G8_WAIT_L(0); G8_BAR; G8_MMA(1, 0, At, B0); G8_MMA(1, 1, At, B1); G8_BAR; G8_SCHED;
            G8_LDB(B0, 1, 0); G8_LDB(B1, 1, 1); G8_SCHED; G8_LDA(At, 1, 0); G8_STAGE(G8_SA(0, 1), a2, v2[1]);
            G8_WAIT_V(8); G8_WAIT_L(0); G8_BAR; G8_MMA(0, 0, At, B0); G8_MMA(0, 1, At, B1); G8_BAR; G8_SCHED;
            G8_LDA(At, 1, 1); G8_STAGE(G8_SB(1, 0), b3, voffB); G8_STAGE(G8_SB(1, 1), b3 + hstep, voffB); G8_STAGE(G8_SA(1, 0), a3, v2[0]);
            G8_WAIT_V(8); G8_WAIT_L(0); G8_BAR; G8_MMA(1, 0, At, B0); G8_MMA(1, 1, At, B1); G8_BAR; G8_SCHED;
        }
        if (wr == 0) G8_BAR;
        E(acc, cur, wr, wc, fr, fq);
        if (!has_next) break;
#pragma unroll
        for (int a = 0; a < 2; ++a)
#pragma unroll
            for (int b = 0; b < 2; ++b)
#pragma unroll
                for (int m = 0; m < 4; ++m)
#pragma unroll
                    for (int n = 0; n < 2; ++n) acc[a][b][m][n] = (f32x4){0.f, 0.f, 0.f, 0.f};
        cur = nxt; cA = nA; cB = nB; ++ui;
#pragma unroll
        for (int h = 0; h < 2; ++h)
#pragma unroll
            for (int i = 0; i < 2; ++i) if (GATHER) vA[h][i] = G8_AOFF(cur, h, i);
        if (wr == 1) G8_BAR;
    }
    G8_WAIT_V(0);
    G8_BAR;
#undef G8_SA
#undef G8_SB
#undef G8_STAGE
#undef G8_LDA
#undef G8_LDB
#undef G8_MMA
#undef G8_AOFF
#undef G8_CAT
#undef G8_WAIT_V
#undef G8_WAIT_L
#undef G8_BAR
#undef G8_SCHED
}

template <class Sched> struct EpiProjF { static constexpr bool PERM = true, ROWINFO = true; static constexpr int MID_T = -1; bf16_t* out; const Sched* S;
    __device__ __forceinline__ void mid(f32x4 (&)[2][2][4][2], const Unit&, int, int, int, int) const {}
    __device__ __forceinline__ void operator()(const f32x4 (&acc)[2][2][4][2], const Unit& u, int wr, int wc, int fr, int fq) const {
        const int row0 = u.pm * BM + wr * 64 + fr, col0 = u.pn * BM + wc * 32 + 8 * fq;
#pragma unroll
        for (int ai = 0; ai < 2; ++ai)
#pragma unroll
            for (int m = 0; m < 4; ++m) { const int row = row0 + ai * HALF + m * 16; const float s = S->scale_of(u, ai * HALF + wr * 64 + m * 16 + fr); bf16_t* rowp = out + (size_t)row * NPROJ + col0;
#pragma unroll
                for (int bj = 0; bj < 2; ++bj) { const f32x4 v0 = acc[ai][bj][m][0] * s, v1 = acc[ai][bj][m][1] * s; u32x4 w; w.x = cvt_pk_bf16(v0[0], v0[1]); w.y = cvt_pk_bf16(v0[2], v0[3]); w.z = cvt_pk_bf16(v1[0], v1[1]); w.w = cvt_pk_bf16(v1[2], v1[3]);
                    *(u32x4*)(rowp + bj * HALF) = w; } }
    }
};
struct EpiG2F { static constexpr bool PERM = true, ROWINFO = false; static constexpr int MID_T = DATT / BK; bf16_t* out; LAS const float* tab;
    __device__ __forceinline__ void mid(f32x4 (&acc)[2][2][4][2], const Unit& u, int wr, int wc, int fr, int fq) const {
        LAS const float* tb = tab + (size_t)(u.e) * 512;
#pragma unroll
        for (int ai = 0; ai < 2; ++ai)
#pragma unroll
            for (int m = 0; m < 4; ++m) { const float s = tb[(ai * HALF + wr * 64 + m * 16 + fr) * 2];
#pragma unroll
                for (int bj = 0; bj < 2; ++bj)
#pragma unroll
                    for (int n = 0; n < 2; ++n) acc[ai][bj][m][n] *= s; }
    }
    __device__ __forceinline__ void operator()(const f32x4 (&acc)[2][2][4][2], const Unit& u, int wr, int wc, int fr, int fq) const {
        LAS const float* tb = tab + (size_t)(u.e) * 512;
        const int col0 = u.pn * BM + wc * 32 + 8 * fq;
#pragma unroll
        for (int ai = 0; ai < 2; ++ai)
#pragma unroll
            for (int m = 0; m < 4; ++m) { const int r = ai * HALF + wr * 64 + m * 16 + fr; const float s = tb[r * 2 + 1]; bf16_t* rowp = out + (size_t)(u.pm * BM + r) * DM + col0;
#pragma unroll
                for (int bj = 0; bj < 2; ++bj) { const f32x4 v0 = acc[ai][bj][m][0] * s, v1 = acc[ai][bj][m][1] * s; u32x4 w; w.x = cvt_pk_bf16(v0[0], v0[1]); w.y = cvt_pk_bf16(v0[2], v0[3]); w.z = cvt_pk_bf16(v1[0], v1[1]); w.w = cvt_pk_bf16(v1[2], v1[3]);
                    *(u32x4*)(rowp + bj * HALF) = w; } }
    }
};
struct EpiG2X { static constexpr bool PERM = true, ROWINFO = false; static constexpr int MID_T = DATT / BK; bf16_t* out; unsigned char* xf8; const float* g2; LAS const float* tab;
    __device__ __forceinline__ void mid(f32x4 (&acc)[2][2][4][2], const Unit& u, int wr, int wc, int fr, int fq) const {
        LAS const float* tb = tab + (size_t)(u.e) * 512;
#pragma unroll
        for (int ai = 0; ai < 2; ++ai)
#pragma unroll
            for (int m = 0; m < 4; ++m) { const float s = tb[(ai * HALF + wr * 64 + m * 16 + fr) * 2];
#pragma unroll
                for (int bj = 0; bj < 2; ++bj)
#pragma unroll
                    for (int n = 0; n < 2; ++n) acc[ai][bj][m][n] *= s; }
    }
    __device__ __forceinline__ void operator()(const f32x4 (&acc)[2][2][4][2], const Unit& u, int wr, int wc, int fr, int fq) const {
        LAS const float* tb = tab + (size_t)(u.e) * 512;
        const int col0 = u.pn * BM + wc * 32 + 8 * fq;
        f32x4 gv[2][2];
#pragma unroll
        for (int bj = 0; bj < 2; ++bj) { gv[bj][0] = *(const f32x4*)(g2 + col0 + bj * HALF); gv[bj][1] = *(const f32x4*)(g2 + col0 + bj * HALF + 4); }
#pragma unroll
        for (int ai = 0; ai < 2; ++ai) {
            u32x4 xv[2][4][2];
#pragma unroll
            for (int m = 0; m < 4; ++m) { const bf16_t* xp = out + (size_t)(u.pm * BM + ai * HALF + wr * 64 + m * 16 + fr) * DM + col0;
#pragma unroll
                for (int bj = 0; bj < 2; ++bj) xv[ai][m][bj] = *(const u32x4*)(xp + bj * HALF); }
#pragma unroll
            for (int m = 0; m < 4; ++m) { const int r = ai * HALF + wr * 64 + m * 16 + fr; const float s = tb[r * 2 + 1]; bf16_t* rowp = out + (size_t)(u.pm * BM + r) * DM + col0;
#pragma unroll
                for (int bj = 0; bj < 2; ++bj) { const u32x4 xw = xv[ai][m][bj];
                    const f32x4 x0 = {__uint_as_float(xw.x << 16), __uint_as_float(xw.x & 0xffff0000u), __uint_as_float(xw.y << 16), __uint_as_float(xw.y & 0xffff0000u)};
                    const f32x4 x1 = {__uint_as_float(xw.z << 16), __uint_as_float(xw.z & 0xffff0000u), __uint_as_float(xw.w << 16), __uint_as_float(xw.w & 0xffff0000u)};
                    const f32x4 v0 = acc[ai][bj][m][0] * s + x0, v1 = acc[ai][bj][m][1] * s + x1; u32x4 w; w.x = cvt_pk_bf16(v0[0], v0[1]); w.y = cvt_pk_bf16(v0[2], v0[3]); w.z = cvt_pk_bf16(v1[0], v1[1]); w.w = cvt_pk_bf16(v1[2], v1[3]);
                    *(u32x4*)(rowp + bj * HALF) = w;
                    const f32x4 y0 = v0 * gv[bj][0], y1 = v1 * gv[bj][1];
                    int f0 = __builtin_amdgcn_cvt_pk_fp8_f32(y0[0], y0[1], 0, false); f0 = __builtin_amdgcn_cvt_pk_fp8_f32(y0[2], y0[3], f0, true);
                    int f1 = __builtin_amdgcn_cvt_pk_fp8_f32(y1[0], y1[1], 0, false); f1 = __builtin_amdgcn_cvt_pk_fp8_f32(y1[2], y1[3], f1, true);
                    *(uint2*)(xf8 + (size_t)(u.pm * BM + r) * DM + col0 + bj * HALF) = make_uint2((unsigned)f0, (unsigned)f1); } }
            __builtin_amdgcn_sched_barrier(0);
        }
    }
};
template <class Sched> struct EpiGUF { static constexpr bool PERM = true, ROWINFO = true; static constexpr int MID_T = -1; bf16_t* Hb; const Sched* S;
    __device__ __forceinline__ void mid(f32x4 (&)[2][2][4][2], const Unit&, int, int, int, int) const {}
    __device__ __forceinline__ void operator()(const f32x4 (&acc)[2][2][4][2], const Unit& u, int wr, int wc, int fr, int fq) const {
        const int col0 = u.pn * HALF + wc * 32 + 8 * fq;
#pragma unroll
        for (int ai = 0; ai < 2; ++ai)
#pragma unroll
            for (int m = 0; m < 4; ++m) { const int r = ai * HALF + wr * 64 + m * 16 + fr; const float s = S->scale_of(u, r) * (1.f / WSCALE8);
                float h[8];
#pragma unroll
                for (int n = 0; n < 2; ++n)
#pragma unroll
                    for (int q = 0; q < 4; ++q) { const float gg = acc[ai][0][m][n][q] * s, uu = acc[ai][1][m][n][q] * s; h[4 * n + q] = gg * __builtin_amdgcn_rcpf(1.f + __expf(-gg)) * uu; }
                int w0 = __builtin_amdgcn_cvt_pk_fp8_f32(h[0] * HSCALE8, h[1] * HSCALE8, 0, false); w0 = __builtin_amdgcn_cvt_pk_fp8_f32(h[2] * HSCALE8, h[3] * HSCALE8, w0, true);
                int w1 = __builtin_amdgcn_cvt_pk_fp8_f32(h[4] * HSCALE8, h[5] * HSCALE8, 0, false); w1 = __builtin_amdgcn_cvt_pk_fp8_f32(h[6] * HSCALE8, h[7] * HSCALE8, w1, true);
                *(uint2*)((unsigned char*)Hb + (size_t)(u.pm * BM + r) * DEXP + col0) = make_uint2((unsigned)w0, (unsigned)w1); }
    }
};
template <class Sched> struct EpiDownF { static constexpr bool PERM = true, ROWINFO = true; static constexpr int MID_T = -1; unsigned char* Y; const Sched* S;
    __device__ __forceinline__ void mid(f32x4 (&)[2][2][4][2], const Unit&, int, int, int, int) const {}
    __device__ __forceinline__ void operator()(const f32x4 (&acc)[2][2][4][2], const Unit& u, int wr, int wc, int fr, int fq) const {
        const int col0 = u.pn * BM + wc * 32 + 8 * fq;
#pragma unroll
        for (int ai = 0; ai < 2; ++ai)
#pragma unroll
            for (int m = 0; m < 4; ++m) { const int r = ai * HALF + wr * 64 + m * 16 + fr; const int pr = S->pair_of(u, r); if (pr < 0) continue; const float s = S->scale_of(u, r) * (YSCALE8 / (HSCALE8 * WDSCALE8)); unsigned char* rowp = Y + (size_t)pr * DM + col0;
#pragma unroll
                for (int bj = 0; bj < 2; ++bj) { const f32x4 v0 = acc[ai][bj][m][0] * s, v1 = acc[ai][bj][m][1] * s;
                    int w0 = __builtin_amdgcn_cvt_pk_fp8_f32(v0[0], v0[1], 0, false); w0 = __builtin_amdgcn_cvt_pk_fp8_f32(v0[2], v0[3], w0, true);
                    int w1 = __builtin_amdgcn_cvt_pk_fp8_f32(v1[0], v1[1], 0, false); w1 = __builtin_amdgcn_cvt_pk_fp8_f32(v1[2], v1[3], w1, true);
                    *(uint2*)(rowp + bj * HALF) = make_uint2((unsigned)w0, (unsigned)w1); } }
    }
};
}


#define XB_TMO      128
#define XB_XCNT(j)  (256  + 64 * (j))
#define XB_XSUB(j)  (1280 + 64 * (j))
#define XB_XGEN(j)  (2304 + 64 * (j))
#define XB_TOP      3328
#define XB_TOPGEN   3392
#define XCD_BAR_WORDS 3456
#define XB_SPIN_CAP (1u << 20)
__device__ __forceinline__ unsigned xb_ld(unsigned* p)              { return __hip_atomic_load(p, __ATOMIC_RELAXED, __HIP_MEMORY_SCOPE_AGENT); }
__device__ __forceinline__ unsigned xb_add(unsigned* p, unsigned v) { return __hip_atomic_fetch_add(p, v, __ATOMIC_RELAXED, __HIP_MEMORY_SCOPE_AGENT); }
__device__ __forceinline__ unsigned xb_xcc_id() { return (unsigned)__builtin_amdgcn_s_getreg((3 << 11) | 20) & 0xFu; }
#define XB_SPIN(cond, bar) do { unsigned _sp = 0; while (cond) { __builtin_amdgcn_s_sleep(1); \
    if ((++_sp & 255u) == 0u) { if (xb_ld(&(bar)[XB_TMO])) break; if (_sp > XB_SPIN_CAP) { atomicAdd(&(bar)[XB_TMO], 1u); break; } } } } while (0)
struct XcdBarrier { unsigned* bar; unsigned x; volatile LAS unsigned* st; };
__device__ __forceinline__ XcdBarrier xcd_barrier_post(unsigned* bar, volatile LAS unsigned* st) {
    XcdBarrier b; b.bar = bar; b.x = xb_xcc_id(); b.st = st;
    if (threadIdx.x == 0) (void)xb_add(&bar[XB_XCNT(b.x)], 1u);
    return b;
}
__device__ __forceinline__ void xcd_barrier_complete(unsigned* bar, unsigned x, unsigned& nloc, unsigned& nx) {
    const unsigned G = gridDim.x * gridDim.y * gridDim.z;
    unsigned sum, cnt, mine, sp = 0u;
    for (;;) {
        sum = 0u; cnt = 0u; mine = 0u;
#pragma unroll
        for (unsigned j = 0; j < 16; ++j) { const unsigned c = xb_ld(&bar[XB_XCNT(j)]); sum += c; cnt += (c > 0u) ? 1u : 0u; mine = (j == x) ? c : mine; }
        if (sum == G) break;
        __builtin_amdgcn_s_sleep(1);
        if ((++sp & 255u) == 0u) { if (xb_ld(&bar[XB_TMO])) break; if (sp > XB_SPIN_CAP) { atomicAdd(&bar[XB_TMO], 1u); break; } }
    }
    nloc = mine > 0u ? mine : 1u; nx = cnt > 0u ? cnt : 1u;
}
__device__ __forceinline__ void xcd_barrier(const XcdBarrier& b) {
    asm volatile("s_waitcnt vmcnt(0)" ::: "memory");
    __syncthreads();
    if (threadIdx.x == 0) {
        unsigned* bar = b.bar;
        __builtin_amdgcn_s_waitcnt(0);
        unsigned nloc = b.st[0], nx = b.st[1];
        if (nloc == 0u) { xcd_barrier_complete(bar, b.x, nloc, nx); b.st[0] = nloc; b.st[1] = nx; }
        const unsigned old = xb_add(&bar[XB_XSUB(b.x)], 1u);
        const unsigned gen = old / nloc;
        if (old + 1u == (gen + 1u) * nloc) {
            __builtin_amdgcn_fence(__ATOMIC_RELEASE, "agent");
            asm volatile("s_waitcnt vmcnt(0)" ::: "memory");
            const unsigned og = xb_add(&bar[XB_TOP], 1u);
            const unsigned tg = og / nx;
            if (og + 1u == (tg + 1u) * nx) xb_add(&bar[XB_TOPGEN], 1u);
            else XB_SPIN(xb_ld(&bar[XB_TOPGEN]) == tg, bar);
            __builtin_amdgcn_fence(__ATOMIC_ACQUIRE, "agent");
            xb_add(&bar[XB_XGEN(b.x)], 1u);
            asm volatile("s_waitcnt vmcnt(0)" ::: "memory");
        } else {
            XB_SPIN(xb_ld(&bar[XB_XGEN(b.x)]) == gen, bar);
            __builtin_amdgcn_fence(__ATOMIC_ACQUIRE, "agent");
            asm volatile("s_waitcnt vmcnt(0)" ::: "memory");
        }
    }
    __syncthreads();
}

__global__ void __launch_bounds__(NTHREADS, 2) mega(Params p) {
    extern __shared__ __attribute__((aligned(16))) unsigned char lds[];
    volatile LAS unsigned* bst = (volatile LAS unsigned*)(lds + LDS_PLAN_OFF + 1024);
    if (threadIdx.x < 2) bst[threadIdx.x] = 0u;
    __syncthreads();
    const XcdBarrier gbar = xcd_barrier_post((unsigned*)(p.ws + WS_BAR), bst);
    unsigned long long ts0 = 0, ts1 = 0;
    if (p.never) cg::this_grid().sync();
    Ctx c; c.tid = threadIdx.x; c.lane = c.tid & 63; c.wave = __builtin_amdgcn_readfirstlane(c.tid >> 6); c.gw = blockIdx.x * NWAVES + c.wave; c.ngw = gridDim.x * NWAVES;
    char* ws = p.ws;
    int* cnt = (int*)(ws + WS_CTL);
    float* r1 = (float*)(ws + WS_R1); float* r2 = (float*)(ws + WS_R2); float* ssC = (float*)(ws + WS_SSC);
    float* wts = (float*)(ws + WS_WTS); bf16_t* Wrh = (bf16_t*)(ws + WS_WR); float* ssA = (float*)(ws + WS_SSA); int* list = (int*)(ws + WS_LIST);
    bf16_t* W2t = (bf16_t*)(ws + WS_W2T); bf16_t* W1t = (bf16_t*)(ws + WS_W1T); bf16_t* Wdt = (bf16_t*)(ws + WS_WDT); bf16_t* Wgut = (bf16_t*)(ws + WS_WGUT);
    bf16_t* xb = (bf16_t*)(ws + WS_XB); bf16_t* mix = (bf16_t*)(ws + WS_MIX); bf16_t* proj = (bf16_t*)(ws + WS_PROJ); bf16_t* Y = (bf16_t*)(ws + WS_Y); bf16_t* Hb = (bf16_t*)(ws + WS_H);
    unsigned char* xf8 = (unsigned char*)(ws + WS_WGUT + 64 * MiB);
    bf16_t* dlt = (bf16_t*)(ws + WS_PROJ);

    TS0(1) TS0(8)
    {
        for (int row = c.gw; row < T * PMUL(10); row += 2 * c.ngw) {
            const int ra = row % T, rb = (row + c.ngw) % T; const bool hb = row + c.ngw < T * PMUL(10);
            const float4* xa = (const float4*)(p.x + (size_t)ra * DM); const float4* xc = (const float4*)(p.x + (size_t)rb * DM);
            float4 va[8], vb[8];
#pragma unroll
            for (int j = 0; j < 8; ++j) { va[j] = xa[j * 64 + c.lane]; if (hb) vb[j] = xc[j * 64 + c.lane]; }
            float sa = 0.f, sb = 0.f; uint2* oa = (uint2*)(xb + (size_t)ra * DM); uint2* ob = (uint2*)(xb + (size_t)rb * DM);
#pragma unroll
            for (int j = 0; j < 8; ++j) { sa += va[j].x * va[j].x + va[j].y * va[j].y + va[j].z * va[j].z + va[j].w * va[j].w; oa[j * 64 + c.lane] = make_uint2(cvtpk2(va[j].x, va[j].y), cvtpk2(va[j].z, va[j].w)); }
            if (hb) {
#pragma unroll
                for (int j = 0; j < 8; ++j) { sb += vb[j].x * vb[j].x + vb[j].y * vb[j].y + vb[j].z * vb[j].z + vb[j].w * vb[j].w; ob[j * 64 + c.lane] = make_uint2(cvtpk2(vb[j].x, vb[j].y), cvtpk2(vb[j].z, vb[j].w)); } }
            sa = wave_sum(sa); sb = wave_sum(sb);
            if (c.lane == 0) { r1[ra] = rsqrtf(sa * (1.f / DM) + EPS); if (hb) r1[rb] = rsqrtf(sb * (1.f / DM) + EPS); }
        }
        LAS float* scr = (LAS float*)lds + c.wave * (64 * 65);
        constexpr int I_IN = (DM / 64) * (NPROJ / 64), I_OUT = (DM / 64) * (DM / 64);
        constexpr int NIT = I_IN + I_OUT;
        for (int it = c.gw; it < NIT * PMUL(10); it += c.ngw) {
            int r = it % NIT;
            if (r < I_IN) { const int nb = NPROJ / 64, kb = r / nb, n0 = (r % nb) * 64; p0_titem(p.w_in, NPROJ, p.norm1, W1t, DM, kb * 64, n0, n0, scr, c.lane, n0 < DATT ? QSCALE : 1.f); continue; } r -= I_IN;
            { const int nb = DM / 64, kb = r / nb, n0 = (r % nb) * 64, k0 = kb * 64;
                const float* g = k0 < DATT ? p.g_oa + k0 : p.g_oc + (k0 - DATT);
                p0_titem(p.w_out + (size_t)k0 * DM, DM, g, W2t + k0, DM, 0, n0, n0, scr, c.lane); }
        }
        for (int i = blockIdx.x * NTHREADS + c.tid; i < 48 * DM; i += gridDim.x * NTHREADS) { const int o = i / DM, k = i % DM; const float w = o < 36 ? (o < 4 ? p.w_rg[k * 4 + o] : p.w_re[k * 32 + (o - 4)]) : 0.f;
            Wrh[i] = (bf16_t)f2bf(w * p.norm2[k]); }
    }
    xcd_barrier(gbar);
    TS1(1) TS0(2)
    {
        g8::DenseOrder S; S.init(xb, W1t, T, NPROJ, DM, (int)gridDim.x, (int)blockIdx.x); S.mul = PMUL(1);
        S.rowscale = r1; S.rtab = (LAS float*)(lds + 131072);
        const g8::EpiProjF<g8::DenseOrder> E{proj, &S};
        g8::gemm_phase<false, 2>((LAS unsigned char*)lds, DM, S, E);
    }
    xcd_barrier(gbar);
    TS1(2) TS0(3)
    {
        struct Side { WConv wc; unsigned long long twait; int s, gw, ngw, nper, lane; LAS float* scr; unsigned scr32; const float *wg, *wu, *wd; bf16_t* Wgut; bf16_t* Wdt;
            __device__ __forceinline__ void step() { if (wc.pending) wc.finish(scr, lane);
                if (s < nper) { const int id = gw + ngw * s; ++s; if (id < WC_GU) wc.issue(id, wg, wu, wd, Wgut, Wdt, scr32, lane); } }
            __device__ __forceinline__ void whole() { step(); asm volatile("s_waitcnt vmcnt(0)" ::: "memory"); } };
        Side side; side.twait = 0; side.wc.pending = false; side.s = 0; side.gw = c.gw; side.ngw = c.ngw; side.nper = (WC_GU + c.ngw - 1) / c.ngw; side.lane = c.lane;
        side.scr = (LAS float*)(lds + 69632) + c.wave * (64 * 32); side.scr32 = (unsigned)(__UINTPTR_TYPE__)((LAS unsigned char*)lds + 69632) + c.wave * 8192;
        side.wg = p.w_gate; side.wu = p.w_up; side.wd = p.w_down; side.Wgut = Wgut; side.Wdt = Wdt;
        const int vblk = (gridDim.x & 7) == 0 ? (int)((blockIdx.x & 7) * (gridDim.x >> 3) + (blockIdx.x >> 3)) : (int)blockIdx.x;
        for (int u1 = vblk; u1 < NB * NH * 4 * PMUL(2); u1 += gridDim.x) { const int u0 = u1 % (NB * NH * 4); const int bh = u0 >> 2;
            for (int i = 0; i < 4; ++i) att::attn_unit((LAS unsigned char*)lds, proj, p.relb, mix, ssA, bh >> 4, bh & 15, (u0 & 3) + 4 * i, side, i == 0); }
        if (TSPROBE == 34 || TSPROBE == 35) { ts0 = 0; ts1 = side.twait; }
        while (side.wc.pending || side.s < side.nper) side.whole();
        for (int it = c.gw; it < (T / 16) * 2 * PMUL(21); it += c.ngw) conv_slab(proj, p.conv_w, mix, ssC, it % ((T / 16) * 2), c.lane);
    }
    xcd_barrier(gbar);
    TS1(3) TS0(4)
    {
        g8::DenseOrder S; S.init(mix, W2t, T, DM, DM, (int)gridDim.x, (int)blockIdx.x); S.mul = PMUL(3);
        LAS float* tab = (LAS float*)(lds + 131072);
        g8::Unit u;
        for (int i = 0; i < 4; ++i) if (S.next(i, u) && c.tid < 256) { const int row = u.pm * 256 + c.tid; float sa = 0.f;
#pragma unroll
            for (int h = 0; h < 16; ++h) sa += ssA[row * 16 + h];
            const float4 sc4 = *(const float4*)(ssC + row * 4); const float ra = rsqrtf(sa * (1.f / DATT) + EPS), rc = rsqrtf((sc4.x + sc4.y) * (1.f / DCONV) + EPS);
            tab[(i * 256 + c.tid) * 2] = ra / rc; tab[(i * 256 + c.tid) * 2 + 1] = rc; }
        __syncthreads();
        const g8::EpiG2X E{xb, xf8, p.norm2, tab};
        g8::gemm_phase<false, 2>((LAS unsigned char*)lds, DM, S, E);
    }
    xcd_barrier(gbar);
    TS1(4) TS0(5)
    for (int it = blockIdx.x; it < (T / 64) * PMUL(4); it += gridDim.x) router_block(xb, Wrh, p.b_rg, p.b_re, cnt, list, wts, r2, it % (T / 64), c.wave, c.lane, (LAS float*)lds, it < T / 64);
    xcd_barrier(gbar);
    TS1(5) TS0(6)
    LAS int* pl = (LAS int*)(lds + LDS_PLAN_OFF);
    if (c.tid < 64) {
        const int ce = c.tid < NE ? cnt[c.tid * 64] : 0, mt = (ce + 255) >> 8;
        int inc = mt;
#pragma unroll
        for (int o = 1; o < 32; o <<= 1) { const int v = __shfl_up(inc, o); if (c.lane >= o) inc += v; }
        if (c.tid < NE) { pl[c.tid] = ce; pl[32 + c.tid] = (inc - mt) * 256; }
        if (c.tid == NE - 1) pl[224] = inc;
    }
    __syncthreads();
    if (c.tid < NTILEMAX) { int e = -1;
        for (int q = 0; q < NE; ++q) { const int st = pl[32 + q] >> 8, mt = (pl[q] + 255) >> 8; if (c.tid >= st && c.tid < st + mt) e = q; }
        pl[64 + c.tid] = e; }
    __syncthreads();
    const int ntile = pl[224];
    {
        const g8::MoeOrder<true> S{(const char*)xf8, (const char*)Wgut, list, pl, DM  , 4, ntile * 4, (int)gridDim.x, (int)blockIdx.x, (size_t)2 * DEXP * DM, PMUL(5), (LAS int*)(lds + 131072), r2};
        const g8::EpiGUF<g8::MoeOrder<true>> E{Hb, &S};
        g8::gemm_phase<true, 1>((LAS unsigned char*)lds, DM, S, E);
    }
    {
        const int U = ntile * 4, G = (int)gridDim.x, nmax = (U + G - 1) / G; int nidle = nmax * G - U, first = G - nidle; if (nidle == 0) { nidle = G; first = 0; }
        if ((int)blockIdx.x >= first) {
            WConv wa, wb; wa.pending = false; wb.pending = false;
            LAS float* s0 = (LAS float*)lds + c.wave * 4096; LAS float* s1 = s0 + 2048;
            const unsigned s0_32 = (unsigned)(__UINTPTR_TYPE__)((LAS unsigned char*)lds) + c.wave * 16384, s1_32 = s0_32 + 8192;
            const int stride = nidle * NWAVES, nd = (WC_ITEMS - WC_GU) * PMUL(7);
            int it = ((int)blockIdx.x - first) * NWAVES + c.wave;
            if (it < nd) wa.issue(WC_GU + it % (WC_ITEMS - WC_GU), p.w_gate, p.w_up, p.w_down, Wgut, Wdt, s0_32, c.lane);
            for (; it < nd; it += 2 * stride) {
                const bool hb = it + stride < nd, ha = it + 2 * stride < nd;
                if (hb) { wb.issue(WC_GU + (it + stride) % (WC_ITEMS - WC_GU), p.w_gate, p.w_up, p.w_down, Wgut, Wdt, s1_32, c.lane); asm volatile("s_waitcnt vmcnt(8)" ::: "memory"); }
                else asm volatile("s_waitcnt vmcnt(0)" ::: "memory");
                wa.finish(s0, c.lane);
                if (ha) { wa.issue(WC_GU + (it + 2 * stride) % (WC_ITEMS - WC_GU), p.w_gate, p.w_up, p.w_down, Wgut, Wdt, s0_32, c.lane); asm volatile("s_waitcnt vmcnt(8)" ::: "memory"); }
                else asm volatile("s_waitcnt vmcnt(0)" ::: "memory");
                if (hb) wb.finish(s1, c.lane);
            }
        }
    }
    xcd_barrier(gbar);
    TS1(6) TS0(7)
    {
        const g8::MoeOrder<false> S{(const char*)Hb, (const char*)Wdt, list, pl, DEXP  , 8, ntile * 8, (int)gridDim.x, (int)blockIdx.x, (size_t)DM * DEXP, PMUL(6), (LAS int*)(lds + 131072), wts};
        const g8::EpiDownF<g8::MoeOrder<false>> E{(unsigned char*)Y, &S};
        g8::gemm_phase<false, 1>((LAS unsigned char*)lds, DEXP, S, E);
    }
    xcd_barrier(gbar);
    TS1(7) TS1(8)
    if (PROBE == 9) { for (int i = 0; i < 8; ++i) xcd_barrier(gbar); }
    const float tsdelta = TSPROBE ? sqrtf((float)(ts1 - ts0) * 0.01f) * 1e-3f : 0.f;
    {
        const unsigned long long tp6 = (TSPROBE == 9) ? __builtin_amdgcn_s_memrealtime() : 0ull;
        FinalRow fa, fb;
        int t = c.gw;
        if (t < T) final_load(fa, xb, Y, t, c.lane);
        for (; t < T; t += 2 * c.ngw) {
            const int t2 = t + c.ngw, t3 = t + 2 * c.ngw;
            if (t2 < T) final_load(fb, xb, Y, t2, c.lane);
            final_store(fa, p.out, p.norm_f, t, c.lane, (TSPROBE == 9) ? sqrtf((float)(__builtin_amdgcn_s_memrealtime() - tp6) * 0.01f) * 1e-3f : tsdelta);
            if (t3 < T) final_load(fa, xb, Y, t3, c.lane);
            if (t2 < T) final_store(fb, p.out, p.norm_f, t2, c.lane, (TSPROBE == 9) ? sqrtf((float)(__builtin_amdgcn_s_memrealtime() - tp6) * 0.01f) * 1e-3f : tsdelta);
        }
    }
}

extern "C" void kernel_launch(void* const* d_in, const int* in_sizes, int n_in, void* d_out, int out_size, void* d_ws, size_t ws_size, hipStream_t stream) {
    static int grid = 0;
    if (grid == 0) {
        int dev = 0, cus = 0, per_cu = 0;
        if (ws_size < WS_END || n_in != 17) { fprintf(stderr, "kernel_launch: unexpected sizes (ws %zu)\n", ws_size); grid = -1; return; }
        (void)hipGetDevice(&dev); (void)hipDeviceGetAttribute(&cus, hipDeviceAttributeMultiprocessorCount, dev);
        if (hipFuncSetAttribute((const void*)mega, hipFuncAttributeMaxDynamicSharedMemorySize, LDS_BYTES) != hipSuccess) { fprintf(stderr, "hipFuncSetAttribute failed\n"); grid = -1; return; }
        if (hipOccupancyMaxActiveBlocksPerMultiprocessor(&per_cu, (const void*)mega, NTHREADS, LDS_BYTES) != hipSuccess || per_cu < 1) { fprintf(stderr, "occupancy query failed (%d)\n", per_cu); grid = -1; return; }
        grid = cus * per_cu;
        fprintf(stderr, "kernel_launch: cus %d per_cu %d grid %d\n", cus, per_cu, grid);
    }
    if (grid < 0) return;
    if (hipMemsetAsync((char*)d_ws + WS_CTL, 0, 64 * 1024, stream) != hipSuccess) { fprintf(stderr, "memset failed\n"); return; }
    Params p{};
    p.x = (const float*)d_in[0]; p.norm1 = (const float*)d_in[1]; p.w_in = (const float*)d_in[2]; p.relb = (const float*)d_in[3];
    p.conv_w = (const float*)d_in[4]; p.g_oa = (const float*)d_in[5]; p.g_oc = (const float*)d_in[6]; p.w_out = (const float*)d_in[7];
    p.norm2 = (const float*)d_in[8]; p.w_rg = (const float*)d_in[9]; p.b_rg = (const float*)d_in[10]; p.w_re = (const float*)d_in[11];
    p.b_re = (const float*)d_in[12]; p.w_gate = (const float*)d_in[13]; p.w_up = (const float*)d_in[14]; p.w_down = (const float*)d_in[15];
    p.norm_f = (const float*)d_in[16]; p.out = (float*)d_out; p.ws = (char*)d_ws;
    void* args[] = {&p};
    hipError_t e = hipLaunchCooperativeKernel((const void*)mega, dim3(grid), dim3(NTHREADS), args, LDS_BYTES, stream);
    if (e != hipSuccess) fprintf(stderr, "cooperative launch failed: %s (grid %d)\n", hipGetErrorString(e), grid);
}
```
